# Optimizing an MI355X kernel written in HIP

```python
import math
import jax, jax.numpy as jnp
from jax import lax
import numpy as np

D_MODEL = 1024
BATCH = 4
SEQ = 8192
DEPTH = 2

GDN_HEADS = 4
GDN_DK = 64
GDN_DV = 64
GDN_QK_W = GDN_HEADS * GDN_DK
GDN_V_W = GDN_HEADS * GDN_DV
GDN_QKV_W = 2 * GDN_QK_W + GDN_V_W
GDN_CONV = 4
GDN_CHUNK = 64
S5_WIDTH = 256
S5_GROUP_CH = 16
S5_GROUPS = S5_WIDTH // S5_GROUP_CH
S5_STATE = 64
DIFF_HEADS = 4
DIFF_DQK = 64
DIFF_DV = 2 * DIFF_DQK
DIFF_QK_W = DIFF_HEADS * 2 * DIFF_DQK
DIFF_V_W = DIFF_HEADS * DIFF_DV
Q_BLOCK = 128
MIX_WIDTH = GDN_V_W + S5_WIDTH + DIFF_V_W
IN_SIZES = (GDN_QKV_W, GDN_V_W, GDN_HEADS, GDN_HEADS, S5_WIDTH, DIFF_QK_W, DIFF_QK_W, DIFF_V_W)
IN_WIDTH = sum(IN_SIZES)
PEER_HEADS = 8
PEER_DQ = 128
PEER_DHALF = PEER_DQ // 2
N_KEYS = 128
N_EXPERTS = N_KEYS * N_KEYS
PEER_TOPK = 16
PEER_BLOCK = 128
NORM_EPS = 1e-6

kernel_name = "hybrid_gdn_s5_diffattn_peer"


def rms_norm(x, gain):
    xf = x.astype(jnp.float32)
    y = xf * lax.rsqrt(jnp.mean(xf * xf, axis=-1, keepdims=True) + NORM_EPS)
    return (y * gain.astype(jnp.float32)).astype(x.dtype)


def l2_normalize(t):
    return t * lax.rsqrt(jnp.sum(t * t, axis=-1, keepdims=True) + 1e-6)


def chunk_gated_delta(q, k, v, g, beta):
    bn, seq, heads, dk = q.shape
    dv = v.shape[-1]
    nc = seq // GDN_CHUNK

    def chunks(t):
        t = t.reshape((bn, nc, GDN_CHUNK, heads) + t.shape[3:])
        return jnp.moveaxis(t, (1, 3), (0, 2))

    q = chunks(q * dk ** -0.5)
    k = chunks(k)
    v = chunks(v)
    beta = chunks(beta)
    g = jnp.cumsum(chunks(g), axis=-1)
    incl = jnp.tril(jnp.ones((GDN_CHUNK, GDN_CHUNK), bool))
    strict = jnp.tril(jnp.ones((GDN_CHUNK, GDN_CHUNK), bool), -1)
    decay = jnp.exp(jnp.where(incl, g[..., :, None] - g[..., None, :], -jnp.inf))
    kk = jnp.einsum('nbhid,nbhjd->nbhij', k, k)
    lower = jnp.where(strict, beta[..., :, None] * kk * decay, 0.0)
    eye = jnp.eye(GDN_CHUNK, dtype=jnp.float32)
    t_inv = lax.linalg.triangular_solve(eye + lower, jnp.broadcast_to(eye, lower.shape),
                                        left_side=True, lower=True)
    u = t_inv @ (v * beta[..., None])
    w = t_inv @ (k * (beta * jnp.exp(g))[..., None])
    qk = jnp.where(incl, jnp.einsum('nbhid,nbhjd->nbhij', q, k) * decay, 0.0)

    def step(state, inp):
        q_c, k_c, u_c, w_c, g_c, qk_c = inp
        v_new = u_c - w_c @ state
        out = (q_c * jnp.exp(g_c)[..., None]) @ state + qk_c @ v_new
        g_last = g_c[..., -1:]
        state = state * jnp.exp(g_last)[..., None] + jnp.einsum(
            'bhck,bhcv->bhkv', k_c * jnp.exp(g_last - g_c)[..., None], v_new)
        return state, out

    state0 = jnp.zeros((bn, heads, dk, dv), jnp.float32)
    _, out = lax.scan(step, state0, (q, k, u, w, g, qk))
    return jnp.moveaxis(out, (0, 2), (1, 3)).reshape(bn, seq, heads, dv)


def gdn_mixer(qkv, z, a, b, conv_w, a_log, dt_bias, norm_g):
    bn, seq, ch = qkv.shape
    qkv = jax.nn.silu(lax.conv_general_dilated(
        qkv, conv_w.astype(qkv.dtype)[:, None, :], (1,), [(GDN_CONV - 1, 0)],
        dimension_numbers=('NWC', 'WIO', 'NWC'), feature_group_count=ch))
    q, k, v = jnp.split(qkv.astype(jnp.float32), [GDN_QK_W, 2 * GDN_QK_W], axis=-1)
    q = l2_normalize(q.reshape(bn, seq, GDN_HEADS, GDN_DK))
    k = l2_normalize(k.reshape(bn, seq, GDN_HEADS, GDN_DK))
    v = v.reshape(bn, seq, GDN_HEADS, GDN_DV)
    beta = jax.nn.sigmoid(b.astype(jnp.float32))
    g = -jnp.exp(a_log.astype(jnp.float32)) * jax.nn.softplus(a.astype(jnp.float32) + dt_bias.astype(jnp.float32))
    o = chunk_gated_delta(q, k, v, g, beta)
    o = rms_norm(o, norm_g) * jax.nn.silu(z.astype(jnp.float32).reshape(bn, seq, GDN_HEADS, GDN_DV))
    return o.reshape(bn, seq, GDN_V_W).astype(z.dtype)


def _lin_combine(e1, e2):
    a1, b1 = e1
    a2, b2 = e2
    return a1 * a2, a2 * b1 + b2


def s5_mixer(u, lam_re, lam_im, b_re, b_im, c_re, c_im, d_skip, log_step, glu_w, glu_b):
    bn, seq, _ = u.shape
    uf = u.astype(jnp.float32)
    lam = lax.complex(lam_re.astype(jnp.float32), lam_im.astype(jnp.float32))
    step = jnp.exp(log_step.astype(jnp.float32))[:, None]
    a_bar = jnp.exp(lam * step)
    b_bar = ((a_bar - 1.0) / lam)[:, :, None] * lax.complex(b_re.astype(jnp.float32), b_im.astype(jnp.float32))
    bu = jnp.einsum('blgc,gnc->blgn', uf.reshape(bn, seq, S5_GROUPS, S5_GROUP_CH), b_bar)
    _, states = lax.associative_scan(_lin_combine, (jnp.broadcast_to(a_bar, bu.shape), bu), axis=1)
    c = lax.complex(c_re.astype(jnp.float32), c_im.astype(jnp.float32))
    y = jnp.einsum('blgn,gcn->blgc', states, c).real.reshape(bn, seq, S5_WIDTH) + d_skip.astype(jnp.float32) * uf
    y = jax.nn.gelu(y).astype(u.dtype)
    zg = y @ glu_w + glu_b
    z_val, z_gate = jnp.split(zg, 2, axis=-1)
    return z_val * jax.nn.sigmoid(z_gate)


def diff_attn_mixer(q, k, v, lq1, lk1, lq2, lk2, norm_g, lam_init):
    bn, seq, _ = q.shape
    q = q.reshape(bn, seq, DIFF_HEADS, 2, DIFF_DQK)
    k = k.reshape(bn, seq, DIFF_HEADS, 2, DIFF_DQK)
    vf = v.reshape(bn, seq, DIFF_HEADS, DIFF_DV).astype(jnp.float32)
    f32 = jnp.float32
    lam = (jnp.exp(jnp.sum(lq1.astype(f32) * lk1.astype(f32)))
           - jnp.exp(jnp.sum(lq2.astype(f32) * lk2.astype(f32))) + lam_init)
    nb = seq // Q_BLOCK
    q_blocks = q.reshape(bn, nb, Q_BLOCK, DIFF_HEADS, 2, DIFF_DQK).swapaxes(0, 1)
    scale = DIFF_DQK ** -0.5
    k_pos = jnp.arange(seq)

    def block(args):
        blk, qb = args
        s = jnp.einsum('bqhmd,bkhmd->bhmqk', qb, k).astype(f32) * scale
        q_pos = blk * Q_BLOCK + jnp.arange(Q_BLOCK)
        s = jnp.where(k_pos[None, :] <= q_pos[:, None], s, -jnp.inf)
        p = jax.nn.softmax(s, axis=-1)
        p_diff = p[:, :, 0] - lam * p[:, :, 1]
        return jnp.einsum('bhqk,bkhe->bqhe', p_diff, vf)

    o = lax.map(block, (jnp.arange(nb), q_blocks))
    o = o.swapaxes(0, 1).reshape(bn, seq, DIFF_HEADS, DIFF_DV)
    o = rms_norm(o, norm_g) * (1.0 - lam_init)
    return o.reshape(bn, seq, DIFF_V_W).astype(v.dtype)


def peer_ffn(x, wq, keys, u_tab, v_tab):
    bn, seq, dm = x.shape
    nb = seq // PEER_BLOCK
    xb = x.reshape(bn, nb, PEER_BLOCK, dm).swapaxes(0, 1)

    def block(xt):
        q = (xt @ wq).reshape(bn, PEER_BLOCK, PEER_HEADS, 2, PEER_DHALF)
        s = jnp.einsum('bthpd,hpnd->bthpn', q, keys).astype(jnp.float32)
        sv, si = lax.top_k(s, PEER_TOPK)
        cand_s = (sv[..., 0, :, None] + sv[..., 1, None, :]).reshape(bn, PEER_BLOCK, PEER_HEADS, PEER_TOPK * PEER_TOPK)
        cand_e = (si[..., 0, :, None] * N_KEYS + si[..., 1, None, :]).reshape(bn, PEER_BLOCK, PEER_HEADS, PEER_TOPK * PEER_TOPK)
        top_s, top_i = lax.top_k(cand_s, PEER_TOPK)
        expert = jnp.take_along_axis(cand_e, top_i, axis=-1)
        gate = jax.nn.softmax(top_s, axis=-1)
        act = jax.nn.gelu(jnp.einsum('bthkd,btd->bthk', u_tab[expert], xt).astype(jnp.float32))
        return jnp.einsum('bthk,bthkd->btd', (gate * act).astype(xt.dtype), v_tab[expert])

    y = lax.map(block, xb)
    return y.swapaxes(0, 1).reshape(bn, seq, dm)


def setup_inputs(seed: int = 0) -> dict:
    key = jax.random.key(seed)
    ks = iter(jax.random.split(key, 32))
    f32 = jnp.float32
    nrm = lambda shape, scale: scale * jax.random.normal(next(ks), shape, f32)
    unif = lambda shape, lo, hi: jax.random.uniform(next(ks), shape, f32, lo, hi)
    x = nrm((BATCH, SEQ, D_MODEL), 1.0)
    norm1_g = 1.0 + nrm((DEPTH, D_MODEL), 0.02)
    w_in = nrm((DEPTH, D_MODEL, IN_WIDTH), D_MODEL ** -0.5)
    gdn_conv_w = nrm((DEPTH, GDN_CONV, GDN_QKV_W), GDN_CONV ** -0.5)
    gdn_a_log = jnp.log(unif((DEPTH, GDN_HEADS), 1.0, 16.0))
    dt = jnp.exp(unif((DEPTH, GDN_HEADS), math.log(1e-3), math.log(1e-1)))
    gdn_dt_bias = dt + jnp.log(-jnp.expm1(-dt))
    gdn_norm_g = 1.0 + nrm((DEPTH, GDN_DV), 0.02)
    s5_lambda_re = -0.5 + nrm((DEPTH, S5_GROUPS, S5_STATE), 0.01)
    s5_lambda_im = math.pi * jnp.arange(S5_STATE, dtype=f32) + nrm((DEPTH, S5_GROUPS, S5_STATE), 0.01)
    s5_b_re = nrm((DEPTH, S5_GROUPS, S5_STATE, S5_GROUP_CH), (2 * S5_GROUP_CH) ** -0.5)
    s5_b_im = nrm((DEPTH, S5_GROUPS, S5_STATE, S5_GROUP_CH), (2 * S5_GROUP_CH) ** -0.5)
    s5_c_re = nrm((DEPTH, S5_GROUPS, S5_GROUP_CH, S5_STATE), (2 * S5_STATE) ** -0.5)
    s5_c_im = nrm((DEPTH, S5_GROUPS, S5_GROUP_CH, S5_STATE), (2 * S5_STATE) ** -0.5)
    s5_d = nrm((DEPTH, S5_WIDTH), 1.0)
    s5_log_step = unif((DEPTH, S5_GROUPS), math.log(1e-3), math.log(1e-1))
    s5_glu_w = nrm((DEPTH, S5_WIDTH, 2 * S5_WIDTH), S5_WIDTH ** -0.5)
    s5_glu_b = nrm((DEPTH, 2 * S5_WIDTH), 0.01)
    diff_lq1 = nrm((DEPTH, DIFF_DQK), 0.1)
    diff_lk1 = nrm((DEPTH, DIFF_DQK), 0.1)
    diff_lq2 = nrm((DEPTH, DIFF_DQK), 0.1)
    diff_lk2 = nrm((DEPTH, DIFF_DQK), 0.1)
    diff_norm_g = 1.0 + nrm((DEPTH, DIFF_DV), 0.02)
    w_out = nrm((DEPTH, MIX_WIDTH, D_MODEL), MIX_WIDTH ** -0.5)
    norm2_g = 1.0 + nrm((DEPTH, D_MODEL), 0.02)
    peer_wq = nrm((DEPTH, D_MODEL, PEER_HEADS * PEER_DQ), D_MODEL ** -0.5)
    peer_keys = nrm((DEPTH, PEER_HEADS, 2, N_KEYS, PEER_DHALF), PEER_DHALF ** -0.5)
    peer_u = nrm((DEPTH, N_EXPERTS, D_MODEL), D_MODEL ** -0.5)
    peer_v = nrm((DEPTH, N_EXPERTS, D_MODEL), PEER_HEADS ** -0.5)
    final_g = 1.0 + nrm((D_MODEL,), 0.02)
    return {"x": x, "norm1_g": norm1_g, "w_in": w_in, "gdn_conv_w": gdn_conv_w, "gdn_a_log": gdn_a_log,
            "gdn_dt_bias": gdn_dt_bias, "gdn_norm_g": gdn_norm_g, "s5_lambda_re": s5_lambda_re,
            "s5_lambda_im": s5_lambda_im, "s5_b_re": s5_b_re, "s5_b_im": s5_b_im, "s5_c_re": s5_c_re,
            "s5_c_im": s5_c_im, "s5_d": s5_d, "s5_log_step": s5_log_step, "s5_glu_w": s5_glu_w,
            "s5_glu_b": s5_glu_b, "diff_lq1": diff_lq1, "diff_lk1": diff_lk1, "diff_lq2": diff_lq2,
            "diff_lk2": diff_lk2, "diff_norm_g": diff_norm_g, "w_out": w_out, "norm2_g": norm2_g,
            "peer_wq": peer_wq, "peer_keys": peer_keys, "peer_u": peer_u, "peer_v": peer_v, "final_g": final_g}


def reference(x, norm1_g, w_in, gdn_conv_w, gdn_a_log, gdn_dt_bias, gdn_norm_g, s5_lambda_re, s5_lambda_im,
              s5_b_re, s5_b_im, s5_c_re, s5_c_im, s5_d, s5_log_step, s5_glu_w, s5_glu_b, diff_lq1, diff_lk1,
              diff_lq2, diff_lk2, diff_norm_g, w_out, norm2_g, peer_wq, peer_keys, peer_u, peer_v, final_g):
    split_at = np.cumsum(IN_SIZES)[:-1].tolist()
    h = x
    for layer in range(DEPTH):
        lam_init = 0.8 - 0.6 * math.exp(-0.3 * layer)
        hn = rms_norm(h, norm1_g[layer])
        proj = hn @ w_in[layer]
        qkv_a, z_a, a_a, b_a, u_s, q_c, k_c, v_c = jnp.split(proj, split_at, axis=-1)
        o_a = gdn_mixer(qkv_a, z_a, a_a, b_a, gdn_conv_w[layer], gdn_a_log[layer], gdn_dt_bias[layer],
                        gdn_norm_g[layer])
        o_b = s5_mixer(u_s, s5_lambda_re[layer], s5_lambda_im[layer], s5_b_re[layer], s5_b_im[layer],
                       s5_c_re[layer], s5_c_im[layer], s5_d[layer], s5_log_step[layer], s5_glu_w[layer],
                       s5_glu_b[layer])
        o_c = diff_attn_mixer(q_c, k_c, v_c, diff_lq1[layer], diff_lk1[layer], diff_lq2[layer], diff_lk2[layer],
                              diff_norm_g[layer], lam_init)
        h = h + jnp.concatenate([o_a, o_b, o_c], axis=-1) @ w_out[layer]
        h = h + peer_ffn(rms_norm(h, norm2_g[layer]), peer_wq[layer], peer_keys[layer], peer_u[layer], peer_v[layer])
    return rms_norm(h, final_g)
```

```cpp
#include <hip/hip_runtime.h>
#include <hip/hip_cooperative_groups.h>
#include <stdint.h>
#include <stdio.h>
namespace cg = cooperative_groups;

#ifndef MK_ONE_LAUNCH
#define MK_ONE_LAUNCH 0
#endif

#define DI __device__ __forceinline__
typedef unsigned short u16;
typedef __attribute__((ext_vector_type(8))) short bf16x8;
typedef __attribute__((ext_vector_type(4))) short bf16x4;
typedef __attribute__((ext_vector_type(16))) float f32x16;
typedef __attribute__((ext_vector_type(4))) float f32x4;
typedef __attribute__((ext_vector_type(2))) float f32x2;

constexpr int NT = 32768, DM = 1024, SEQ = 8192, NBATCH = 4;
constexpr int NTHR = 512;
constexpr int INW = 2824;
constexpr int PROJW = 2816;
constexpr float LOG2E = 1.4426950408889634f;

constexpr size_t OFF_CTL   = 0;
constexpr size_t OFF_WINT  = 65536;
constexpr size_t OFF_WOUTT = OFF_WINT  + (size_t)2 * PROJW * 1024 * 2;
constexpr size_t OFF_WQT   = OFF_WOUTT + (size_t)2 * 1024 * 1024 * 2;
constexpr size_t OFF_GLUT  = OFF_WQT   + (size_t)2 * 1024 * 1024 * 2;
constexpr size_t OFF_KEYS  = OFF_GLUT  + (size_t)2 * 512 * 256 * 2;
constexpr size_t OFF_WAB   = OFF_KEYS  + (size_t)2 * 8 * 2 * 128 * 64 * 2;
constexpr size_t OFF_S5P   = OFF_WAB   + (size_t)2 * 8 * 1024 * 4;
constexpr size_t S5P_LAYER = 262144;
constexpr size_t S5P_ABAR = 0, S5P_A64 = 8192, S5P_BRE = 16384, S5P_BIM = 16384 + 65536, S5P_CM = 16384 + 131072;
constexpr size_t OFF_SCAL  = OFF_S5P   + 2 * S5P_LAYER;
constexpr size_t OFF_UTAB  = OFF_SCAL  + 256;
constexpr size_t OFF_VTAB  = OFF_UTAB  + (size_t)2 * 16384 * 1024;
constexpr size_t OFF_ABUF  = OFF_VTAB  + (size_t)2 * 16384 * 1024;
constexpr size_t OFF_GG    = OFF_ABUF  + (size_t)NT * 1024 * 2;
constexpr size_t OFF_BETA  = OFF_GG    + (size_t)NT * 4 * 4;
constexpr size_t OFF_PROJ  = OFF_BETA  + (size_t)NT * 4 * 4;
constexpr size_t OFF_QKV   = OFF_PROJ;
constexpr size_t OFF_Z     = OFF_QKV   + (size_t)NT * 768 * 2;
constexpr size_t OFF_US    = OFF_Z     + (size_t)NT * 256 * 2;
constexpr size_t OFF_QC    = OFF_US    + (size_t)NT * 256 * 2;
constexpr size_t OFF_KC    = OFF_QC    + (size_t)NT * 512 * 2;
constexpr size_t OFF_VT    = OFF_KC    + (size_t)NT * 512 * 2;
constexpr size_t OFF_GREC  = OFF_VT    + (size_t)NT * 512 * 2;
constexpr size_t GREC_BYTES = 40960;
constexpr size_t OFF_EGL   = OFF_GREC  + (size_t)2048 * GREC_BYTES;
constexpr size_t OFF_S5ST  = OFF_EGL   + 2048 * 4;
constexpr size_t OFF_YS5   = OFF_S5ST  + (size_t)8192 * 64 * 8;
constexpr size_t OFF_END   = OFF_YS5   + (size_t)NT * 256 * 2;
constexpr size_t OFF_GDNO  = OFF_QKV;
constexpr size_t OFF_PQ    = OFF_PROJ;
constexpr size_t OFF_PICKE = OFF_GREC;
constexpr size_t OFF_PICKG = OFF_GREC + (size_t)NT * 128 * 2;
static_assert(OFF_END < (size_t)512 * 1024 * 1024, "workspace");

constexpr int LDS_BYTES = 148480;

struct Params {
    const float* in[29];
    float* out;
    char* ws;
};

DI u16 f2bf(float x) { unsigned u = __float_as_uint(x); u += 0x7fffu + ((u >> 16) & 1u); return (u16)(u >> 16); }
DI float bf2f(u16 v) { return __uint_as_float(((unsigned)v) << 16); }
DI unsigned pack2(float a, float b) { return (unsigned)f2bf(a) | ((unsigned)f2bf(b) << 16); }
DI float wave_sum(float v) { for (int o = 32; o > 0; o >>= 1) v += __shfl_xor(v, o); return v; }
DI float gelu_tanh(float x) { float u = 0.7978845608028654f * (x + 0.044715f * x * x * x); float e = __expf(2.f * u); float th = 1.f - 2.f / (e + 1.f); return 0.5f * x * (1.f + th); }
DI float sigmoidf_(float x) { return 1.f / (1.f + __expf(-x)); }
#define MFMA32(a, b, c) __builtin_amdgcn_mfma_f32_32x32x16_bf16((a), (b), (c), 0, 0, 0)
#define MFMA16(a, b, c) __builtin_amdgcn_mfma_f32_16x16x32_bf16((a), (b), (c), 0, 0, 0)
DI bf16x8 ld8(const void* p) { return *(const bf16x8*)p; }
DI bf16x8 cat4(bf16x4 lo, bf16x4 hi) { return __builtin_shufflevector(lo, hi, 0, 1, 2, 3, 4, 5, 6, 7); }
DI bf16x8 pack8(float a0, float a1, float a2, float a3, float a4, float a5, float a6, float a7) {
    uint4 u; u.x = pack2(a0, a1); u.y = pack2(a2, a3); u.z = pack2(a4, a5); u.w = pack2(a6, a7);
    return __builtin_bit_cast(bf16x8, u);
}

template <class CM>
DI void transpose_tile(const float* __restrict__ src, int src_ld, u16* __restrict__ dst, int K, int n0, int k0, CM colmap, float* tl) {
    const int tid = threadIdx.x;
    {
        const int nn = tid & 63;
        const int sc = colmap(n0 + nn);
#pragma unroll
        for (int i = 0; i < 8; ++i) { const int kk = (tid >> 6) + 8 * i; tl[kk * 65 + nn] = src[(size_t)(k0 + kk) * src_ld + sc]; }
    }
    __syncthreads();
    {
        const int kk = tid & 63;
#pragma unroll
        for (int i = 0; i < 8; ++i) { const int nn = (tid >> 6) + 8 * i; dst[(size_t)(n0 + nn) * K + k0 + kk] = f2bf(tl[kk * 65 + nn]); }
    }
    __syncthreads();
}

DI void phase_prep(const Params& P, char* lds) {
    float* tl = (float*)lds;
    char* ws = P.ws;
    const int bid = blockIdx.x, nb = gridDim.x, tid = threadIdx.x;
    for (int j = bid; j < 2496; j += nb) {
        if (j < 1408) {
            const int l = j / 704, r = j % 704, nt = r / 16, kt = r % 16;
            transpose_tile(P.in[2] + (size_t)l * 1024 * INW, INW, (u16*)(ws + OFF_WINT) + (size_t)l * PROJW * 1024, 1024, nt * 64, kt * 64,
                           [](int n) { return n < 1024 ? n : n + 8; }, tl);
        } else if (j < 1920) {
            const int q = j - 1408; const int l = q / 256, r = q % 256, nt = r / 16, kt = r % 16;
            transpose_tile(P.in[22] + (size_t)l * 1024 * 1024, 1024, (u16*)(ws + OFF_WOUTT) + (size_t)l * 1024 * 1024, 1024, nt * 64, kt * 64, [](int n) { return n; }, tl);
        } else if (j < 2432) {
            const int q = j - 1920; const int l = q / 256, r = q % 256, nt = r / 16, kt = r % 16;
            transpose_tile(P.in[24] + (size_t)l * 1024 * 1024, 1024, (u16*)(ws + OFF_WQT) + (size_t)l * 1024 * 1024, 1024, nt * 64, kt * 64, [](int n) { return n; }, tl);
        } else {
            const int q = j - 2432; const int l = q / 32, r = q % 32, nt = r / 4, kt = r % 4;
            transpose_tile(P.in[15] + (size_t)l * 256 * 512, 512, (u16*)(ws + OFF_GLUT) + (size_t)l * 512 * 256, 256, nt * 64, kt * 64,
                           [](int n) { const int blk = n >> 6, wi = n & 63; return wi < 32 ? 32 * blk + wi : 256 + 32 * blk + (wi - 32); }, tl);
        }
    }
    const size_t gtid = (size_t)bid * NTHR + tid, gsz = (size_t)nb * NTHR;
    for (size_t i = gtid; i < (size_t)2 * 8 * 2 * 128 * 64; i += gsz) ((u16*)(ws + OFF_KEYS))[i] = f2bf(P.in[25][i]);
    for (size_t i = gtid; i < (size_t)2 * 8 * 1024; i += gsz) {
        const int l = (int)(i / 8192), j = (int)((i / 1024) % 8), k = (int)(i % 1024);
        ((float*)(ws + OFF_WAB))[i] = P.in[2][(size_t)l * 1024 * INW + (size_t)k * INW + 1024 + j];
    }
    {
        const size_t n16 = (size_t)2 * 16384 * 1024 / 16;
        for (size_t i = gtid; i < 2 * n16; i += gsz) {
            const bool isv = i >= n16; const size_t ii = isv ? i - n16 : i;
            const float4* s = (const float4*)(isv ? P.in[27] : P.in[26]) + ii * 4;
            const float sc = isv ? 8.f : 64.f;
            uint4 o; unsigned* op = (unsigned*)&o;
#pragma unroll
            for (int q = 0; q < 4; ++q) {
                const float4 v = s[q];
                int wv = __builtin_amdgcn_cvt_pk_fp8_f32(v.x * sc, v.y * sc, 0, false);
                wv = __builtin_amdgcn_cvt_pk_fp8_f32(v.z * sc, v.w * sc, wv, true);
                op[q] = (unsigned)wv;
            }
            ((uint4*)(ws + (isv ? OFF_VTAB : OFF_UTAB)))[ii] = o;
        }
    }
    for (size_t i = gtid; i < (size_t)2 * 16 * 64; i += gsz) {
        const int l = (int)(i / 1024), g = (int)((i / 64) % 16), n = (int)(i % 64);
        const float step = __expf(P.in[14][l * 16 + g]);
        const float lr = P.in[7][i], li = P.in[8][i];
        const float er = expf(lr * step); const float ar = er * cosf(li * step), ai = er * sinf(li * step);
        const float e64 = expf(64.f * lr * step); const float a64r = e64 * cosf(64.f * li * step), a64i = e64 * sinf(64.f * li * step);
        char* sp = ws + OFF_S5P + l * S5P_LAYER;
        ((float2*)(sp + S5P_ABAR))[g * 64 + n] = make_float2(ar, ai);
        ((float2*)(sp + S5P_A64))[g * 64 + n] = make_float2(a64r, a64i);
        const float xr = ar - 1.f, xi = ai; const float den = 1.f / (lr * lr + li * li);
        const float cr = (xr * lr + xi * li) * den, ci = (xi * lr - xr * li) * den;
        for (int c = 0; c < 16; ++c) {
            const float br = P.in[9][i * 16 + c], bi = P.in[10][i * 16 + c];
            ((float*)(sp + S5P_BRE))[(g * 64 + n) * 16 + c] = cr * br - ci * bi;
            ((float*)(sp + S5P_BIM))[(g * 64 + n) * 16 + c] = cr * bi + ci * br;
        }
    }
    for (size_t i = gtid; i < (size_t)2 * 16 * 16 * 128; i += gsz) {
        const int l = (int)(i / 32768), g = (int)((i / 2048) % 16), c = (int)((i / 128) % 16), k = (int)(i % 128);
        const size_t si = ((size_t)(l * 16 + g) * 16 + c) * 64 + (k & 63);
        const float v = k < 64 ? P.in[11][si] : -P.in[12][si];
        ((u16*)(ws + OFF_S5P + l * S5P_LAYER + S5P_CM))[(g * 16 + c) * 128 + k] = f2bf(v);
    }
    if (bid == 0 && tid < 2) {
        const int l = tid; float s1 = 0.f, s2 = 0.f;
        for (int d = 0; d < 64; ++d) { s1 += P.in[17][l * 64 + d] * P.in[18][l * 64 + d]; s2 += P.in[19][l * 64 + d] * P.in[20][l * 64 + d]; }
        const float lam_init = 0.8f - 0.6f * expf(-0.3f * (float)l);
        ((float*)(ws + OFF_SCAL))[l] = expf(s1) - expf(s2) + lam_init;
    }
}

DI void rms_token(const Params& P, int t, int lane, float4 (&v)[4], const float* gain, u16* dst, int ab_layer  ) {
    float ss = 0.f;
#pragma unroll
    for (int i = 0; i < 4; ++i) ss += v[i].x * v[i].x + v[i].y * v[i].y + v[i].z * v[i].z + v[i].w * v[i].w;
    ss = wave_sum(ss);
    const float rstd = rsqrtf(ss * (1.f / DM) + 1e-6f);
    const float4* g4 = (const float4*)gain;
#pragma unroll
    for (int i = 0; i < 4; ++i) {
        const float4 g = g4[lane + 64 * i];
        v[i].x *= rstd * g.x; v[i].y *= rstd * g.y; v[i].z *= rstd * g.z; v[i].w *= rstd * g.w;
        uint2 o; o.x = pack2(v[i].x, v[i].y); o.y = pack2(v[i].z, v[i].w);
        *(uint2*)(dst + (size_t)t * DM + (lane + 64 * i) * 4) = o;
    }
    if (ab_layer >= 0) {
        const float4* wab = (const float4*)(P.ws + OFF_WAB) + ab_layer * 8 * 256;
        float acc[8];
#pragma unroll
        for (int j = 0; j < 8; ++j) {
            float a = 0.f;
#pragma unroll
            for (int i = 0; i < 4; ++i) { const float4 w = wab[j * 256 + lane + 64 * i]; a += v[i].x * w.x + v[i].y * w.y + v[i].z * w.z + v[i].w * w.w; }
            acc[j] = wave_sum(a);
        }
        if (lane < 4) {
            const float a = lane == 0 ? acc[0] : lane == 1 ? acc[1] : lane == 2 ? acc[2] : acc[3];
            const float b = lane == 0 ? acc[4] : lane == 1 ? acc[5] : lane == 2 ? acc[6] : acc[7];
            const float xx = a + P.in[5][ab_layer * 4 + lane];
            const float sp = xx > 20.f ? xx : log1pf(__expf(xx));
            ((float*)(P.ws + OFF_GG))[t * 4 + lane] = -__expf(P.in[4][ab_layer * 4 + lane]) * sp;
            ((float*)(P.ws + OFF_BETA))[t * 4 + lane] = sigmoidf_(b);
        }
    }
}

DI void phase_rms(const Params& P, const float* src, const float* gain, u16* dst, int ab_layer) {
    const int w = threadIdx.x >> 6, lane = threadIdx.x & 63;
    for (int t = blockIdx.x * 8 + w; t < NT; t += gridDim.x * 8) {
        const float4* s4 = (const float4*)(src + (size_t)t * DM);
        float4 v[4];
#pragma unroll
        for (int i = 0; i < 4; ++i) v[i] = s4[lane + 64 * i];
        rms_token(P, t, lane, v, gain, dst, ab_layer);
    }
}

constexpr int GP = 40;
template <class Epi>
DI void gemm_tile(const u16* __restrict__ A, int lda, const u16* __restrict__ Bt, int ldb, int K, int m0, int n0, Epi& epi, char* lds) {
    const int tid = threadIdx.x, lane = tid & 63, w = tid >> 6;
    const int wm = w >> 2, wn = w & 3, r = lane & 31, hh = lane >> 5;
    u16* As = (u16*)lds;
    u16* Bs = As + 2 * 256 * GP;
    f32x16 acc[4][2];
#pragma unroll
    for (int i = 0; i < 4; ++i)
#pragma unroll
        for (int j = 0; j < 2; ++j)
#pragma unroll
            for (int e = 0; e < 16; ++e) acc[i][j][e] = 0.f;
    const int lrow = tid >> 2, lkc = tid & 3;
    const u16* ga0 = A + (size_t)(m0 + lrow) * lda + lkc * 8;
    const u16* ga1 = A + (size_t)(m0 + lrow + 128) * lda + lkc * 8;
    const u16* gb0 = Bt + (size_t)(n0 + lrow) * ldb + lkc * 8;
    const u16* gb1 = Bt + (size_t)(n0 + lrow + 128) * ldb + lkc * 8;
    const int so0 = lrow * GP + lkc * 8, so1 = (lrow + 128) * GP + lkc * 8;
    uint4 ra0 = *(const uint4*)ga0, ra1 = *(const uint4*)ga1, rb0 = *(const uint4*)gb0, rb1 = *(const uint4*)gb1;
    *(uint4*)(As + so0) = ra0; *(uint4*)(As + so1) = ra1; *(uint4*)(Bs + so0) = rb0; *(uint4*)(Bs + so1) = rb1;
    __syncthreads();
    const int nk = K / 32;
    for (int kt = 0; kt < nk; ++kt) {
        const int cur = kt & 1;
        if (kt + 1 < nk) {
            const int ko = (kt + 1) * 32;
            ra0 = *(const uint4*)(ga0 + ko); ra1 = *(const uint4*)(ga1 + ko); rb0 = *(const uint4*)(gb0 + ko); rb1 = *(const uint4*)(gb1 + ko);
        }
        const u16* Ac = As + cur * 256 * GP + (wm * 128 + r) * GP + hh * 8;
        const u16* Bc = Bs + cur * 256 * GP + (wn * 64 + r) * GP + hh * 8;
#pragma unroll
        for (int ks = 0; ks < 2; ++ks) {
            bf16x8 af[4], bfr[2];
#pragma unroll
            for (int i = 0; i < 4; ++i) af[i] = ld8(Ac + i * 32 * GP + ks * 16);
#pragma unroll
            for (int j = 0; j < 2; ++j) bfr[j] = ld8(Bc + j * 32 * GP + ks * 16);
#pragma unroll
            for (int i = 0; i < 4; ++i)
#pragma unroll
                for (int j = 0; j < 2; ++j) acc[i][j] = MFMA32(af[i], bfr[j], acc[i][j]);
        }
        if (kt + 1 < nk) {
            const int nx = (cur ^ 1) * 256 * GP;
            *(uint4*)(As + nx + so0) = ra0; *(uint4*)(As + nx + so1) = ra1; *(uint4*)(Bs + nx + so0) = rb0; *(uint4*)(Bs + nx + so1) = rb1;
        }
        __syncthreads();
    }
    epi(acc, m0 + wm * 128, n0 + wn * 64, r, hh);
}

struct EpiInProj {
    char* ws;
    DI void operator()(f32x16 (&acc)[4][2], int mw, int nw, int r, int hh) const {
        if (nw >= 2304) {
            u16* vt = (u16*)(ws + OFF_VT);
#pragma unroll
            for (int i = 0; i < 4; ++i)
#pragma unroll
                for (int j = 0; j < 2; ++j) {
                    const int c = nw - 2304 + 32 * j + r; const int head = c >> 7, dv = c & 127;
#pragma unroll
                    for (int q = 0; q < 4; ++q) {
                        const int row = mw + 32 * i + 8 * q + 4 * hh; const int b = row >> 13, l = row & 8191;
                        uint2 o; o.x = pack2(acc[i][j][4 * q], acc[i][j][4 * q + 1]); o.y = pack2(acc[i][j][4 * q + 2], acc[i][j][4 * q + 3]);
                        *(uint2*)(vt + ((size_t)((b * 4 + head) * 128 + dv)) * SEQ + l) = o;
                    }
                }
            return;
        }
        u16* base; int pitch, c0; float sc = 1.f;
        if (nw < 768) { base = (u16*)(ws + OFF_QKV); pitch = 768; c0 = nw; }
        else if (nw < 1024) { base = (u16*)(ws + OFF_Z); pitch = 256; c0 = nw - 768; }
        else if (nw < 1280) { base = (u16*)(ws + OFF_US); pitch = 256; c0 = nw - 1024; }
        else if (nw < 1792) { base = (u16*)(ws + OFF_QC); pitch = 512; c0 = nw - 1280; sc = 0.125f * LOG2E; }
        else { base = (u16*)(ws + OFF_KC); pitch = 512; c0 = nw - 1792; }
#pragma unroll
        for (int i = 0; i < 4; ++i)
#pragma unroll
            for (int j = 0; j < 2; ++j)
#pragma unroll
                for (int e = 0; e < 16; ++e) {
                    const int row = mw + 32 * i + (e & 3) + 8 * (e >> 2) + 4 * hh;
                    base[(size_t)row * pitch + c0 + 32 * j + r] = f2bf(acc[i][j][e] * sc);
                }
    }
};
struct EpiResidual {
    const float* hin; float* hout;
    DI void operator()(f32x16 (&acc)[4][2], int mw, int nw, int r, int hh) const {
#pragma unroll
        for (int i = 0; i < 4; ++i)
#pragma unroll
            for (int j = 0; j < 2; ++j)
#pragma unroll
                for (int e = 0; e < 16; ++e) {
                    const size_t idx = (size_t)(mw + 32 * i + (e & 3) + 8 * (e >> 2) + 4 * hh) * DM + nw + 32 * j + r;
                    hout[idx] = hin[idx] + acc[i][j][e];
                }
    }
};
struct EpiBf16 {
    u16* dst; int pitch;
    DI void operator()(f32x16 (&acc)[4][2], int mw, int nw, int r, int hh) const {
#pragma unroll
        for (int i = 0; i < 4; ++i)
#pragma unroll
            for (int j = 0; j < 2; ++j)
#pragma unroll
                for (int e = 0; e < 16; ++e)
                    dst[(size_t)(mw + 32 * i + (e & 3) + 8 * (e >> 2) + 4 * hh) * pitch + nw + 32 * j + r] = f2bf(acc[i][j][e]);
    }
};
struct EpiGlu {
    u16* mix; const float* bias;
    DI void operator()(f32x16 (&acc)[4][2], int mw, int nw, int r, int hh) const {
        const int col = 32 * (nw >> 6) + r;
        const float bv = bias[col], bg = bias[256 + col];
#pragma unroll
        for (int i = 0; i < 4; ++i)
#pragma unroll
            for (int e = 0; e < 16; ++e) {
                const int row = mw + 32 * i + (e & 3) + 8 * (e >> 2) + 4 * hh;
                const float val = acc[i][0][e] + bv, gate = acc[i][1][e] + bg;
                mix[(size_t)row * DM + 256 + col] = f2bf(val * sigmoidf_(gate));
            }
    }
};

template <class Epi>
DI void phase_gemm(const u16* A, int lda, const u16* Bt, int ldb, int M, int N, int K, Epi epi, char* lds) {
    const int ntn = N / 256, ntm = M / 256;
    for (int t = blockIdx.x; t < ntn * ntm; t += gridDim.x) {
        const int mt = t / ntn, nt = t % ntn;
        gemm_tile(A, lda, Bt, ldb, K, mt * 256, nt * 256, epi, lds);
    }
}

DI void gdn_prep_item(const Params& P, int layer, int item, char* lds) {
    const int tid = threadIdx.x, lane = tid & 63, w = tid >> 6;
    const int b = item >> 9, head = (item >> 7) & 3, ch = item & 127;
    const int t0 = b * SEQ + ch * 64;
    u16* raw = (u16*)lds;
    float* qs = (float*)(lds + 25856);
    float* ks = qs + 64 * 68;
    float* vs = ks + 64 * 68;
    float* Ls = vs + 64 * 68;
    u16* qb = (u16*)(Ls + 64 * 68);
    u16* kb = qb + 64 * 72;
    float* Gs = (float*)(kb + 64 * 72);
    float* bs = Gs + 64;
    float* rn = bs + 64;
    const u16* qkv = (const u16*)(P.ws + OFF_QKV);
    for (int i = tid; i < 67 * 24; i += NTHR) {
        const int row = i / 24, c8 = i % 24; const int part = c8 >> 3, cc = (c8 & 7) * 8;
        const int l = ch * 64 + row - 3;
        uint4 v = make_uint4(0, 0, 0, 0);
        if (l >= 0) v = *(const uint4*)(qkv + (size_t)(b * SEQ + l) * 768 + part * 256 + head * 64 + cc);
        *(uint4*)(raw + row * 192 + part * 64 + cc) = v;
    }
    if (tid < 64) { bs[tid] = ((const float*)(P.ws + OFF_BETA))[(t0 + tid) * 4 + head]; Gs[tid] = ((const float*)(P.ws + OFF_GG))[(t0 + tid) * 4 + head]; }
    __syncthreads();
    {
        const float* cw = P.in[3] + (size_t)layer * 4 * 768;
        for (int i = tid; i < 64 * 192; i += NTHR) {
            const int t = i / 192, c = i % 192; const int part = c >> 6, d = c & 63; const int gc = part * 256 + head * 64 + d;
            float a = 0.f;
#pragma unroll
            for (int j = 0; j < 4; ++j) a += cw[j * 768 + gc] * bf2f(raw[(t + j) * 192 + c]);
            a = a * sigmoidf_(a);
            (part == 0 ? qs : part == 1 ? ks : vs)[t * 68 + d] = a;
        }
    }
    if (tid == 0) { float g = 0.f; for (int i = 0; i < 64; ++i) { g += Gs[i]; Gs[i] = g; } }
    __syncthreads();
    if (tid < 128) {
        const float* s = (tid < 64 ? qs : ks) + (tid & 63) * 68; float ss = 0.f;
        for (int d = 0; d < 64; ++d) ss += s[d] * s[d];
        rn[tid] = rsqrtf(ss + 1e-6f) * (tid < 64 ? 0.125f : 1.f);
    }
    __syncthreads();
    for (int i = tid; i < 2 * 64 * 64; i += NTHR) {
        const int which = i >> 12, t = (i >> 6) & 63, d = i & 63;
        float* s = which ? ks : qs; const float v = s[t * 68 + d] * rn[which * 64 + t];
        s[t * 68 + d] = v; (which ? kb : qb)[t * 72 + d] = f2bf(v);
    }
    __syncthreads();
    u16* rec = (u16*)(P.ws + OFF_GREC + (size_t)item * GREC_BYTES);
    {
        const int r = lane & 31, hh = lane >> 5; const int bi = (w >> 1) & 1, bj = w & 1; const bool isqk = w >= 4;
        const u16* Am = (isqk ? qb : kb) + (bi * 32 + r) * 72 + hh * 8;
        const u16* Bm = kb + (bj * 32 + r) * 72 + hh * 8;
        f32x16 acc;
#pragma unroll
        for (int e = 0; e < 16; ++e) acc[e] = 0.f;
#pragma unroll
        for (int s = 0; s < 4; ++s) acc = MFMA32(ld8(Am + s * 16), ld8(Bm + s * 16), acc);
        const int j = bj * 32 + r; const float Gj = Gs[j];
#pragma unroll
        for (int e = 0; e < 16; ++e) {
            const int i = bi * 32 + (e & 3) + 8 * (e >> 2) + 4 * hh;
            const float dec = __expf(Gs[i] - Gj);
            if (isqk) rec[2 * 4096 + i * 64 + j] = f2bf(j <= i ? acc[e] * dec : 0.f);
            else Ls[i * 68 + j] = (j < i) ? bs[i] * acc[e] * dec : 0.f;
        }
    }
    __syncthreads();
    {
        const float Gl = Gs[63];
        for (int i = tid; i < 2 * 4096; i += NTHR) {
            const int which = i >> 12, a = (i >> 6) & 63, bq = i & 63;
            if (which == 0) rec[3 * 4096 + a * 64 + bq] = f2bf(qs[a * 68 + bq] * __expf(Gs[a]));
            else rec[4 * 4096 + a * 64 + bq] = f2bf(ks[bq * 68 + a] * __expf(Gl - Gs[bq]));
        }
        if (tid == 0) ((float*)(P.ws + OFF_EGL))[item] = __expf(Gl);
    }
    float* Xs = rn + 128;
    for (int i = tid; i < 64 * 130; i += NTHR) Xs[i] = 0.f;
    __syncthreads();
    {
        const int c = tid >> 2, q = tid & 3;
        const bool isw = c >= 64; const int cc = c & 63;
        for (int i = 0; i < 64; ++i) {
            const float bi = bs[i];
            const float rhs = isw ? ks[i * 68 + cc] * bi * __expf(Gs[i]) : vs[i * 68 + cc] * bi;
            const float4* Lr = (const float4*)(Ls + i * 68);
            float sacc = 0.f;
#pragma unroll
            for (int mq = 0; mq < 4; ++mq) {
                const int j4 = q + 4 * mq;
                const float4 l4 = Lr[j4];
                const float* xp = Xs + (4 * j4) * 130 + c;
                sacc += l4.x * xp[0] + l4.y * xp[130] + l4.z * xp[260] + l4.w * xp[390];
            }
            sacc += __shfl_xor(sacc, 1); sacc += __shfl_xor(sacc, 2);
            if (q == 0) Xs[i * 130 + c] = rhs - sacc;
        }
    }
    __syncthreads();
    for (int i = tid; i < 2 * 4096; i += NTHR) {
        const int which = i >> 12, t = (i >> 6) & 63, d = i & 63;
        rec[which * 4096 + t * 64 + d] = f2bf(Xs[t * 130 + which * 64 + d]);
    }
    __syncthreads();
}

constexpr int RP = 72;
DI void gdn_scan_chain(const Params& P, int chain, char* lds) {
    const int tid = threadIdx.x, lane = tid & 63, w = tid >> 6;
    const int b = chain >> 2, head = chain & 3;
    u16* buf0 = (u16*)lds;
    u16* buf1 = buf0 + 320 * RP;
    const char* recbase = P.ws + OFF_GREC + (size_t)(chain * 128) * GREC_BYTES;
    const float* egl = (const float*)(P.ws + OFF_EGL) + chain * 128;
    float* gout = (float*)(P.ws + OFF_GDNO);
    uint4 rg0, rg1, rg2, rg3, rg4;
#define SCAN_ISSUE(c_) do { const uint4* src_ = (const uint4*)(recbase + (size_t)(c_) * GREC_BYTES) + tid; \
        rg0 = src_[0]; rg1 = src_[NTHR]; rg2 = src_[2 * NTHR]; rg3 = src_[3 * NTHR]; rg4 = src_[4 * NTHR]; } while (0)
#define SCAN_PUT(buf_, i_, v_) do { const int id_ = tid + NTHR * (i_); *(uint4*)((buf_) + (id_ >> 3) * RP + (id_ & 7) * 8) = (v_); } while (0)
#define SCAN_COMMIT(buf_) do { SCAN_PUT(buf_, 0, rg0); SCAN_PUT(buf_, 1, rg1); SCAN_PUT(buf_, 2, rg2); SCAN_PUT(buf_, 3, rg3); SCAN_PUT(buf_, 4, rg4); } while (0)
    f32x4 S[4];
#pragma unroll
    for (int m = 0; m < 4; ++m) S[m] = (f32x4){0.f, 0.f, 0.f, 0.f};
    const int r16 = lane & 15, g = lane >> 4;
    SCAN_ISSUE(0); SCAN_COMMIT(buf0);
    __syncthreads();
    for (int c = 0; c < 128; ++c) {
        u16* cur = (c & 1) ? buf1 : buf0; u16* nxt = (c & 1) ? buf0 : buf1;
        if (c + 1 < 128) SCAN_ISSUE(c + 1);
        if (w < 4) {
            const float dec = egl[c];
            const u16* Ub = cur;
            const u16* Wb = cur + 64 * RP;
            const u16* QKb = cur + 128 * RP;
            const u16* QGb = cur + 192 * RP;
            const u16* KDb = cur + 256 * RP;
            bf16x8 Sb[2];
#pragma unroll
            for (int s = 0; s < 2; ++s) Sb[s] = pack8(S[2 * s][0], S[2 * s][1], S[2 * s][2], S[2 * s][3], S[2 * s + 1][0], S[2 * s + 1][1], S[2 * s + 1][2], S[2 * s + 1][3]);
            f32x4 vn[4], o[4];
#pragma unroll
            for (int mb = 0; mb < 4; ++mb) {
                f32x4 a = (f32x4){0.f, 0.f, 0.f, 0.f}, oo = (f32x4){0.f, 0.f, 0.f, 0.f};
#pragma unroll
                for (int s = 0; s < 2; ++s) {
                    const u16* pw = Wb + (16 * mb + r16) * RP + 32 * s + 4 * g;
                    const u16* pq = QGb + (16 * mb + r16) * RP + 32 * s + 4 * g;
                    a = MFMA16(cat4(*(const bf16x4*)pw, *(const bf16x4*)(pw + 16)), Sb[s], a);
                    oo = MFMA16(cat4(*(const bf16x4*)pq, *(const bf16x4*)(pq + 16)), Sb[s], oo);
                }
#pragma unroll
                for (int e = 0; e < 4; ++e) vn[mb][e] = bf2f(Ub[(16 * mb + 4 * g + e) * RP + 16 * w + r16]) - a[e];
                o[mb] = oo;
            }
            bf16x8 Vb[2];
#pragma unroll
            for (int s = 0; s < 2; ++s) Vb[s] = pack8(vn[2 * s][0], vn[2 * s][1], vn[2 * s][2], vn[2 * s][3], vn[2 * s + 1][0], vn[2 * s + 1][1], vn[2 * s + 1][2], vn[2 * s + 1][3]);
#pragma unroll
            for (int mb = 0; mb < 4; ++mb) {
                f32x4 oo = o[mb];
                f32x4 sn = S[mb] * dec;
#pragma unroll
                for (int s = 0; s < 2; ++s) {
                    const u16* pk = QKb + (16 * mb + r16) * RP + 32 * s + 4 * g;
                    const u16* pd = KDb + (16 * mb + r16) * RP + 32 * s + 4 * g;
                    oo = MFMA16(cat4(*(const bf16x4*)pk, *(const bf16x4*)(pk + 16)), Vb[s], oo);
                    sn = MFMA16(cat4(*(const bf16x4*)pd, *(const bf16x4*)(pd + 16)), Vb[s], sn);
                }
                S[mb] = sn;
#pragma unroll
                for (int e = 0; e < 4; ++e)
                    gout[(size_t)(b * SEQ + c * 64 + 16 * mb + 4 * g + e) * 256 + head * 64 + 16 * w + r16] = oo[e];
            }
        }
        if (c + 1 < 128) SCAN_COMMIT(nxt);
        __syncthreads();
    }
}

DI void phase_gdn_norm(const Params& P, int layer) {
    const int w = threadIdx.x >> 6, lane = threadIdx.x & 63;
    const float* gout = (const float*)(P.ws + OFF_GDNO);
    const u16* z = (const u16*)(P.ws + OFF_Z);
    u16* mix = (u16*)(P.ws + OFF_ABUF);
    const float4 ng = ((const float4*)(P.in[6] + layer * 64))[lane & 15];
    for (int t = blockIdx.x * 8 + w; t < NT; t += gridDim.x * 8) {
        const float4 o = ((const float4*)(gout + (size_t)t * 256))[lane];
        float ss = o.x * o.x + o.y * o.y + o.z * o.z + o.w * o.w;
        ss += __shfl_xor(ss, 1); ss += __shfl_xor(ss, 2); ss += __shfl_xor(ss, 4); ss += __shfl_xor(ss, 8);
        const float rstd = rsqrtf(ss * (1.f / 64.f) + 1e-6f);
        const uint2 zz = *(const uint2*)(z + (size_t)t * 256 + lane * 4);
        const float z0 = bf2f((u16)(zz.x & 0xffff)), z1 = bf2f((u16)(zz.x >> 16)), z2 = bf2f((u16)(zz.y & 0xffff)), z3 = bf2f((u16)(zz.y >> 16));
        uint2 r;
        r.x = pack2(o.x * rstd * ng.x * z0 * sigmoidf_(z0), o.y * rstd * ng.y * z1 * sigmoidf_(z1));
        r.y = pack2(o.z * rstd * ng.z * z2 * sigmoidf_(z2), o.w * rstd * ng.w * z3 * sigmoidf_(z3));
        *(uint2*)(mix + (size_t)t * DM + lane * 4) = r;
    }
}

template <bool FINAL>
DI void s5_item(const Params& P, int layer, int item, char* wlds, int lane) {
    const int b = item >> 11, g = (item >> 7) & 15, ch = item & 127;
    const int t0 = b * SEQ + ch * 64;
    const char* sp = P.ws + OFF_S5P + layer * S5P_LAYER;
    float* ut = (float*)wlds;
    u16* Xs = (u16*)(wlds + 4096);
    {
        const u16* src = (const u16*)(P.ws + OFF_US) + (size_t)(t0 + lane) * 256 + g * 16;
        const uint4 a = *(const uint4*)src, c = *(const uint4*)(src + 8);
        const unsigned uu[8] = {a.x, a.y, a.z, a.w, c.x, c.y, c.z, c.w};
#pragma unroll
        for (int i = 0; i < 8; ++i) { ut[lane * 16 + 2 * i] = bf2f((u16)(uu[i] & 0xffff)); ut[lane * 16 + 2 * i + 1] = bf2f((u16)(uu[i] >> 16)); }
    }
    float Br[16], Bi[16];
    {
        const float4* br = (const float4*)(sp + S5P_BRE) + (g * 64 + lane) * 4; const float4* bi = (const float4*)(sp + S5P_BIM) + (g * 64 + lane) * 4;
#pragma unroll
        for (int i = 0; i < 4; ++i) { const float4 x = br[i], y = bi[i]; Br[4 * i] = x.x; Br[4 * i + 1] = x.y; Br[4 * i + 2] = x.z; Br[4 * i + 3] = x.w; Bi[4 * i] = y.x; Bi[4 * i + 1] = y.y; Bi[4 * i + 2] = y.z; Bi[4 * i + 3] = y.w; }
    }
    const float2 ab = ((const float2*)(sp + S5P_ABAR))[g * 64 + lane];
    float2* st = (float2*)(P.ws + OFF_S5ST) + (size_t)item * 64 + lane;
    float xr = 0.f, xi = 0.f;
    if (FINAL) { const float2 c0 = *st; xr = c0.x; xi = c0.y; }
    bf16x8 cf[4];
    if (FINAL) {
        const u16* cm = (const u16*)(sp + S5P_CM) + (g * 16 + (lane & 15)) * 128 + 8 * (lane >> 4);
#pragma unroll
        for (int s = 0; s < 4; ++s) cf[s] = ld8(cm + 32 * s);
    }
    __builtin_amdgcn_wave_barrier();
    asm volatile("s_waitcnt lgkmcnt(0)" ::: "memory");
    for (int half = 0; half < 2; ++half) {
        for (int tt = 0; tt < 32; ++tt) {
            const int t = half * 32 + tt;
            const float4* u4 = (const float4*)(ut + t * 16);
            float br_ = 0.f, bi_ = 0.f;
#pragma unroll
            for (int q = 0; q < 4; ++q) {
                const float4 u = u4[q];
                br_ += Br[4 * q] * u.x + Br[4 * q + 1] * u.y + Br[4 * q + 2] * u.z + Br[4 * q + 3] * u.w;
                bi_ += Bi[4 * q] * u.x + Bi[4 * q + 1] * u.y + Bi[4 * q + 2] * u.z + Bi[4 * q + 3] * u.w;
            }
            const float nr = ab.x * xr - ab.y * xi + br_, ni = ab.x * xi + ab.y * xr + bi_;
            xr = nr; xi = ni;
            if (FINAL) { Xs[tt * 136 + lane] = f2bf(xr); Xs[tt * 136 + 64 + lane] = f2bf(xi); }
        }
        if (FINAL) {
            asm volatile("s_waitcnt lgkmcnt(0)" ::: "memory");
            __builtin_amdgcn_wave_barrier();
            const int r16 = lane & 15, gg = lane >> 4;
            const float dsv = P.in[13][layer * 256 + g * 16 + r16];
#pragma unroll
            for (int mb = 0; mb < 2; ++mb) {
                f32x4 acc = (f32x4){0.f, 0.f, 0.f, 0.f};
#pragma unroll
                for (int s = 0; s < 4; ++s) acc = MFMA16(ld8(Xs + (16 * mb + r16) * 136 + 32 * s + 8 * gg), cf[s], acc);
#pragma unroll
                for (int e = 0; e < 4; ++e) {
                    const int tk = half * 32 + 16 * mb + 4 * gg + e;
                    const float y = acc[e] + dsv * ut[tk * 16 + r16];
                    ((u16*)(P.ws + OFF_YS5))[(size_t)(t0 + tk) * 256 + g * 16 + r16] = f2bf(gelu_tanh(y));
                }
            }
            asm volatile("s_waitcnt lgkmcnt(0)" ::: "memory");
            __builtin_amdgcn_wave_barrier();
        }
    }
    if (!FINAL) *st = make_float2(xr, xi);
    asm volatile("s_waitcnt lgkmcnt(0)" ::: "memory");
    __builtin_amdgcn_wave_barrier();
}
template <bool FINAL>
DI void phase_s5(const Params& P, int layer, char* lds) {
    const int w = threadIdx.x >> 6, lane = threadIdx.x & 63;
    char* wl = lds + w * 12800;
    for (int it = blockIdx.x * 8 + w; it < 8192; it += gridDim.x * 8) s5_item<FINAL>(P, layer, it, wl, lane);
}
constexpr int KP = 136;
constexpr int VP = 68;
constexpr int ATT_STAGE = 64 * KP + 128 * VP;
DI void attn_item(const Params& P, int layer, int b, int head, int qb, char* lds) {
    const int tid = threadIdx.x, lane = tid & 63, w = tid >> 6;
    const int m = w >> 2, wq = w & 3, r = lane & 31, hh = lane >> 5;
    u16* st0 = (u16*)lds;
    const u16* QC = (const u16*)(P.ws + OFF_QC);
    const u16* KC = (const u16*)(P.ws + OFF_KC);
    const u16* VT = (const u16*)(P.ws + OFF_VT);
    const int qw0 = qb * 128 + 32 * wq;
    const int q = qw0 + r;
    bf16x8 qf[4];
    {
        const u16* qp = QC + (size_t)(b * SEQ + q) * 512 + head * 128 + m * 64 + hh * 8;
#pragma unroll
        for (int s = 0; s < 4; ++s) qf[s] = ld8(qp + 16 * s);
    }
    f32x16 o[4];
#pragma unroll
    for (int d = 0; d < 4; ++d)
#pragma unroll
        for (int e = 0; e < 16; ++e) o[d][e] = 0.f;
    float mrun = -INFINITY, lrun = 0.f;
    const int nkv = 2 * (qb + 1);
    const int kkey = tid >> 4, kch = tid & 15;
    const int vdv = tid >> 3, vch = tid & 7;
    const u16* kg = KC + (size_t)(b * SEQ + kkey) * 512 + head * 128 + kch * 8;
    const u16* vg = VT + ((size_t)((b * 4 + head) * 128 + vdv)) * SEQ + vch * 8;
    uint4 rk0, rk1, rv0, rv1;
#define ATT_ISSUE(j_) do { rk0 = *(const uint4*)(kg + (size_t)(64 * (j_)) * 512); rk1 = *(const uint4*)(kg + (size_t)(64 * (j_) + 32) * 512); \
        rv0 = *(const uint4*)(vg + 64 * (j_)); rv1 = *(const uint4*)(vg + (size_t)64 * SEQ + 64 * (j_)); } while (0)
#define ATT_COMMIT(stg_) do { u16* sg_ = (stg_); *(uint4*)(sg_ + kkey * KP + kch * 8) = rk0; *(uint4*)(sg_ + (kkey + 32) * KP + kch * 8) = rk1; \
        u16* vb_ = sg_ + 64 * KP; \
        *(uint2*)(vb_ + vdv * VP + vch * 8) = make_uint2(rv0.x, rv0.y); *(uint2*)(vb_ + vdv * VP + vch * 8 + 4) = make_uint2(rv0.z, rv0.w); \
        *(uint2*)(vb_ + (vdv + 64) * VP + vch * 8) = make_uint2(rv1.x, rv1.y); *(uint2*)(vb_ + (vdv + 64) * VP + vch * 8 + 4) = make_uint2(rv1.z, rv1.w); } while (0)
    ATT_ISSUE(0); ATT_COMMIT(st0);
    __syncthreads();
    for (int j = 0; j < nkv; ++j) {
        u16* cur = st0 + (j & 1) * ATT_STAGE; u16* nxt = st0 + ((j & 1) ^ 1) * ATT_STAGE;
        if (j + 1 < nkv) ATT_ISSUE(j + 1);
        if (64 * j <= qw0 + 31) {
            f32x16 s0, s1;
#pragma unroll
            for (int e = 0; e < 16; ++e) { s0[e] = 0.f; s1[e] = 0.f; }
            const u16* kp = cur + r * KP + m * 64 + hh * 8;
#pragma unroll
            for (int s = 0; s < 4; ++s) {
                s0 = MFMA32(ld8(kp + 16 * s), qf[s], s0);
                s1 = MFMA32(ld8(kp + 32 * KP + 16 * s), qf[s], s1);
            }
            if (64 * j + 63 > qw0) {
#pragma unroll
                for (int e = 0; e < 16; ++e) {
                    const int key = 64 * j + (e & 3) + 8 * (e >> 2) + 4 * hh;
                    if (key > q) s0[e] = -INFINITY;
                    if (key + 32 > q) s1[e] = -INFINITY;
                }
            }
            float mx = s0[0];
#pragma unroll
            for (int e = 1; e < 16; ++e) mx = fmaxf(mx, s0[e]);
#pragma unroll
            for (int e = 0; e < 16; ++e) mx = fmaxf(mx, s1[e]);
            mx = fmaxf(mx, __shfl_xor(mx, 32));
            const float mnew = fmaxf(mrun, mx);
            const float alpha = __builtin_amdgcn_exp2f(mrun - mnew);
            mrun = mnew;
            float psum = 0.f;
#pragma unroll
            for (int e = 0; e < 16; ++e) { s0[e] = __builtin_amdgcn_exp2f(s0[e] - mnew); psum += s0[e]; }
#pragma unroll
            for (int e = 0; e < 16; ++e) { s1[e] = __builtin_amdgcn_exp2f(s1[e] - mnew); psum += s1[e]; }
            lrun = lrun * alpha + psum;
#pragma unroll
            for (int d = 0; d < 4; ++d) o[d] = o[d] * alpha;
            bf16x8 pf[4];
            pf[0] = pack8(s0[0], s0[1], s0[2], s0[3], s0[4], s0[5], s0[6], s0[7]);
            pf[1] = pack8(s0[8], s0[9], s0[10], s0[11], s0[12], s0[13], s0[14], s0[15]);
            pf[2] = pack8(s1[0], s1[1], s1[2], s1[3], s1[4], s1[5], s1[6], s1[7]);
            pf[3] = pack8(s1[8], s1[9], s1[10], s1[11], s1[12], s1[13], s1[14], s1[15]);
            const u16* vp = cur + 64 * KP + r * VP + 4 * hh;
#pragma unroll
            for (int d = 0; d < 4; ++d)
#pragma unroll
                for (int kk = 0; kk < 4; ++kk) {
                    const u16* pa = vp + d * 32 * VP + 16 * kk;
                    o[d] = MFMA32(cat4(*(const bf16x4*)pa, *(const bf16x4*)(pa + 8)), pf[kk], o[d]);
                }
        }
        if (j + 1 < nkv) ATT_COMMIT(nxt);
        __syncthreads();
    }
    const float ltot = lrun + __shfl_xor(lrun, 32);
    const float inv = 1.f / ltot;
    float* ex = (float*)lds;
    if (m == 1) {
#pragma unroll
        for (int d = 0; d < 4; ++d)
#pragma unroll
            for (int e = 0; e < 16; ++e) ex[(wq * 64 + d * 16 + e) * 64 + lane] = o[d][e] * inv;
    }
    __syncthreads();
    if (m == 0) {
        const float lam = ((const float*)(P.ws + OFF_SCAL))[layer];
        const float lam_init = 0.8f - 0.6f * __expf(-0.3f * (float)layer);
        float ss = 0.f;
#pragma unroll
        for (int d = 0; d < 4; ++d)
#pragma unroll
            for (int e = 0; e < 16; ++e) { const float v = o[d][e] * inv - lam * ex[(wq * 64 + d * 16 + e) * 64 + lane]; o[d][e] = v; ss += v * v; }
        ss += __shfl_xor(ss, 32);
        const float sc = rsqrtf(ss * (1.f / 128.f) + 1e-6f) * (1.f - lam_init);
        const float* ng = P.in[21] + layer * 128;
        u16* mix = (u16*)(P.ws + OFF_ABUF) + (size_t)(b * SEQ + q) * DM + 512 + head * 128;
#pragma unroll
        for (int d = 0; d < 4; ++d)
#pragma unroll
            for (int qd = 0; qd < 4; ++qd) {
                const int dv0 = 32 * d + 8 * qd + 4 * hh;
                const float4 g4 = *(const float4*)(ng + dv0);
                uint2 pk; pk.x = pack2(o[d][4 * qd] * sc * g4.x, o[d][4 * qd + 1] * sc * g4.y); pk.y = pack2(o[d][4 * qd + 2] * sc * g4.z, o[d][4 * qd + 3] * sc * g4.w);
                *(uint2*)(mix + dv0) = pk;
            }
    }
    __syncthreads();
}
DI void phase_attn(const Params& P, int layer, char* lds) {
    for (int pi = blockIdx.x; pi < 512; pi += gridDim.x) {
        const int bh = pi >> 5, i = pi & 31;
        attn_item(P, layer, bh >> 2, bh & 3, 63 - i, lds);
        attn_item(P, layer, bh >> 2, bh & 3, i, lds);
    }
}

DI void ins16(float (&top)[16], float v) {
#pragma unroll
    for (int k = 0; k < 16; ++k) { const float hi = fmaxf(top[k], v); v = fminf(top[k], v); top[k] = hi; }
}
DI void phase_topk(const Params& P, int layer) {
    const int w = threadIdx.x >> 6, lane = threadIdx.x & 63, r = lane & 31, hh = lane >> 5;
    const u16* PQ = (const u16*)(P.ws + OFF_PQ);
    const u16* KEYS = (const u16*)(P.ws + OFF_KEYS) + (size_t)layer * 8 * 2 * 128 * 64;
    u16* pe = (u16*)(P.ws + OFF_PICKE); float* pg = (float*)(P.ws + OFF_PICKG);
    for (int it = blockIdx.x * 8 + w; it < 8192; it += gridDim.x * 8) {
        const int tile = it >> 3, h = it & 7; const int tok = tile * 32 + r;
        float sv[2][16];
#pragma unroll
        for (int p = 0; p < 2; ++p) {
            bf16x8 bq[4];
            const u16* qp = PQ + (size_t)tok * 1024 + h * 128 + p * 64 + hh * 8;
#pragma unroll
            for (int s = 0; s < 4; ++s) bq[s] = ld8(qp + 16 * s);
            float top[16];
#pragma unroll
            for (int k = 0; k < 16; ++k) top[k] = -INFINITY;
#pragma unroll 1
            for (int kb = 0; kb < 4; ++kb) {
                f32x16 acc;
#pragma unroll
                for (int e = 0; e < 16; ++e) acc[e] = 0.f;
                const u16* kp = KEYS + ((size_t)((h * 2 + p) * 128 + 32 * kb + r)) * 64 + hh * 8;
#pragma unroll
                for (int s = 0; s < 4; ++s) acc = MFMA32(ld8(kp + 16 * s), bq[s], acc);
#pragma unroll
                for (int e = 0; e < 16; ++e) {
                    const unsigned key = 32 * kb + (e & 3) + 8 * (e >> 2) + 4 * hh;
                    ins16(top, __uint_as_float((__float_as_uint(acc[e]) & ~0x7Fu) | key));
                }
            }
            float oth[16];
#pragma unroll
            for (int k = 0; k < 16; ++k) oth[k] = __shfl_xor(top[k], 32);
#pragma unroll
            for (int k = 0; k < 16; ++k) ins16(top, oth[k]);
#pragma unroll
            for (int k = 0; k < 16; ++k) sv[p][k] = top[k];
        }
        float top[16];
#pragma unroll
        for (int k = 0; k < 16; ++k) top[k] = -INFINITY;
#pragma unroll
        for (int i = 0; i < 16; ++i)
#pragma unroll
            for (int j = 0; j < 16; ++j)
                if ((i + 1) * (j + 1) <= 16) {
                    const float s = __uint_as_float(__float_as_uint(sv[0][i]) & ~0x7Fu) + __uint_as_float(__float_as_uint(sv[1][j]) & ~0x7Fu);
                    ins16(top, __uint_as_float((__float_as_uint(s) & ~0xFFu) | (unsigned)(i * 16 + j)));
                }
        float ev[16]; float den = 0.f;
        const float mx = __uint_as_float(__float_as_uint(top[0]) & ~0xFFu);
#pragma unroll
        for (int k = 0; k < 16; ++k) { ev[k] = __expf(__uint_as_float(__float_as_uint(top[k]) & ~0xFFu) - mx); den += ev[k]; }
        const float rden = 1.f / den;
#pragma unroll
        for (int k = 0; k < 16; ++k) {
            const unsigned code = __float_as_uint(top[k]) & 0xFFu; const unsigned wi = code >> 4, wj = code & 15u;
            unsigned i0 = 0, i1 = 0;
#pragma unroll
            for (int i = 0; i < 16; ++i) { i0 = (wi == (unsigned)i) ? (__float_as_uint(sv[0][i]) & 0x7Fu) : i0; i1 = (wj == (unsigned)i) ? (__float_as_uint(sv[1][i]) & 0x7Fu) : i1; }
            if ((k >> 3) == hh) {
                pe[(size_t)tok * 128 + h * 16 + k] = (u16)(i0 * 128 + i1);
                pg[(size_t)tok * 128 + h * 16 + k] = ev[k] * rden;
            }
        }
    }
}

DI void fp8x16_to_f32(const uint4& u, float (&f)[16]) {
    const unsigned uu[4] = {u.x, u.y, u.z, u.w};
#pragma unroll
    for (int q = 0; q < 4; ++q) {
        const f32x2 lo = __builtin_amdgcn_cvt_pk_f32_fp8((int)uu[q], false), hi = __builtin_amdgcn_cvt_pk_f32_fp8((int)uu[q], true);
        f[4 * q] = lo[0]; f[4 * q + 1] = lo[1]; f[4 * q + 2] = hi[0]; f[4 * q + 3] = hi[1];
    }
}
DI void phase_peer(const Params& P, int layer, const float* hin, float* hout, bool last) {
    const int w = threadIdx.x >> 6, lane = threadIdx.x & 63;
    const uint8_t* UT = (const uint8_t*)(P.ws + OFF_UTAB) + (size_t)layer * 16384 * 1024;
    const uint8_t* VTb = (const uint8_t*)(P.ws + OFF_VTAB) + (size_t)layer * 16384 * 1024;
    const u16* pe = (const u16*)(P.ws + OFF_PICKE); const float* pg = (const float*)(P.ws + OFF_PICKG);
    u16* abuf = (u16*)(P.ws + OFF_ABUF);
    for (int t = blockIdx.x * 8 + w; t < NT; t += gridDim.x * 8) {
        float x[16];
        {
            const uint4 a = *(const uint4*)(abuf + (size_t)t * DM + lane * 16), c = *(const uint4*)(abuf + (size_t)t * DM + lane * 16 + 8);
            const unsigned uu[8] = {a.x, a.y, a.z, a.w, c.x, c.y, c.z, c.w};
#pragma unroll
            for (int i = 0; i < 8; ++i) { x[2 * i] = bf2f((u16)(uu[i] & 0xffff)); x[2 * i + 1] = bf2f((u16)(uu[i] >> 16)); }
        }
        float y[16];
#pragma unroll
        for (int i = 0; i < 16; ++i) y[i] = 0.f;
        for (int rnd = 0; rnd < 2; ++rnd) {
            const int my_e = pe[(size_t)t * 128 + rnd * 64 + lane];
            const float my_g = pg[(size_t)t * 128 + rnd * 64 + lane];
            float mydot = 0.f;
            for (int i0 = 0; i0 < 64; i0 += 8) {
                uint4 rows[8];
#pragma unroll
                for (int i = 0; i < 8; ++i) { const int e = __builtin_amdgcn_readlane(my_e, i0 + i); rows[i] = *(const uint4*)(UT + (size_t)e * 1024 + lane * 16); }
#pragma unroll
                for (int i = 0; i < 8; ++i) {
                    float f[16]; fp8x16_to_f32(rows[i], f);
                    float p = 0.f;
#pragma unroll
                    for (int k = 0; k < 16; ++k) p += f[k] * x[k];
                    p = wave_sum(p);
                    mydot = (lane == i0 + i) ? p : mydot;
                }
            }
            const float coef = my_g * gelu_tanh(mydot * (1.f / 64.f)) * (1.f / 8.f);
            for (int i0 = 0; i0 < 64; i0 += 8) {
                uint4 rows[8];
#pragma unroll
                for (int i = 0; i < 8; ++i) { const int e = __builtin_amdgcn_readlane(my_e, i0 + i); rows[i] = *(const uint4*)(VTb + (size_t)e * 1024 + lane * 16); }
#pragma unroll
                for (int i = 0; i < 8; ++i) {
                    float f[16]; fp8x16_to_f32(rows[i], f);
                    const float c = __uint_as_float((unsigned)__builtin_amdgcn_readlane((int)__float_as_uint(coef), i0 + i));
#pragma unroll
                    for (int k = 0; k < 16; ++k) y[k] += c * f[k];
                }
            }
        }
        float4 v[4];
        const float4* h4 = (const float4*)(hin + (size_t)t * DM + lane * 16);
#pragma unroll
        for (int i = 0; i < 4; ++i) { v[i] = h4[i]; v[i].x += y[4 * i]; v[i].y += y[4 * i + 1]; v[i].z += y[4 * i + 2]; v[i].w += y[4 * i + 3]; }
        float ss = 0.f;
#pragma unroll
        for (int i = 0; i < 4; ++i) ss += v[i].x * v[i].x + v[i].y * v[i].y + v[i].z * v[i].z + v[i].w * v[i].w;
        ss = wave_sum(ss);
        const float rstd = rsqrtf(ss * (1.f / DM) + 1e-6f);
        if (last) {
            const float4* g4 = (const float4*)(P.in[28]) + lane * 4;
            float4* o4 = (float4*)(hout + (size_t)t * DM + lane * 16);
#pragma unroll
            for (int i = 0; i < 4; ++i) { const float4 g = g4[i]; o4[i] = make_float4(v[i].x * rstd * g.x, v[i].y * rstd * g.y, v[i].z * rstd * g.z, v[i].w * rstd * g.w); }
        } else {
            float4* o4 = (float4*)(hout + (size_t)t * DM + lane * 16);
#pragma unroll
            for (int i = 0; i < 4; ++i) o4[i] = v[i];
            const float4* g4 = (const float4*)(P.in[1] + (layer + 1) * DM) + lane * 4;
            float vn[16];
#pragma unroll
            for (int i = 0; i < 4; ++i) { const float4 g = g4[i]; vn[4 * i] = v[i].x * rstd * g.x; vn[4 * i + 1] = v[i].y * rstd * g.y; vn[4 * i + 2] = v[i].z * rstd * g.z; vn[4 * i + 3] = v[i].w * rstd * g.w; }
            uint4 o0, o1;
            o0.x = pack2(vn[0], vn[1]); o0.y = pack2(vn[2], vn[3]); o0.z = pack2(vn[4], vn[5]); o0.w = pack2(vn[6], vn[7]);
            o1.x = pack2(vn[8], vn[9]); o1.y = pack2(vn[10], vn[11]); o1.z = pack2(vn[12], vn[13]); o1.w = pack2(vn[14], vn[15]);
            *(uint4*)(abuf + (size_t)t * DM + lane * 16) = o0; *(uint4*)(abuf + (size_t)t * DM + lane * 16 + 8) = o1;
            const float4* wab = (const float4*)(P.ws + OFF_WAB) + (layer + 1) * 8 * 256;
            float acc[8];
#pragma unroll
            for (int j = 0; j < 8; ++j) {
                float a = 0.f;
#pragma unroll
                for (int i = 0; i < 4; ++i) { const float4 ww = wab[j * 256 + lane * 4 + i]; a += vn[4 * i] * ww.x + vn[4 * i + 1] * ww.y + vn[4 * i + 2] * ww.z + vn[4 * i + 3] * ww.w; }
                acc[j] = wave_sum(a);
            }
            if (lane < 4) {
                const int L1 = layer + 1;
                const float a = lane == 0 ? acc[0] : lane == 1 ? acc[1] : lane == 2 ? acc[2] : acc[3];
                const float bb = lane == 0 ? acc[4] : lane == 1 ? acc[5] : lane == 2 ? acc[6] : acc[7];
                const float xx = a + P.in[5][L1 * 4 + lane];
                const float sp = xx > 20.f ? xx : log1pf(__expf(xx));
                ((float*)(P.ws + OFF_GG))[t * 4 + lane] = -__expf(P.in[4][L1 * 4 + lane]) * sp;
                ((float*)(P.ws + OFF_BETA))[t * 4 + lane] = sigmoidf_(bb);
            }
        }
    }
}

constexpr int PH_PER_LAYER = 11;
constexpr int NPHASE = 2 + 2 * PH_PER_LAYER;

#ifdef ONLY_SUB
#define SUB_ON(k) (ONLY_SUB == (k))
#else
#define SUB_ON(k) 1
#endif
DI void run_phase(const Params& P, int ph, char* lds) {
    char* ws = P.ws;
#if SUB_ON(100)
    if (ph == 0) { phase_prep(P, lds); return; }
#endif
#if SUB_ON(101)
    if (ph == 1) { phase_rms(P, P.in[0], P.in[1], (u16*)(ws + OFF_ABUF), 0); return; }
#endif
    if (ph < 2) return;
    const int layer = (ph - 2) / PH_PER_LAYER, sub = (ph - 2) % PH_PER_LAYER;
    const float* hin = layer == 0 ? P.in[0] : P.out;
    switch (sub) {
    #if SUB_ON(0)
    case 0: { EpiInProj e{ws}; phase_gemm((const u16*)(ws + OFF_ABUF), 1024, (const u16*)(ws + OFF_WINT) + (size_t)layer * PROJW * 1024, 1024, NT, PROJW, 1024, e, lds); } break;

#endif
    #if SUB_ON(1)
    case 1:
        for (int it = blockIdx.x; it < 2048; it += gridDim.x) gdn_prep_item(P, layer, it, lds);
        phase_s5<false>(P, layer, lds);
        break;

#endif
    #if SUB_ON(2)
    case 2:
        if (blockIdx.x < 16) gdn_scan_chain(P, blockIdx.x, lds);
        else if (blockIdx.x < 24) {
            const int gt = (blockIdx.x - 16) * NTHR + threadIdx.x;
            if (gt < 4096) {
                const int bg = gt >> 6, n = gt & 63;
                const float2 a = ((const float2*)(ws + OFF_S5P + layer * S5P_LAYER + S5P_A64))[(bg & 15) * 64 + n];
                float2* st = (float2*)(ws + OFF_S5ST) + (size_t)bg * 128 * 64 + n;
                float xr = 0.f, xi = 0.f;
                for (int c = 0; c < 128; ++c) {
                    const float2 sv = st[c * 64];
                    st[c * 64] = make_float2(xr, xi);
                    const float nr = a.x * xr - a.y * xi + sv.x, ni = a.x * xi + a.y * xr + sv.y;
                    xr = nr; xi = ni;
                }
            }
        }
        break;

#endif
    #if SUB_ON(3)
    case 3: phase_s5<true>(P, layer, lds); break;

#endif
    #if SUB_ON(4)
    case 4: {
        EpiGlu e{(u16*)(ws + OFF_ABUF), P.in[16] + layer * 512};
        phase_gemm((const u16*)(ws + OFF_YS5), 256, (const u16*)(ws + OFF_GLUT) + (size_t)layer * 512 * 256, 256, NT, 512, 256, e, lds);
        phase_gdn_norm(P, layer);
    } break;

#endif
    #if SUB_ON(5)
    case 5: phase_attn(P, layer, lds); break;

#endif
    #if SUB_ON(6)
    case 6: { EpiResidual e{hin, P.out}; phase_gemm((const u16*)(ws + OFF_ABUF), 1024, (const u16*)(ws + OFF_WOUTT) + (size_t)layer * 1024 * 1024, 1024, NT, 1024, 1024, e, lds); } break;

#endif
    #if SUB_ON(7)
    case 7: phase_rms(P, P.out, P.in[23] + layer * DM, (u16*)(ws + OFF_ABUF), -1); break;

#endif
    #if SUB_ON(8)
    case 8: { EpiBf16 e{(u16*)(ws + OFF_PQ), 1024}; phase_gemm((const u16*)(ws + OFF_ABUF), 1024, (const u16*)(ws + OFF_WQT) + (size_t)layer * 1024 * 1024, 1024, NT, 1024, 1024, e, lds); } break;

#endif
    #if SUB_ON(9)
    case 9: phase_topk(P, layer); break;

#endif
    #if SUB_ON(10)
    case 10: phase_peer(P, layer, P.out, P.out, layer == 1); break;
#endif
    }
}

__global__ void __launch_bounds__(NTHR) mk_fwd(Params P, int ph_lo, int ph_hi) {
    extern __shared__ __attribute__((aligned(16))) char lds[];
#define PH(k) if (ph_lo <= (k) && (k) < ph_hi) { run_phase(P, (k), lds); if ((k) + 1 < ph_hi) cg::this_grid().sync(); }
    PH(0) PH(1) PH(2) PH(3) PH(4) PH(5) PH(6) PH(7) PH(8) PH(9) PH(10) PH(11) PH(12)
    PH(13) PH(14) PH(15) PH(16) PH(17) PH(18) PH(19) PH(20) PH(21) PH(22) PH(23)
#undef PH
}

extern "C" void kernel_launch(void* const* d_in, const int* in_sizes, int n_in, void* d_out, int out_size, void* d_ws, size_t ws_size, hipStream_t stream) {
    static int grid = 0;
    if (grid == 0) {
        int dev = 0, cus = 0, per_cu = 0;
        hipGetDevice(&dev);
        hipDeviceGetAttribute(&cus, hipDeviceAttributeMultiprocessorCount, dev);
        hipFuncSetAttribute((const void*)mk_fwd, hipFuncAttributeMaxDynamicSharedMemorySize, LDS_BYTES);
        hipOccupancyMaxActiveBlocksPerMultiprocessor(&per_cu, (const void*)mk_fwd, NTHR, LDS_BYTES);
        if (per_cu < 1) { fprintf(stderr, "occupancy query says %d blocks per CU\n", per_cu); per_cu = 1; }
        grid = cus;
        if (ws_size < OFF_END) { fprintf(stderr, "workspace too small: %zu < %zu\n", ws_size, (size_t)OFF_END); }
    }
    Params p{};
    for (int i = 0; i < 29; ++i) p.in[i] = (const float*)d_in[i];
    p.out = (float*)d_out; p.ws = (char*)d_ws;
#if MK_ONE_LAUNCH
    int lo = 0, hi = NPHASE;
    void* args[] = {&p, &lo, &hi};
    hipError_t e = hipLaunchCooperativeKernel((const void*)mk_fwd, dim3(grid), dim3(NTHR), args, LDS_BYTES, stream);
    if (e != hipSuccess) fprintf(stderr, "cooperative launch failed: %s\n", hipGetErrorString(e));
#else
    for (int ph = 0; ph < NPHASE; ++ph) hipLaunchKernelGGL(mk_fwd, dim3(grid), dim3(NTHR), LDS_BYTES, stream, p, ph, ph + 1);
#endif
}
```

```cpp
#include <hip/hip_runtime.h>
#include <hip/hip_cooperative_groups.h>
#include <stdint.h>
#include <stdio.h>
namespace cg = cooperative_groups;

#ifndef MK_ONE_LAUNCH
#define MK_ONE_LAUNCH 1
#endif

#define DI __device__ __forceinline__
typedef unsigned short u16;
typedef __attribute__((ext_vector_type(8))) short bf16x8;
typedef __attribute__((ext_vector_type(4))) short bf16x4;
typedef __attribute__((ext_vector_type(16))) float f32x16;
typedef __attribute__((ext_vector_type(4))) float f32x4;
typedef __attribute__((ext_vector_type(2))) float f32x2;

constexpr int NT = 32768, DM = 1024, SEQ = 8192, NBATCH = 4;
constexpr int NTHR = 512;
constexpr int INW = 2824;
constexpr int PROJW = 2816;
constexpr float LOG2E = 1.4426950408889634f;

constexpr size_t OFF_CTL   = 0;
constexpr size_t OFF_WINT  = 65536;
constexpr size_t OFF_WOUTT = OFF_WINT  + (size_t)2 * PROJW * 1024 * 2;
constexpr size_t OFF_WQT   = OFF_WOUTT + (size_t)2 * 1024 * 1024 * 2;
constexpr size_t OFF_GLUT  = OFF_WQT   + (size_t)2 * 1024 * 1024 * 2;
constexpr size_t OFF_KEYS  = OFF_GLUT  + (size_t)2 * 512 * 256 * 2;
constexpr size_t OFF_WAB   = OFF_KEYS  + (size_t)2 * 8 * 2 * 128 * 64 * 2;
constexpr size_t OFF_S5P   = OFF_WAB   + (size_t)2 * 8 * 1024 * 4;
constexpr size_t S5P_LAYER = 262144;
constexpr size_t S5P_ABAR = 0, S5P_A64 = 8192, S5P_BRE = 16384, S5P_BIM = 16384 + 65536, S5P_CM = 16384 + 131072;
constexpr size_t OFF_SCAL  = OFF_S5P   + 2 * S5P_LAYER;
constexpr size_t OFF_UTAB  = OFF_SCAL  + 256;
constexpr size_t OFF_VTAB  = OFF_UTAB  + (size_t)2 * 16384 * 1024;
constexpr size_t OFF_ABUF  = OFF_VTAB  + (size_t)2 * 16384 * 1024;
constexpr size_t OFF_GG    = OFF_ABUF  + (size_t)NT * 1024 * 2;
constexpr size_t OFF_BETA  = OFF_GG    + (size_t)NT * 4 * 4;
constexpr size_t OFF_PROJ  = OFF_BETA  + (size_t)NT * 4 * 4;
constexpr size_t OFF_QKV   = OFF_PROJ;
constexpr size_t OFF_Z     = OFF_QKV   + (size_t)NT * 768 * 2;
constexpr size_t OFF_US    = OFF_Z     + (size_t)NT * 256 * 2;
constexpr size_t OFF_QC    = OFF_US    + (size_t)NT * 256 * 2;
constexpr size_t OFF_KC    = OFF_QC    + (size_t)NT * 512 * 2;
constexpr size_t OFF_VT    = OFF_KC    + (size_t)NT * 512 * 2;
constexpr size_t OFF_GREC  = OFF_VT    + (size_t)NT * 512 * 2;
constexpr size_t GREC_BYTES = 40960;
constexpr size_t OFF_EGL   = OFF_GREC  + (size_t)2048 * GREC_BYTES;
constexpr size_t OFF_S5ST  = OFF_EGL   + 2048 * 4;
constexpr size_t OFF_YS5   = OFF_S5ST  + (size_t)8192 * 64 * 8;
constexpr size_t OFF_END   = OFF_YS5   + (size_t)NT * 256 * 2;
constexpr size_t OFF_GDNO  = OFF_QKV;
constexpr size_t OFF_PQ    = OFF_PROJ;
constexpr size_t OFF_PICKE = OFF_GREC;
constexpr size_t OFF_PICKG = OFF_GREC + (size_t)NT * 128 * 2;
static_assert(OFF_END < (size_t)512 * 1024 * 1024, "workspace");

constexpr int LDS_BYTES = 148480;

struct Params {
    const float* in[29];
    float* out;
    char* ws;
};

DI u16 f2bf(float x) { unsigned u = __float_as_uint(x); u += 0x7fffu + ((u >> 16) & 1u); return (u16)(u >> 16); }
DI float bf2f(u16 v) { return __uint_as_float(((unsigned)v) << 16); }
DI unsigned pack2(float a, float b) { return (unsigned)f2bf(a) | ((unsigned)f2bf(b) << 16); }
DI float wave_sum(float v) { for (int o = 32; o > 0; o >>= 1) v += __shfl_xor(v, o); return v; }
DI float gelu_tanh(float x) { float u = 0.7978845608028654f * (x + 0.044715f * x * x * x); float e = __expf(2.f * u); float th = 1.f - 2.f / (e + 1.f); return 0.5f * x * (1.f + th); }
DI float sigmoidf_(float x) { return 1.f / (1.f + __expf(-x)); }
#define MFMA32(a, b, c) __builtin_amdgcn_mfma_f32_32x32x16_bf16((a), (b), (c), 0, 0, 0)
#define MFMA16(a, b, c) __builtin_amdgcn_mfma_f32_16x16x32_bf16((a), (b), (c), 0, 0, 0)
DI bf16x8 ld8(const void* p) { return *(const bf16x8*)p; }
DI bf16x8 cat4(bf16x4 lo, bf16x4 hi) { return __builtin_shufflevector(lo, hi, 0, 1, 2, 3, 4, 5, 6, 7); }
DI bf16x8 pack8(float a0, float a1, float a2, float a3, float a4, float a5, float a6, float a7) {
    uint4 u; u.x = pack2(a0, a1); u.y = pack2(a2, a3); u.z = pack2(a4, a5); u.w = pack2(a6, a7);
    return __builtin_bit_cast(bf16x8, u);
}

template <class CM>
DI void transpose_tile(const float* __restrict__ src, int src_ld, u16* __restrict__ dst, int K, int n0, int k0, CM colmap, float* tl) {
    const int tid = threadIdx.x;
    {
        const int nn = tid & 63;
        const int sc = colmap(n0 + nn);
#pragma unroll
        for (int i = 0; i < 8; ++i) { const int kk = (tid >> 6) + 8 * i; tl[kk * 65 + nn] = src[(size_t)(k0 + kk) * src_ld + sc]; }
    }
    __syncthreads();
    {
        const int kk = tid & 63;
#pragma unroll
        for (int i = 0; i < 8; ++i) { const int nn = (tid >> 6) + 8 * i; dst[(size_t)(n0 + nn) * K + k0 + kk] = f2bf(tl[kk * 65 + nn]); }
    }
    __syncthreads();
}

DI void phase_prep(const Params& P, char* lds) {
    float* tl = (float*)lds;
    char* ws = P.ws;
    const int bid = blockIdx.x, nb = gridDim.x, tid = threadIdx.x;
    for (int j = bid; j < 2496; j += nb) {
        if (j < 1408) {
            const int l = j / 704, r = j % 704, nt = r / 16, kt = r % 16;
            transpose_tile(P.in[2] + (size_t)l * 1024 * INW, INW, (u16*)(ws + OFF_WINT) + (size_t)l * PROJW * 1024, 1024, nt * 64, kt * 64,
                           [](int n) { return n < 1024 ? n : n + 8; }, tl);
        } else if (j < 1920) {
            const int q = j - 1408; const int l = q / 256, r = q % 256, nt = r / 16, kt = r % 16;
            transpose_tile(P.in[22] + (size_t)l * 1024 * 1024, 1024, (u16*)(ws + OFF_WOUTT) + (size_t)l * 1024 * 1024, 1024, nt * 64, kt * 64, [](int n) { return n; }, tl);
        } else if (j < 2432) {
            const int q = j - 1920; const int l = q / 256, r = q % 256, nt = r / 16, kt = r % 16;
            transpose_tile(P.in[24] + (size_t)l * 1024 * 1024, 1024, (u16*)(ws + OFF_WQT) + (size_t)l * 1024 * 1024, 1024, nt * 64, kt * 64, [](int n) { return n; }, tl);
        } else {
            const int q = j - 2432; const int l = q / 32, r = q % 32, nt = r / 4, kt = r % 4;
            transpose_tile(P.in[15] + (size_t)l * 256 * 512, 512, (u16*)(ws + OFF_GLUT) + (size_t)l * 512 * 256, 256, nt * 64, kt * 64,
                           [](int n) { const int blk = n >> 6, wi = n & 63; return wi < 32 ? 32 * blk + wi : 256 + 32 * blk + (wi - 32); }, tl);
        }
    }
    const size_t gtid = (size_t)bid * NTHR + tid, gsz = (size_t)nb * NTHR;
    for (size_t i = gtid; i < (size_t)2 * 8 * 2 * 128 * 64; i += gsz) ((u16*)(ws + OFF_KEYS))[i] = f2bf(P.in[25][i]);
    for (size_t i = gtid; i < (size_t)2 * 8 * 1024; i += gsz) {
        const int l = (int)(i / 8192), j = (int)((i / 1024) % 8), k = (int)(i % 1024);
        ((float*)(ws + OFF_WAB))[i] = P.in[2][(size_t)l * 1024 * INW + (size_t)k * INW + 1024 + j];
    }
    {
        const size_t n16 = (size_t)2 * 16384 * 1024 / 16;
        for (size_t i = gtid; i < 2 * n16; i += gsz) {
            const bool isv = i >= n16; const size_t ii = isv ? i - n16 : i;
            const float4* s = (const float4*)(isv ? P.in[27] : P.in[26]) + ii * 4;
            const float sc = isv ? 8.f : 64.f;
            uint4 o; unsigned* op = (unsigned*)&o;
#pragma unroll
            for (int q = 0; q < 4; ++q) {
                const float4 v = s[q];
                int wv = __builtin_amdgcn_cvt_pk_fp8_f32(v.x * sc, v.y * sc, 0, false);
                wv = __builtin_amdgcn_cvt_pk_fp8_f32(v.z * sc, v.w * sc, wv, true);
                op[q] = (unsigned)wv;
            }
            ((uint4*)(ws + (isv ? OFF_VTAB : OFF_UTAB)))[ii] = o;
        }
    }
    for (size_t i = gtid; i < (size_t)2 * 16 * 64; i += gsz) {
        const int l = (int)(i / 1024), g = (int)((i / 64) % 16), n = (int)(i % 64);
        const float step = __expf(P.in[14][l * 16 + g]);
        const float lr = P.in[7][i], li = P.in[8][i];
        const float er = expf(lr * step); const float ar = er * cosf(li * step), ai = er * sinf(li * step);
        const float e64 = expf(64.f * lr * step); const float a64r = e64 * cosf(64.f * li * step), a64i = e64 * sinf(64.f * li * step);
        char* sp = ws + OFF_S5P + l * S5P_LAYER;
        ((float2*)(sp + S5P_ABAR))[g * 64 + n] = make_float2(ar, ai);
        ((float2*)(sp + S5P_A64))[g * 64 + n] = make_float2(a64r, a64i);
        const float xr = ar - 1.f, xi = ai; const float den = 1.f / (lr * lr + li * li);
        const float cr = (xr * lr + xi * li) * den, ci = (xi * lr - xr * li) * den;
        for (int c = 0; c < 16; ++c) {
            const float br = P.in[9][i * 16 + c], bi = P.in[10][i * 16 + c];
            ((float*)(sp + S5P_BRE))[(g * 64 + n) * 16 + c] = cr * br - ci * bi;
            ((float*)(sp + S5P_BIM))[(g * 64 + n) * 16 + c] = cr * bi + ci * br;
        }
    }
    for (size_t i = gtid; i < (size_t)2 * 16 * 16 * 128; i += gsz) {
        const int l = (int)(i / 32768), g = (int)((i / 2048) % 16), c = (int)((i / 128) % 16), k = (int)(i % 128);
        const size_t si = ((size_t)(l * 16 + g) * 16 + c) * 64 + (k & 63);
        const float v = k < 64 ? P.in[11][si] : -P.in[12][si];
        ((u16*)(ws + OFF_S5P + l * S5P_LAYER + S5P_CM))[(g * 16 + c) * 128 + k] = f2bf(v);
    }
    if (bid == 0 && tid < 2) {
        const int l = tid; float s1 = 0.f, s2 = 0.f;
        for (int d = 0; d < 64; ++d) { s1 += P.in[17][l * 64 + d] * P.in[18][l * 64 + d]; s2 += P.in[19][l * 64 + d] * P.in[20][l * 64 + d]; }
        const float lam_init = 0.8f - 0.6f * expf(-0.3f * (float)l);
        ((float*)(ws + OFF_SCAL))[l] = expf(s1) - expf(s2) + lam_init;
    }
}

DI void rms_token(const Params& P, int t, int lane, float4 (&v)[4], const float* gain, u16* dst, int ab_layer  ) {
    float ss = 0.f;
#pragma unroll
    for (int i = 0; i < 4; ++i) ss += v[i].x * v[i].x + v[i].y * v[i].y + v[i].z * v[i].z + v[i].w * v[i].w;
    ss = wave_sum(ss);
    const float rstd = rsqrtf(ss * (1.f / DM) + 1e-6f);
    const float4* g4 = (const float4*)gain;
#pragma unroll
    for (int i = 0; i < 4; ++i) {
        const float4 g = g4[lane + 64 * i];
        v[i].x *= rstd * g.x; v[i].y *= rstd * g.y; v[i].z *= rstd * g.z; v[i].w *= rstd * g.w;
        uint2 o; o.x = pack2(v[i].x, v[i].y); o.y = pack2(v[i].z, v[i].w);
        *(uint2*)(dst + (size_t)t * DM + (lane + 64 * i) * 4) = o;
    }
    if (ab_layer >= 0) {
        const float4* wab = (const float4*)(P.ws + OFF_WAB) + ab_layer * 8 * 256;
        float acc[8];
#pragma unroll
        for (int j = 0; j < 8; ++j) {
            float a = 0.f;
#pragma unroll
            for (int i = 0; i < 4; ++i) { const float4 w = wab[j * 256 + lane + 64 * i]; a += v[i].x * w.x + v[i].y * w.y + v[i].z * w.z + v[i].w * w.w; }
            acc[j] = wave_sum(a);
        }
        if (lane < 4) {
            const float a = lane == 0 ? acc[0] : lane == 1 ? acc[1] : lane == 2 ? acc[2] : acc[3];
            const float b = lane == 0 ? acc[4] : lane == 1 ? acc[5] : lane == 2 ? acc[6] : acc[7];
            const float xx = a + P.in[5][ab_layer * 4 + lane];
            const float sp = xx > 20.f ? xx : log1pf(__expf(xx));
            ((float*)(P.ws + OFF_GG))[t * 4 + lane] = -__expf(P.in[4][ab_layer * 4 + lane]) * sp;
            ((float*)(P.ws + OFF_BETA))[t * 4 + lane] = sigmoidf_(b);
        }
    }
}

DI void phase_rms(const Params& P, const float* src, const float* gain, u16* dst, int ab_layer) {
    const int w = threadIdx.x >> 6, lane = threadIdx.x & 63;
    for (int t = blockIdx.x * 8 + w; t < NT; t += gridDim.x * 8) {
        const float4* s4 = (const float4*)(src + (size_t)t * DM);
        float4 v[4];
#pragma unroll
        for (int i = 0; i < 4; ++i) v[i] = s4[lane + 64 * i];
        rms_token(P, t, lane, v, gain, dst, ab_layer);
    }
}

constexpr int GP = 40;
template <class Epi>
DI void gemm_tile(const u16* __restrict__ A, int lda, const u16* __restrict__ Bt, int ldb, int K, int m0, int n0, Epi& epi, char* lds) {
    const int tid = threadIdx.x, lane = tid & 63, w = tid >> 6;
    const int wm = w >> 2, wn = w & 3, r = lane & 31, hh = lane >> 5;
    u16* As = (u16*)lds;
    u16* Bs = As + 2 * 256 * GP;
    f32x16 acc[4][2];
#pragma unroll
    for (int i = 0; i < 4; ++i)
#pragma unroll
        for (int j = 0; j < 2; ++j)
#pragma unroll
            for (int e = 0; e < 16; ++e) acc[i][j][e] = 0.f;
    const int lrow = tid >> 2, lkc = tid & 3;
    const u16* ga0 = A + (size_t)(m0 + lrow) * lda + lkc * 8;
    const u16* ga1 = A + (size_t)(m0 + lrow + 128) * lda + lkc * 8;
    const u16* gb0 = Bt + (size_t)(n0 + lrow) * ldb + lkc * 8;
    const u16* gb1 = Bt + (size_t)(n0 + lrow + 128) * ldb + lkc * 8;
    const int so0 = lrow * GP + lkc * 8, so1 = (lrow + 128) * GP + lkc * 8;
    uint4 ra0 = *(const uint4*)ga0, ra1 = *(const uint4*)ga1, rb0 = *(const uint4*)gb0, rb1 = *(const uint4*)gb1;
    *(uint4*)(As + so0) = ra0; *(uint4*)(As + so1) = ra1; *(uint4*)(Bs + so0) = rb0; *(uint4*)(Bs + so1) = rb1;
    __syncthreads();
    const int nk = K / 32;
    for (int kt = 0; kt < nk; ++kt) {
        const int cur = kt & 1;
        if (kt + 1 < nk) {
            const int ko = (kt + 1) * 32;
            ra0 = *(const uint4*)(ga0 + ko); ra1 = *(const uint4*)(ga1 + ko); rb0 = *(const uint4*)(gb0 + ko); rb1 = *(const uint4*)(gb1 + ko);
        }
        const u16* Ac = As + cur * 256 * GP + (wm * 128 + r) * GP + hh * 8;
        const u16* Bc = Bs + cur * 256 * GP + (wn * 64 + r) * GP + hh * 8;
#pragma unroll
        for (int ks = 0; ks < 2; ++ks) {
            bf16x8 af[4], bfr[2];
#pragma unroll
            for (int i = 0; i < 4; ++i) af[i] = ld8(Ac + i * 32 * GP + ks * 16);
#pragma unroll
            for (int j = 0; j < 2; ++j) bfr[j] = ld8(Bc + j * 32 * GP + ks * 16);
#pragma unroll
            for (int i = 0; i < 4; ++i)
#pragma unroll
                for (int j = 0; j < 2; ++j) acc[i][j] = MFMA32(af[i], bfr[j], acc[i][j]);
        }
        if (kt + 1 < nk) {
            const int nx = (cur ^ 1) * 256 * GP;
            *(uint4*)(As + nx + so0) = ra0; *(uint4*)(As + nx + so1) = ra1; *(uint4*)(Bs + nx + so0) = rb0; *(uint4*)(Bs + nx + so1) = rb1;
        }
        __syncthreads();
    }
    epi(acc, m0 + wm * 128, n0 + wn * 64, r, hh);
}

struct EpiInProj {
    char* ws;
    DI void operator()(f32x16 (&acc)[4][2], int mw, int nw, int r, int hh) const {
        if (nw >= 2304) {
            u16* vt = (u16*)(ws + OFF_VT);
#pragma unroll
            for (int i = 0; i < 4; ++i)
#pragma unroll
                for (int j = 0; j < 2; ++j) {
                    const int c = nw - 2304 + 32 * j + r; const int head = c >> 7, dv = c & 127;
#pragma unroll
                    for (int q = 0; q < 4; ++q) {
                        const int row = mw + 32 * i + 8 * q + 4 * hh; const int b = row >> 13, l = row & 8191;
                        uint2 o; o.x = pack2(acc[i][j][4 * q], acc[i][j][4 * q + 1]); o.y = pack2(acc[i][j][4 * q + 2], acc[i][j][4 * q + 3]);
                        *(uint2*)(vt + ((size_t)((b * 4 + head) * 128 + dv)) * SEQ + l) = o;
                    }
                }
            return;
        }
        u16* base; int pitch, c0; float sc = 1.f;
        if (nw < 768) { base = (u16*)(ws + OFF_QKV); pitch = 768; c0 = nw; }
        else if (nw < 1024) { base = (u16*)(ws + OFF_Z); pitch = 256; c0 = nw - 768; }
        else if (nw < 1280) { base = (u16*)(ws + OFF_US); pitch = 256; c0 = nw - 1024; }
        else if (nw < 1792) { base = (u16*)(ws + OFF_QC); pitch = 512; c0 = nw - 1280; sc = 0.125f * LOG2E; }
        else { base = (u16*)(ws + OFF_KC); pitch = 512; c0 = nw - 1792; }
#pragma unroll
        for (int i = 0; i < 4; ++i)
#pragma unroll
            for (int j = 0; j < 2; ++j)
#pragma unroll
                for (int e = 0; e < 16; ++e) {
                    const int row = mw + 32 * i + (e & 3) + 8 * (e >> 2) + 4 * hh;
                    base[(size_t)row * pitch + c0 + 32 * j + r] = f2bf(acc[i][j][e] * sc);
                }
    }
};
struct EpiResidual {
    const float* hin; float* hout;
    DI void operator()(f32x16 (&acc)[4][2], int mw, int nw, int r, int hh) const {
#pragma unroll
        for (int i = 0; i < 4; ++i)
#pragma unroll
            for (int j = 0; j < 2; ++j)
#pragma unroll
                for (int e = 0; e < 16; ++e) {
                    const size_t idx = (size_t)(mw + 32 * i + (e & 3) + 8 * (e >> 2) + 4 * hh) * DM + nw + 32 * j + r;
                    hout[idx] = hin[idx] + acc[i][j][e];
                }
    }
};
struct EpiBf16 {
    u16* dst; int pitch;
    DI void operator()(f32x16 (&acc)[4][2], int mw, int nw, int r, int hh) const {
#pragma unroll
        for (int i = 0; i < 4; ++i)
#pragma unroll
            for (int j = 0; j < 2; ++j)
#pragma unroll
                for (int e = 0; e < 16; ++e)
                    dst[(size_t)(mw + 32 * i + (e & 3) + 8 * (e >> 2) + 4 * hh) * pitch + nw + 32 * j + r] = f2bf(acc[i][j][e]);
    }
};
struct EpiGlu {
    u16* mix; const float* bias;
    DI void operator()(f32x16 (&acc)[4][2], int mw, int nw, int r, int hh) const {
        const int col = 32 * (nw >> 6) + r;
        const float bv = bias[col], bg = bias[256 + col];
#pragma unroll
        for (int i = 0; i < 4; ++i)
#pragma unroll
            for (int e = 0; e < 16; ++e) {
                const int row = mw + 32 * i + (e & 3) + 8 * (e >> 2) + 4 * hh;
                const float val = acc[i][0][e] + bv, gate = acc[i][1][e] + bg;
                mix[(size_t)row * DM + 256 + col] = f2bf(val * sigmoidf_(gate));
            }
    }
};

template <class Epi>
DI void phase_gemm(const u16* A, int lda, const u16* Bt, int ldb, int M, int N, int K, Epi epi, char* lds) {
    const int ntn = N / 256, ntm = M / 256;
    for (int t = blockIdx.x; t < ntn * ntm; t += gridDim.x) {
        const int mt = t / ntn, nt = t % ntn;
        gemm_tile(A, lda, Bt, ldb, K, mt * 256, nt * 256, epi, lds);
    }
}

DI void gdn_prep_item(const Params& P, int layer, int item, char* lds) {
    const int tid = threadIdx.x, lane = tid & 63, w = tid >> 6;
    const int b = item >> 9, head = (item >> 7) & 3, ch = item & 127;
    const int t0 = b * SEQ + ch * 64;
    u16* raw = (u16*)lds;
    float* qs = (float*)(lds + 25856);
    float* ks = qs + 64 * 68;
    float* vs = ks + 64 * 68;
    float* Ls = vs + 64 * 68;
    u16* qb = (u16*)(Ls + 64 * 68);
    u16* kb = qb + 64 * 72;
    float* Gs = (float*)(kb + 64 * 72);
    float* bs = Gs + 64;
    float* rn = bs + 64;
    const u16* qkv = (const u16*)(P.ws + OFF_QKV);
    for (int i = tid; i < 67 * 24; i += NTHR) {
        const int row = i / 24, c8 = i % 24; const int part = c8 >> 3, cc = (c8 & 7) * 8;
        const int l = ch * 64 + row - 3;
        uint4 v = make_uint4(0, 0, 0, 0);
        if (l >= 0) v = *(const uint4*)(qkv + (size_t)(b * SEQ + l) * 768 + part * 256 + head * 64 + cc);
        *(uint4*)(raw + row * 192 + part * 64 + cc) = v;
    }
    if (tid < 64) { bs[tid] = ((const float*)(P.ws + OFF_BETA))[(t0 + tid) * 4 + head]; Gs[tid] = ((const float*)(P.ws + OFF_GG))[(t0 + tid) * 4 + head]; }
    __syncthreads();
    {
        const float* cw = P.in[3] + (size_t)layer * 4 * 768;
        for (int i = tid; i < 64 * 192; i += NTHR) {
            const int t = i / 192, c = i % 192; const int part = c >> 6, d = c & 63; const int gc = part * 256 + head * 64 + d;
            float a = 0.f;
#pragma unroll
            for (int j = 0; j < 4; ++j) a += cw[j * 768 + gc] * bf2f(raw[(t + j) * 192 + c]);
            a = a * sigmoidf_(a);
            (part == 0 ? qs : part == 1 ? ks : vs)[t * 68 + d] = a;
        }
    }
    if (tid == 0) { float g = 0.f; for (int i = 0; i < 64; ++i) { g += Gs[i]; Gs[i] = g; } }
    __syncthreads();
    if (tid < 128) {
        const float* s = (tid < 64 ? qs : ks) + (tid & 63) * 68; float ss = 0.f;
        for (int d = 0; d < 64; ++d) ss += s[d] * s[d];
        rn[tid] = rsqrtf(ss + 1e-6f) * (tid < 64 ? 0.125f : 1.f);
    }
    __syncthreads();
    for (int i = tid; i < 2 * 64 * 64; i += NTHR) {
        const int which = i >> 12, t = (i >> 6) & 63, d = i & 63;
        float* s = which ? ks : qs; const float v = s[t * 68 + d] * rn[which * 64 + t];
        s[t * 68 + d] = v; (which ? kb : qb)[t * 72 + d] = f2bf(v);
    }
    __syncthreads();
    u16* rec = (u16*)(P.ws + OFF_GREC + (size_t)item * GREC_BYTES);
    {
        const int r = lane & 31, hh = lane >> 5; const int bi = (w >> 1) & 1, bj = w & 1; const bool isqk = w >= 4;
        const u16* Am = (isqk ? qb : kb) + (bi * 32 + r) * 72 + hh * 8;
        const u16* Bm = kb + (bj * 32 + r) * 72 + hh * 8;
        f32x16 acc;
#pragma unroll
        for (int e = 0; e < 16; ++e) acc[e] = 0.f;
#pragma unroll
        for (int s = 0; s < 4; ++s) acc = MFMA32(ld8(Am + s * 16), ld8(Bm + s * 16), acc);
        const int j = bj * 32 + r; const float Gj = Gs[j];
#pragma unroll
        for (int e = 0; e < 16; ++e) {
            const int i = bi * 32 + (e & 3) + 8 * (e >> 2) + 4 * hh;
            const float dec = __expf(Gs[i] - Gj);
            if (isqk) rec[2 * 4096 + i * 64 + j] = f2bf(j <= i ? acc[e] * dec : 0.f);
            else Ls[i * 68 + j] = (j < i) ? bs[i] * acc[e] * dec : 0.f;
        }
    }
    __syncthreads();
    {
        const float Gl = Gs[63];
        for (int i = tid; i < 2 * 4096; i += NTHR) {
            const int which = i >> 12, a = (i >> 6) & 63, bq = i & 63;
            if (which == 0) rec[3 * 4096 + a * 64 + bq] = f2bf(qs[a * 68 + bq] * __expf(Gs[a]));
            else rec[4 * 4096 + a * 64 + bq] = f2bf(ks[bq * 68 + a] * __expf(Gl - Gs[bq]));
        }
        if (tid == 0) ((float*)(P.ws + OFF_EGL))[item] = __expf(Gl);
    }
    float* Xs = rn + 128;
    for (int i = tid; i < 64 * 130; i += NTHR) Xs[i] = 0.f;
    __syncthreads();
    {
        const int c = tid >> 2, q = tid & 3;
        const bool isw = c >= 64; const int cc = c & 63;
        for (int i = 0; i < 64; ++i) {
            const float bi = bs[i];
            const float rhs = isw ? ks[i * 68 + cc] * bi * __expf(Gs[i]) : vs[i * 68 + cc] * bi;
            const float4* Lr = (const float4*)(Ls + i * 68);
            float sacc = 0.f;
#pragma unroll
            for (int mq = 0; mq < 4; ++mq) {
                const int j4 = q + 4 * mq;
                const float4 l4 = Lr[j4];
                const float* xp = Xs + (4 * j4) * 130 + c;
                sacc += l4.x * xp[0] + l4.y * xp[130] + l4.z * xp[260] + l4.w * xp[390];
            }
            sacc += __shfl_xor(sacc, 1); sacc += __shfl_xor(sacc, 2);
            if (q == 0) Xs[i * 130 + c] = rhs - sacc;
        }
    }
    __syncthreads();
    for (int i = tid; i < 2 * 4096; i += NTHR) {
        const int which = i >> 12, t = (i >> 6) & 63, d = i & 63;
        rec[which * 4096 + t * 64 + d] = f2bf(Xs[t * 130 + which * 64 + d]);
    }
    __syncthreads();
}

constexpr int RP = 72;
DI void gdn_scan_chain(const Params& P, int chain, char* lds) {
    const int tid = threadIdx.x, lane = tid & 63, w = tid >> 6;
    const int b = chain >> 2, head = chain & 3;
    u16* buf0 = (u16*)lds;
    u16* buf1 = buf0 + 320 * RP;
    const char* recbase = P.ws + OFF_GREC + (size_t)(chain * 128) * GREC_BYTES;
    const float* egl = (const float*)(P.ws + OFF_EGL) + chain * 128;
    float* gout = (float*)(P.ws + OFF_GDNO);
    uint4 rg0, rg1, rg2, rg3, rg4;
#define SCAN_ISSUE(c_) do { const uint4* src_ = (const uint4*)(recbase + (size_t)(c_) * GREC_BYTES) + tid; \
        rg0 = src_[0]; rg1 = src_[NTHR]; rg2 = src_[2 * NTHR]; rg3 = src_[3 * NTHR]; rg4 = src_[4 * NTHR]; } while (0)
#define SCAN_PUT(buf_, i_, v_) do { const int id_ = tid + NTHR * (i_); *(uint4*)((buf_) + (id_ >> 3) * RP + (id_ & 7) * 8) = (v_); } while (0)
#define SCAN_COMMIT(buf_) do { SCAN_PUT(buf_, 0, rg0); SCAN_PUT(buf_, 1, rg1); SCAN_PUT(buf_, 2, rg2); SCAN_PUT(buf_, 3, rg3); SCAN_PUT(buf_, 4, rg4); } while (0)
    f32x4 S[4];
#pragma unroll
    for (int m = 0; m < 4; ++m) S[m] = (f32x4){0.f, 0.f, 0.f, 0.f};
    const int r16 = lane & 15, g = lane >> 4;
    SCAN_ISSUE(0); SCAN_COMMIT(buf0);
    __syncthreads();
    for (int c = 0; c < 128; ++c) {
        u16* cur = (c & 1) ? buf1 : buf0; u16* nxt = (c & 1) ? buf0 : buf1;
        if (c + 1 < 128) SCAN_ISSUE(c + 1);
        if (w < 4) {
            const float dec = egl[c];
            const u16* Ub = cur;
            const u16* Wb = cur + 64 * RP;
            const u16* QKb = cur + 128 * RP;
            const u16* QGb = cur + 192 * RP;
            const u16* KDb = cur + 256 * RP;
            bf16x8 Sb[2];
#pragma unroll
            for (int s = 0; s < 2; ++s) Sb[s] = pack8(S[2 * s][0], S[2 * s][1], S[2 * s][2], S[2 * s][3], S[2 * s + 1][0], S[2 * s + 1][1], S[2 * s + 1][2], S[2 * s + 1][3]);
            f32x4 vn[4], o[4];
#pragma unroll
            for (int mb = 0; mb < 4; ++mb) {
                f32x4 a = (f32x4){0.f, 0.f, 0.f, 0.f}, oo = (f32x4){0.f, 0.f, 0.f, 0.f};
#pragma unroll
                for (int s = 0; s < 2; ++s) {
                    const u16* pw = Wb + (16 * mb + r16) * RP + 32 * s + 4 * g;
                    const u16* pq = QGb + (16 * mb + r16) * RP + 32 * s + 4 * g;
                    a = MFMA16(cat4(*(const bf16x4*)pw, *(const bf16x4*)(pw + 16)), Sb[s], a);
                    oo = MFMA16(cat4(*(const bf16x4*)pq, *(const bf16x4*)(pq + 16)), Sb[s], oo);
                }
#pragma unroll
                for (int e = 0; e < 4; ++e) vn[mb][e] = bf2f(Ub[(16 * mb + 4 * g + e) * RP + 16 * w + r16]) - a[e];
                o[mb] = oo;
            }
            bf16x8 Vb[2];
#pragma unroll
            for (int s = 0; s < 2; ++s) Vb[s] = pack8(vn[2 * s][0], vn[2 * s][1], vn[2 * s][2], vn[2 * s][3], vn[2 * s + 1][0], vn[2 * s + 1][1], vn[2 * s + 1][2], vn[2 * s + 1][3]);
#pragma unroll
            for (int mb = 0; mb < 4; ++mb) {
                f32x4 oo = o[mb];
                f32x4 sn = S[mb] * dec;
#pragma unroll
                for (int s = 0; s < 2; ++s) {
                    const u16* pk = QKb + (16 * mb + r16) * RP + 32 * s + 4 * g;
                    const u16* pd = KDb + (16 * mb + r16) * RP + 32 * s + 4 * g;
                    oo = MFMA16(cat4(*(const bf16x4*)pk, *(const bf16x4*)(pk + 16)), Vb[s], oo);
                    sn = MFMA16(cat4(*(const bf16x4*)pd, *(const bf16x4*)(pd + 16)), Vb[s], sn);
                }
                S[mb] = sn;
#pragma unroll
                for (int e = 0; e < 4; ++e)
                    gout[(size_t)(b * SEQ + c * 64 + 16 * mb + 4 * g + e) * 256 + head * 64 + 16 * w + r16] = oo[e];
            }
        }
        if (c + 1 < 128) SCAN_COMMIT(nxt);
        __syncthreads();
    }
}

DI void phase_gdn_norm(const Params& P, int layer) {
    const int w = threadIdx.x >> 6, lane = threadIdx.x & 63;
    const float* gout = (const float*)(P.ws + OFF_GDNO);
    const u16* z = (const u16*)(P.ws + OFF_Z);
    u16* mix = (u16*)(P.ws + OFF_ABUF);
    const float4 ng = ((const float4*)(P.in[6] + layer * 64))[lane & 15];
    for (int t = blockIdx.x * 8 + w; t < NT; t += gridDim.x * 8) {
        const float4 o = ((const float4*)(gout + (size_t)t * 256))[lane];
        float ss = o.x * o.x + o.y * o.y + o.z * o.z + o.w * o.w;
        ss += __shfl_xor(ss, 1); ss += __shfl_xor(ss, 2); ss += __shfl_xor(ss, 4); ss += __shfl_xor(ss, 8);
        const float rstd = rsqrtf(ss * (1.f / 64.f) + 1e-6f);
        const uint2 zz = *(const uint2*)(z + (size_t)t * 256 + lane * 4);
        const float z0 = bf2f((u16)(zz.x & 0xffff)), z1 = bf2f((u16)(zz.x >> 16)), z2 = bf2f((u16)(zz.y & 0xffff)), z3 = bf2f((u16)(zz.y >> 16));
        uint2 r;
        r.x = pack2(o.x * rstd * ng.x * z0 * sigmoidf_(z0), o.y * rstd * ng.y * z1 * sigmoidf_(z1));
        r.y = pack2(o.z * rstd * ng.z * z2 * sigmoidf_(z2), o.w * rstd * ng.w * z3 * sigmoidf_(z3));
        *(uint2*)(mix + (size_t)t * DM + lane * 4) = r;
    }
}

template <bool FINAL>
DI void s5_item(const Params& P, int layer, int item, char* wlds, int lane) {
    const int b = item >> 11, g = (item >> 7) & 15, ch = item & 127;
    const int t0 = b * SEQ + ch * 64;
    const char* sp = P.ws + OFF_S5P + layer * S5P_LAYER;
    float* ut = (float*)wlds;
    u16* Xs = (u16*)(wlds + 4096);
    {
        const u16* src = (const u16*)(P.ws + OFF_US) + (size_t)(t0 + lane) * 256 + g * 16;
        const uint4 a = *(const uint4*)src, c = *(const uint4*)(src + 8);
        const unsigned uu[8] = {a.x, a.y, a.z, a.w, c.x, c.y, c.z, c.w};
#pragma unroll
        for (int i = 0; i < 8; ++i) { ut[lane * 16 + 2 * i] = bf2f((u16)(uu[i] & 0xffff)); ut[lane * 16 + 2 * i + 1] = bf2f((u16)(uu[i] >> 16)); }
    }
    float Br[16], Bi[16];
    {
        const float4* br = (const float4*)(sp + S5P_BRE) + (g * 64 + lane) * 4; const float4* bi = (const float4*)(sp + S5P_BIM) + (g * 64 + lane) * 4;
#pragma unroll
        for (int i = 0; i < 4; ++i) { const float4 x = br[i], y = bi[i]; Br[4 * i] = x.x; Br[4 * i + 1] = x.y; Br[4 * i + 2] = x.z; Br[4 * i + 3] = x.w; Bi[4 * i] = y.x; Bi[4 * i + 1] = y.y; Bi[4 * i + 2] = y.z; Bi[4 * i + 3] = y.w; }
    }
    const float2 ab = ((const float2*)(sp + S5P_ABAR))[g * 64 + lane];
    float2* st = (float2*)(P.ws + OFF_S5ST) + (size_t)item * 64 + lane;
    float xr = 0.f, xi = 0.f;
    if (FINAL) { const float2 c0 = *st; xr = c0.x; xi = c0.y; }
    bf16x8 cf[4];
    if (FINAL) {
        const u16* cm = (const u16*)(sp + S5P_CM) + (g * 16 + (lane & 15)) * 128 + 8 * (lane >> 4);
#pragma unroll
        for (int s = 0; s < 4; ++s) cf[s] = ld8(cm + 32 * s);
    }
    __builtin_amdgcn_wave_barrier();
    asm volatile("s_waitcnt lgkmcnt(0)" ::: "memory");
    for (int half = 0; half < 2; ++half) {
        for (int tt = 0; tt < 32; ++tt) {
            const int t = half * 32 + tt;
            const float4* u4 = (const float4*)(ut + t * 16);
            float br_ = 0.f, bi_ = 0.f;
#pragma unroll
            for (int q = 0; q < 4; ++q) {
                const float4 u = u4[q];
                br_ += Br[4 * q] * u.x + Br[4 * q + 1] * u.y + Br[4 * q + 2] * u.z + Br[4 * q + 3] * u.w;
                bi_ += Bi[4 * q] * u.x + Bi[4 * q + 1] * u.y + Bi[4 * q + 2] * u.z + Bi[4 * q + 3] * u.w;
            }
            const float nr = ab.x * xr - ab.y * xi + br_, ni = ab.x * xi + ab.y * xr + bi_;
            xr = nr; xi = ni;
            if (FINAL) { Xs[tt * 136 + lane] = f2bf(xr); Xs[tt * 136 + 64 + lane] = f2bf(xi); }
        }
        if (FINAL) {
            asm volatile("s_waitcnt lgkmcnt(0)" ::: "memory");
            __builtin_amdgcn_wave_barrier();
            const int r16 = lane & 15, gg = lane >> 4;
            const float dsv = P.in[13][layer * 256 + g * 16 + r16];
#pragma unroll
            for (int mb = 0; mb < 2; ++mb) {
                f32x4 acc = (f32x4){0.f, 0.f, 0.f, 0.f};
#pragma unroll
                for (int s = 0; s < 4; ++s) acc = MFMA16(ld8(Xs + (16 * mb + r16) * 136 + 32 * s + 8 * gg), cf[s], acc);
#pragma unroll
                for (int e = 0; e < 4; ++e) {
                    const int tk = half * 32 + 16 * mb + 4 * gg + e;
                    const float y = acc[e] + dsv * ut[tk * 16 + r16];
                    ((u16*)(P.ws + OFF_YS5))[(size_t)(t0 + tk) * 256 + g * 16 + r16] = f2bf(gelu_tanh(y));
                }
            }
            asm volatile("s_waitcnt lgkmcnt(0)" ::: "memory");
            __builtin_amdgcn_wave_barrier();
        }
    }
    if (!FINAL) *st = make_float2(xr, xi);
    asm volatile("s_waitcnt lgkmcnt(0)" ::: "memory");
    __builtin_amdgcn_wave_barrier();
}
template <bool FINAL>
DI void phase_s5(const Params& P, int layer, char* lds) {
    const int w = threadIdx.x >> 6, lane = threadIdx.x & 63;
    char* wl = lds + w * 12800;
    for (int it = blockIdx.x * 8 + w; it < 8192; it += gridDim.x * 8) s5_item<FINAL>(P, layer, it, wl, lane);
}
constexpr int KP = 136;
constexpr int VP = 68;
constexpr int ATT_STAGE = 64 * KP + 128 * VP;
DI void attn_item(const Params& P, int layer, int b, int head, int qb, char* lds) {
    const int tid = threadIdx.x, lane = tid & 63, w = tid >> 6;
    const int m = w >> 2, wq = w & 3, r = lane & 31, hh = lane >> 5;
    u16* st0 = (u16*)lds;
    const u16* QC = (const u16*)(P.ws + OFF_QC);
    const u16* KC = (const u16*)(P.ws + OFF_KC);
    const u16* VT = (const u16*)(P.ws + OFF_VT);
    const int qw0 = qb * 128 + 32 * wq;
    const int q = qw0 + r;
    bf16x8 qf[4];
    {
        const u16* qp = QC + (size_t)(b * SEQ + q) * 512 + head * 128 + m * 64 + hh * 8;
#pragma unroll
        for (int s = 0; s < 4; ++s) qf[s] = ld8(qp + 16 * s);
    }
    f32x16 o[4];
#pragma unroll
    for (int d = 0; d < 4; ++d)
#pragma unroll
        for (int e = 0; e < 16; ++e) o[d][e] = 0.f;
    float mrun = -INFINITY, lrun = 0.f;
    const int nkv = 2 * (qb + 1);
    const int kkey = tid >> 4, kch = tid & 15;
    const int vdv = tid >> 3, vch = tid & 7;
    const u16* kg = KC + (size_t)(b * SEQ + kkey) * 512 + head * 128 + kch * 8;
    const u16* vg = VT + ((size_t)((b * 4 + head) * 128 + vdv)) * SEQ + vch * 8;
    uint4 rk0, rk1, rv0, rv1;
#define ATT_ISSUE(j_) do { rk0 = *(const uint4*)(kg + (size_t)(64 * (j_)) * 512); rk1 = *(const uint4*)(kg + (size_t)(64 * (j_) + 32) * 512); \
        rv0 = *(const uint4*)(vg + 64 * (j_)); rv1 = *(const uint4*)(vg + (size_t)64 * SEQ + 64 * (j_)); } while (0)
#define ATT_COMMIT(stg_) do { u16* sg_ = (stg_); *(uint4*)(sg_ + kkey * KP + kch * 8) = rk0; *(uint4*)(sg_ + (kkey + 32) * KP + kch * 8) = rk1; \
        u16* vb_ = sg_ + 64 * KP; \
        *(uint2*)(vb_ + vdv * VP + vch * 8) = make_uint2(rv0.x, rv0.y); *(uint2*)(vb_ + vdv * VP + vch * 8 + 4) = make_uint2(rv0.z, rv0.w); \
        *(uint2*)(vb_ + (vdv + 64) * VP + vch * 8) = make_uint2(rv1.x, rv1.y); *(uint2*)(vb_ + (vdv + 64) * VP + vch * 8 + 4) = make_uint2(rv1.z, rv1.w); } while (0)
    ATT_ISSUE(0); ATT_COMMIT(st0);
    __syncthreads();
    for (int j = 0; j < nkv; ++j) {
        u16* cur = st0 + (j & 1) * ATT_STAGE; u16* nxt = st0 + ((j & 1) ^ 1) * ATT_STAGE;
        if (j + 1 < nkv) ATT_ISSUE(j + 1);
        if (64 * j <= qw0 + 31) {
            f32x16 s0, s1;
#pragma unroll
            for (int e = 0; e < 16; ++e) { s0[e] = 0.f; s1[e] = 0.f; }
            const u16* kp = cur + r * KP + m * 64 + hh * 8;
#pragma unroll
            for (int s = 0; s < 4; ++s) {
                s0 = MFMA32(ld8(kp + 16 * s), qf[s], s0);
                s1 = MFMA32(ld8(kp + 32 * KP + 16 * s), qf[s], s1);
            }
            if (64 * j + 63 > qw0) {
#pragma unroll
                for (int e = 0; e < 16; ++e) {
                    const int key = 64 * j + (e & 3) + 8 * (e >> 2) + 4 * hh;
                    if (key > q) s0[e] = -INFINITY;
                    if (key + 32 > q) s1[e] = -INFINITY;
                }
            }
            float mx = s0[0];
#pragma unroll
            for (int e = 1; e < 16; ++e) mx = fmaxf(mx, s0[e]);
#pragma unroll
            for (int e = 0; e < 16; ++e) mx = fmaxf(mx, s1[e]);
            mx = fmaxf(mx, __shfl_xor(mx, 32));
            const float mnew = fmaxf(mrun, mx);
            const float alpha = __builtin_amdgcn_exp2f(mrun - mnew);
            mrun = mnew;
            float psum = 0.f;
#pragma unroll
            for (int e = 0; e < 16; ++e) { s0[e] = __builtin_amdgcn_exp2f(s0[e] - mnew); psum += s0[e]; }
#pragma unroll
            for (int e = 0; e < 16; ++e) { s1[e] = __builtin_amdgcn_exp2f(s1[e] - mnew); psum += s1[e]; }
            lrun = lrun * alpha + psum;
#pragma unroll
            for (int d = 0; d < 4; ++d) o[d] = o[d] * alpha;
            bf16x8 pf[4];
            pf[0] = pack8(s0[0], s0[1], s0[2], s0[3], s0[4], s0[5], s0[6], s0[7]);
            pf[1] = pack8(s0[8], s0[9], s0[10], s0[11], s0[12], s0[13], s0[14], s0[15]);
            pf[2] = pack8(s1[0], s1[1], s1[2], s1[3], s1[4], s1[5], s1[6], s1[7]);
            pf[3] = pack8(s1[8], s1[9], s1[10], s1[11], s1[12], s1[13], s1[14], s1[15]);
            const u16* vp = cur + 64 * KP + r * VP + 4 * hh;
#pragma unroll
            for (int d = 0; d < 4; ++d)
#pragma unroll
                for (int kk = 0; kk < 4; ++kk) {
                    const u16* pa = vp + d * 32 * VP + 16 * kk;
                    o[d] = MFMA32(cat4(*(const bf16x4*)pa, *(const bf16x4*)(pa + 8)), pf[kk], o[d]);
                }
        }
        if (j + 1 < nkv) ATT_COMMIT(nxt);
        __syncthreads();
    }
    const float ltot = lrun + __shfl_xor(lrun, 32);
    const float inv = 1.f / ltot;
    float* ex = (float*)lds;
    if (m == 1) {
#pragma unroll
        for (int d = 0; d < 4; ++d)
#pragma unroll
            for (int e = 0; e < 16; ++e) ex[(wq * 64 + d * 16 + e) * 64 + lane] = o[d][e] * inv;
    }
    __syncthreads();
    if (m == 0) {
        const float lam = ((const float*)(P.ws + OFF_SCAL))[layer];
        const float lam_init = 0.8f - 0.6f * __expf(-0.3f * (float)layer);
        float ss = 0.f;
#pragma unroll
        for (int d = 0; d < 4; ++d)
#pragma unroll
            for (int e = 0; e < 16; ++e) { const float v = o[d][e] * inv - lam * ex[(wq * 64 + d * 16 + e) * 64 + lane]; o[d][e] = v; ss += v * v; }
        ss += __shfl_xor(ss, 32);
        const float sc = rsqrtf(ss * (1.f / 128.f) + 1e-6f) * (1.f - lam_init);
        const float* ng = P.in[21] + layer * 128;
        u16* mix = (u16*)(P.ws + OFF_ABUF) + (size_t)(b * SEQ + q) * DM + 512 + head * 128;
#pragma unroll
        for (int d = 0; d < 4; ++d)
#pragma unroll
            for (int qd = 0; qd < 4; ++qd) {
                const int dv0 = 32 * d + 8 * qd + 4 * hh;
                const float4 g4 = *(const float4*)(ng + dv0);
                uint2 pk; pk.x = pack2(o[d][4 * qd] * sc * g4.x, o[d][4 * qd + 1] * sc * g4.y); pk.y = pack2(o[d][4 * qd + 2] * sc * g4.z, o[d][4 * qd + 3] * sc * g4.w);
                *(uint2*)(mix + dv0) = pk;
            }
    }
    __syncthreads();
}
DI void phase_attn(const Params& P, int layer, char* lds) {
    for (int pi = blockIdx.x; pi < 512; pi += gridDim.x) {
        const int bh = pi >> 5, i = pi & 31;
        attn_item(P, layer, bh >> 2, bh & 3, 63 - i, lds);
        attn_item(P, layer, bh >> 2, bh & 3, i, lds);
    }
}

DI void ins16(float (&top)[16], float v) {
#pragma unroll
    for (int k = 0; k < 16; ++k) { const float hi = fmaxf(top[k], v); v = fminf(top[k], v); top[k] = hi; }
}
DI void phase_topk(const Params& P, int layer) {
    const int w = threadIdx.x >> 6, lane = threadIdx.x & 63, r = lane & 31, hh = lane >> 5;
    const u16* PQ = (const u16*)(P.ws + OFF_PQ);
    const u16* KEYS = (const u16*)(P.ws + OFF_KEYS) + (size_t)layer * 8 * 2 * 128 * 64;
    u16* pe = (u16*)(P.ws + OFF_PICKE); float* pg = (float*)(P.ws + OFF_PICKG);
    for (int it = blockIdx.x * 8 + w; it < 8192; it += gridDim.x * 8) {
        const int tile = it >> 3, h = it & 7; const int tok = tile * 32 + r;
        float sv[2][16];
#pragma unroll
        for (int p = 0; p < 2; ++p) {
            bf16x8 bq[4];
            const u16* qp = PQ + (size_t)tok * 1024 + h * 128 + p * 64 + hh * 8;
#pragma unroll
            for (int s = 0; s < 4; ++s) bq[s] = ld8(qp + 16 * s);
            float top[16];
#pragma unroll
            for (int k = 0; k < 16; ++k) top[k] = -INFINITY;
#pragma unroll 1
            for (int kb = 0; kb < 4; ++kb) {
                f32x16 acc;
#pragma unroll
                for (int e = 0; e < 16; ++e) acc[e] = 0.f;
                const u16* kp = KEYS + ((size_t)((h * 2 + p) * 128 + 32 * kb + r)) * 64 + hh * 8;
#pragma unroll
                for (int s = 0; s < 4; ++s) acc = MFMA32(ld8(kp + 16 * s), bq[s], acc);
#pragma unroll
                for (int e = 0; e < 16; ++e) {
                    const unsigned key = 32 * kb + (e & 3) + 8 * (e >> 2) + 4 * hh;
                    ins16(top, __uint_as_float((__float_as_uint(acc[e]) & ~0x7Fu) | key));
                }
            }
            float oth[16];
#pragma unroll
            for (int k = 0; k < 16; ++k) oth[k] = __shfl_xor(top[k], 32);
#pragma unroll
            for (int k = 0; k < 16; ++k) ins16(top, oth[k]);
#pragma unroll
            for (int k = 0; k < 16; ++k) sv[p][k] = top[k];
        }
        float top[16];
#pragma unroll
        for (int k = 0; k < 16; ++k) top[k] = -INFINITY;
#pragma unroll
        for (int i = 0; i < 16; ++i)
#pragma unroll
            for (int j = 0; j < 16; ++j)
                if ((i + 1) * (j + 1) <= 16) {
                    const float s = __uint_as_float(__float_as_uint(sv[0][i]) & ~0x7Fu) + __uint_as_float(__float_as_uint(sv[1][j]) & ~0x7Fu);
                    ins16(top, __uint_as_float((__float_as_uint(s) & ~0xFFu) | (unsigned)(i * 16 + j)));
                }
        float ev[16]; float den = 0.f;
        const float mx = __uint_as_float(__float_as_uint(top[0]) & ~0xFFu);
#pragma unroll
        for (int k = 0; k < 16; ++k) { ev[k] = __expf(__uint_as_float(__float_as_uint(top[k]) & ~0xFFu) - mx); den += ev[k]; }
        const float rden = 1.f / den;
#pragma unroll
        for (int k = 0; k < 16; ++k) {
            const unsigned code = __float_as_uint(top[k]) & 0xFFu; const unsigned wi = code >> 4, wj = code & 15u;
            unsigned i0 = 0, i1 = 0;
#pragma unroll
            for (int i = 0; i < 16; ++i) { i0 = (wi == (unsigned)i) ? (__float_as_uint(sv[0][i]) & 0x7Fu) : i0; i1 = (wj == (unsigned)i) ? (__float_as_uint(sv[1][i]) & 0x7Fu) : i1; }
            if ((k >> 3) == hh) {
                pe[(size_t)tok * 128 + h * 16 + k] = (u16)(i0 * 128 + i1);
                pg[(size_t)tok * 128 + h * 16 + k] = ev[k] * rden;
            }
        }
    }
}

DI void fp8x16_to_f32(const uint4& u, float (&f)[16]) {
    const unsigned uu[4] = {u.x, u.y, u.z, u.w};
#pragma unroll
    for (int q = 0; q < 4; ++q) {
        const f32x2 lo = __builtin_amdgcn_cvt_pk_f32_fp8((int)uu[q], false), hi = __builtin_amdgcn_cvt_pk_f32_fp8((int)uu[q], true);
        f[4 * q] = lo[0]; f[4 * q + 1] = lo[1]; f[4 * q + 2] = hi[0]; f[4 * q + 3] = hi[1];
    }
}
DI void phase_peer(const Params& P, int layer, const float* hin, float* hout, bool last) {
    const int w = threadIdx.x >> 6, lane = threadIdx.x & 63;
    const uint8_t* UT = (const uint8_t*)(P.ws + OFF_UTAB) + (size_t)layer * 16384 * 1024;
    const uint8_t* VTb = (const uint8_t*)(P.ws + OFF_VTAB) + (size_t)layer * 16384 * 1024;
    const u16* pe = (const u16*)(P.ws + OFF_PICKE); const float* pg = (const float*)(P.ws + OFF_PICKG);
    u16* abuf = (u16*)(P.ws + OFF_ABUF);
    for (int t = blockIdx.x * 8 + w; t < NT; t += gridDim.x * 8) {
        float x[16];
        {
            const uint4 a = *(const uint4*)(abuf + (size_t)t * DM + lane * 16), c = *(const uint4*)(abuf + (size_t)t * DM + lane * 16 + 8);
            const unsigned uu[8] = {a.x, a.y, a.z, a.w, c.x, c.y, c.z, c.w};
#pragma unroll
            for (int i = 0; i < 8; ++i) { x[2 * i] = bf2f((u16)(uu[i] & 0xffff)); x[2 * i + 1] = bf2f((u16)(uu[i] >> 16)); }
        }
        float y[16];
#pragma unroll
        for (int i = 0; i < 16; ++i) y[i] = 0.f;
        for (int rnd = 0; rnd < 2; ++rnd) {
            const int my_e = pe[(size_t)t * 128 + rnd * 64 + lane];
            const float my_g = pg[(size_t)t * 128 + rnd * 64 + lane];
            float mydot = 0.f;
            for (int i0 = 0; i0 < 64; i0 += 8) {
                uint4 rows[8];
#pragma unroll
                for (int i = 0; i < 8; ++i) { const int e = __builtin_amdgcn_readlane(my_e, i0 + i); rows[i] = *(const uint4*)(UT + (size_t)e * 1024 + lane * 16); }
#pragma unroll
                for (int i = 0; i < 8; ++i) {
                    float f[16]; fp8x16_to_f32(rows[i], f);
                    float p = 0.f;
#pragma unroll
                    for (int k = 0; k < 16; ++k) p += f[k] * x[k];
                    p = wave_sum(p);
                    mydot = (lane == i0 + i) ? p : mydot;
                }
            }
            const float coef = my_g * gelu_tanh(mydot * (1.f / 64.f)) * (1.f / 8.f);
            for (int i0 = 0; i0 < 64; i0 += 8) {
                uint4 rows[8];
#pragma unroll
                for (int i = 0; i < 8; ++i) { const int e = __builtin_amdgcn_readlane(my_e, i0 + i); rows[i] = *(const uint4*)(VTb + (size_t)e * 1024 + lane * 16); }
#pragma unroll
                for (int i = 0; i < 8; ++i) {
                    float f[16]; fp8x16_to_f32(rows[i], f);
                    const float c = __uint_as_float((unsigned)__builtin_amdgcn_readlane((int)__float_as_uint(coef), i0 + i));
#pragma unroll
                    for (int k = 0; k < 16; ++k) y[k] += c * f[k];
                }
            }
        }
        float4 v[4];
        const float4* h4 = (const float4*)(hin + (size_t)t * DM + lane * 16);
#pragma unroll
        for (int i = 0; i < 4; ++i) { v[i] = h4[i]; v[i].x += y[4 * i]; v[i].y += y[4 * i + 1]; v[i].z += y[4 * i + 2]; v[i].w += y[4 * i + 3]; }
        float ss = 0.f;
#pragma unroll
        for (int i = 0; i < 4; ++i) ss += v[i].x * v[i].x + v[i].y * v[i].y + v[i].z * v[i].z + v[i].w * v[i].w;
        ss = wave_sum(ss);
        const float rstd = rsqrtf(ss * (1.f / DM) + 1e-6f);
        if (last) {
            const float4* g4 = (const float4*)(P.in[28]) + lane * 4;
            float4* o4 = (float4*)(hout + (size_t)t * DM + lane * 16);
#pragma unroll
            for (int i = 0; i < 4; ++i) { const float4 g = g4[i]; o4[i] = make_float4(v[i].x * rstd * g.x, v[i].y * rstd * g.y, v[i].z * rstd * g.z, v[i].w * rstd * g.w); }
        } else {
            float4* o4 = (float4*)(hout + (size_t)t * DM + lane * 16);
#pragma unroll
            for (int i = 0; i < 4; ++i) o4[i] = v[i];
            const float4* g4 = (const float4*)(P.in[1] + (layer + 1) * DM) + lane * 4;
            float vn[16];
#pragma unroll
            for (int i = 0; i < 4; ++i) { const float4 g = g4[i]; vn[4 * i] = v[i].x * rstd * g.x; vn[4 * i + 1] = v[i].y * rstd * g.y; vn[4 * i + 2] = v[i].z * rstd * g.z; vn[4 * i + 3] = v[i].w * rstd * g.w; }
            uint4 o0, o1;
            o0.x = pack2(vn[0], vn[1]); o0.y = pack2(vn[2], vn[3]); o0.z = pack2(vn[4], vn[5]); o0.w = pack2(vn[6], vn[7]);
            o1.x = pack2(vn[8], vn[9]); o1.y = pack2(vn[10], vn[11]); o1.z = pack2(vn[12], vn[13]); o1.w = pack2(vn[14], vn[15]);
            *(uint4*)(abuf + (size_t)t * DM + lane * 16) = o0; *(uint4*)(abuf + (size_t)t * DM + lane * 16 + 8) = o1;
            const float4* wab = (const float4*)(P.ws + OFF_WAB) + (layer + 1) * 8 * 256;
            float acc[8];
#pragma unroll
            for (int j = 0; j < 8; ++j) {
                float a = 0.f;
#pragma unroll
                for (int i = 0; i < 4; ++i) { const float4 ww = wab[j * 256 + lane * 4 + i]; a += vn[4 * i] * ww.x + vn[4 * i + 1] * ww.y + vn[4 * i + 2] * ww.z + vn[4 * i + 3] * ww.w; }
                acc[j] = wave_sum(a);
            }
            if (lane < 4) {
                const int L1 = layer + 1;
                const float a = lane == 0 ? acc[0] : lane == 1 ? acc[1] : lane == 2 ? acc[2] : acc[3];
                const float bb = lane == 0 ? acc[4] : lane == 1 ? acc[5] : lane == 2 ? acc[6] : acc[7];
                const float xx = a + P.in[5][L1 * 4 + lane];
                const float sp = xx > 20.f ? xx : log1pf(__expf(xx));
                ((float*)(P.ws + OFF_GG))[t * 4 + lane] = -__expf(P.in[4][L1 * 4 + lane]) * sp;
                ((float*)(P.ws + OFF_BETA))[t * 4 + lane] = sigmoidf_(bb);
            }
        }
    }
}

constexpr int PH_PER_LAYER = 11;
constexpr int NPHASE = 2 + 2 * PH_PER_LAYER;

#ifdef ONLY_SUB
#define SUB_ON(k) (ONLY_SUB == (k))
#else
#define SUB_ON(k) 1
#endif
DI void run_phase(const Params& P, int ph, char* lds) {
    char* ws = P.ws;
#if SUB_ON(100)
    if (ph == 0) { phase_prep(P, lds); return; }
#endif
#if SUB_ON(101)
    if (ph == 1) { phase_rms(P, P.in[0], P.in[1], (u16*)(ws + OFF_ABUF), 0); return; }
#endif
    if (ph < 2) return;
    const int layer = (ph - 2) / PH_PER_LAYER, sub = (ph - 2) % PH_PER_LAYER;
    const float* hin = layer == 0 ? P.in[0] : P.out;
    switch (sub) {
    #if SUB_ON(0)
    case 0: { EpiInProj e{ws}; phase_gemm((const u16*)(ws + OFF_ABUF), 1024, (const u16*)(ws + OFF_WINT) + (size_t)layer * PROJW * 1024, 1024, NT, PROJW, 1024, e, lds); } break;

#endif
    #if SUB_ON(1)
    case 1:
        for (int it = blockIdx.x; it < 2048; it += gridDim.x) gdn_prep_item(P, layer, it, lds);
        phase_s5<false>(P, layer, lds);
        break;

#endif
    #if SUB_ON(2)
    case 2:
        if (blockIdx.x < 16) gdn_scan_chain(P, blockIdx.x, lds);
        else if (blockIdx.x < 24) {
            const int gt = (blockIdx.x - 16) * NTHR + threadIdx.x;
            if (gt < 4096) {
                const int bg = gt >> 6, n = gt & 63;
                const float2 a = ((const float2*)(ws + OFF_S5P + layer * S5P_LAYER + S5P_A64))[(bg & 15) * 64 + n];
                float2* st = (float2*)(ws + OFF_S5ST) + (size_t)bg * 128 * 64 + n;
                float xr = 0.f, xi = 0.f;
                for (int c = 0; c < 128; ++c) {
                    const float2 sv = st[c * 64];
                    st[c * 64] = make_float2(xr, xi);
                    const float nr = a.x * xr - a.y * xi + sv.x, ni = a.x * xi + a.y * xr + sv.y;
                    xr = nr; xi = ni;
                }
            }
        }
        break;

#endif
    #if SUB_ON(3)
    case 3: phase_s5<true>(P, layer, lds); break;

#endif
    #if SUB_ON(4)
    case 4: {
        EpiGlu e{(u16*)(ws + OFF_ABUF), P.in[16] + layer * 512};
        phase_gemm((const u16*)(ws + OFF_YS5), 256, (const u16*)(ws + OFF_GLUT) + (size_t)layer * 512 * 256, 256, NT, 512, 256, e, lds);
        phase_gdn_norm(P, layer);
    } break;

#endif
    #if SUB_ON(5)
    case 5: phase_attn(P, layer, lds); break;

#endif
    #if SUB_ON(6)
    case 6: { EpiResidual e{hin, P.out}; phase_gemm((const u16*)(ws + OFF_ABUF), 1024, (const u16*)(ws + OFF_WOUTT) + (size_t)layer * 1024 * 1024, 1024, NT, 1024, 1024, e, lds); } break;

#endif
    #if SUB_ON(7)
    case 7: phase_rms(P, P.out, P.in[23] + layer * DM, (u16*)(ws + OFF_ABUF), -1); break;

#endif
    #if SUB_ON(8)
    case 8: { EpiBf16 e{(u16*)(ws + OFF_PQ), 1024}; phase_gemm((const u16*)(ws + OFF_ABUF), 1024, (const u16*)(ws + OFF_WQT) + (size_t)layer * 1024 * 1024, 1024, NT, 1024, 1024, e, lds); } break;

#endif
    #if SUB_ON(9)
    case 9: phase_topk(P, layer); break;

#endif
    #if SUB_ON(10)
    case 10: phase_peer(P, layer, P.out, P.out, layer == 1); break;
#endif
    }
}

__global__ void __launch_bounds__(NTHR) mk_fwd(Params P, int ph_lo, int ph_hi) {
    extern __shared__ __attribute__((aligned(16))) char lds[];
#define PH(k) if (ph_lo <= (k) && (k) < ph_hi) { run_phase(P, (k), lds); if ((k) + 1 < ph_hi) cg::this_grid().sync(); }
    PH(0) PH(1) PH(2) PH(3) PH(4) PH(5) PH(6) PH(7) PH(8) PH(9) PH(10) PH(11) PH(12)
    PH(13) PH(14) PH(15) PH(16) PH(17) PH(18) PH(19) PH(20) PH(21) PH(22) PH(23)
#undef PH
}

extern "C" void kernel_launch(void* const* d_in, const int* in_sizes, int n_in, void* d_out, int out_size, void* d_ws, size_t ws_size, hipStream_t stream) {
    static int grid = 0;
    if (grid == 0) {
        int dev = 0, cus = 0, per_cu = 0;
        hipGetDevice(&dev);
        hipDeviceGetAttribute(&cus, hipDeviceAttributeMultiprocessorCount, dev);
        hipFuncSetAttribute((const void*)mk_fwd, hipFuncAttributeMaxDynamicSharedMemorySize, LDS_BYTES);
        hipOccupancyMaxActiveBlocksPerMultiprocessor(&per_cu, (const void*)mk_fwd, NTHR, LDS_BYTES);
        if (per_cu < 1) { fprintf(stderr, "occupancy query says %d blocks per CU\n", per_cu); per_cu = 1; }
        grid = cus;
        if (ws_size < OFF_END) { fprintf(stderr, "workspace too small: %zu < %zu\n", ws_size, (size_t)OFF_END); }
    }
    Params p{};
    for (int i = 0; i < 29; ++i) p.in[i] = (const float*)d_in[i];
    p.out = (float*)d_out; p.ws = (char*)d_ws;
#if MK_ONE_LAUNCH
    int lo = 0, hi = NPHASE;
    void* args[] = {&p, &lo, &hi};
    hipError_t e = hipLaunchCooperativeKernel((const void*)mk_fwd, dim3(grid), dim3(NTHR), args, LDS_BYTES, stream);
    if (e != hipSuccess) fprintf(stderr, "cooperative launch failed: %s\n", hipGetErrorString(e));
#else
    for (int ph = 0; ph < NPHASE; ++ph) hipLaunchKernelGGL(mk_fwd, dim3(grid), dim3(NTHR), LDS_BYTES, stream, p, ph, ph + 1);
#endif
}
```

```cpp
#include <hip/hip_runtime.h>
#include <hip/hip_cooperative_groups.h>
#include <stdint.h>
#include <stdio.h>
namespace cg = cooperative_groups;

#ifndef MK_ONE_LAUNCH
#define MK_ONE_LAUNCH 1
#endif

#define DI __device__ __forceinline__
typedef unsigned short u16;
typedef __attribute__((ext_vector_type(8))) short bf16x8;
typedef __attribute__((ext_vector_type(4))) short bf16x4;
typedef __attribute__((ext_vector_type(16))) float f32x16;
typedef __attribute__((ext_vector_type(4))) float f32x4;
typedef __attribute__((ext_vector_type(2))) float f32x2;

constexpr int NT = 32768, DM = 1024, SEQ = 8192, NBATCH = 4;
constexpr int NTHR = 512;
constexpr int INW = 2824;
constexpr int PROJW = 2816;
constexpr float LOG2E = 1.4426950408889634f;

constexpr size_t OFF_CTL   = 0;
constexpr size_t OFF_WINT  = 65536;
constexpr size_t OFF_WOUTT = OFF_WINT  + (size_t)2 * PROJW * 1024 * 2;
constexpr size_t OFF_WQT   = OFF_WOUTT + (size_t)2 * 1024 * 1024 * 2;
constexpr size_t OFF_GLUT  = OFF_WQT   + (size_t)2 * 1024 * 1024 * 2;
constexpr size_t OFF_KEYS  = OFF_GLUT  + (size_t)2 * 512 * 256 * 2;
constexpr size_t OFF_WAB   = OFF_KEYS  + (size_t)2 * 8 * 2 * 128 * 64 * 2;
constexpr size_t OFF_S5P   = OFF_WAB   + (size_t)2 * 8 * 1024 * 4;
constexpr size_t S5P_LAYER = 262144;
constexpr size_t S5P_ABAR = 0, S5P_A64 = 8192, S5P_BRE = 16384, S5P_BIM = 16384 + 65536, S5P_CM = 16384 + 131072;
constexpr size_t OFF_SCAL  = OFF_S5P   + 2 * S5P_LAYER;
constexpr size_t OFF_UTAB  = OFF_SCAL  + 256;
constexpr size_t OFF_VTAB  = OFF_UTAB  + (size_t)2 * 16384 * 1024;
constexpr size_t OFF_USCALE = OFF_VTAB + (size_t)2 * 16384 * 1024;
constexpr size_t OFF_ABUF  = OFF_USCALE + (size_t)2 * 16384 * 4;
constexpr size_t OFF_GG    = OFF_ABUF  + (size_t)NT * 1024 * 2;
constexpr size_t OFF_BETA  = OFF_GG    + (size_t)NT * 4 * 4;
constexpr size_t OFF_PROJ  = OFF_BETA  + (size_t)NT * 4 * 4;
constexpr size_t OFF_QKV   = OFF_PROJ;
constexpr size_t OFF_Z     = OFF_QKV   + (size_t)NT * 768 * 2;
constexpr size_t OFF_US    = OFF_Z     + (size_t)NT * 256 * 2;
constexpr size_t OFF_QC    = OFF_US    + (size_t)NT * 256 * 2;
constexpr size_t OFF_KC    = OFF_QC    + (size_t)NT * 512 * 2;
constexpr size_t OFF_VT    = OFF_KC    + (size_t)NT * 512 * 2;
constexpr size_t OFF_GREC  = OFF_VT    + (size_t)NT * 512 * 2;
constexpr size_t GREC_BYTES = 40960;
constexpr size_t OFF_EGL   = OFF_GREC  + (size_t)2048 * GREC_BYTES;
constexpr size_t OFF_S5ST  = OFF_EGL   + 2048 * 4;
constexpr size_t OFF_YS5   = OFF_S5ST  + (size_t)8192 * 64 * 8;
constexpr size_t OFF_END   = OFF_YS5   + (size_t)NT * 256 * 2;
constexpr size_t OFF_GDNO  = OFF_QKV;
constexpr size_t OFF_PQ    = OFF_PROJ;
constexpr size_t OFF_PICKE = OFF_GREC;
constexpr size_t OFF_PICKG = OFF_GREC + (size_t)NT * 128 * 2;
static_assert(OFF_END < (size_t)512 * 1024 * 1024, "workspace");

constexpr int LDS_BYTES = 148480 + 16;

struct Params {
    const float* in[29];
    float* out;
    char* ws;
};

DI u16 f2bf(float x) { unsigned u = __float_as_uint(x); u += 0x7fffu + ((u >> 16) & 1u); return (u16)(u >> 16); }
DI float bf2f(u16 v) { return __uint_as_float(((unsigned)v) << 16); }
DI unsigned pack2(float a, float b) { return (unsigned)f2bf(a) | ((unsigned)f2bf(b) << 16); }
DI float wave_sum(float v) { for (int o = 32; o > 0; o >>= 1) v += __shfl_xor(v, o); return v; }
DI float gelu_tanh(float x) { float u = 0.7978845608028654f * (x + 0.044715f * x * x * x); float e = __expf(2.f * u); float th = 1.f - 2.f / (e + 1.f); return 0.5f * x * (1.f + th); }
DI float sigmoidf_(float x) { return 1.f / (1.f + __expf(-x)); }
#define MFMA32(a, b, c) __builtin_amdgcn_mfma_f32_32x32x16_bf16((a), (b), (c), 0, 0, 0)
#define MFMA16(a, b, c) __builtin_amdgcn_mfma_f32_16x16x32_bf16((a), (b), (c), 0, 0, 0)
DI bf16x8 ld8(const void* p) { return *(const bf16x8*)p; }
DI bf16x8 cat4(bf16x4 lo, bf16x4 hi) { return __builtin_shufflevector(lo, hi, 0, 1, 2, 3, 4, 5, 6, 7); }
DI bf16x8 pack8(float a0, float a1, float a2, float a3, float a4, float a5, float a6, float a7) {
    uint4 u; u.x = pack2(a0, a1); u.y = pack2(a2, a3); u.z = pack2(a4, a5); u.w = pack2(a6, a7);
    return __builtin_bit_cast(bf16x8, u);
}

template <class CM>
DI void transpose_tile(const float* __restrict__ src, int src_ld, u16* __restrict__ dst, int K, int n0, int k0, CM colmap, float* tl) {
    const int tid = threadIdx.x;
    {
        const int nn = tid & 63;
        const int sc = colmap(n0 + nn);
#pragma unroll
        for (int i = 0; i < 8; ++i) { const int kk = (tid >> 6) + 8 * i; tl[kk * 65 + nn] = src[(size_t)(k0 + kk) * src_ld + sc]; }
    }
    __syncthreads();
    {
        const int kk = tid & 63;
#pragma unroll
        for (int i = 0; i < 8; ++i) { const int nn = (tid >> 6) + 8 * i; dst[(size_t)(n0 + nn) * K + k0 + kk] = f2bf(tl[kk * 65 + nn]); }
    }
    __syncthreads();
}

DI void phase_prep(const Params& P, char* lds) {
    float* tl = (float*)lds;
    char* ws = P.ws;
    const int bid = blockIdx.x, nb = gridDim.x, tid = threadIdx.x;
    for (int j = bid; j < 2496; j += nb) {
        if (j < 1408) {
            const int l = j / 704, r = j % 704, nt = r / 16, kt = r % 16;
            transpose_tile(P.in[2] + (size_t)l * 1024 * INW, INW, (u16*)(ws + OFF_WINT) + (size_t)l * PROJW * 1024, 1024, nt * 64, kt * 64,
                           [](int n) { return n < 1024 ? n : n + 8; }, tl);
        } else if (j < 1920) {
            const int q = j - 1408; const int l = q / 256, r = q % 256, nt = r / 16, kt = r % 16;
            transpose_tile(P.in[22] + (size_t)l * 1024 * 1024, 1024, (u16*)(ws + OFF_WOUTT) + (size_t)l * 1024 * 1024, 1024, nt * 64, kt * 64, [](int n) { return n; }, tl);
        } else if (j < 2432) {
            const int q = j - 1920; const int l = q / 256, r = q % 256, nt = r / 16, kt = r % 16;
            transpose_tile(P.in[24] + (size_t)l * 1024 * 1024, 1024, (u16*)(ws + OFF_WQT) + (size_t)l * 1024 * 1024, 1024, nt * 64, kt * 64, [](int n) { return n; }, tl);
        } else {
            const int q = j - 2432; const int l = q / 32, r = q % 32, nt = r / 4, kt = r % 4;
            transpose_tile(P.in[15] + (size_t)l * 256 * 512, 512, (u16*)(ws + OFF_GLUT) + (size_t)l * 512 * 256, 256, nt * 64, kt * 64,
                           [](int n) { const int blk = n >> 6, wi = n & 63; return wi < 32 ? 32 * blk + wi : 256 + 32 * blk + (wi - 32); }, tl);
        }
    }
    const size_t gtid = (size_t)bid * NTHR + tid, gsz = (size_t)nb * NTHR;
    for (size_t i = gtid; i < (size_t)2 * 8 * 2 * 128 * 64; i += gsz) ((u16*)(ws + OFF_KEYS))[i] = f2bf(P.in[25][i]);
    for (size_t i = gtid; i < (size_t)2 * 8 * 1024; i += gsz) {
        const int l = (int)(i / 8192), j = (int)((i / 1024) % 8), k = (int)(i % 1024);
        ((float*)(ws + OFF_WAB))[i] = P.in[2][(size_t)l * 1024 * INW + (size_t)k * INW + 1024 + j];
    }
    {
        const int wv = tid >> 6, lane = tid & 63;
        for (int row = bid * 8 + wv; row < 2 * 16384; row += nb * 8) {
            const float4* s = (const float4*)(P.in[26] + (size_t)row * 1024) + lane * 4;
            float4 v[4]; float am = 0.f;
#pragma unroll
            for (int q = 0; q < 4; ++q) { v[q] = s[q]; am = fmaxf(am, fmaxf(fmaxf(fabsf(v[q].x), fabsf(v[q].y)), fmaxf(fabsf(v[q].z), fabsf(v[q].w)))); }
            for (int o = 32; o > 0; o >>= 1) am = fmaxf(am, __shfl_xor(am, o));
            const float sc = am > 0.f ? 127.f / am : 0.f;
            uint4 o4; unsigned* op = (unsigned*)&o4;
#pragma unroll
            for (int q = 0; q < 4; ++q) {
                const int a = (int)rintf(v[q].x * sc), b = (int)rintf(v[q].y * sc), c = (int)rintf(v[q].z * sc), d = (int)rintf(v[q].w * sc);
                op[q] = (unsigned)(a & 0xff) | ((unsigned)(b & 0xff) << 8) | ((unsigned)(c & 0xff) << 16) | ((unsigned)(d & 0xff) << 24);
            }
            ((uint4*)(ws + OFF_UTAB))[(size_t)row * 64 + lane] = o4;
            if (lane == 0) ((float*)(ws + OFF_USCALE))[row] = am * (1.f / 127.f);
        }
        const size_t n16 = (size_t)2 * 16384 * 1024 / 16;
        for (size_t i = gtid; i < n16; i += gsz) {
            const float4* s = (const float4*)P.in[27] + i * 4;
            uint4 o; unsigned* op = (unsigned*)&o;
#pragma unroll
            for (int q = 0; q < 4; ++q) {
                const float4 v = s[q];
                int wv2 = __builtin_amdgcn_cvt_pk_fp8_f32(v.x * 8.f, v.y * 8.f, 0, false);
                wv2 = __builtin_amdgcn_cvt_pk_fp8_f32(v.z * 8.f, v.w * 8.f, wv2, true);
                op[q] = (unsigned)wv2;
            }
            ((uint4*)(ws + OFF_VTAB))[i] = o;
        }
    }
    for (size_t i = gtid; i < (size_t)2 * 16 * 64; i += gsz) {
        const int l = (int)(i / 1024), g = (int)((i / 64) % 16), n = (int)(i % 64);
        const float step = __expf(P.in[14][l * 16 + g]);
        const float lr = P.in[7][i], li = P.in[8][i];
        const float er = expf(lr * step); const float ar = er * cosf(li * step), ai = er * sinf(li * step);
        const float e64 = expf(64.f * lr * step); const float a64r = e64 * cosf(64.f * li * step), a64i = e64 * sinf(64.f * li * step);
        char* sp = ws + OFF_S5P + l * S5P_LAYER;
        ((float2*)(sp + S5P_ABAR))[g * 64 + n] = make_float2(ar, ai);
        ((float2*)(sp + S5P_A64))[g * 64 + n] = make_float2(a64r, a64i);
        const float xr = ar - 1.f, xi = ai; const float den = 1.f / (lr * lr + li * li);
        const float cr = (xr * lr + xi * li) * den, ci = (xi * lr - xr * li) * den;
        for (int c = 0; c < 16; ++c) {
            const float br = P.in[9][i * 16 + c], bi = P.in[10][i * 16 + c];
            ((float*)(sp + S5P_BRE))[(g * 64 + n) * 16 + c] = cr * br - ci * bi;
            ((float*)(sp + S5P_BIM))[(g * 64 + n) * 16 + c] = cr * bi + ci * br;
        }
    }
    for (size_t i = gtid; i < (size_t)2 * 16 * 16 * 128; i += gsz) {
        const int l = (int)(i / 32768), g = (int)((i / 2048) % 16), c = (int)((i / 128) % 16), k = (int)(i % 128);
        const size_t si = ((size_t)(l * 16 + g) * 16 + c) * 64 + (k & 63);
        const float v = k < 64 ? P.in[11][si] : -P.in[12][si];
        ((u16*)(ws + OFF_S5P + l * S5P_LAYER + S5P_CM))[(g * 16 + c) * 128 + k] = f2bf(v);
    }
    if (bid == 0 && tid < 2) {
        const int l = tid; float s1 = 0.f, s2 = 0.f;
        for (int d = 0; d < 64; ++d) { s1 += P.in[17][l * 64 + d] * P.in[18][l * 64 + d]; s2 += P.in[19][l * 64 + d] * P.in[20][l * 64 + d]; }
        const float lam_init = 0.8f - 0.6f * expf(-0.3f * (float)l);
        ((float*)(ws + OFF_SCAL))[l] = expf(s1) - expf(s2) + lam_init;
    }
}

DI void rms_token(const Params& P, int t, int lane, float4 (&v)[4], const float* gain, u16* dst, int ab_layer  ) {
    float ss = 0.f;
#pragma unroll
    for (int i = 0; i < 4; ++i) ss += v[i].x * v[i].x + v[i].y * v[i].y + v[i].z * v[i].z + v[i].w * v[i].w;
    ss = wave_sum(ss);
    const float rstd = rsqrtf(ss * (1.f / DM) + 1e-6f);
    const float4* g4 = (const float4*)gain;
#pragma unroll
    for (int i = 0; i < 4; ++i) {
        const float4 g = g4[lane + 64 * i];
        v[i].x *= rstd * g.x; v[i].y *= rstd * g.y; v[i].z *= rstd * g.z; v[i].w *= rstd * g.w;
        uint2 o; o.x = pack2(v[i].x, v[i].y); o.y = pack2(v[i].z, v[i].w);
        *(uint2*)(dst + (size_t)t * DM + (lane + 64 * i) * 4) = o;
    }
    if (ab_layer >= 0) {
        const float4* wab = (const float4*)(P.ws + OFF_WAB) + ab_layer * 8 * 256;
        float acc[8];
#pragma unroll
        for (int j = 0; j < 8; ++j) {
            float a = 0.f;
#pragma unroll
            for (int i = 0; i < 4; ++i) { const float4 w = wab[j * 256 + lane + 64 * i]; a += v[i].x * w.x + v[i].y * w.y + v[i].z * w.z + v[i].w * w.w; }
            acc[j] = wave_sum(a);
        }
        if (lane < 4) {
            const float a = lane == 0 ? acc[0] : lane == 1 ? acc[1] : lane == 2 ? acc[2] : acc[3];
            const float b = lane == 0 ? acc[4] : lane == 1 ? acc[5] : lane == 2 ? acc[6] : acc[7];
            const float xx = a + P.in[5][ab_layer * 4 + lane];
            const float sp = xx > 20.f ? xx : log1pf(__expf(xx));
            ((float*)(P.ws + OFF_GG))[t * 4 + lane] = -__expf(P.in[4][ab_layer * 4 + lane]) * sp;
            ((float*)(P.ws + OFF_BETA))[t * 4 + lane] = sigmoidf_(b);
        }
    }
}

DI void phase_rms(const Params& P, const float* src, const float* gain, u16* dst, int ab_layer) {
    const int w = threadIdx.x >> 6, lane = threadIdx.x & 63;
    for (int t = blockIdx.x * 8 + w; t < NT; t += gridDim.x * 8) {
        const float4* s4 = (const float4*)(src + (size_t)t * DM);
        float4 v[4];
#pragma unroll
        for (int i = 0; i < 4; ++i) v[i] = s4[lane + 64 * i];
        rms_token(P, t, lane, v, gain, dst, ab_layer);
    }
}

constexpr int GP = 40;
template <class Epi>
DI void gemm_tile(const u16* __restrict__ A, int lda, const u16* __restrict__ Bt, int ldb, int K, int m0, int n0, Epi& epi, char* lds) {
    const int tid = threadIdx.x, lane = tid & 63, w = tid >> 6;
    const int wm = w >> 2, wn = w & 3, r = lane & 31, hh = lane >> 5;
    u16* As = (u16*)lds;
    u16* Bs = As + 2 * 256 * GP;
    f32x16 acc[4][2];
#pragma unroll
    for (int i = 0; i < 4; ++i)
#pragma unroll
        for (int j = 0; j < 2; ++j)
#pragma unroll
            for (int e = 0; e < 16; ++e) acc[i][j][e] = 0.f;
    const int lrow = tid >> 2, lkc = tid & 3;
    const u16* ga0 = A + (size_t)(m0 + lrow) * lda + lkc * 8;
    const u16* ga1 = A + (size_t)(m0 + lrow + 128) * lda + lkc * 8;
    const u16* gb0 = Bt + (size_t)(n0 + lrow) * ldb + lkc * 8;
    const u16* gb1 = Bt + (size_t)(n0 + lrow + 128) * ldb + lkc * 8;
    const int so0 = lrow * GP + lkc * 8, so1 = (lrow + 128) * GP + lkc * 8;
    uint4 ra0 = *(const uint4*)ga0, ra1 = *(const uint4*)ga1, rb0 = *(const uint4*)gb0, rb1 = *(const uint4*)gb1;
    *(uint4*)(As + so0) = ra0; *(uint4*)(As + so1) = ra1; *(uint4*)(Bs + so0) = rb0; *(uint4*)(Bs + so1) = rb1;
    __syncthreads();
    const int nk = K / 32;
    for (int kt = 0; kt < nk; ++kt) {
        const int cur = kt & 1;
        if (kt + 1 < nk) {
            const int ko = (kt + 1) * 32;
            ra0 = *(const uint4*)(ga0 + ko); ra1 = *(const uint4*)(ga1 + ko); rb0 = *(const uint4*)(gb0 + ko); rb1 = *(const uint4*)(gb1 + ko);
        }
        const u16* Ac = As + cur * 256 * GP + (wm * 128 + r) * GP + hh * 8;
        const u16* Bc = Bs + cur * 256 * GP + (wn * 64 + r) * GP + hh * 8;
#pragma unroll
        for (int ks = 0; ks < 2; ++ks) {
            bf16x8 af[4], bfr[2];
#pragma unroll
            for (int i = 0; i < 4; ++i) af[i] = ld8(Ac + i * 32 * GP + ks * 16);
#pragma unroll
            for (int j = 0; j < 2; ++j) bfr[j] = ld8(Bc + j * 32 * GP + ks * 16);
#pragma unroll
            for (int i = 0; i < 4; ++i)
#pragma unroll
                for (int j = 0; j < 2; ++j) acc[i][j] = MFMA32(af[i], bfr[j], acc[i][j]);
        }
        if (kt + 1 < nk) {
            const int nx = (cur ^ 1) * 256 * GP;
            *(uint4*)(As + nx + so0) = ra0; *(uint4*)(As + nx + so1) = ra1; *(uint4*)(Bs + nx + so0) = rb0; *(uint4*)(Bs + nx + so1) = rb1;
        }
        __syncthreads();
    }
    epi(acc, m0 + wm * 128, n0 + wn * 64, r, hh);
}

struct EpiInProj {
    char* ws;
    DI void operator()(f32x16 (&acc)[4][2], int mw, int nw, int r, int hh) const {
        if (nw >= 2304) {
            u16* vt = (u16*)(ws + OFF_VT);
#pragma unroll
            for (int i = 0; i < 4; ++i)
#pragma unroll
                for (int j = 0; j < 2; ++j) {
                    const int c = nw - 2304 + 32 * j + r; const int head = c >> 7, dv = c & 127;
#pragma unroll
                    for (int q = 0; q < 4; ++q) {
                        const int row = mw + 32 * i + 8 * q + 4 * hh; const int b = row >> 13, l = row & 8191;
                        uint2 o; o.x = pack2(acc[i][j][4 * q], acc[i][j][4 * q + 1]); o.y = pack2(acc[i][j][4 * q + 2], acc[i][j][4 * q + 3]);
                        *(uint2*)(vt + ((size_t)((b * 4 + head) * 128 + dv)) * SEQ + l) = o;
                    }
                }
            return;
        }
        u16* base; int pitch, c0; float sc = 1.f;
        if (nw < 768) { base = (u16*)(ws + OFF_QKV); pitch = 768; c0 = nw; }
        else if (nw < 1024) { base = (u16*)(ws + OFF_Z); pitch = 256; c0 = nw - 768; }
        else if (nw < 1280) { base = (u16*)(ws + OFF_US); pitch = 256; c0 = nw - 1024; }
        else if (nw < 1792) { base = (u16*)(ws + OFF_QC); pitch = 512; c0 = nw - 1280; sc = 0.125f * LOG2E; }
        else { base = (u16*)(ws + OFF_KC); pitch = 512; c0 = nw - 1792; }
#pragma unroll
        for (int i = 0; i < 4; ++i)
#pragma unroll
            for (int j = 0; j < 2; ++j)
#pragma unroll
                for (int e = 0; e < 16; ++e) {
                    const int row = mw + 32 * i + (e & 3) + 8 * (e >> 2) + 4 * hh;
                    base[(size_t)row * pitch + c0 + 32 * j + r] = f2bf(acc[i][j][e] * sc);
                }
    }
};
struct EpiResidual {
    const float* hin; float* hout;
    DI void operator()(f32x16 (&acc)[4][2], int mw, int nw, int r, int hh) const {
#pragma unroll
        for (int i = 0; i < 4; ++i)
#pragma unroll
            for (int j = 0; j < 2; ++j)
#pragma unroll
                for (int e = 0; e < 16; ++e) {
                    const size_t idx = (size_t)(mw + 32 * i + (e & 3) + 8 * (e >> 2) + 4 * hh) * DM + nw + 32 * j + r;
                    hout[idx] = hin[idx] + acc[i][j][e];
                }
    }
};
struct EpiBf16 {
    u16* dst; int pitch;
    DI void operator()(f32x16 (&acc)[4][2], int mw, int nw, int r, int hh) const {
#pragma unroll
        for (int i = 0; i < 4; ++i)
#pragma unroll
            for (int j = 0; j < 2; ++j)
#pragma unroll
                for (int e = 0; e < 16; ++e)
                    dst[(size_t)(mw + 32 * i + (e & 3) + 8 * (e >> 2) + 4 * hh) * pitch + nw + 32 * j + r] = f2bf(acc[i][j][e]);
    }
};
struct EpiGlu {
    u16* mix; const float* bias;
    DI void operator()(f32x16 (&acc)[4][2], int mw, int nw, int r, int hh) const {
        const int col = 32 * (nw >> 6) + r;
        const float bv = bias[col], bg = bias[256 + col];
#pragma unroll
        for (int i = 0; i < 4; ++i)
#pragma unroll
            for (int e = 0; e < 16; ++e) {
                const int row = mw + 32 * i + (e & 3) + 8 * (e >> 2) + 4 * hh;
                const float val = acc[i][0][e] + bv, gate = acc[i][1][e] + bg;
                mix[(size_t)row * DM + 256 + col] = f2bf(val * sigmoidf_(gate));
            }
    }
};

template <class Epi>
DI void phase_gemm(const u16* A, int lda, const u16* Bt, int ldb, int M, int N, int K, Epi epi, char* lds) {
    const int ntn = N / 256, ntm = M / 256;
    for (int t = blockIdx.x; t < ntn * ntm; t += gridDim.x) {
        const int mt = t / ntn, nt = t % ntn;
        gemm_tile(A, lda, Bt, ldb, K, mt * 256, nt * 256, epi, lds);
    }
}

DI void gdn_prep_item(const Params& P, int layer, int item, char* lds) {
    const int tid = threadIdx.x, lane = tid & 63, w = tid >> 6;
    const int b = item >> 9, head = (item >> 7) & 3, ch = item & 127;
    const int t0 = b * SEQ + ch * 64;
    u16* raw = (u16*)lds;
    float* qs = (float*)(lds + 25856);
    float* ks = qs + 64 * 68;
    float* vs = ks + 64 * 68;
    float* Ls = vs + 64 * 68;
    u16* qb = (u16*)(Ls + 64 * 68);
    u16* kb = qb + 64 * 72;
    float* Gs = (float*)(kb + 64 * 72);
    float* bs = Gs + 64;
    float* rn = bs + 64;
    const u16* qkv = (const u16*)(P.ws + OFF_QKV);
    for (int i = tid; i < 67 * 24; i += NTHR) {
        const int row = i / 24, c8 = i % 24; const int part = c8 >> 3, cc = (c8 & 7) * 8;
        const int l = ch * 64 + row - 3;
        uint4 v = make_uint4(0, 0, 0, 0);
        if (l >= 0) v = *(const uint4*)(qkv + (size_t)(b * SEQ + l) * 768 + part * 256 + head * 64 + cc);
        *(uint4*)(raw + row * 192 + part * 64 + cc) = v;
    }
    if (tid < 64) { bs[tid] = ((const float*)(P.ws + OFF_BETA))[(t0 + tid) * 4 + head]; Gs[tid] = ((const float*)(P.ws + OFF_GG))[(t0 + tid) * 4 + head]; }
    __syncthreads();
    {
        const float* cw = P.in[3] + (size_t)layer * 4 * 768;
        for (int i = tid; i < 64 * 192; i += NTHR) {
            const int t = i / 192, c = i % 192; const int part = c >> 6, d = c & 63; const int gc = part * 256 + head * 64 + d;
            float a = 0.f;
#pragma unroll
            for (int j = 0; j < 4; ++j) a += cw[j * 768 + gc] * bf2f(raw[(t + j) * 192 + c]);
            a = a * sigmoidf_(a);
            (part == 0 ? qs : part == 1 ? ks : vs)[t * 68 + d] = a;
        }
    }
    if (tid == 0) { float g = 0.f; for (int i = 0; i < 64; ++i) { g += Gs[i]; Gs[i] = g; } }
    __syncthreads();
    if (tid < 128) {
        const float* s = (tid < 64 ? qs : ks) + (tid & 63) * 68; float ss = 0.f;
        for (int d = 0; d < 64; ++d) ss += s[d] * s[d];
        rn[tid] = rsqrtf(ss + 1e-6f) * (tid < 64 ? 0.125f : 1.f);
    }
    __syncthreads();
    for (int i = tid; i < 2 * 64 * 64; i += NTHR) {
        const int which = i >> 12, t = (i >> 6) & 63, d = i & 63;
        float* s = which ? ks : qs; const float v = s[t * 68 + d] * rn[which * 64 + t];
        s[t * 68 + d] = v; (which ? kb : qb)[t * 72 + d] = f2bf(v);
    }
    __syncthreads();
    u16* rec = (u16*)(P.ws + OFF_GREC + (size_t)item * GREC_BYTES);
    {
        const int r = lane & 31, hh = lane >> 5; const int bi = (w >> 1) & 1, bj = w & 1; const bool isqk = w >= 4;
        const u16* Am = (isqk ? qb : kb) + (bi * 32 + r) * 72 + hh * 8;
        const u16* Bm = kb + (bj * 32 + r) * 72 + hh * 8;
        f32x16 acc;
#pragma unroll
        for (int e = 0; e < 16; ++e) acc[e] = 0.f;
#pragma unroll
        for (int s = 0; s < 4; ++s) acc = MFMA32(ld8(Am + s * 16), ld8(Bm + s * 16), acc);
        const int j = bj * 32 + r; const float Gj = Gs[j];
#pragma unroll
        for (int e = 0; e < 16; ++e) {
            const int i = bi * 32 + (e & 3) + 8 * (e >> 2) + 4 * hh;
            const float dec = __expf(Gs[i] - Gj);
            if (isqk) rec[2 * 4096 + i * 64 + j] = f2bf(j <= i ? acc[e] * dec : 0.f);
            else Ls[i * 68 + j] = (j < i) ? bs[i] * acc[e] * dec : 0.f;
        }
    }
    __syncthreads();
    {
        const float Gl = Gs[63];
        for (int i = tid; i < 2 * 4096; i += NTHR) {
            const int which = i >> 12, a = (i >> 6) & 63, bq = i & 63;
            if (which == 0) rec[3 * 4096 + a * 64 + bq] = f2bf(qs[a * 68 + bq] * __expf(Gs[a]));
            else rec[4 * 4096 + a * 64 + bq] = f2bf(ks[bq * 68 + a] * __expf(Gl - Gs[bq]));
        }
        if (tid == 0) ((float*)(P.ws + OFF_EGL))[item] = __expf(Gl);
    }
    float* Xs = rn + 128;
    for (int i = tid; i < 64 * 130; i += NTHR) Xs[i] = 0.f;
    __syncthreads();
    {
        const int c = tid >> 2, q = tid & 3;
        const bool isw = c >= 64; const int cc = c & 63;
        for (int i = 0; i < 64; ++i) {
            const float bi = bs[i];
            const float rhs = isw ? ks[i * 68 + cc] * bi * __expf(Gs[i]) : vs[i * 68 + cc] * bi;
            const float4* Lr = (const float4*)(Ls + i * 68);
            float sacc = 0.f;
#pragma unroll
            for (int mq = 0; mq < 4; ++mq) {
                const int j4 = q + 4 * mq;
                const float4 l4 = Lr[j4];
                const float* xp = Xs + (4 * j4) * 130 + c;
                sacc += l4.x * xp[0] + l4.y * xp[130] + l4.z * xp[260] + l4.w * xp[390];
            }
            sacc += __shfl_xor(sacc, 1); sacc += __shfl_xor(sacc, 2);
            if (q == 0) Xs[i * 130 + c] = rhs - sacc;
        }
    }
    __syncthreads();
    for (int i = tid; i < 2 * 4096; i += NTHR) {
        const int which = i >> 12, t = (i >> 6) & 63, d = i & 63;
        rec[which * 4096 + t * 64 + d] = f2bf(Xs[t * 130 + which * 64 + d]);
    }
    __syncthreads();
}

constexpr int RP = 72;
DI void gdn_scan_chain(const Params& P, int chain, char* lds) {
    const int tid = threadIdx.x, lane = tid & 63, w = tid >> 6;
    const int b = chain >> 2, head = chain & 3;
    u16* buf0 = (u16*)lds;
    u16* buf1 = buf0 + 320 * RP;
    const char* recbase = P.ws + OFF_GREC + (size_t)(chain * 128) * GREC_BYTES;
    const float* egl = (const float*)(P.ws + OFF_EGL) + chain * 128;
    float* gout = (float*)(P.ws + OFF_GDNO);
    uint4 rg0, rg1, rg2, rg3, rg4;
#define SCAN_ISSUE(c_) do { const uint4* src_ = (const uint4*)(recbase + (size_t)(c_) * GREC_BYTES) + tid; \
        rg0 = src_[0]; rg1 = src_[NTHR]; rg2 = src_[2 * NTHR]; rg3 = src_[3 * NTHR]; rg4 = src_[4 * NTHR]; } while (0)
#define SCAN_PUT(buf_, i_, v_) do { const int id_ = tid + NTHR * (i_); *(uint4*)((buf_) + (id_ >> 3) * RP + (id_ & 7) * 8) = (v_); } while (0)
#define SCAN_COMMIT(buf_) do { SCAN_PUT(buf_, 0, rg0); SCAN_PUT(buf_, 1, rg1); SCAN_PUT(buf_, 2, rg2); SCAN_PUT(buf_, 3, rg3); SCAN_PUT(buf_, 4, rg4); } while (0)
    f32x4 S[4];
#pragma unroll
    for (int m = 0; m < 4; ++m) S[m] = (f32x4){0.f, 0.f, 0.f, 0.f};
    const int r16 = lane & 15, g = lane >> 4;
    SCAN_ISSUE(0); SCAN_COMMIT(buf0);
    __syncthreads();
    for (int c = 0; c < 128; ++c) {
        u16* cur = (c & 1) ? buf1 : buf0; u16* nxt = (c & 1) ? buf0 : buf1;
        if (c + 1 < 128) SCAN_ISSUE(c + 1);
        if (w < 4) {
            const float dec = egl[c];
            const u16* Ub = cur;
            const u16* Wb = cur + 64 * RP;
            const u16* QKb = cur + 128 * RP;
            const u16* QGb = cur + 192 * RP;
            const u16* KDb = cur + 256 * RP;
            bf16x8 Sb[2];
#pragma unroll
            for (int s = 0; s < 2; ++s) Sb[s] = pack8(S[2 * s][0], S[2 * s][1], S[2 * s][2], S[2 * s][3], S[2 * s + 1][0], S[2 * s + 1][1], S[2 * s + 1][2], S[2 * s + 1][3]);
            f32x4 vn[4], o[4];
#pragma unroll
            for (int mb = 0; mb < 4; ++mb) {
                f32x4 a = (f32x4){0.f, 0.f, 0.f, 0.f}, oo = (f32x4){0.f, 0.f, 0.f, 0.f};
#pragma unroll
                for (int s = 0; s < 2; ++s) {
                    const u16* pw = Wb + (16 * mb + r16) * RP + 32 * s + 4 * g;
                    const u16* pq = QGb + (16 * mb + r16) * RP + 32 * s + 4 * g;
                    a = MFMA16(cat4(*(const bf16x4*)pw, *(const bf16x4*)(pw + 16)), Sb[s], a);
                    oo = MFMA16(cat4(*(const bf16x4*)pq, *(const bf16x4*)(pq + 16)), Sb[s], oo);
                }
#pragma unroll
                for (int e = 0; e < 4; ++e) vn[mb][e] = bf2f(Ub[(16 * mb + 4 * g + e) * RP + 16 * w + r16]) - a[e];
                o[mb] = oo;
            }
            bf16x8 Vb[2];
#pragma unroll
            for (int s = 0; s < 2; ++s) Vb[s] = pack8(vn[2 * s][0], vn[2 * s][1], vn[2 * s][2], vn[2 * s][3], vn[2 * s + 1][0], vn[2 * s + 1][1], vn[2 * s + 1][2], vn[2 * s + 1][3]);
#pragma unroll
            for (int mb = 0; mb < 4; ++mb) {
                f32x4 oo = o[mb];
                f32x4 sn = S[mb] * dec;
#pragma unroll
                for (int s = 0; s < 2; ++s) {
                    const u16* pk = QKb + (16 * mb + r16) * RP + 32 * s + 4 * g;
                    const u16* pd = KDb + (16 * mb + r16) * RP + 32 * s + 4 * g;
                    oo = MFMA16(cat4(*(const bf16x4*)pk, *(const bf16x4*)(pk + 16)), Vb[s], oo);
                    sn = MFMA16(cat4(*(const bf16x4*)pd, *(const bf16x4*)(pd + 16)), Vb[s], sn);
                }
                S[mb] = sn;
#pragma unroll
                for (int e = 0; e < 4; ++e)
                    gout[(size_t)(b * SEQ + c * 64 + 16 * mb + 4 * g + e) * 256 + head * 64 + 16 * w + r16] = oo[e];
            }
        }
        if (c + 1 < 128) SCAN_COMMIT(nxt);
        __syncthreads();
    }
}

DI void phase_gdn_norm(const Params& P, int layer) {
    const int w = threadIdx.x >> 6, lane = threadIdx.x & 63;
    const float* gout = (const float*)(P.ws + OFF_GDNO);
    const u16* z = (const u16*)(P.ws + OFF_Z);
    u16* mix = (u16*)(P.ws + OFF_ABUF);
    const float4 ng = ((const float4*)(P.in[6] + layer * 64))[lane & 15];
    for (int t = blockIdx.x * 8 + w; t < NT; t += gridDim.x * 8) {
        const float4 o = ((const float4*)(gout + (size_t)t * 256))[lane];
        float ss = o.x * o.x + o.y * o.y + o.z * o.z + o.w * o.w;
        ss += __shfl_xor(ss, 1); ss += __shfl_xor(ss, 2); ss += __shfl_xor(ss, 4); ss += __shfl_xor(ss, 8);
        const float rstd = rsqrtf(ss * (1.f / 64.f) + 1e-6f);
        const uint2 zz = *(const uint2*)(z + (size_t)t * 256 + lane * 4);
        const float z0 = bf2f((u16)(zz.x & 0xffff)), z1 = bf2f((u16)(zz.x >> 16)), z2 = bf2f((u16)(zz.y & 0xffff)), z3 = bf2f((u16)(zz.y >> 16));
        uint2 r;
        r.x = pack2(o.x * rstd * ng.x * z0 * sigmoidf_(z0), o.y * rstd * ng.y * z1 * sigmoidf_(z1));
        r.y = pack2(o.z * rstd * ng.z * z2 * sigmoidf_(z2), o.w * rstd * ng.w * z3 * sigmoidf_(z3));
        *(uint2*)(mix + (size_t)t * DM + lane * 4) = r;
    }
}

template <bool FINAL>
DI void s5_item(const Params& P, int layer, int item, char* wlds, int lane) {
    const int b = item >> 11, g = (item >> 7) & 15, ch = item & 127;
    const int t0 = b * SEQ + ch * 64;
    const char* sp = P.ws + OFF_S5P + layer * S5P_LAYER;
    float* ut = (float*)wlds;
    u16* Xs = (u16*)(wlds + 4096);
    {
        const u16* src = (const u16*)(P.ws + OFF_US) + (size_t)(t0 + lane) * 256 + g * 16;
        const uint4 a = *(const uint4*)src, c = *(const uint4*)(src + 8);
        const unsigned uu[8] = {a.x, a.y, a.z, a.w, c.x, c.y, c.z, c.w};
#pragma unroll
        for (int i = 0; i < 8; ++i) { ut[lane * 16 + 2 * i] = bf2f((u16)(uu[i] & 0xffff)); ut[lane * 16 + 2 * i + 1] = bf2f((u16)(uu[i] >> 16)); }
    }
    float Br[16], Bi[16];
    {
        const float4* br = (const float4*)(sp + S5P_BRE) + (g * 64 + lane) * 4; const float4* bi = (const float4*)(sp + S5P_BIM) + (g * 64 + lane) * 4;
#pragma unroll
        for (int i = 0; i < 4; ++i) { const float4 x = br[i], y = bi[i]; Br[4 * i] = x.x; Br[4 * i + 1] = x.y; Br[4 * i + 2] = x.z; Br[4 * i + 3] = x.w; Bi[4 * i] = y.x; Bi[4 * i + 1] = y.y; Bi[4 * i + 2] = y.z; Bi[4 * i + 3] = y.w; }
    }
    const float2 ab = ((const float2*)(sp + S5P_ABAR))[g * 64 + lane];
    float2* st = (float2*)(P.ws + OFF_S5ST) + (size_t)item * 64 + lane;
    float xr = 0.f, xi = 0.f;
    if (FINAL) { const float2 c0 = *st; xr = c0.x; xi = c0.y; }
    bf16x8 cf[4];
    if (FINAL) {
        const u16* cm = (const u16*)(sp + S5P_CM) + (g * 16 + (lane & 15)) * 128 + 8 * (lane >> 4);
#pragma unroll
        for (int s = 0; s < 4; ++s) cf[s] = ld8(cm + 32 * s);
    }
    __builtin_amdgcn_wave_barrier();
    asm volatile("s_waitcnt lgkmcnt(0)" ::: "memory");
    for (int half = 0; half < 2; ++half) {
        for (int tt = 0; tt < 32; ++tt) {
            const int t = half * 32 + tt;
            const float4* u4 = (const float4*)(ut + t * 16);
            float br_ = 0.f, bi_ = 0.f;
#pragma unroll
            for (int q = 0; q < 4; ++q) {
                const float4 u = u4[q];
                br_ += Br[4 * q] * u.x + Br[4 * q + 1] * u.y + Br[4 * q + 2] * u.z + Br[4 * q + 3] * u.w;
                bi_ += Bi[4 * q] * u.x + Bi[4 * q + 1] * u.y + Bi[4 * q + 2] * u.z + Bi[4 * q + 3] * u.w;
            }
            const float nr = ab.x * xr - ab.y * xi + br_, ni = ab.x * xi + ab.y * xr + bi_;
            xr = nr; xi = ni;
            if (FINAL) { Xs[tt * 136 + lane] = f2bf(xr); Xs[tt * 136 + 64 + lane] = f2bf(xi); }
        }
        if (FINAL) {
            asm volatile("s_waitcnt lgkmcnt(0)" ::: "memory");
            __builtin_amdgcn_wave_barrier();
            const int r16 = lane & 15, gg = lane >> 4;
            const float dsv = P.in[13][layer * 256 + g * 16 + r16];
#pragma unroll
            for (int mb = 0; mb < 2; ++mb) {
                f32x4 acc = (f32x4){0.f, 0.f, 0.f, 0.f};
#pragma unroll
                for (int s = 0; s < 4; ++s) acc = MFMA16(ld8(Xs + (16 * mb + r16) * 136 + 32 * s + 8 * gg), cf[s], acc);
#pragma unroll
                for (int e = 0; e < 4; ++e) {
                    const int tk = half * 32 + 16 * mb + 4 * gg + e;
                    const float y = acc[e] + dsv * ut[tk * 16 + r16];
                    ((u16*)(P.ws + OFF_YS5))[(size_t)(t0 + tk) * 256 + g * 16 + r16] = f2bf(gelu_tanh(y));
                }
            }
            asm volatile("s_waitcnt lgkmcnt(0)" ::: "memory");
            __builtin_amdgcn_wave_barrier();
        }
    }
    if (!FINAL) *st = make_float2(xr, xi);
    asm volatile("s_waitcnt lgkmcnt(0)" ::: "memory");
    __builtin_amdgcn_wave_barrier();
}
template <bool FINAL>
DI void phase_s5(const Params& P, int layer, char* lds) {
    const int w = threadIdx.x >> 6, lane = threadIdx.x & 63;
    char* wl = lds + w * 12800;
    for (int it = blockIdx.x * 8 + w; it < 8192; it += gridDim.x * 8) s5_item<FINAL>(P, layer, it, wl, lane);
}
constexpr int KP = 136;
constexpr int VP = 68;
constexpr int ATT_STAGE = 64 * KP + 128 * VP;
DI void attn_item(const Params& P, int layer, int b, int head, int qb, char* lds) {
    const int tid = threadIdx.x, lane = tid & 63, w = tid >> 6;
    const int m = w >> 2, wq = w & 3, r = lane & 31, hh = lane >> 5;
    u16* st0 = (u16*)lds;
    const u16* QC = (const u16*)(P.ws + OFF_QC);
    const u16* KC = (const u16*)(P.ws + OFF_KC);
    const u16* VT = (const u16*)(P.ws + OFF_VT);
    const int qw0 = qb * 128 + 32 * wq;
    const int q = qw0 + r;
    bf16x8 qf[4];
    {
        const u16* qp = QC + (size_t)(b * SEQ + q) * 512 + head * 128 + m * 64 + hh * 8;
#pragma unroll
        for (int s = 0; s < 4; ++s) qf[s] = ld8(qp + 16 * s);
    }
    f32x16 o[4];
#pragma unroll
    for (int d = 0; d < 4; ++d)
#pragma unroll
        for (int e = 0; e < 16; ++e) o[d][e] = 0.f;
    float mrun = -INFINITY, lrun = 0.f;
    const int nkv = 2 * (qb + 1);
    const int kkey = tid >> 4, kch = tid & 15;
    const int vdv = tid >> 3, vch = tid & 7;
    const u16* kg = KC + (size_t)(b * SEQ + kkey) * 512 + head * 128 + kch * 8;
    const u16* vg = VT + ((size_t)((b * 4 + head) * 128 + vdv)) * SEQ + vch * 8;
    uint4 rk0, rk1, rv0, rv1;
#define ATT_ISSUE(j_) do { rk0 = *(const uint4*)(kg + (size_t)(64 * (j_)) * 512); rk1 = *(const uint4*)(kg + (size_t)(64 * (j_) + 32) * 512); \
        rv0 = *(const uint4*)(vg + 64 * (j_)); rv1 = *(const uint4*)(vg + (size_t)64 * SEQ + 64 * (j_)); } while (0)
#define ATT_COMMIT(stg_) do { u16* sg_ = (stg_); *(uint4*)(sg_ + kkey * KP + kch * 8) = rk0; *(uint4*)(sg_ + (kkey + 32) * KP + kch * 8) = rk1; \
        u16* vb_ = sg_ + 64 * KP; \
        *(uint2*)(vb_ + vdv * VP + vch * 8) = make_uint2(rv0.x, rv0.y); *(uint2*)(vb_ + vdv * VP + vch * 8 + 4) = make_uint2(rv0.z, rv0.w); \
        *(uint2*)(vb_ + (vdv + 64) * VP + vch * 8) = make_uint2(rv1.x, rv1.y); *(uint2*)(vb_ + (vdv + 64) * VP + vch * 8 + 4) = make_uint2(rv1.z, rv1.w); } while (0)
    ATT_ISSUE(0); ATT_COMMIT(st0);
    __syncthreads();
    for (int j = 0; j < nkv; ++j) {
        u16* cur = st0 + (j & 1) * ATT_STAGE; u16* nxt = st0 + ((j & 1) ^ 1) * ATT_STAGE;
        if (j + 1 < nkv) ATT_ISSUE(j + 1);
        if (64 * j <= qw0 + 31) {
            f32x16 s0, s1;
#pragma unroll
            for (int e = 0; e < 16; ++e) { s0[e] = 0.f; s1[e] = 0.f; }
            const u16* kp = cur + r * KP + m * 64 + hh * 8;
#pragma unroll
            for (int s = 0; s < 4; ++s) {
                s0 = MFMA32(ld8(kp + 16 * s), qf[s], s0);
                s1 = MFMA32(ld8(kp + 32 * KP + 16 * s), qf[s], s1);
            }
            if (64 * j + 63 > qw0) {
#pragma unroll
                for (int e = 0; e < 16; ++e) {
                    const int key = 64 * j + (e & 3) + 8 * (e >> 2) + 4 * hh;
                    if (key > q) s0[e] = -INFINITY;
                    if (key + 32 > q) s1[e] = -INFINITY;
                }
            }
            float mx = s0[0];
#pragma unroll
            for (int e = 1; e < 16; ++e) mx = fmaxf(mx, s0[e]);
#pragma unroll
            for (int e = 0; e < 16; ++e) mx = fmaxf(mx, s1[e]);
            mx = fmaxf(mx, __shfl_xor(mx, 32));
            const float mnew = fmaxf(mrun, mx);
            const float alpha = __builtin_amdgcn_exp2f(mrun - mnew);
            mrun = mnew;
            float psum = 0.f;
#pragma unroll
            for (int e = 0; e < 16; ++e) { s0[e] = __builtin_amdgcn_exp2f(s0[e] - mnew); psum += s0[e]; }
#pragma unroll
            for (int e = 0; e < 16; ++e) { s1[e] = __builtin_amdgcn_exp2f(s1[e] - mnew); psum += s1[e]; }
            lrun = lrun * alpha + psum;
#pragma unroll
            for (int d = 0; d < 4; ++d) o[d] = o[d] * alpha;
            bf16x8 pf[4];
            pf[0] = pack8(s0[0], s0[1], s0[2], s0[3], s0[4], s0[5], s0[6], s0[7]);
            pf[1] = pack8(s0[8], s0[9], s0[10], s0[11], s0[12], s0[13], s0[14], s0[15]);
            pf[2] = pack8(s1[0], s1[1], s1[2], s1[3], s1[4], s1[5], s1[6], s1[7]);
            pf[3] = pack8(s1[8], s1[9], s1[10], s1[11], s1[12], s1[13], s1[14], s1[15]);
            const u16* vp = cur + 64 * KP + r * VP + 4 * hh;
#pragma unroll
            for (int d = 0; d < 4; ++d)
#pragma unroll
                for (int kk = 0; kk < 4; ++kk) {
                    const u16* pa = vp + d * 32 * VP + 16 * kk;
                    o[d] = MFMA32(cat4(*(const bf16x4*)pa, *(const bf16x4*)(pa + 8)), pf[kk], o[d]);
                }
        }
        if (j + 1 < nkv) ATT_COMMIT(nxt);
        __syncthreads();
    }
    const float ltot = lrun + __shfl_xor(lrun, 32);
    const float inv = 1.f / ltot;
    float* ex = (float*)lds;
    if (m == 1) {
#pragma unroll
        for (int d = 0; d < 4; ++d)
#pragma unroll
            for (int e = 0; e < 16; ++e) ex[(wq * 64 + d * 16 + e) * 64 + lane] = o[d][e] * inv;
    }
    __syncthreads();
    if (m == 0) {
        const float lam = ((const float*)(P.ws + OFF_SCAL))[layer];
        const float lam_init = 0.8f - 0.6f * __expf(-0.3f * (float)layer);
        float ss = 0.f;
#pragma unroll
        for (int d = 0; d < 4; ++d)
#pragma unroll
            for (int e = 0; e < 16; ++e) { const float v = o[d][e] * inv - lam * ex[(wq * 64 + d * 16 + e) * 64 + lane]; o[d][e] = v; ss += v * v; }
        ss += __shfl_xor(ss, 32);
        const float sc = rsqrtf(ss * (1.f / 128.f) + 1e-6f) * (1.f - lam_init);
        const float* ng = P.in[21] + layer * 128;
        u16* mix = (u16*)(P.ws + OFF_ABUF) + (size_t)(b * SEQ + q) * DM + 512 + head * 128;
#pragma unroll
        for (int d = 0; d < 4; ++d)
#pragma unroll
            for (int qd = 0; qd < 4; ++qd) {
                const int dv0 = 32 * d + 8 * qd + 4 * hh;
                const float4 g4 = *(const float4*)(ng + dv0);
                uint2 pk; pk.x = pack2(o[d][4 * qd] * sc * g4.x, o[d][4 * qd + 1] * sc * g4.y); pk.y = pack2(o[d][4 * qd + 2] * sc * g4.z, o[d][4 * qd + 3] * sc * g4.w);
                *(uint2*)(mix + dv0) = pk;
            }
    }
    __syncthreads();
}
DI void phase_attn(const Params& P, int layer, char* lds) {
    for (int pi = blockIdx.x; pi < 512; pi += gridDim.x) {
        const int bh = pi >> 5, i = pi & 31;
        attn_item(P, layer, bh >> 2, bh & 3, 63 - i, lds);
        attn_item(P, layer, bh >> 2, bh & 3, i, lds);
    }
}

DI void ins16(float (&top)[16], float v) {
#pragma unroll
    for (int k = 0; k < 16; ++k) { const float hi = fmaxf(top[k], v); v = fminf(top[k], v); top[k] = hi; }
}
DI void phase_topk(const Params& P, int layer) {
    const int w = threadIdx.x >> 6, lane = threadIdx.x & 63, r = lane & 31, hh = lane >> 5;
    const u16* PQ = (const u16*)(P.ws + OFF_PQ);
    const u16* KEYS = (const u16*)(P.ws + OFF_KEYS) + (size_t)layer * 8 * 2 * 128 * 64;
    u16* pe = (u16*)(P.ws + OFF_PICKE); float* pg = (float*)(P.ws + OFF_PICKG);
    for (int it = blockIdx.x * 8 + w; it < 8192; it += gridDim.x * 8) {
        const int tile = it >> 3, h = it & 7; const int tok = tile * 32 + r;
        float sv[2][16];
#pragma unroll
        for (int p = 0; p < 2; ++p) {
            bf16x8 bq[4];
            const u16* qp = PQ + (size_t)tok * 1024 + h * 128 + p * 64 + hh * 8;
#pragma unroll
            for (int s = 0; s < 4; ++s) bq[s] = ld8(qp + 16 * s);
            float top[16];
#pragma unroll
            for (int k = 0; k < 16; ++k) top[k] = -INFINITY;
#pragma unroll 1
            for (int kb = 0; kb < 4; ++kb) {
                f32x16 acc;
#pragma unroll
                for (int e = 0; e < 16; ++e) acc[e] = 0.f;
                const u16* kp = KEYS + ((size_t)((h * 2 + p) * 128 + 32 * kb + r)) * 64 + hh * 8;
#pragma unroll
                for (int s = 0; s < 4; ++s) acc = MFMA32(ld8(kp + 16 * s), bq[s], acc);
#pragma unroll
                for (int e = 0; e < 16; ++e) {
                    const unsigned key = 32 * kb + (e & 3) + 8 * (e >> 2) + 4 * hh;
                    ins16(top, __uint_as_float((__float_as_uint(acc[e]) & ~0x7Fu) | key));
                }
            }
            float oth[16];
#pragma unroll
            for (int k = 0; k < 16; ++k) oth[k] = __shfl_xor(top[k], 32);
#pragma unroll
            for (int k = 0; k < 16; ++k) ins16(top, oth[k]);
#pragma unroll
            for (int k = 0; k < 16; ++k) sv[p][k] = top[k];
        }
        float top[16];
#pragma unroll
        for (int k = 0; k < 16; ++k) top[k] = -INFINITY;
#pragma unroll
        for (int i = 0; i < 16; ++i)
#pragma unroll
            for (int j = 0; j < 16; ++j)
                if ((i + 1) * (j + 1) <= 16) {
                    const float s = __uint_as_float(__float_as_uint(sv[0][i]) & ~0x7Fu) + __uint_as_float(__float_as_uint(sv[1][j]) & ~0x7Fu);
                    ins16(top, __uint_as_float((__float_as_uint(s) & ~0xFFu) | (unsigned)(i * 16 + j)));
                }
        float ev[16]; float den = 0.f;
        const float mx = __uint_as_float(__float_as_uint(top[0]) & ~0xFFu);
#pragma unroll
        for (int k = 0; k < 16; ++k) { ev[k] = __expf(__uint_as_float(__float_as_uint(top[k]) & ~0xFFu) - mx); den += ev[k]; }
        const float rden = 1.f / den;
#pragma unroll
        for (int k = 0; k < 16; ++k) {
            const unsigned code = __float_as_uint(top[k]) & 0xFFu; const unsigned wi = code >> 4, wj = code & 15u;
            unsigned i0 = 0, i1 = 0;
#pragma unroll
            for (int i = 0; i < 16; ++i) { i0 = (wi == (unsigned)i) ? (__float_as_uint(sv[0][i]) & 0x7Fu) : i0; i1 = (wj == (unsigned)i) ? (__float_as_uint(sv[1][i]) & 0x7Fu) : i1; }
            if ((k >> 3) == hh) {
                pe[(size_t)tok * 128 + h * 16 + k] = (u16)(i0 * 128 + i1);
                pg[(size_t)tok * 128 + h * 16 + k] = ev[k] * rden;
            }
        }
    }
}

DI void fp8x16_to_f32(const uint4& u, float (&f)[16]) {
    const unsigned uu[4] = {u.x, u.y, u.z, u.w};
#pragma unroll
    for (int q = 0; q < 4; ++q) {
        const f32x2 lo = __builtin_amdgcn_cvt_pk_f32_fp8((int)uu[q], false), hi = __builtin_amdgcn_cvt_pk_f32_fp8((int)uu[q], true);
        f[4 * q] = lo[0]; f[4 * q + 1] = lo[1]; f[4 * q + 2] = hi[0]; f[4 * q + 3] = hi[1];
    }
}
template <int CTRL> DI int dpp_i(int v) { return __builtin_amdgcn_update_dpp(0, v, CTRL, 0xF, 0xF, true); }
template <int CTRL> DI float dpp_f(float v) { return __int_as_float(__builtin_amdgcn_update_dpp(0, __float_as_int(v), CTRL, 0xF, 0xF, true)); }
DI int rowreduce4(int p0, int p1, int p2, int p3, bool odd, bool bit1) {
    const int a01 = odd ? p1 : p0, b01 = odd ? p0 : p1;
    const int r01 = a01 + dpp_i<0xB1>(b01);
    const int a23 = odd ? p3 : p2, b23 = odd ? p2 : p3;
    const int r23 = a23 + dpp_i<0xB1>(b23);
    const int a = bit1 ? r23 : r01, b = bit1 ? r01 : r23;
    int r = a + dpp_i<0x4E>(b);
    r += dpp_i<0x124>(r);
    r += dpp_i<0x128>(r);
    return r;
}
DI int dot16_i8(const uint4& u, const int (&xq)[4]) {
    int p = __builtin_amdgcn_sdot4((int)u.x, xq[0], 0, false);
    p = __builtin_amdgcn_sdot4((int)u.y, xq[1], p, false);
    p = __builtin_amdgcn_sdot4((int)u.z, xq[2], p, false);
    p = __builtin_amdgcn_sdot4((int)u.w, xq[3], p, false);
    return p;
}
#define PEER_LOAD8(buf_, tab_, ev_, base_) do { _Pragma("unroll") for (int i_ = 0; i_ < 8; ++i_) { \
        const int e_ = __builtin_amdgcn_readlane((ev_), (base_) + i_); buf_[i_] = *(const uint4*)((tab_) + (size_t)e_ * 1024 + lane * 16); } } while (0)

template <bool DRY>
DI void phase_peer(const Params& P, int layer, const float* hin, float* hout, bool last) {
    const int w = threadIdx.x >> 6, lane = threadIdx.x & 63;
    const uint8_t* UT = (const uint8_t*)(P.ws + OFF_UTAB) + (size_t)layer * 16384 * 1024;
    const uint8_t* VTb = (const uint8_t*)(P.ws + OFF_VTAB) + (size_t)layer * 16384 * 1024;
    const float* USC = (const float*)(P.ws + OFF_USCALE) + layer * 16384;
    const u16* pe = (const u16*)(P.ws + OFF_PICKE); const float* pg = (const float*)(P.ws + OFF_PICKG);
    u16* abuf = (u16*)(P.ws + OFF_ABUF);
    const bool odd = lane & 1, bit1 = lane & 2; const int qsel = (lane >> 2) & 3, R = lane >> 4;
    for (int t = blockIdx.x * 8 + w; t < NT; t += gridDim.x * 8) {
        int xq[4]; float sx;
        {
            const uint4 a = *(const uint4*)(abuf + (size_t)t * DM + lane * 16), c = *(const uint4*)(abuf + (size_t)t * DM + lane * 16 + 8);
            const unsigned uu[8] = {a.x, a.y, a.z, a.w, c.x, c.y, c.z, c.w};
            float x[16]; float am = 0.f;
#pragma unroll
            for (int i = 0; i < 8; ++i) { x[2 * i] = bf2f((u16)(uu[i] & 0xffff)); x[2 * i + 1] = bf2f((u16)(uu[i] >> 16)); am = fmaxf(am, fmaxf(fabsf(x[2 * i]), fabsf(x[2 * i + 1]))); }
            am = fmaxf(am, dpp_f<0xB1>(am)); am = fmaxf(am, dpp_f<0x4E>(am)); am = fmaxf(am, dpp_f<0x124>(am)); am = fmaxf(am, dpp_f<0x128>(am));
            am = fmaxf(am, __shfl_xor(am, 16)); am = fmaxf(am, __shfl_xor(am, 32));
            const float sc = am > 0.f ? 127.f / am : 0.f; sx = am * (1.f / 127.f);
#pragma unroll
            for (int q = 0; q < 4; ++q) {
                const int a0 = (int)rintf(x[4 * q] * sc), a1 = (int)rintf(x[4 * q + 1] * sc), a2 = (int)rintf(x[4 * q + 2] * sc), a3 = (int)rintf(x[4 * q + 3] * sc);
                xq[q] = (int)((unsigned)(a0 & 0xff) | ((unsigned)(a1 & 0xff) << 8) | ((unsigned)(a2 & 0xff) << 16) | ((unsigned)(a3 & 0xff) << 24));
            }
        }
        const int e0 = pe[(size_t)t * 128 + lane], e1 = pe[(size_t)t * 128 + 64 + lane];
        const float g0 = pg[(size_t)t * 128 + lane], g1 = pg[(size_t)t * 128 + 64 + lane];
        const float su0 = USC[e0], su1 = USC[e1];
        f32x2 y2[8];
#pragma unroll
        for (int i = 0; i < 8; ++i) y2[i] = (f32x2){0.f, 0.f};
        uint4 bufA[8], bufB[8], bufC[8], bufD[8];
        int e0v = e0, e1v = e1; asm volatile("" : "+v"(e0v), "+v"(e1v));
        int md[4] = {0, 0, 0, 0};
        float coef = 0.f;
#define PB_TAB(k_) ((((k_) >> 3) & 1) ? VTb : UT)
#define PB_EV(k_) ((((k_) >> 3) & 1) ? (((k_) >> 4) ? e1v : e0v) : (((k_) >> 4) ? e1 : e0))
#define PB_LOAD(buf_, k_) PEER_LOAD8(buf_, PB_TAB(k_), PB_EV(k_), 8 * ((k_) & 7))
#define PB_UCOMP(cur_, k_) do { \
            if (((k_) & 7) == 0) { md[0] = 0; md[1] = 0; md[2] = 0; md[3] = 0; } \
            _Pragma("unroll") for (int gq = 0; gq < 2; ++gq) { \
                const int p0 = dot16_i8(cur_[4 * gq], xq), p1 = dot16_i8(cur_[4 * gq + 1], xq), p2 = dot16_i8(cur_[4 * gq + 2], xq), p3 = dot16_i8(cur_[4 * gq + 3], xq); \
                const int r = rowreduce4(p0, p1, p2, p3, odd, bit1); \
                const int bidx = 2 * ((k_) & 7) + gq; \
                md[bidx >> 2] = (qsel == (bidx & 3)) ? r : md[bidx >> 2]; } \
            if (((k_) & 7) == 7) { \
                _Pragma("unroll") for (int kk = 0; kk < 4; ++kk) { md[kk] += __shfl_xor(md[kk], 16); md[kk] += __shfl_xor(md[kk], 32); } \
                const int mdot = R == 0 ? md[0] : R == 1 ? md[1] : R == 2 ? md[2] : md[3]; \
                const float dot = (float)mdot * (((k_) >> 4) ? su1 : su0) * sx; \
                coef = (((k_) >> 4) ? g1 : g0) * gelu_tanh(dot) * (1.f / 8.f); } } while (0)
#define PB_VCOMP(cur_, k_) do { _Pragma("unroll") for (int i = 0; i < 8; ++i) { \
            const float c = __uint_as_float((unsigned)__builtin_amdgcn_readlane((int)__float_as_uint(coef), 8 * ((k_) & 7) + i)); \
            const unsigned uu_[4] = {cur_[i].x, cur_[i].y, cur_[i].z, cur_[i].w}; \
            _Pragma("unroll") for (int q = 0; q < 4; ++q) { \
                const f32x2 lo_ = __builtin_amdgcn_cvt_pk_f32_fp8((int)uu_[q], false), hi_ = __builtin_amdgcn_cvt_pk_f32_fp8((int)uu_[q], true); \
                y2[2 * q] += lo_ * c; y2[2 * q + 1] += hi_ * c; } } } while (0)
#define PB_STEP(k_, cur_, pf_) do { \
            if ((k_) + 3 < 32) { PB_LOAD(pf_, (k_) + 3); } \
            asm volatile("" ::: "memory"); __builtin_amdgcn_sched_barrier(0); \
            if ((((k_) >> 3) & 1) == 0) PB_UCOMP(cur_, k_); else PB_VCOMP(cur_, k_); \
            asm volatile("" ::: "memory"); __builtin_amdgcn_sched_barrier(0); } while (0)
        PB_LOAD(bufA, 0); PB_LOAD(bufB, 1); PB_LOAD(bufC, 2);
        PB_STEP(0, bufA, bufD); PB_STEP(1, bufB, bufA); PB_STEP(2, bufC, bufB); PB_STEP(3, bufD, bufC);
        PB_STEP(4, bufA, bufD); PB_STEP(5, bufB, bufA); PB_STEP(6, bufC, bufB); PB_STEP(7, bufD, bufC);
        PB_STEP(8, bufA, bufD); PB_STEP(9, bufB, bufA); PB_STEP(10, bufC, bufB); PB_STEP(11, bufD, bufC);
        PB_STEP(12, bufA, bufD); PB_STEP(13, bufB, bufA); PB_STEP(14, bufC, bufB); PB_STEP(15, bufD, bufC);
        PB_STEP(16, bufA, bufD); PB_STEP(17, bufB, bufA); PB_STEP(18, bufC, bufB); PB_STEP(19, bufD, bufC);
        PB_STEP(20, bufA, bufD); PB_STEP(21, bufB, bufA); PB_STEP(22, bufC, bufB); PB_STEP(23, bufD, bufC);
        PB_STEP(24, bufA, bufD); PB_STEP(25, bufB, bufA); PB_STEP(26, bufC, bufB); PB_STEP(27, bufD, bufC);
        PB_STEP(28, bufA, bufD); PB_STEP(29, bufB, bufA); PB_STEP(30, bufC, bufB); PB_STEP(31, bufD, bufC);
        float4 v[4];
        const float4* h4 = (const float4*)(hin + (size_t)t * DM + lane * 16);
#pragma unroll
        for (int i = 0; i < 4; ++i) { v[i] = h4[i]; v[i].x += y2[2 * i][0]; v[i].y += y2[2 * i][1]; v[i].z += y2[2 * i + 1][0]; v[i].w += y2[2 * i + 1][1]; }
        float ss = 0.f;
#pragma unroll
        for (int i = 0; i < 4; ++i) ss += v[i].x * v[i].x + v[i].y * v[i].y + v[i].z * v[i].z + v[i].w * v[i].w;
        ss = wave_sum(ss);
        const float rstd = rsqrtf(ss * (1.f / DM) + 1e-6f);
        if (DRY) { asm volatile("" :: "v"(rstd)); continue; }
        if (last) {
            const float4* g4 = (const float4*)(P.in[28]) + lane * 4;
            float4* o4 = (float4*)(hout + (size_t)t * DM + lane * 16);
#pragma unroll
            for (int i = 0; i < 4; ++i) { const float4 g = g4[i]; o4[i] = make_float4(v[i].x * rstd * g.x, v[i].y * rstd * g.y, v[i].z * rstd * g.z, v[i].w * rstd * g.w); }
        } else {
            float4* o4 = (float4*)(hout + (size_t)t * DM + lane * 16);
#pragma unroll
            for (int i = 0; i < 4; ++i) o4[i] = v[i];
            const float4* g4 = (const float4*)(P.in[1] + (layer + 1) * DM) + lane * 4;
            float vn[16];
#pragma unroll
            for (int i = 0; i < 4; ++i) { const float4 g = g4[i]; vn[4 * i] = v[i].x * rstd * g.x; vn[4 * i + 1] = v[i].y * rstd * g.y; vn[4 * i + 2] = v[i].z * rstd * g.z; vn[4 * i + 3] = v[i].w * rstd * g.w; }
            uint4 o0, o1;
            o0.x = pack2(vn[0], vn[1]); o0.y = pack2(vn[2], vn[3]); o0.z = pack2(vn[4], vn[5]); o0.w = pack2(vn[6], vn[7]);
            o1.x = pack2(vn[8], vn[9]); o1.y = pack2(vn[10], vn[11]); o1.z = pack2(vn[12], vn[13]); o1.w = pack2(vn[14], vn[15]);
            *(uint4*)(abuf + (size_t)t * DM + lane * 16) = o0; *(uint4*)(abuf + (size_t)t * DM + lane * 16 + 8) = o1;
            const float4* wab = (const float4*)(P.ws + OFF_WAB) + (layer + 1) * 8 * 256;
            float myacc = 0.f;
#pragma unroll 1
            for (int j = 0; j < 8; ++j) {
                asm volatile("" : "+s"(wab));
                float a = 0.f;
#pragma unroll
                for (int i = 0; i < 4; ++i) { const float4 ww = wab[j * 256 + lane * 4 + i]; a += vn[4 * i] * ww.x + vn[4 * i + 1] * ww.y + vn[4 * i + 2] * ww.z + vn[4 * i + 3] * ww.w; }
                a = wave_sum(a);
                myacc = (lane == j) ? a : myacc;
            }
            const float bb = __shfl(myacc, (lane + 4) & 63);
            if (lane < 4) {
                const int L1 = layer + 1;
                const float a = myacc;
                const float xx = a + P.in[5][L1 * 4 + lane];
                const float sp = xx > 20.f ? xx : log1pf(__expf(xx));
                ((float*)(P.ws + OFF_GG))[t * 4 + lane] = -__expf(P.in[4][L1 * 4 + lane]) * sp;
                ((float*)(P.ws + OFF_BETA))[t * 4 + lane] = sigmoidf_(bb);
            }
        }
    }
}


#define XB_TMO      128
#define XB_XCNT(j)  (256  + 64 * (j))
#define XB_XSUB(j)  (1280 + 64 * (j))
#define XB_XGEN(j)  (2304 + 64 * (j))
#define XB_TOP      3328
#define XB_TOPGEN   3392
#define XCD_BAR_WORDS 3456
#define XB_SPIN_CAP (1u << 22)
#define LAS __attribute__((address_space(3)))
DI unsigned xb_ld(unsigned* p)              { return __hip_atomic_load(p, __ATOMIC_RELAXED, __HIP_MEMORY_SCOPE_AGENT); }
DI unsigned xb_add(unsigned* p, unsigned v) { return __hip_atomic_fetch_add(p, v, __ATOMIC_RELAXED, __HIP_MEMORY_SCOPE_AGENT); }
DI unsigned xb_xcc_id() { return (unsigned)__builtin_amdgcn_s_getreg((3 << 11) | 20) & 0xFu; }
#define XB_SPIN(cond, bar) do { unsigned _sp = 0; while (cond) { __builtin_amdgcn_s_sleep(1); \
    if ((++_sp & 255u) == 0u) { if (xb_ld(&(bar)[XB_TMO])) break; if (_sp > XB_SPIN_CAP) { atomicAdd(&(bar)[XB_TMO], 1u); break; } } } } while (0)
struct XcdBarrier { unsigned* bar; unsigned x; volatile LAS unsigned* st; };
DI XcdBarrier xcd_barrier_post(unsigned* bar, volatile LAS unsigned* st) {
    XcdBarrier b; b.bar = bar; b.x = xb_xcc_id(); b.st = st;
    if (threadIdx.x == 0) (void)xb_add(&bar[XB_XCNT(b.x)], 1u);
    return b;
}
DI void xcd_barrier_complete(unsigned* bar, unsigned x, unsigned& nloc, unsigned& nx) {
    const unsigned G = gridDim.x * gridDim.y * gridDim.z;
    unsigned sum, cnt, mine, sp = 0u;
    for (;;) {
        sum = 0u; cnt = 0u; mine = 0u;
#pragma unroll
        for (unsigned j = 0; j < 16; ++j) { const unsigned c = xb_ld(&bar[XB_XCNT(j)]); sum += c; cnt += (c > 0u) ? 1u : 0u; mine = (j == x) ? c : mine; }
        if (sum == G) break;
        __builtin_amdgcn_s_sleep(1);
        if ((++sp & 255u) == 0u) { if (xb_ld(&bar[XB_TMO])) break; if (sp > XB_SPIN_CAP) { atomicAdd(&bar[XB_TMO], 1u); break; } }
    }
    nloc = mine > 0u ? mine : 1u; nx = cnt > 0u ? cnt : 1u;
}
DI void xcd_barrier(const XcdBarrier& b) {
    asm volatile("s_waitcnt vmcnt(0)" ::: "memory");
    __syncthreads();
    if (threadIdx.x == 0) {
        unsigned* bar = b.bar;
        __builtin_amdgcn_s_waitcnt(0);
        unsigned nloc = b.st[0], nx = b.st[1];
        if (nloc == 0u) { xcd_barrier_complete(bar, b.x, nloc, nx); b.st[0] = nloc; b.st[1] = nx; }
        const unsigned old = xb_add(&bar[XB_XSUB(b.x)], 1u);
        const unsigned gen = old / nloc;
        if (old + 1u == (gen + 1u) * nloc) {
            __builtin_amdgcn_fence(__ATOMIC_RELEASE, "agent");
            asm volatile("s_waitcnt vmcnt(0)" ::: "memory");
            const unsigned og = xb_add(&bar[XB_TOP], 1u);
            const unsigned tg = og / nx;
            if (og + 1u == (tg + 1u) * nx) xb_add(&bar[XB_TOPGEN], 1u);
            else XB_SPIN(xb_ld(&bar[XB_TOPGEN]) == tg, bar);
            __builtin_amdgcn_fence(__ATOMIC_ACQUIRE, "agent");
            xb_add(&bar[XB_XGEN(b.x)], 1u);
            asm volatile("s_waitcnt vmcnt(0)" ::: "memory");
        } else {
            XB_SPIN(xb_ld(&bar[XB_XGEN(b.x)]) == gen, bar);
            __builtin_amdgcn_fence(__ATOMIC_ACQUIRE, "agent");
            asm volatile("s_waitcnt vmcnt(0)" ::: "memory");
        }
    }
    __syncthreads();
}

constexpr int PH_PER_LAYER = 11;
constexpr int NPHASE = 2 + 2 * PH_PER_LAYER;

#ifdef ONLY_SUB
#define SUB_ON(k) (ONLY_SUB == (k))
#else
#define SUB_ON(k) 1
#endif
DI void run_phase(const Params& P, int ph, char* lds) {
    char* ws = P.ws;
#if SUB_ON(100)
    if (ph == 0) { phase_prep(P, lds); return; }
#endif
#if SUB_ON(101)
    if (ph == 1) { phase_rms(P, P.in[0], P.in[1], (u16*)(ws + OFF_ABUF), 0); return; }
#endif
    if (ph < 2) return;
    const int layer = (ph - 2) / PH_PER_LAYER, sub = (ph - 2) % PH_PER_LAYER;
    const float* hin = layer == 0 ? P.in[0] : P.out;
    switch (sub) {
    #if SUB_ON(0)
    case 0: { EpiInProj e{ws}; phase_gemm((const u16*)(ws + OFF_ABUF), 1024, (const u16*)(ws + OFF_WINT) + (size_t)layer * PROJW * 1024, 1024, NT, PROJW, 1024, e, lds); } break;

#endif
    #if SUB_ON(1)
    case 1:
        for (int it = blockIdx.x; it < 2048; it += gridDim.x) gdn_prep_item(P, layer, it, lds);
        phase_s5<false>(P, layer, lds);
        break;

#endif
    #if SUB_ON(2)
    case 2:
        if (blockIdx.x < 16) gdn_scan_chain(P, blockIdx.x, lds);
        else if (blockIdx.x < 24) {
            const int gt = (blockIdx.x - 16) * NTHR + threadIdx.x;
            if (gt < 4096) {
                const int bg = gt >> 6, n = gt & 63;
                const float2 a = ((const float2*)(ws + OFF_S5P + layer * S5P_LAYER + S5P_A64))[(bg & 15) * 64 + n];
                float2* st = (float2*)(ws + OFF_S5ST) + (size_t)bg * 128 * 64 + n;
                float xr = 0.f, xi = 0.f;
                for (int c = 0; c < 128; ++c) {
                    const float2 sv = st[c * 64];
                    st[c * 64] = make_float2(xr, xi);
                    const float nr = a.x * xr - a.y * xi + sv.x, ni = a.x * xi + a.y * xr + sv.y;
                    xr = nr; xi = ni;
                }
            }
        }
        break;

#endif
    #if SUB_ON(3)
    case 3: phase_s5<true>(P, layer, lds); break;

#endif
    #if SUB_ON(4)
    case 4: {
        EpiGlu e{(u16*)(ws + OFF_ABUF), P.in[16] + layer * 512};
        phase_gemm((const u16*)(ws + OFF_YS5), 256, (const u16*)(ws + OFF_GLUT) + (size_t)layer * 512 * 256, 256, NT, 512, 256, e, lds);
        phase_gdn_norm(P, layer);
    } break;

#endif
    #if SUB_ON(5)
    case 5: phase_attn(P, layer, lds); break;

#endif
    #if SUB_ON(6)
    case 6: { EpiResidual e{hin, P.out}; phase_gemm((const u16*)(ws + OFF_ABUF), 1024, (const u16*)(ws + OFF_WOUTT) + (size_t)layer * 1024 * 1024, 1024, NT, 1024, 1024, e, lds); } break;

#endif
    #if SUB_ON(7)
    case 7: phase_rms(P, P.out, P.in[23] + layer * DM, (u16*)(ws + OFF_ABUF), -1); break;

#endif
    #if SUB_ON(8)
    case 8: { EpiBf16 e{(u16*)(ws + OFF_PQ), 1024}; phase_gemm((const u16*)(ws + OFF_ABUF), 1024, (const u16*)(ws + OFF_WQT) + (size_t)layer * 1024 * 1024, 1024, NT, 1024, 1024, e, lds); } break;

#endif
    #if SUB_ON(9)
    case 9: phase_topk(P, layer); break;

#endif
    #if SUB_ON(10)
    case 10: phase_peer<false>(P, layer, P.out, P.out, layer == 1); break;
#endif
    }
}

#ifndef USE_CG_SYNC
#define USE_CG_SYNC 0
#endif
#if USE_CG_SYNC
#define GRID_SYNC() cg::this_grid().sync()
#else
#define GRID_SYNC() xcd_barrier(xbar)
#endif
__global__ void __launch_bounds__(NTHR) mk_fwd(Params P, int ph_lo, int ph_hi) {
    extern __shared__ __attribute__((aligned(16))) char lds[];
#if !USE_CG_SYNC
    volatile LAS unsigned* xst = (volatile LAS unsigned*)(lds + LDS_BYTES - 16);
    if (threadIdx.x == 0) { xst[0] = 0u; xst[1] = 0u; }
    __syncthreads();
    XcdBarrier xbar = xcd_barrier_post((unsigned*)(P.ws + OFF_CTL), xst);
#endif
#ifndef DUP_SUB
#define DUP_SUB -1
#endif
#define PH(k) if (ph_lo <= (k) && (k) < ph_hi) { \
        if ((k) >= 2 && ((k) - 2) % PH_PER_LAYER == DUP_SUB) { \
            if (DUP_SUB == 10) phase_peer<true>(P, ((k) - 2) / PH_PER_LAYER, P.out, P.out, false); \
            else if (DUP_SUB == 2) { if (blockIdx.x < 16) gdn_scan_chain(P, blockIdx.x, lds); } \
            else if (DUP_SUB == 6) { if ((k) < 2 + PH_PER_LAYER) run_phase(P, (k), lds); } \
            else run_phase(P, (k), lds); } \
        if ((k) < 2 && DUP_SUB == 100 + (k)) run_phase(P, (k), lds); \
        run_phase(P, (k), lds); if (DUP_SUB == 99) GRID_SYNC(); if ((k) + 1 < ph_hi) GRID_SYNC(); }
    PH(0) PH(1) PH(2) PH(3) PH(4) PH(5) PH(6) PH(7) PH(8) PH(9) PH(10) PH(11) PH(12)
    PH(13) PH(14) PH(15) PH(16) PH(17) PH(18) PH(19) PH(20) PH(21) PH(22) PH(23)
#undef PH
}

extern "C" void kernel_launch(void* const* d_in, const int* in_sizes, int n_in, void* d_out, int out_size, void* d_ws, size_t ws_size, hipStream_t stream) {
    static int grid = 0;
    if (grid == 0) {
        int dev = 0, cus = 0, per_cu = 0;
        hipGetDevice(&dev);
        hipDeviceGetAttribute(&cus, hipDeviceAttributeMultiprocessorCount, dev);
        hipFuncSetAttribute((const void*)mk_fwd, hipFuncAttributeMaxDynamicSharedMemorySize, LDS_BYTES);
        hipOccupancyMaxActiveBlocksPerMultiprocessor(&per_cu, (const void*)mk_fwd, NTHR, LDS_BYTES);
        if (per_cu < 1) { fprintf(stderr, "occupancy query says %d blocks per CU\n", per_cu); per_cu = 1; }
        grid = cus;
        if (ws_size < OFF_END) { fprintf(stderr, "workspace too small: %zu < %zu\n", ws_size, (size_t)OFF_END); }
    }
    Params p{};
    for (int i = 0; i < 29; ++i) p.in[i] = (const float*)d_in[i];
    p.out = (float*)d_out; p.ws = (char*)d_ws;
#if MK_ONE_LAUNCH
    int lo = 0, hi = NPHASE;
    (void)hipMemsetAsync((char*)d_ws + OFF_CTL, 0, 65536, stream);
#if USE_CG_SYNC
    void* args[] = {&p, &lo, &hi};
    hipError_t e = hipLaunchCooperativeKernel((const void*)mk_fwd, dim3(grid), dim3(NTHR), args, LDS_BYTES, stream);
    if (e != hipSuccess) fprintf(stderr, "cooperative launch failed: %s\n", hipGetErrorString(e));
#else
    hipLaunchKernelGGL(mk_fwd, dim3(grid), dim3(NTHR), LDS_BYTES, stream, p, lo, hi);
#endif
#else
    for (int ph = 0; ph < NPHASE; ++ph) hipLaunchKernelGGL(mk_fwd, dim3(grid), dim3(NTHR), LDS_BYTES, stream, p, ph, ph + 1);
#endif
}
```

```cpp
#include <hip/hip_runtime.h>
#include <hip/hip_cooperative_groups.h>
#include <stdint.h>
#include <stdio.h>
namespace cg = cooperative_groups;

#ifndef MK_ONE_LAUNCH
#define MK_ONE_LAUNCH 1
#endif

#define DI __device__ __forceinline__
typedef unsigned short u16;
typedef __attribute__((ext_vector_type(8))) short bf16x8;
typedef __attribute__((ext_vector_type(4))) short bf16x4;
typedef __attribute__((ext_vector_type(16))) float f32x16;
typedef __attribute__((ext_vector_type(4))) float f32x4;
typedef __attribute__((ext_vector_type(2))) float f32x2;

constexpr int NT = 32768, DM = 1024, SEQ = 8192, NBATCH = 4;
constexpr int NTHR = 512;
constexpr int INW = 2824;
constexpr int PROJW = 2816;
constexpr float LOG2E = 1.4426950408889634f;

constexpr size_t OFF_CTL   = 0;
constexpr size_t OFF_WINT  = 65536;
constexpr size_t OFF_WOUTT = OFF_WINT  + (size_t)2 * PROJW * 1024 * 2;
constexpr size_t OFF_WQT   = OFF_WOUTT + (size_t)2 * 1024 * 1024 * 2;
constexpr size_t OFF_GLUT  = OFF_WQT   + (size_t)2 * 1024 * 1024 * 2;
constexpr size_t OFF_KEYS  = OFF_GLUT  + (size_t)2 * 512 * 256 * 2;
constexpr size_t OFF_WAB   = OFF_KEYS  + (size_t)2 * 8 * 2 * 128 * 64 * 2;
constexpr size_t OFF_S5P   = OFF_WAB   + (size_t)2 * 8 * 1024 * 4;
constexpr size_t S5P_LAYER = 262144;
constexpr size_t S5P_ABAR = 0, S5P_A64 = 8192, S5P_BRE = 16384, S5P_BIM = 16384 + 65536, S5P_CM = 16384 + 131072;
constexpr size_t OFF_SCAL  = OFF_S5P   + 2 * S5P_LAYER;
constexpr size_t OFF_UTAB  = OFF_SCAL  + 256;
constexpr size_t OFF_VTAB  = OFF_UTAB  + (size_t)2 * 16384 * 1024;
constexpr size_t OFF_USCALE = OFF_VTAB + (size_t)2 * 16384 * 1024;
constexpr size_t OFF_ABUF  = OFF_USCALE + (size_t)2 * 16384 * 4;
constexpr size_t OFF_GG    = OFF_ABUF  + (size_t)NT * 1024 * 2;
constexpr size_t OFF_BETA  = OFF_GG    + (size_t)NT * 4 * 4;
constexpr size_t OFF_PROJ  = OFF_BETA  + (size_t)NT * 4 * 4;
constexpr size_t OFF_QKV   = OFF_PROJ;
constexpr size_t OFF_Z     = OFF_QKV   + (size_t)NT * 768 * 2;
constexpr size_t OFF_US    = OFF_Z     + (size_t)NT * 256 * 2;
constexpr size_t OFF_QC    = OFF_US    + (size_t)NT * 256 * 2;
constexpr size_t OFF_KC    = OFF_QC    + (size_t)NT * 512 * 2;
constexpr size_t OFF_VT    = OFF_KC    + (size_t)NT * 512 * 2;
constexpr size_t OFF_GREC  = OFF_VT    + (size_t)NT * 512 * 2;
constexpr size_t GREC_BYTES = 40960;
constexpr size_t OFF_EGL   = OFF_GREC  + (size_t)2048 * GREC_BYTES;
constexpr size_t OFF_S5ST  = OFF_EGL   + 2048 * 4;
constexpr size_t OFF_YS5   = OFF_S5ST  + (size_t)8192 * 64 * 8;
constexpr size_t OFF_END   = OFF_YS5   + (size_t)NT * 256 * 2;
constexpr size_t OFF_GDNO  = OFF_QKV;
constexpr size_t OFF_PQ    = OFF_PROJ;
constexpr size_t OFF_PICKE = OFF_GREC;
constexpr size_t OFF_PICKG = OFF_GREC + (size_t)NT * 128 * 2;
static_assert(OFF_END < (size_t)512 * 1024 * 1024, "workspace");

constexpr int LDS_BYTES = 148480 + 16;

struct Params {
    const float* in[29];
    float* out;
    char* ws;
};

DI u16 f2bf(float x) { unsigned u = __float_as_uint(x); u += 0x7fffu + ((u >> 16) & 1u); return (u16)(u >> 16); }
DI float bf2f(u16 v) { return __uint_as_float(((unsigned)v) << 16); }
DI unsigned pack2(float a, float b) { unsigned r; asm("v_cvt_pk_bf16_f32 %0, %1, %2" : "=v"(r) : "v"(a), "v"(b)); return r; }
DI float wave_sum(float v) { for (int o = 32; o > 0; o >>= 1) v += __shfl_xor(v, o); return v; }
DI float gelu_tanh(float x) { float u = 0.7978845608028654f * (x + 0.044715f * x * x * x); float e = __expf(2.f * u); float th = 1.f - 2.f / (e + 1.f); return 0.5f * x * (1.f + th); }
DI float sigmoidf_(float x) { return 1.f / (1.f + __expf(-x)); }
#define MFMA32(a, b, c) __builtin_amdgcn_mfma_f32_32x32x16_bf16((a), (b), (c), 0, 0, 0)
#define MFMA16(a, b, c) __builtin_amdgcn_mfma_f32_16x16x32_bf16((a), (b), (c), 0, 0, 0)
DI bf16x8 ld8(const void* p) { return *(const bf16x8*)p; }
DI bf16x8 cat4(bf16x4 lo, bf16x4 hi) { return __builtin_shufflevector(lo, hi, 0, 1, 2, 3, 4, 5, 6, 7); }
DI bf16x8 pack8(float a0, float a1, float a2, float a3, float a4, float a5, float a6, float a7) {
    uint4 u; u.x = pack2(a0, a1); u.y = pack2(a2, a3); u.z = pack2(a4, a5); u.w = pack2(a6, a7);
    return __builtin_bit_cast(bf16x8, u);
}

template <class CM>
DI void transpose_tile(const float* __restrict__ src, int src_ld, u16* __restrict__ dst, int K, int n0, int k0, CM colmap, float* tl) {
    const int tid = threadIdx.x;
    {
        const int nn = tid & 63;
        const int sc = colmap(n0 + nn);
#pragma unroll
        for (int i = 0; i < 8; ++i) { const int kk = (tid >> 6) + 8 * i; tl[kk * 65 + nn] = src[(size_t)(k0 + kk) * src_ld + sc]; }
    }
    __syncthreads();
    {
        const int kk = tid & 63;
#pragma unroll
        for (int i = 0; i < 8; ++i) { const int nn = (tid >> 6) + 8 * i; dst[(size_t)(n0 + nn) * K + k0 + kk] = f2bf(tl[kk * 65 + nn]); }
    }
    __syncthreads();
}

DI void phase_prep(const Params& P, char* lds) {
    float* tl = (float*)lds;
    char* ws = P.ws;
    const int bid = blockIdx.x, nb = gridDim.x, tid = threadIdx.x;
    for (int j = bid; j < 2496; j += nb) {
        if (j < 1408) {
            const int l = j / 704, r = j % 704, nt = r / 16, kt = r % 16;
            transpose_tile(P.in[2] + (size_t)l * 1024 * INW, INW, (u16*)(ws + OFF_WINT) + (size_t)l * PROJW * 1024, 1024, nt * 64, kt * 64,
                           [](int n) { return n < 1024 ? n : n + 8; }, tl);
        } else if (j < 1920) {
            const int q = j - 1408; const int l = q / 256, r = q % 256, nt = r / 16, kt = r % 16;
            transpose_tile(P.in[22] + (size_t)l * 1024 * 1024, 1024, (u16*)(ws + OFF_WOUTT) + (size_t)l * 1024 * 1024, 1024, nt * 64, kt * 64, [](int n) { return n; }, tl);
        } else if (j < 2432) {
            const int q = j - 1920; const int l = q / 256, r = q % 256, nt = r / 16, kt = r % 16;
            transpose_tile(P.in[24] + (size_t)l * 1024 * 1024, 1024, (u16*)(ws + OFF_WQT) + (size_t)l * 1024 * 1024, 1024, nt * 64, kt * 64, [](int n) { return n; }, tl);
        } else {
            const int q = j - 2432; const int l = q / 32, r = q % 32, nt = r / 4, kt = r % 4;
            transpose_tile(P.in[15] + (size_t)l * 256 * 512, 512, (u16*)(ws + OFF_GLUT) + (size_t)l * 512 * 256, 256, nt * 64, kt * 64,
                           [](int n) { const int blk = n >> 6, wi = n & 63; return wi < 32 ? 32 * blk + wi : 256 + 32 * blk + (wi - 32); }, tl);
        }
    }
    const size_t gtid = (size_t)bid * NTHR + tid, gsz = (size_t)nb * NTHR;
    for (size_t i = gtid; i < (size_t)2 * 8 * 2 * 128 * 64; i += gsz) ((u16*)(ws + OFF_KEYS))[i] = f2bf(P.in[25][i]);
    for (size_t i = gtid; i < (size_t)2 * 8 * 1024; i += gsz) {
        const int l = (int)(i / 8192), j = (int)((i / 1024) % 8), k = (int)(i % 1024);
        ((float*)(ws + OFF_WAB))[i] = P.in[2][(size_t)l * 1024 * INW + (size_t)k * INW + 1024 + j];
    }
    {
        const int wv = tid >> 6, lane = tid & 63;
        for (int row = bid * 8 + wv; row < 2 * 16384; row += nb * 8) {
            const float4* s = (const float4*)(P.in[26] + (size_t)row * 1024) + lane * 4;
            float4 v[4]; float am = 0.f;
#pragma unroll
            for (int q = 0; q < 4; ++q) { v[q] = s[q]; am = fmaxf(am, fmaxf(fmaxf(fabsf(v[q].x), fabsf(v[q].y)), fmaxf(fabsf(v[q].z), fabsf(v[q].w)))); }
            for (int o = 32; o > 0; o >>= 1) am = fmaxf(am, __shfl_xor(am, o));
            const float sc = am > 0.f ? 127.f / am : 0.f;
            uint4 o4; unsigned* op = (unsigned*)&o4;
#pragma unroll
            for (int q = 0; q < 4; ++q) {
                const int a = (int)rintf(v[q].x * sc), b = (int)rintf(v[q].y * sc), c = (int)rintf(v[q].z * sc), d = (int)rintf(v[q].w * sc);
                op[q] = (unsigned)(a & 0xff) | ((unsigned)(b & 0xff) << 8) | ((unsigned)(c & 0xff) << 16) | ((unsigned)(d & 0xff) << 24);
            }
            ((uint4*)(ws + OFF_UTAB))[(size_t)row * 64 + lane] = o4;
            if (lane == 0) ((float*)(ws + OFF_USCALE))[row] = am * (1.f / 127.f);
        }
        const size_t n16 = (size_t)2 * 16384 * 1024 / 16;
        for (size_t i = gtid; i < n16; i += gsz) {
            const float4* s = (const float4*)P.in[27] + i * 4;
            uint4 o; unsigned* op = (unsigned*)&o;
#pragma unroll
            for (int q = 0; q < 4; ++q) {
                const float4 v = s[q];
                int wv2 = __builtin_amdgcn_cvt_pk_fp8_f32(v.x * 8.f, v.y * 8.f, 0, false);
                wv2 = __builtin_amdgcn_cvt_pk_fp8_f32(v.z * 8.f, v.w * 8.f, wv2, true);
                op[q] = (unsigned)wv2;
            }
            ((uint4*)(ws + OFF_VTAB))[i] = o;
        }
    }
    for (size_t i = gtid; i < (size_t)2 * 16 * 64; i += gsz) {
        const int l = (int)(i / 1024), g = (int)((i / 64) % 16), n = (int)(i % 64);
        const float step = __expf(P.in[14][l * 16 + g]);
        const float lr = P.in[7][i], li = P.in[8][i];
        const float er = expf(lr * step); const float ar = er * cosf(li * step), ai = er * sinf(li * step);
        const float e64 = expf(64.f * lr * step); const float a64r = e64 * cosf(64.f * li * step), a64i = e64 * sinf(64.f * li * step);
        char* sp = ws + OFF_S5P + l * S5P_LAYER;
        ((float2*)(sp + S5P_ABAR))[g * 64 + n] = make_float2(ar, ai);
        ((float2*)(sp + S5P_A64))[g * 64 + n] = make_float2(a64r, a64i);
        const float xr = ar - 1.f, xi = ai; const float den = 1.f / (lr * lr + li * li);
        const float cr = (xr * lr + xi * li) * den, ci = (xi * lr - xr * li) * den;
        for (int c = 0; c < 16; ++c) {
            const float br = P.in[9][i * 16 + c], bi = P.in[10][i * 16 + c];
            ((float*)(sp + S5P_BRE))[(g * 64 + n) * 16 + c] = cr * br - ci * bi;
            ((float*)(sp + S5P_BIM))[(g * 64 + n) * 16 + c] = cr * bi + ci * br;
        }
    }
    for (size_t i = gtid; i < (size_t)2 * 16 * 16 * 128; i += gsz) {
        const int l = (int)(i / 32768), g = (int)((i / 2048) % 16), c = (int)((i / 128) % 16), k = (int)(i % 128);
        const size_t si = ((size_t)(l * 16 + g) * 16 + c) * 64 + (k & 63);
        const float v = k < 64 ? P.in[11][si] : -P.in[12][si];
        ((u16*)(ws + OFF_S5P + l * S5P_LAYER + S5P_CM))[(g * 16 + c) * 128 + k] = f2bf(v);
    }
    if (bid == 0 && tid < 2) {
        const int l = tid; float s1 = 0.f, s2 = 0.f;
        for (int d = 0; d < 64; ++d) { s1 += P.in[17][l * 64 + d] * P.in[18][l * 64 + d]; s2 += P.in[19][l * 64 + d] * P.in[20][l * 64 + d]; }
        const float lam_init = 0.8f - 0.6f * expf(-0.3f * (float)l);
        ((float*)(ws + OFF_SCAL))[l] = expf(s1) - expf(s2) + lam_init;
    }
}

DI void rms_token(const Params& P, int t, int lane, float4 (&v)[4], const float* gain, u16* dst, int ab_layer  ) {
    float ss = 0.f;
#pragma unroll
    for (int i = 0; i < 4; ++i) ss += v[i].x * v[i].x + v[i].y * v[i].y + v[i].z * v[i].z + v[i].w * v[i].w;
    ss = wave_sum(ss);
    const float rstd = rsqrtf(ss * (1.f / DM) + 1e-6f);
    const float4* g4 = (const float4*)gain;
#pragma unroll
    for (int i = 0; i < 4; ++i) {
        const float4 g = g4[lane + 64 * i];
        v[i].x *= rstd * g.x; v[i].y *= rstd * g.y; v[i].z *= rstd * g.z; v[i].w *= rstd * g.w;
        uint2 o; o.x = pack2(v[i].x, v[i].y); o.y = pack2(v[i].z, v[i].w);
        *(uint2*)(dst + (size_t)t * DM + (lane + 64 * i) * 4) = o;
    }
    if (ab_layer >= 0) {
        const float4* wab = (const float4*)(P.ws + OFF_WAB) + ab_layer * 8 * 256;
        float acc[8];
#pragma unroll
        for (int j = 0; j < 8; ++j) {
            float a = 0.f;
#pragma unroll
            for (int i = 0; i < 4; ++i) { const float4 w = wab[j * 256 + lane + 64 * i]; a += v[i].x * w.x + v[i].y * w.y + v[i].z * w.z + v[i].w * w.w; }
            acc[j] = wave_sum(a);
        }
        if (lane < 4) {
            const float a = lane == 0 ? acc[0] : lane == 1 ? acc[1] : lane == 2 ? acc[2] : acc[3];
            const float b = lane == 0 ? acc[4] : lane == 1 ? acc[5] : lane == 2 ? acc[6] : acc[7];
            const float xx = a + P.in[5][ab_layer * 4 + lane];
            const float sp = xx > 20.f ? xx : log1pf(__expf(xx));
            ((float*)(P.ws + OFF_GG))[t * 4 + lane] = -__expf(P.in[4][ab_layer * 4 + lane]) * sp;
            ((float*)(P.ws + OFF_BETA))[t * 4 + lane] = sigmoidf_(b);
        }
    }
}

DI void phase_rms(const Params& P, const float* src, const float* gain, u16* dst, int ab_layer) {
    const int w = threadIdx.x >> 6, lane = threadIdx.x & 63;
    for (int t = blockIdx.x * 8 + w; t < NT; t += gridDim.x * 8) {
        const float4* s4 = (const float4*)(src + (size_t)t * DM);
        float4 v[4];
#pragma unroll
        for (int i = 0; i < 4; ++i) v[i] = s4[lane + 64 * i];
        rms_token(P, t, lane, v, gain, dst, ab_layer);
    }
}

constexpr int GP = 40;
template <class Epi>
DI void gemm_tile(const u16* __restrict__ A, int lda, const u16* __restrict__ Bt, int ldb, int K, int m0, int n0, Epi& epi, char* lds) {
    const int tid = threadIdx.x, lane = tid & 63, w = tid >> 6;
    const int wm = w >> 2, wn = w & 3, r = lane & 31, hh = lane >> 5;
    u16* As = (u16*)lds;
    u16* Bs = As + 2 * 256 * GP;
    f32x16 acc[4][2];
#pragma unroll
    for (int i = 0; i < 4; ++i)
#pragma unroll
        for (int j = 0; j < 2; ++j)
#pragma unroll
            for (int e = 0; e < 16; ++e) acc[i][j][e] = 0.f;
    const int lrow = tid >> 2, lkc = tid & 3;
    const u16* ga0 = A + (size_t)(m0 + lrow) * lda + lkc * 8;
    const u16* ga1 = A + (size_t)(m0 + lrow + 128) * lda + lkc * 8;
    const u16* gb0 = Bt + (size_t)(n0 + lrow) * ldb + lkc * 8;
    const u16* gb1 = Bt + (size_t)(n0 + lrow + 128) * ldb + lkc * 8;
    const int so0 = lrow * GP + lkc * 8, so1 = (lrow + 128) * GP + lkc * 8;
    uint4 ra0 = *(const uint4*)ga0, ra1 = *(const uint4*)ga1, rb0 = *(const uint4*)gb0, rb1 = *(const uint4*)gb1;
    *(uint4*)(As + so0) = ra0; *(uint4*)(As + so1) = ra1; *(uint4*)(Bs + so0) = rb0; *(uint4*)(Bs + so1) = rb1;
    __syncthreads();
    const int nk = K / 32;
    for (int kt = 0; kt < nk; ++kt) {
        const int cur = kt & 1;
        if (kt + 1 < nk) {
            const int ko = (kt + 1) * 32;
            ra0 = *(const uint4*)(ga0 + ko); ra1 = *(const uint4*)(ga1 + ko); rb0 = *(const uint4*)(gb0 + ko); rb1 = *(const uint4*)(gb1 + ko);
        }
        const u16* Ac = As + cur * 256 * GP + (wm * 128 + r) * GP + hh * 8;
        const u16* Bc = Bs + cur * 256 * GP + (wn * 64 + r) * GP + hh * 8;
#pragma unroll
        for (int ks = 0; ks < 2; ++ks) {
            bf16x8 af[4], bfr[2];
#pragma unroll
            for (int i = 0; i < 4; ++i) af[i] = ld8(Ac + i * 32 * GP + ks * 16);
#pragma unroll
            for (int j = 0; j < 2; ++j) bfr[j] = ld8(Bc + j * 32 * GP + ks * 16);
#pragma unroll
            for (int i = 0; i < 4; ++i)
#pragma unroll
                for (int j = 0; j < 2; ++j) acc[i][j] = MFMA32(af[i], bfr[j], acc[i][j]);
        }
        if (kt + 1 < nk) {
            const int nx = (cur ^ 1) * 256 * GP;
            *(uint4*)(As + nx + so0) = ra0; *(uint4*)(As + nx + so1) = ra1; *(uint4*)(Bs + nx + so0) = rb0; *(uint4*)(Bs + nx + so1) = rb1;
        }
        __syncthreads();
    }
    epi(acc, m0 + wm * 128, n0 + wn * 64, r, hh);
}

struct EpiInProj {
    char* ws;
    DI void operator()(f32x16 (&acc)[4][2], int mw, int nw, int r, int hh) const {
        if (nw >= 2304) {
            u16* vt = (u16*)(ws + OFF_VT);
#pragma unroll
            for (int i = 0; i < 4; ++i)
#pragma unroll
                for (int j = 0; j < 2; ++j) {
                    const int c = nw - 2304 + 32 * j + r; const int head = c >> 7, dv = c & 127;
#pragma unroll
                    for (int q = 0; q < 4; ++q) {
                        const int row = mw + 32 * i + 8 * q + 4 * hh; const int b = row >> 13, l = row & 8191;
                        uint2 o; o.x = pack2(acc[i][j][4 * q], acc[i][j][4 * q + 1]); o.y = pack2(acc[i][j][4 * q + 2], acc[i][j][4 * q + 3]);
                        *(uint2*)(vt + ((size_t)((b * 4 + head) * 128 + dv)) * SEQ + l) = o;
                    }
                }
            return;
        }
        u16* base; int pitch, c0; float sc = 1.f;
        if (nw < 768) { base = (u16*)(ws + OFF_QKV); pitch = 768; c0 = nw; }
        else if (nw < 1024) { base = (u16*)(ws + OFF_Z); pitch = 256; c0 = nw - 768; }
        else if (nw < 1280) { base = (u16*)(ws + OFF_US); pitch = 256; c0 = nw - 1024; }
        else if (nw < 1792) { base = (u16*)(ws + OFF_QC); pitch = 512; c0 = nw - 1280; sc = 0.125f * LOG2E; }
        else { base = (u16*)(ws + OFF_KC); pitch = 512; c0 = nw - 1792; }
#pragma unroll
        for (int i = 0; i < 4; ++i)
#pragma unroll
            for (int j = 0; j < 2; ++j)
#pragma unroll
                for (int e = 0; e < 16; ++e) {
                    const int row = mw + 32 * i + (e & 3) + 8 * (e >> 2) + 4 * hh;
                    base[(size_t)row * pitch + c0 + 32 * j + r] = f2bf(acc[i][j][e] * sc);
                }
    }
};
struct EpiResidual {
    const float* hin; float* hout;
    DI void operator()(f32x16 (&acc)[4][2], int mw, int nw, int r, int hh) const {
#pragma unroll
        for (int i = 0; i < 4; ++i)
#pragma unroll
            for (int j = 0; j < 2; ++j)
#pragma unroll
                for (int e = 0; e < 16; ++e) {
                    const size_t idx = (size_t)(mw + 32 * i + (e & 3) + 8 * (e >> 2) + 4 * hh) * DM + nw + 32 * j + r;
                    hout[idx] = hin[idx] + acc[i][j][e];
                }
    }
};
struct EpiBf16 {
    u16* dst; int pitch;
    DI void operator()(f32x16 (&acc)[4][2], int mw, int nw, int r, int hh) const {
#pragma unroll
        for (int i = 0; i < 4; ++i)
#pragma unroll
            for (int j = 0; j < 2; ++j)
#pragma unroll
                for (int e = 0; e < 16; ++e)
                    dst[(size_t)(mw + 32 * i + (e & 3) + 8 * (e >> 2) + 4 * hh) * pitch + nw + 32 * j + r] = f2bf(acc[i][j][e]);
    }
};
struct EpiGlu {
    u16* mix; const float* bias;
    DI void operator()(f32x16 (&acc)[4][2], int mw, int nw, int r, int hh) const {
        const int col = 32 * (nw >> 6) + r;
        const float bv = bias[col], bg = bias[256 + col];
#pragma unroll
        for (int i = 0; i < 4; ++i)
#pragma unroll
            for (int e = 0; e < 16; ++e) {
                const int row = mw + 32 * i + (e & 3) + 8 * (e >> 2) + 4 * hh;
                const float val = acc[i][0][e] + bv, gate = acc[i][1][e] + bg;
                mix[(size_t)row * DM + 256 + col] = f2bf(val * sigmoidf_(gate));
            }
    }
};

template <class Epi>
DI void phase_gemm(const u16* A, int lda, const u16* Bt, int ldb, int M, int N, int K, Epi epi, char* lds) {
    const int ntn = N / 256, ntm = M / 256;
    for (int t = blockIdx.x; t < ntn * ntm; t += gridDim.x) {
        const int mt = t / ntn, nt = t % ntn;
        gemm_tile(A, lda, Bt, ldb, K, mt * 256, nt * 256, epi, lds);
    }
}

template <int CTRL> DI float dppf(float v) { return __int_as_float(__builtin_amdgcn_update_dpp(0, __float_as_int(v), CTRL, 0xF, 0xF, true)); }
DI void gdn_prep_item(const Params& P, int layer, int item, char* lds) {
    const int tid = threadIdx.x, lane = tid & 63, w = tid >> 6;
    const int b = item >> 9, head = (item >> 7) & 3, ch = item & 127;
    const int t0 = b * SEQ + ch * 64;
    u16* raw = (u16*)lds;
    float* qs = (float*)(lds + 25856);
    float* ks = qs + 64 * 68;
    float* vs = ks + 64 * 68;
    float* Lp = vs + 64 * 68;
    u16* qb = (u16*)(Lp + 64 * 68);
    u16* kb = qb + 64 * 72;
    float* Gs = (float*)(kb + 64 * 72);
    float* bs = Gs + 64;
    u16* Xs = raw;
    const u16* qkv = (const u16*)(P.ws + OFF_QKV);
    u16* rec = (u16*)(P.ws + OFF_GREC + (size_t)item * GREC_BYTES);
    for (int i = tid; i < 67 * 24; i += NTHR) {
        const int row = i / 24, c8 = i % 24; const int part = c8 >> 3, cc = (c8 & 7) * 8;
        const int l = ch * 64 + row - 3;
        uint4 v = make_uint4(0, 0, 0, 0);
        if (l >= 0) v = *(const uint4*)(qkv + (size_t)(b * SEQ + l) * 768 + part * 256 + head * 64 + cc);
        *(uint4*)(raw + row * 192 + part * 64 + cc) = v;
    }
    if (tid < 64) {
        bs[tid] = ((const float*)(P.ws + OFF_BETA))[(t0 + tid) * 4 + head];
        float g = ((const float*)(P.ws + OFF_GG))[(t0 + tid) * 4 + head];
#pragma unroll
        for (int o = 1; o < 64; o <<= 1) { const float tt = __shfl_up(g, o); if (lane >= o) g += tt; }
        Gs[tid] = g;
    }
    __syncthreads();
    {
        const float* cw = P.in[3] + (size_t)layer * 4 * 768;
#pragma unroll 1
        for (int it = 0; it < 3; ++it) {
            const int id = tid + NTHR * it; const int t = id / 24, c8 = id % 24; const int part = c8 >> 3, d0 = (c8 & 7) * 8;
            float a[8];
#pragma unroll
            for (int k = 0; k < 8; ++k) a[k] = 0.f;
#pragma unroll
            for (int j = 0; j < 4; ++j) {
                const uint4 rv = *(const uint4*)(raw + (t + j) * 192 + part * 64 + d0);
                const float4 w0 = *(const float4*)(cw + j * 768 + part * 256 + head * 64 + d0), w1 = *(const float4*)(cw + j * 768 + part * 256 + head * 64 + d0 + 4);
                a[0] += w0.x * bf2f((u16)(rv.x & 0xffff)); a[1] += w0.y * bf2f((u16)(rv.x >> 16));
                a[2] += w0.z * bf2f((u16)(rv.y & 0xffff)); a[3] += w0.w * bf2f((u16)(rv.y >> 16));
                a[4] += w1.x * bf2f((u16)(rv.z & 0xffff)); a[5] += w1.y * bf2f((u16)(rv.z >> 16));
                a[6] += w1.z * bf2f((u16)(rv.w & 0xffff)); a[7] += w1.w * bf2f((u16)(rv.w >> 16));
            }
            float ss = 0.f;
#pragma unroll
            for (int k = 0; k < 8; ++k) { a[k] = a[k] * sigmoidf_(a[k]); ss += a[k] * a[k]; }
            ss += dppf<0xB1>(ss); ss += dppf<0x4E>(ss); ss += dppf<0x141>(ss);
            const float sc = part == 2 ? 1.f : rsqrtf(ss + 1e-6f) * (part == 0 ? 0.125f : 1.f);
#pragma unroll
            for (int k = 0; k < 8; ++k) a[k] *= sc;
            float* dst = (part == 0 ? qs : part == 1 ? ks : vs) + t * 68 + d0;
            *(float4*)dst = make_float4(a[0], a[1], a[2], a[3]); *(float4*)(dst + 4) = make_float4(a[4], a[5], a[6], a[7]);
            if (part < 2) {
                uint4 pk; pk.x = pack2(a[0], a[1]); pk.y = pack2(a[2], a[3]); pk.z = pack2(a[4], a[5]); pk.w = pack2(a[6], a[7]);
                *(uint4*)((part == 0 ? qb : kb) + t * 72 + d0) = pk;
            }
        }
    }
    __syncthreads();
    {
        const int r = lane & 31, hh = lane >> 5; const int bi = (w >> 1) & 1, bj = w & 1; const bool isqk = w >= 4;
        const u16* Am = (isqk ? qb : kb) + (bi * 32 + r) * 72 + hh * 8;
        const u16* Bm = kb + (bj * 32 + r) * 72 + hh * 8;
        f32x16 acc;
#pragma unroll
        for (int e = 0; e < 16; ++e) acc[e] = 0.f;
#pragma unroll
        for (int s = 0; s < 4; ++s) acc = MFMA32(ld8(Am + s * 16), ld8(Bm + s * 16), acc);
        const int cidx = bj * 32 + r; const float Gc = Gs[cidx], bc = bs[cidx];
#pragma unroll
        for (int e = 0; e < 16; ++e) {
            const int ridx = bi * 32 + (e & 3) + 8 * (e >> 2) + 4 * hh;
            if (isqk) {
                rec[2 * 4096 + ridx * 64 + cidx] = f2bf(cidx <= ridx ? acc[e] * __expf(Gs[ridx] - Gc) : 0.f);
            } else {
                Lp[ridx * 68 + (cidx & 3) * 16 + (cidx >> 2)] = (ridx < cidx) ? bc * acc[e] * __expf(Gc - Gs[ridx]) : 0.f;
            }
        }
    }
    __syncthreads();
    {
        const int c = tid >> 2, q = tid & 3; const bool isw = c >= 64; const int cc = c & 63;
        float rhs[16];
#pragma unroll
        for (int m = 0; m < 16; ++m) {
            const int i = 4 * m + q; const float bi_ = bs[i];
            rhs[m] = isw ? ks[i * 68 + cc] * bi_ * __expf(Gs[i]) : vs[i * 68 + cc] * bi_;
        }
        const float* Lq = Lp + q * 16;
#define SOLVE_STEP(j_, CTRL_) do { \
            const float xj = dppf<CTRL_>(rhs[(j_) >> 2]); \
            const float4* l4 = (const float4*)(Lq + (j_) * 68); \
            const float4 la = l4[0], lb = l4[1], lc = l4[2], ld = l4[3]; \
            rhs[0] -= la.x * xj; rhs[1] -= la.y * xj; rhs[2] -= la.z * xj; rhs[3] -= la.w * xj; \
            rhs[4] -= lb.x * xj; rhs[5] -= lb.y * xj; rhs[6] -= lb.z * xj; rhs[7] -= lb.w * xj; \
            rhs[8] -= lc.x * xj; rhs[9] -= lc.y * xj; rhs[10] -= lc.z * xj; rhs[11] -= lc.w * xj; \
            rhs[12] -= ld.x * xj; rhs[13] -= ld.y * xj; rhs[14] -= ld.z * xj; rhs[15] -= ld.w * xj; } while (0)
#pragma unroll
        for (int jj = 0; jj < 16; ++jj) {
            SOLVE_STEP(4 * jj + 0, 0x00); SOLVE_STEP(4 * jj + 1, 0x55); SOLVE_STEP(4 * jj + 2, 0xAA); SOLVE_STEP(4 * jj + 3, 0xFF);
        }
#undef SOLVE_STEP
        __syncthreads();
#pragma unroll
        for (int m = 0; m < 16; ++m) Xs[(4 * m + q) * 136 + c] = f2bf(rhs[m]);
    }
    __syncthreads();
    {
#pragma unroll
        for (int it = 0; it < 2; ++it) {
            const int id = tid + NTHR * it; const int i = id >> 4, c8 = (id & 15) * 8;
            *(uint4*)(rec + (c8 >> 6) * 4096 + i * 64 + (c8 & 63)) = *(const uint4*)(Xs + i * 136 + c8);
        }
        {
            const int t = tid >> 3, d0 = (tid & 7) * 8; const float eg = __expf(Gs[t]);
            const float4 x0 = *(const float4*)(qs + t * 68 + d0), x1 = *(const float4*)(qs + t * 68 + d0 + 4);
            uint4 pk; pk.x = pack2(x0.x * eg, x0.y * eg); pk.y = pack2(x0.z * eg, x0.w * eg); pk.z = pack2(x1.x * eg, x1.y * eg); pk.w = pack2(x1.z * eg, x1.w * eg);
            *(uint4*)(rec + 3 * 4096 + t * 64 + d0) = pk;
        }
        {
            const int d = tid & 63, tb = (tid >> 6) * 8; const float Gl = Gs[63];
            float kv[8];
#pragma unroll
            for (int k = 0; k < 8; ++k) kv[k] = ks[(tb + k) * 68 + d] * __expf(Gl - Gs[tb + k]);
            uint4 pk; pk.x = pack2(kv[0], kv[1]); pk.y = pack2(kv[2], kv[3]); pk.z = pack2(kv[4], kv[5]); pk.w = pack2(kv[6], kv[7]);
            *(uint4*)(rec + 4 * 4096 + d * 64 + tb) = pk;
            if (tid == 0) ((float*)(P.ws + OFF_EGL))[item] = __expf(Gl);
        }
    }
    __syncthreads();
}

constexpr int RP = 72;
DI void gdn_scan_chain(const Params& P, int chain, char* lds) {
    const int tid = threadIdx.x, lane = tid & 63, w = tid >> 6;
    const int b = chain >> 2, head = chain & 3;
    u16* buf0 = (u16*)lds;
    u16* buf1 = buf0 + 320 * RP;
    const char* recbase = P.ws + OFF_GREC + (size_t)(chain * 128) * GREC_BYTES;
    const float* egl = (const float*)(P.ws + OFF_EGL) + chain * 128;
    float* gout = (float*)(P.ws + OFF_GDNO);
    uint4 rg0, rg1, rg2, rg3, rg4;
#define SCAN_ISSUE(c_) do { const uint4* src_ = (const uint4*)(recbase + (size_t)(c_) * GREC_BYTES) + tid; \
        rg0 = src_[0]; rg1 = src_[NTHR]; rg2 = src_[2 * NTHR]; rg3 = src_[3 * NTHR]; rg4 = src_[4 * NTHR]; } while (0)
#define SCAN_PUT(buf_, i_, v_) do { const int id_ = tid + NTHR * (i_); *(uint4*)((buf_) + (id_ >> 3) * RP + (id_ & 7) * 8) = (v_); } while (0)
#define SCAN_COMMIT(buf_) do { SCAN_PUT(buf_, 0, rg0); SCAN_PUT(buf_, 1, rg1); SCAN_PUT(buf_, 2, rg2); SCAN_PUT(buf_, 3, rg3); SCAN_PUT(buf_, 4, rg4); } while (0)
    f32x4 S[4];
#pragma unroll
    for (int m = 0; m < 4; ++m) S[m] = (f32x4){0.f, 0.f, 0.f, 0.f};
    const int r16 = lane & 15, g = lane >> 4;
    SCAN_ISSUE(0); SCAN_COMMIT(buf0);
    __syncthreads();
    for (int c = 0; c < 128; ++c) {
        u16* cur = (c & 1) ? buf1 : buf0; u16* nxt = (c & 1) ? buf0 : buf1;
        if (c + 1 < 128) SCAN_ISSUE(c + 1);
        if (w < 4) {
            const float dec = egl[c];
            const u16* Ub = cur;
            const u16* Wb = cur + 64 * RP;
            const u16* QKb = cur + 128 * RP;
            const u16* QGb = cur + 192 * RP;
            const u16* KDb = cur + 256 * RP;
            bf16x8 Sb[2];
#pragma unroll
            for (int s = 0; s < 2; ++s) Sb[s] = pack8(S[2 * s][0], S[2 * s][1], S[2 * s][2], S[2 * s][3], S[2 * s + 1][0], S[2 * s + 1][1], S[2 * s + 1][2], S[2 * s + 1][3]);
            f32x4 vn[4], o[4];
#pragma unroll
            for (int mb = 0; mb < 4; ++mb) {
                f32x4 a = (f32x4){0.f, 0.f, 0.f, 0.f}, oo = (f32x4){0.f, 0.f, 0.f, 0.f};
#pragma unroll
                for (int s = 0; s < 2; ++s) {
                    const u16* pw = Wb + (16 * mb + r16) * RP + 32 * s + 4 * g;
                    const u16* pq = QGb + (16 * mb + r16) * RP + 32 * s + 4 * g;
                    a = MFMA16(cat4(*(const bf16x4*)pw, *(const bf16x4*)(pw + 16)), Sb[s], a);
                    oo = MFMA16(cat4(*(const bf16x4*)pq, *(const bf16x4*)(pq + 16)), Sb[s], oo);
                }
#pragma unroll
                for (int e = 0; e < 4; ++e) vn[mb][e] = bf2f(Ub[(16 * mb + 4 * g + e) * RP + 16 * w + r16]) - a[e];
                o[mb] = oo;
            }
            bf16x8 Vb[2];
#pragma unroll
            for (int s = 0; s < 2; ++s) Vb[s] = pack8(vn[2 * s][0], vn[2 * s][1], vn[2 * s][2], vn[2 * s][3], vn[2 * s + 1][0], vn[2 * s + 1][1], vn[2 * s + 1][2], vn[2 * s + 1][3]);
#pragma unroll
            for (int mb = 0; mb < 4; ++mb) {
                f32x4 oo = o[mb];
                f32x4 sn = S[mb] * dec;
#pragma unroll
                for (int s = 0; s < 2; ++s) {
                    const u16* pk = QKb + (16 * mb + r16) * RP + 32 * s + 4 * g;
                    const u16* pd = KDb + (16 * mb + r16) * RP + 32 * s + 4 * g;
                    oo = MFMA16(cat4(*(const bf16x4*)pk, *(const bf16x4*)(pk + 16)), Vb[s], oo);
                    sn = MFMA16(cat4(*(const bf16x4*)pd, *(const bf16x4*)(pd + 16)), Vb[s], sn);
                }
                S[mb] = sn;
#pragma unroll
                for (int e = 0; e < 4; ++e)
                    gout[(size_t)(b * SEQ + c * 64 + 16 * mb + 4 * g + e) * 256 + head * 64 + 16 * w + r16] = oo[e];
            }
        }
        if (c + 1 < 128) SCAN_COMMIT(nxt);
        __syncthreads();
    }
}

DI void phase_gdn_norm(const Params& P, int layer) {
    const int w = threadIdx.x >> 6, lane = threadIdx.x & 63;
    const float* gout = (const float*)(P.ws + OFF_GDNO);
    const u16* z = (const u16*)(P.ws + OFF_Z);
    u16* mix = (u16*)(P.ws + OFF_ABUF);
    const float4 ng = ((const float4*)(P.in[6] + layer * 64))[lane & 15];
    for (int t = blockIdx.x * 8 + w; t < NT; t += gridDim.x * 8) {
        const float4 o = ((const float4*)(gout + (size_t)t * 256))[lane];
        float ss = o.x * o.x + o.y * o.y + o.z * o.z + o.w * o.w;
        ss += __shfl_xor(ss, 1); ss += __shfl_xor(ss, 2); ss += __shfl_xor(ss, 4); ss += __shfl_xor(ss, 8);
        const float rstd = rsqrtf(ss * (1.f / 64.f) + 1e-6f);
        const uint2 zz = *(const uint2*)(z + (size_t)t * 256 + lane * 4);
        const float z0 = bf2f((u16)(zz.x & 0xffff)), z1 = bf2f((u16)(zz.x >> 16)), z2 = bf2f((u16)(zz.y & 0xffff)), z3 = bf2f((u16)(zz.y >> 16));
        uint2 r;
        r.x = pack2(o.x * rstd * ng.x * z0 * sigmoidf_(z0), o.y * rstd * ng.y * z1 * sigmoidf_(z1));
        r.y = pack2(o.z * rstd * ng.z * z2 * sigmoidf_(z2), o.w * rstd * ng.w * z3 * sigmoidf_(z3));
        *(uint2*)(mix + (size_t)t * DM + lane * 4) = r;
    }
}

template <bool FINAL>
DI void s5_item(const Params& P, int layer, int item, char* wlds, int lane) {
    const int b = item >> 11, g = (item >> 7) & 15, ch = item & 127;
    const int t0 = b * SEQ + ch * 64;
    const char* sp = P.ws + OFF_S5P + layer * S5P_LAYER;
    float* ut = (float*)wlds;
    u16* Xs = (u16*)(wlds + 4096);
    {
        const u16* src = (const u16*)(P.ws + OFF_US) + (size_t)(t0 + lane) * 256 + g * 16;
        const uint4 a = *(const uint4*)src, c = *(const uint4*)(src + 8);
        const unsigned uu[8] = {a.x, a.y, a.z, a.w, c.x, c.y, c.z, c.w};
#pragma unroll
        for (int i = 0; i < 8; ++i) { ut[lane * 16 + 2 * i] = bf2f((u16)(uu[i] & 0xffff)); ut[lane * 16 + 2 * i + 1] = bf2f((u16)(uu[i] >> 16)); }
    }
    float Br[16], Bi[16];
    {
        const float4* br = (const float4*)(sp + S5P_BRE) + (g * 64 + lane) * 4; const float4* bi = (const float4*)(sp + S5P_BIM) + (g * 64 + lane) * 4;
#pragma unroll
        for (int i = 0; i < 4; ++i) { const float4 x = br[i], y = bi[i]; Br[4 * i] = x.x; Br[4 * i + 1] = x.y; Br[4 * i + 2] = x.z; Br[4 * i + 3] = x.w; Bi[4 * i] = y.x; Bi[4 * i + 1] = y.y; Bi[4 * i + 2] = y.z; Bi[4 * i + 3] = y.w; }
    }
    const float2 ab = ((const float2*)(sp + S5P_ABAR))[g * 64 + lane];
    float2* st = (float2*)(P.ws + OFF_S5ST) + (size_t)item * 64 + lane;
    float xr = 0.f, xi = 0.f;
    if (FINAL) { const float2 c0 = *st; xr = c0.x; xi = c0.y; }
    bf16x8 cf[4];
    if (FINAL) {
        const u16* cm = (const u16*)(sp + S5P_CM) + (g * 16 + (lane & 15)) * 128 + 8 * (lane >> 4);
#pragma unroll
        for (int s = 0; s < 4; ++s) cf[s] = ld8(cm + 32 * s);
    }
    __builtin_amdgcn_wave_barrier();
    asm volatile("s_waitcnt lgkmcnt(0)" ::: "memory");
    for (int half = 0; half < 2; ++half) {
        for (int tt = 0; tt < 32; ++tt) {
            const int t = half * 32 + tt;
            const float4* u4 = (const float4*)(ut + t * 16);
            float br_ = 0.f, bi_ = 0.f;
#pragma unroll
            for (int q = 0; q < 4; ++q) {
                const float4 u = u4[q];
                br_ += Br[4 * q] * u.x + Br[4 * q + 1] * u.y + Br[4 * q + 2] * u.z + Br[4 * q + 3] * u.w;
                bi_ += Bi[4 * q] * u.x + Bi[4 * q + 1] * u.y + Bi[4 * q + 2] * u.z + Bi[4 * q + 3] * u.w;
            }
            const float nr = ab.x * xr - ab.y * xi + br_, ni = ab.x * xi + ab.y * xr + bi_;
            xr = nr; xi = ni;
            if (FINAL) { Xs[tt * 136 + lane] = f2bf(xr); Xs[tt * 136 + 64 + lane] = f2bf(xi); }
        }
        if (FINAL) {
            asm volatile("s_waitcnt lgkmcnt(0)" ::: "memory");
            __builtin_amdgcn_wave_barrier();
            const int r16 = lane & 15, gg = lane >> 4;
            const float dsv = P.in[13][layer * 256 + g * 16 + r16];
#pragma unroll
            for (int mb = 0; mb < 2; ++mb) {
                f32x4 acc = (f32x4){0.f, 0.f, 0.f, 0.f};
#pragma unroll
                for (int s = 0; s < 4; ++s) acc = MFMA16(ld8(Xs + (16 * mb + r16) * 136 + 32 * s + 8 * gg), cf[s], acc);
#pragma unroll
                for (int e = 0; e < 4; ++e) {
                    const int tk = half * 32 + 16 * mb + 4 * gg + e;
                    const float y = acc[e] + dsv * ut[tk * 16 + r16];
                    ((u16*)(P.ws + OFF_YS5))[(size_t)(t0 + tk) * 256 + g * 16 + r16] = f2bf(gelu_tanh(y));
                }
            }
            asm volatile("s_waitcnt lgkmcnt(0)" ::: "memory");
            __builtin_amdgcn_wave_barrier();
        }
    }
    if (!FINAL) *st = make_float2(xr, xi);
    asm volatile("s_waitcnt lgkmcnt(0)" ::: "memory");
    __builtin_amdgcn_wave_barrier();
}
template <bool FINAL>
DI void phase_s5(const Params& P, int layer, char* lds) {
    const int w = threadIdx.x >> 6, lane = threadIdx.x & 63;
    char* wl = lds + w * 12800;
    for (int it = blockIdx.x * 8 + w; it < 8192; it += gridDim.x * 8) s5_item<FINAL>(P, layer, it, wl, lane);
}
constexpr int KP = 136;
constexpr int VP = 68;
constexpr int ATT_STAGE = 64 * KP + 128 * VP;
DI void attn_item(const Params& P, int layer, int b, int head, int qb, char* lds) {
    const int tid = threadIdx.x, lane = tid & 63, w = tid >> 6;
    const int m = w >> 2, wq = w & 3, r = lane & 31, hh = lane >> 5;
    u16* st0 = (u16*)lds;
    const u16* QC = (const u16*)(P.ws + OFF_QC);
    const u16* KC = (const u16*)(P.ws + OFF_KC);
    const u16* VT = (const u16*)(P.ws + OFF_VT);
    const int qw0 = qb * 128 + 32 * wq;
    const int q = qw0 + r;
    bf16x8 qf[4];
    {
        const u16* qp = QC + (size_t)(b * SEQ + q) * 512 + head * 128 + m * 64 + hh * 8;
#pragma unroll
        for (int s = 0; s < 4; ++s) qf[s] = ld8(qp + 16 * s);
    }
    f32x16 o[4];
#pragma unroll
    for (int d = 0; d < 4; ++d)
#pragma unroll
        for (int e = 0; e < 16; ++e) o[d][e] = 0.f;
    float mrun = -INFINITY, lrun = 0.f;
    const int nkv = 2 * (qb + 1);
    const int kkey = tid >> 4, kch = tid & 15;
    const int vdv = tid >> 3, vch = tid & 7;
    const u16* kg = KC + (size_t)(b * SEQ + kkey) * 512 + head * 128 + kch * 8;
    const u16* vg = VT + ((size_t)((b * 4 + head) * 128 + vdv)) * SEQ + vch * 8;
    uint4 rk0, rk1, rv0, rv1;
#define ATT_ISSUE(j_) do { rk0 = *(const uint4*)(kg + (size_t)(64 * (j_)) * 512); rk1 = *(const uint4*)(kg + (size_t)(64 * (j_) + 32) * 512); \
        rv0 = *(const uint4*)(vg + 64 * (j_)); rv1 = *(const uint4*)(vg + (size_t)64 * SEQ + 64 * (j_)); } while (0)
#define ATT_COMMIT(stg_) do { u16* sg_ = (stg_); *(uint4*)(sg_ + kkey * KP + kch * 8) = rk0; *(uint4*)(sg_ + (kkey + 32) * KP + kch * 8) = rk1; \
        u16* vb_ = sg_ + 64 * KP; \
        *(uint2*)(vb_ + vdv * VP + vch * 8) = make_uint2(rv0.x, rv0.y); *(uint2*)(vb_ + vdv * VP + vch * 8 + 4) = make_uint2(rv0.z, rv0.w); \
        *(uint2*)(vb_ + (vdv + 64) * VP + vch * 8) = make_uint2(rv1.x, rv1.y); *(uint2*)(vb_ + (vdv + 64) * VP + vch * 8 + 4) = make_uint2(rv1.z, rv1.w); } while (0)
    ATT_ISSUE(0); ATT_COMMIT(st0);
    __syncthreads();
    for (int j = 0; j < nkv; ++j) {
        u16* cur = st0 + (j & 1) * ATT_STAGE; u16* nxt = st0 + ((j & 1) ^ 1) * ATT_STAGE;
        if (j + 1 < nkv) ATT_ISSUE(j + 1);
        if (64 * j <= qw0 + 31) {
            f32x16 s0, s1;
#pragma unroll
            for (int e = 0; e < 16; ++e) { s0[e] = 0.f; s1[e] = 0.f; }
            const u16* kp = cur + r * KP + m * 64 + hh * 8;
#pragma unroll
            for (int s = 0; s < 4; ++s) {
                s0 = MFMA32(ld8(kp + 16 * s), qf[s], s0);
                s1 = MFMA32(ld8(kp + 32 * KP + 16 * s), qf[s], s1);
            }
            if (64 * j + 63 > qw0) {
#pragma unroll
                for (int e = 0; e < 16; ++e) {
                    const int key = 64 * j + (e & 3) + 8 * (e >> 2) + 4 * hh;
                    if (key > q) s0[e] = -INFINITY;
                    if (key + 32 > q) s1[e] = -INFINITY;
                }
            }
            float mx = s0[0];
#pragma unroll
            for (int e = 1; e < 16; ++e) mx = fmaxf(mx, s0[e]);
#pragma unroll
            for (int e = 0; e < 16; ++e) mx = fmaxf(mx, s1[e]);
            mx = fmaxf(mx, __shfl_xor(mx, 32));
            float mnew = mrun;
            if (__builtin_amdgcn_ballot_w64(mx > mrun + 8.f) != 0ull) {
                mnew = fmaxf(mrun, mx);
                const float alpha = __builtin_amdgcn_exp2f(mrun - mnew);
                mrun = mnew;
                lrun *= alpha;
#pragma unroll
                for (int d = 0; d < 4; ++d) o[d] = o[d] * alpha;
            }
            float psum = 0.f;
#pragma unroll
            for (int e = 0; e < 16; ++e) { s0[e] = __builtin_amdgcn_exp2f(s0[e] - mnew); psum += s0[e]; }
#pragma unroll
            for (int e = 0; e < 16; ++e) { s1[e] = __builtin_amdgcn_exp2f(s1[e] - mnew); psum += s1[e]; }
            lrun += psum;
            bf16x8 pf[4];
            pf[0] = pack8(s0[0], s0[1], s0[2], s0[3], s0[4], s0[5], s0[6], s0[7]);
            pf[1] = pack8(s0[8], s0[9], s0[10], s0[11], s0[12], s0[13], s0[14], s0[15]);
            pf[2] = pack8(s1[0], s1[1], s1[2], s1[3], s1[4], s1[5], s1[6], s1[7]);
            pf[3] = pack8(s1[8], s1[9], s1[10], s1[11], s1[12], s1[13], s1[14], s1[15]);
            const u16* vp = cur + 64 * KP + r * VP + 4 * hh;
#pragma unroll
            for (int d = 0; d < 4; ++d)
#pragma unroll
                for (int kk = 0; kk < 4; ++kk) {
                    const u16* pa = vp + d * 32 * VP + 16 * kk;
                    o[d] = MFMA32(cat4(*(const bf16x4*)pa, *(const bf16x4*)(pa + 8)), pf[kk], o[d]);
                }
        }
        if (j + 1 < nkv) ATT_COMMIT(nxt);
        __syncthreads();
    }
    const float ltot = lrun + __shfl_xor(lrun, 32);
    const float inv = 1.f / ltot;
    float* ex = (float*)lds;
    if (m == 1) {
#pragma unroll
        for (int d = 0; d < 4; ++d)
#pragma unroll
            for (int e = 0; e < 16; ++e) ex[(wq * 64 + d * 16 + e) * 64 + lane] = o[d][e] * inv;
    }
    __syncthreads();
    if (m == 0) {
        const float lam = ((const float*)(P.ws + OFF_SCAL))[layer];
        const float lam_init = 0.8f - 0.6f * __expf(-0.3f * (float)layer);
        float ss = 0.f;
#pragma unroll
        for (int d = 0; d < 4; ++d)
#pragma unroll
            for (int e = 0; e < 16; ++e) { const float v = o[d][e] * inv - lam * ex[(wq * 64 + d * 16 + e) * 64 + lane]; o[d][e] = v; ss += v * v; }
        ss += __shfl_xor(ss, 32);
        const float sc = rsqrtf(ss * (1.f / 128.f) + 1e-6f) * (1.f - lam_init);
        const float* ng = P.in[21] + layer * 128;
        u16* mix = (u16*)(P.ws + OFF_ABUF) + (size_t)(b * SEQ + q) * DM + 512 + head * 128;
#pragma unroll
        for (int d = 0; d < 4; ++d)
#pragma unroll
            for (int qd = 0; qd < 4; ++qd) {
                const int dv0 = 32 * d + 8 * qd + 4 * hh;
                const float4 g4 = *(const float4*)(ng + dv0);
                uint2 pk; pk.x = pack2(o[d][4 * qd] * sc * g4.x, o[d][4 * qd + 1] * sc * g4.y); pk.y = pack2(o[d][4 * qd + 2] * sc * g4.z, o[d][4 * qd + 3] * sc * g4.w);
                *(uint2*)(mix + dv0) = pk;
            }
    }
    __syncthreads();
}
DI void phase_attn(const Params& P, int layer, char* lds) {
    unsigned* ctr = (unsigned*)(P.ws + OFF_CTL + 16384 + layer * 256);
    volatile int* slot = (volatile int*)(lds + LDS_BYTES - 32);
    for (;;) {
        if (threadIdx.x == 0) *slot = (int)atomicAdd(ctr, 1u);
        __syncthreads();
        const int idx = *slot;
        __syncthreads();
        if (idx >= 1024) break;
        const int qb = 63 - (idx >> 4), bh = idx & 15;
        attn_item(P, layer, bh >> 2, bh & 3, qb, lds);
    }
}

DI void ins16(float (&top)[16], float v) {
#pragma unroll
    for (int k = 0; k < 16; ++k) { const float hi = fmaxf(top[k], v); v = fminf(top[k], v); top[k] = hi; }
}
DI void phase_topk(const Params& P, int layer) {
    const int w = threadIdx.x >> 6, lane = threadIdx.x & 63, r = lane & 31, hh = lane >> 5;
    const u16* PQ = (const u16*)(P.ws + OFF_PQ);
    const u16* KEYS = (const u16*)(P.ws + OFF_KEYS) + (size_t)layer * 8 * 2 * 128 * 64;
    u16* pe = (u16*)(P.ws + OFF_PICKE); float* pg = (float*)(P.ws + OFF_PICKG);
    for (int it = blockIdx.x * 8 + w; it < 8192; it += gridDim.x * 8) {
        const int tile = it >> 3, h = it & 7; const int tok = tile * 32 + r;
        float sv[2][16];
#pragma unroll
        for (int p = 0; p < 2; ++p) {
            bf16x8 bq[4];
            const u16* qp = PQ + (size_t)tok * 1024 + h * 128 + p * 64 + hh * 8;
#pragma unroll
            for (int s = 0; s < 4; ++s) bq[s] = ld8(qp + 16 * s);
            float top[16];
#pragma unroll
            for (int k = 0; k < 16; ++k) top[k] = -INFINITY;
#pragma unroll 1
            for (int kb = 0; kb < 4; ++kb) {
                f32x16 acc;
#pragma unroll
                for (int e = 0; e < 16; ++e) acc[e] = 0.f;
                const u16* kp = KEYS + ((size_t)((h * 2 + p) * 128 + 32 * kb + r)) * 64 + hh * 8;
#pragma unroll
                for (int s = 0; s < 4; ++s) acc = MFMA32(ld8(kp + 16 * s), bq[s], acc);
#pragma unroll
                for (int e = 0; e < 16; ++e) {
                    const unsigned key = 32 * kb + (e & 3) + 8 * (e >> 2) + 4 * hh;
                    ins16(top, __uint_as_float((__float_as_uint(acc[e]) & ~0x7Fu) | key));
                }
            }
            float oth[16];
#pragma unroll
            for (int k = 0; k < 16; ++k) oth[k] = __shfl_xor(top[k], 32);
#pragma unroll
            for (int k = 0; k < 16; ++k) ins16(top, oth[k]);
#pragma unroll
            for (int k = 0; k < 16; ++k) sv[p][k] = top[k];
        }
        float top[16];
#pragma unroll
        for (int k = 0; k < 16; ++k) top[k] = -INFINITY;
#pragma unroll
        for (int i = 0; i < 16; ++i)
#pragma unroll
            for (int j = 0; j < 16; ++j)
                if ((i + 1) * (j + 1) <= 16) {
                    const float s = __uint_as_float(__float_as_uint(sv[0][i]) & ~0x7Fu) + __uint_as_float(__float_as_uint(sv[1][j]) & ~0x7Fu);
                    ins16(top, __uint_as_float((__float_as_uint(s) & ~0xFFu) | (unsigned)(i * 16 + j)));
                }
        float ev[16]; float den = 0.f;
        const float mx = __uint_as_float(__float_as_uint(top[0]) & ~0xFFu);
#pragma unroll
        for (int k = 0; k < 16; ++k) { ev[k] = __expf(__uint_as_float(__float_as_uint(top[k]) & ~0xFFu) - mx); den += ev[k]; }
        const float rden = 1.f / den;
#pragma unroll
        for (int k = 0; k < 16; ++k) {
            const unsigned code = __float_as_uint(top[k]) & 0xFFu; const unsigned wi = code >> 4, wj = code & 15u;
            unsigned i0 = 0, i1 = 0;
#pragma unroll
            for (int i = 0; i < 16; ++i) { i0 = (wi == (unsigned)i) ? (__float_as_uint(sv[0][i]) & 0x7Fu) : i0; i1 = (wj == (unsigned)i) ? (__float_as_uint(sv[1][i]) & 0x7Fu) : i1; }
            if ((k >> 3) == hh) {
                pe[(size_t)tok * 128 + h * 16 + k] = (u16)(i0 * 128 + i1);
                pg[(size_t)tok * 128 + h * 16 + k] = ev[k] * rden;
            }
        }
    }
}

DI void fp8x16_to_f32(const uint4& u, float (&f)[16]) {
    const unsigned uu[4] = {u.x, u.y, u.z, u.w};
#pragma unroll
    for (int q = 0; q < 4; ++q) {
        const f32x2 lo = __builtin_amdgcn_cvt_pk_f32_fp8((int)uu[q], false), hi = __builtin_amdgcn_cvt_pk_f32_fp8((int)uu[q], true);
        f[4 * q] = lo[0]; f[4 * q + 1] = lo[1]; f[4 * q + 2] = hi[0]; f[4 * q + 3] = hi[1];
    }
}
template <int CTRL> DI int dpp_i(int v) { return __builtin_amdgcn_update_dpp(0, v, CTRL, 0xF, 0xF, true); }
template <int CTRL> DI float dpp_f(float v) { return __int_as_float(__builtin_amdgcn_update_dpp(0, __float_as_int(v), CTRL, 0xF, 0xF, true)); }
DI int rowreduce4(int p0, int p1, int p2, int p3, bool odd, bool bit1) {
    const int a01 = odd ? p1 : p0, b01 = odd ? p0 : p1;
    const int r01 = a01 + dpp_i<0xB1>(b01);
    const int a23 = odd ? p3 : p2, b23 = odd ? p2 : p3;
    const int r23 = a23 + dpp_i<0xB1>(b23);
    const int a = bit1 ? r23 : r01, b = bit1 ? r01 : r23;
    int r = a + dpp_i<0x4E>(b);
    r += dpp_i<0x124>(r);
    r += dpp_i<0x128>(r);
    return r;
}
DI int dot16_i8(const uint4& u, const int (&xq)[4]) {
    int p = __builtin_amdgcn_sdot4((int)u.x, xq[0], 0, false);
    p = __builtin_amdgcn_sdot4((int)u.y, xq[1], p, false);
    p = __builtin_amdgcn_sdot4((int)u.z, xq[2], p, false);
    p = __builtin_amdgcn_sdot4((int)u.w, xq[3], p, false);
    return p;
}
#define PEER_LOAD8(buf_, tab_, ev_, base_) do { _Pragma("unroll") for (int i_ = 0; i_ < 8; ++i_) { \
        const int e_ = __builtin_amdgcn_readlane((ev_), (base_) + i_); buf_[i_] = *(const uint4*)((tab_) + (size_t)e_ * 1024 + lane * 16); } } while (0)

template <bool DRY>
DI void phase_peer(const Params& P, int layer, const float* hin, float* hout, bool last) {
    const int w = threadIdx.x >> 6, lane = threadIdx.x & 63;
    const uint8_t* UT = (const uint8_t*)(P.ws + OFF_UTAB) + (size_t)layer * 16384 * 1024;
    const uint8_t* VTb = (const uint8_t*)(P.ws + OFF_VTAB) + (size_t)layer * 16384 * 1024;
    const float* USC = (const float*)(P.ws + OFF_USCALE) + layer * 16384;
    const u16* pe = (const u16*)(P.ws + OFF_PICKE); const float* pg = (const float*)(P.ws + OFF_PICKG);
    u16* abuf = (u16*)(P.ws + OFF_ABUF);
    const bool odd = lane & 1, bit1 = lane & 2; const int qsel = (lane >> 2) & 3, R = lane >> 4;
    for (int t = blockIdx.x * 8 + w; t < NT; t += gridDim.x * 8) {
        int xq[4]; float sx;
        {
            const uint4 a = *(const uint4*)(abuf + (size_t)t * DM + lane * 16), c = *(const uint4*)(abuf + (size_t)t * DM + lane * 16 + 8);
            const unsigned uu[8] = {a.x, a.y, a.z, a.w, c.x, c.y, c.z, c.w};
            float x[16]; float am = 0.f;
#pragma unroll
            for (int i = 0; i < 8; ++i) { x[2 * i] = bf2f((u16)(uu[i] & 0xffff)); x[2 * i + 1] = bf2f((u16)(uu[i] >> 16)); am = fmaxf(am, fmaxf(fabsf(x[2 * i]), fabsf(x[2 * i + 1]))); }
            am = fmaxf(am, dpp_f<0xB1>(am)); am = fmaxf(am, dpp_f<0x4E>(am)); am = fmaxf(am, dpp_f<0x124>(am)); am = fmaxf(am, dpp_f<0x128>(am));
            am = fmaxf(am, __shfl_xor(am, 16)); am = fmaxf(am, __shfl_xor(am, 32));
            const float sc = am > 0.f ? 127.f / am : 0.f; sx = am * (1.f / 127.f);
#pragma unroll
            for (int q = 0; q < 4; ++q) {
                const int a0 = (int)rintf(x[4 * q] * sc), a1 = (int)rintf(x[4 * q + 1] * sc), a2 = (int)rintf(x[4 * q + 2] * sc), a3 = (int)rintf(x[4 * q + 3] * sc);
                xq[q] = (int)((unsigned)(a0 & 0xff) | ((unsigned)(a1 & 0xff) << 8) | ((unsigned)(a2 & 0xff) << 16) | ((unsigned)(a3 & 0xff) << 24));
            }
        }
        const int e0 = pe[(size_t)t * 128 + lane], e1 = pe[(size_t)t * 128 + 64 + lane];
        const float g0 = pg[(size_t)t * 128 + lane], g1 = pg[(size_t)t * 128 + 64 + lane];
        const float su0 = USC[e0], su1 = USC[e1];
        f32x2 y2[8];
#pragma unroll
        for (int i = 0; i < 8; ++i) y2[i] = (f32x2){0.f, 0.f};
        uint4 bufA[8], bufB[8], bufC[8], bufD[8];
        int e0v = e0, e1v = e1; asm volatile("" : "+v"(e0v), "+v"(e1v));
        int md[4] = {0, 0, 0, 0};
        float coef = 0.f;
#define PB_TAB(k_) ((((k_) >> 3) & 1) ? VTb : UT)
#define PB_EV(k_) ((((k_) >> 3) & 1) ? (((k_) >> 4) ? e1v : e0v) : (((k_) >> 4) ? e1 : e0))
#define PB_LOAD(buf_, k_) PEER_LOAD8(buf_, PB_TAB(k_), PB_EV(k_), 8 * ((k_) & 7))
#define PB_UCOMP(cur_, k_) do { \
            if (((k_) & 7) == 0) { md[0] = 0; md[1] = 0; md[2] = 0; md[3] = 0; } \
            _Pragma("unroll") for (int gq = 0; gq < 2; ++gq) { \
                const int p0 = dot16_i8(cur_[4 * gq], xq), p1 = dot16_i8(cur_[4 * gq + 1], xq), p2 = dot16_i8(cur_[4 * gq + 2], xq), p3 = dot16_i8(cur_[4 * gq + 3], xq); \
                const int r = rowreduce4(p0, p1, p2, p3, odd, bit1); \
                const int bidx = 2 * ((k_) & 7) + gq; \
                md[bidx >> 2] = (qsel == (bidx & 3)) ? r : md[bidx >> 2]; } \
            if (((k_) & 7) == 7) { \
                _Pragma("unroll") for (int kk = 0; kk < 4; ++kk) { md[kk] += __shfl_xor(md[kk], 16); md[kk] += __shfl_xor(md[kk], 32); } \
                const int mdot = R == 0 ? md[0] : R == 1 ? md[1] : R == 2 ? md[2] : md[3]; \
                const float dot = (float)mdot * (((k_) >> 4) ? su1 : su0) * sx; \
                coef = (((k_) >> 4) ? g1 : g0) * gelu_tanh(dot) * (1.f / 8.f); } } while (0)
#define PB_VCOMP(cur_, k_) do { _Pragma("unroll") for (int i = 0; i < 8; ++i) { \
            const float c = __uint_as_float((unsigned)__builtin_amdgcn_readlane((int)__float_as_uint(coef), 8 * ((k_) & 7) + i)); \
            const unsigned uu_[4] = {cur_[i].x, cur_[i].y, cur_[i].z, cur_[i].w}; \
            _Pragma("unroll") for (int q = 0; q < 4; ++q) { \
                const f32x2 lo_ = __builtin_amdgcn_cvt_pk_f32_fp8((int)uu_[q], false), hi_ = __builtin_amdgcn_cvt_pk_f32_fp8((int)uu_[q], true); \
                y2[2 * q] += lo_ * c; y2[2 * q + 1] += hi_ * c; } } } while (0)
#define PB_STEP(k_, cur_, pf_) do { \
            if ((k_) + 3 < 32) { PB_LOAD(pf_, (k_) + 3); } \
            asm volatile("" ::: "memory"); __builtin_amdgcn_sched_barrier(0); \
            if ((((k_) >> 3) & 1) == 0) PB_UCOMP(cur_, k_); else PB_VCOMP(cur_, k_); \
            asm volatile("" ::: "memory"); __builtin_amdgcn_sched_barrier(0); } while (0)
        PB_LOAD(bufA, 0); PB_LOAD(bufB, 1); PB_LOAD(bufC, 2);
        PB_STEP(0, bufA, bufD); PB_STEP(1, bufB, bufA); PB_STEP(2, bufC, bufB); PB_STEP(3, bufD, bufC);
        PB_STEP(4, bufA, bufD); PB_STEP(5, bufB, bufA); PB_STEP(6, bufC, bufB); PB_STEP(7, bufD, bufC);
        PB_STEP(8, bufA, bufD); PB_STEP(9, bufB, bufA); PB_STEP(10, bufC, bufB); PB_STEP(11, bufD, bufC);
        PB_STEP(12, bufA, bufD); PB_STEP(13, bufB, bufA); PB_STEP(14, bufC, bufB); PB_STEP(15, bufD, bufC);
        PB_STEP(16, bufA, bufD); PB_STEP(17, bufB, bufA); PB_STEP(18, bufC, bufB); PB_STEP(19, bufD, bufC);
        PB_STEP(20, bufA, bufD); PB_STEP(21, bufB, bufA); PB_STEP(22, bufC, bufB); PB_STEP(23, bufD, bufC);
        PB_STEP(24, bufA, bufD); PB_STEP(25, bufB, bufA); PB_STEP(26, bufC, bufB); PB_STEP(27, bufD, bufC);
        PB_STEP(28, bufA, bufD); PB_STEP(29, bufB, bufA); PB_STEP(30, bufC, bufB); PB_STEP(31, bufD, bufC);
        float4 v[4];
        const float4* h4 = (const float4*)(hin + (size_t)t * DM + lane * 16);
#pragma unroll
        for (int i = 0; i < 4; ++i) { v[i] = h4[i]; v[i].x += y2[2 * i][0]; v[i].y += y2[2 * i][1]; v[i].z += y2[2 * i + 1][0]; v[i].w += y2[2 * i + 1][1]; }
        float ss = 0.f;
#pragma unroll
        for (int i = 0; i < 4; ++i) ss += v[i].x * v[i].x + v[i].y * v[i].y + v[i].z * v[i].z + v[i].w * v[i].w;
        ss = wave_sum(ss);
        const float rstd = rsqrtf(ss * (1.f / DM) + 1e-6f);
        if (DRY) { asm volatile("" :: "v"(rstd)); continue; }
        if (last) {
            const float4* g4 = (const float4*)(P.in[28]) + lane * 4;
            float4* o4 = (float4*)(hout + (size_t)t * DM + lane * 16);
#pragma unroll
            for (int i = 0; i < 4; ++i) { const float4 g = g4[i]; o4[i] = make_float4(v[i].x * rstd * g.x, v[i].y * rstd * g.y, v[i].z * rstd * g.z, v[i].w * rstd * g.w); }
        } else {
            float4* o4 = (float4*)(hout + (size_t)t * DM + lane * 16);
#pragma unroll
            for (int i = 0; i < 4; ++i) o4[i] = v[i];
            const float4* g4 = (const float4*)(P.in[1] + (layer + 1) * DM) + lane * 4;
            float vn[16];
#pragma unroll
            for (int i = 0; i < 4; ++i) { const float4 g = g4[i]; vn[4 * i] = v[i].x * rstd * g.x; vn[4 * i + 1] = v[i].y * rstd * g.y; vn[4 * i + 2] = v[i].z * rstd * g.z; vn[4 * i + 3] = v[i].w * rstd * g.w; }
            uint4 o0, o1;
            o0.x = pack2(vn[0], vn[1]); o0.y = pack2(vn[2], vn[3]); o0.z = pack2(vn[4], vn[5]); o0.w = pack2(vn[6], vn[7]);
            o1.x = pack2(vn[8], vn[9]); o1.y = pack2(vn[10], vn[11]); o1.z = pack2(vn[12], vn[13]); o1.w = pack2(vn[14], vn[15]);
            *(uint4*)(abuf + (size_t)t * DM + lane * 16) = o0; *(uint4*)(abuf + (size_t)t * DM + lane * 16 + 8) = o1;
            const float4* wab = (const float4*)(P.ws + OFF_WAB) + (layer + 1) * 8 * 256;
            float myacc = 0.f;
#pragma unroll 1
            for (int j = 0; j < 8; ++j) {
                asm volatile("" : "+s"(wab));
                float a = 0.f;
#pragma unroll
                for (int i = 0; i < 4; ++i) { const float4 ww = wab[j * 256 + lane * 4 + i]; a += vn[4 * i] * ww.x + vn[4 * i + 1] * ww.y + vn[4 * i + 2] * ww.z + vn[4 * i + 3] * ww.w; }
                a = wave_sum(a);
                myacc = (lane == j) ? a : myacc;
            }
            const float bb = __shfl(myacc, (lane + 4) & 63);
            if (lane < 4) {
                const int L1 = layer + 1;
                const float a = myacc;
                const float xx = a + P.in[5][L1 * 4 + lane];
                const float sp = xx > 20.f ? xx : log1pf(__expf(xx));
                ((float*)(P.ws + OFF_GG))[t * 4 + lane] = -__expf(P.in[4][L1 * 4 + lane]) * sp;
                ((float*)(P.ws + OFF_BETA))[t * 4 + lane] = sigmoidf_(bb);
            }
        }
    }
}


#define XB_TMO      128
#define XB_XCNT(j)  (256  + 64 * (j))
#define XB_XSUB(j)  (1280 + 64 * (j))
#define XB_XGEN(j)  (2304 + 64 * (j))
#define XB_TOP      3328
#define XB_TOPGEN   3392
#define XCD_BAR_WORDS 3456
#define XB_SPIN_CAP (1u << 22)
#define LAS __attribute__((address_space(3)))
DI unsigned xb_ld(unsigned* p)              { return __hip_atomic_load(p, __ATOMIC_RELAXED, __HIP_MEMORY_SCOPE_AGENT); }
DI unsigned xb_add(unsigned* p, unsigned v) { return __hip_atomic_fetch_add(p, v, __ATOMIC_RELAXED, __HIP_MEMORY_SCOPE_AGENT); }
DI unsigned xb_xcc_id() { return (unsigned)__builtin_amdgcn_s_getreg((3 << 11) | 20) & 0xFu; }
#define XB_SPIN(cond, bar) do { unsigned _sp = 0; while (cond) { __builtin_amdgcn_s_sleep(1); \
    if ((++_sp & 255u) == 0u) { if (xb_ld(&(bar)[XB_TMO])) break; if (_sp > XB_SPIN_CAP) { atomicAdd(&(bar)[XB_TMO], 1u); break; } } } } while (0)
struct XcdBarrier { unsigned* bar; unsigned x; volatile LAS unsigned* st; };
DI XcdBarrier xcd_barrier_post(unsigned* bar, volatile LAS unsigned* st) {
    XcdBarrier b; b.bar = bar; b.x = xb_xcc_id(); b.st = st;
    if (threadIdx.x == 0) (void)xb_add(&bar[XB_XCNT(b.x)], 1u);
    return b;
}
DI void xcd_barrier_complete(unsigned* bar, unsigned x, unsigned& nloc, unsigned& nx) {
    const unsigned G = gridDim.x * gridDim.y * gridDim.z;
    unsigned sum, cnt, mine, sp = 0u;
    for (;;) {
        sum = 0u; cnt = 0u; mine = 0u;
#pragma unroll
        for (unsigned j = 0; j < 16; ++j) { const unsigned c = xb_ld(&bar[XB_XCNT(j)]); sum += c; cnt += (c > 0u) ? 1u : 0u; mine = (j == x) ? c : mine; }
        if (sum == G) break;
        __builtin_amdgcn_s_sleep(1);
        if ((++sp & 255u) == 0u) { if (xb_ld(&bar[XB_TMO])) break; if (sp > XB_SPIN_CAP) { atomicAdd(&bar[XB_TMO], 1u); break; } }
    }
    nloc = mine > 0u ? mine : 1u; nx = cnt > 0u ? cnt : 1u;
}
DI void xcd_barrier(const XcdBarrier& b) {
    asm volatile("s_waitcnt vmcnt(0)" ::: "memory");
    __syncthreads();
    if (threadIdx.x == 0) {
        unsigned* bar = b.bar;
        __builtin_amdgcn_s_waitcnt(0);
        unsigned nloc = b.st[0], nx = b.st[1];
        if (nloc == 0u) { xcd_barrier_complete(bar, b.x, nloc, nx); b.st[0] = nloc; b.st[1] = nx; }
        const unsigned old = xb_add(&bar[XB_XSUB(b.x)], 1u);
        const unsigned gen = old / nloc;
        if (old + 1u == (gen + 1u) * nloc) {
            __builtin_amdgcn_fence(__ATOMIC_RELEASE, "agent");
            asm volatile("s_waitcnt vmcnt(0)" ::: "memory");
            const unsigned og = xb_add(&bar[XB_TOP], 1u);
            const unsigned tg = og / nx;
            if (og + 1u == (tg + 1u) * nx) xb_add(&bar[XB_TOPGEN], 1u);
            else XB_SPIN(xb_ld(&bar[XB_TOPGEN]) == tg, bar);
            __builtin_amdgcn_fence(__ATOMIC_ACQUIRE, "agent");
            xb_add(&bar[XB_XGEN(b.x)], 1u);
            asm volatile("s_waitcnt vmcnt(0)" ::: "memory");
        } else {
            XB_SPIN(xb_ld(&bar[XB_XGEN(b.x)]) == gen, bar);
            __builtin_amdgcn_fence(__ATOMIC_ACQUIRE, "agent");
            asm volatile("s_waitcnt vmcnt(0)" ::: "memory");
        }
    }
    __syncthreads();
}

constexpr int PH_PER_LAYER = 10;
constexpr int NPHASE = 2 + 2 * PH_PER_LAYER;

#ifdef ONLY_SUB
#define SUB_ON(k) (ONLY_SUB == (k))
#else
#define SUB_ON(k) 1
#endif
DI void run_phase(const Params& P, int ph, char* lds) {
    char* ws = P.ws;
#if SUB_ON(100)
    if (ph == 0) { phase_prep(P, lds); return; }
#endif
#if SUB_ON(101)
    if (ph == 1) { phase_rms(P, P.in[0], P.in[1], (u16*)(ws + OFF_ABUF), 0); return; }
#endif
    if (ph < 2) return;
    const int layer = (ph - 2) / PH_PER_LAYER, sub = (ph - 2) % PH_PER_LAYER;
    const float* hin = layer == 0 ? P.in[0] : P.out;
    switch (sub) {
    #if SUB_ON(0)
    case 0: { EpiInProj e{ws}; phase_gemm((const u16*)(ws + OFF_ABUF), 1024, (const u16*)(ws + OFF_WINT) + (size_t)layer * PROJW * 1024, 1024, NT, PROJW, 1024, e, lds); } break;

#endif
    #if SUB_ON(1)
    case 1:
        for (int it = blockIdx.x; it < 2048; it += gridDim.x) gdn_prep_item(P, layer, it, lds);
        phase_s5<false>(P, layer, lds);
        break;

#endif
    #if SUB_ON(2)
    case 2:
        if (blockIdx.x < 16) gdn_scan_chain(P, blockIdx.x, lds);
        else if (blockIdx.x < 24) {
            const int gt = (blockIdx.x - 16) * NTHR + threadIdx.x;
            if (gt < 4096) {
                const int bg = gt >> 6, n = gt & 63;
                const float2 a = ((const float2*)(ws + OFF_S5P + layer * S5P_LAYER + S5P_A64))[(bg & 15) * 64 + n];
                float2* st = (float2*)(ws + OFF_S5ST) + (size_t)bg * 128 * 64 + n;
                float xr = 0.f, xi = 0.f;
                for (int c = 0; c < 128; ++c) {
                    const float2 sv = st[c * 64];
                    st[c * 64] = make_float2(xr, xi);
                    const float nr = a.x * xr - a.y * xi + sv.x, ni = a.x * xi + a.y * xr + sv.y;
                    xr = nr; xi = ni;
                }
            }
        }
        __syncthreads();
        phase_attn(P, layer, lds);
        break;

#endif
    #if SUB_ON(3)
    case 3: phase_s5<true>(P, layer, lds); phase_gdn_norm(P, layer); break;

#endif
    #if SUB_ON(4)
    case 4: {
        EpiGlu e{(u16*)(ws + OFF_ABUF), P.in[16] + layer * 512};
        phase_gemm((const u16*)(ws + OFF_YS5), 256, (const u16*)(ws + OFF_GLUT) + (size_t)layer * 512 * 256, 256, NT, 512, 256, e, lds);
    } break;

#endif
    #if SUB_ON(5)
    case 5: { EpiResidual e{hin, P.out}; phase_gemm((const u16*)(ws + OFF_ABUF), 1024, (const u16*)(ws + OFF_WOUTT) + (size_t)layer * 1024 * 1024, 1024, NT, 1024, 1024, e, lds); } break;

#endif
    #if SUB_ON(6)
    case 6: phase_rms(P, P.out, P.in[23] + layer * DM, (u16*)(ws + OFF_ABUF), -1); break;

#endif
    #if SUB_ON(7)
    case 7: { EpiBf16 e{(u16*)(ws + OFF_PQ), 1024}; phase_gemm((const u16*)(ws + OFF_ABUF), 1024, (const u16*)(ws + OFF_WQT) + (size_t)layer * 1024 * 1024, 1024, NT, 1024, 1024, e, lds); } break;

#endif
    #if SUB_ON(8)
    case 8: phase_topk(P, layer); break;

#endif
    #if SUB_ON(9)
    case 9: phase_peer<false>(P, layer, P.out, P.out, layer == 1); break;
#endif
    }
}

#ifndef USE_CG_SYNC
#define USE_CG_SYNC 0
#endif
#if USE_CG_SYNC
#define GRID_SYNC() cg::this_grid().sync()
#else
#define GRID_SYNC() xcd_barrier(xbar)
#endif
__global__ void __launch_bounds__(NTHR) mk_fwd(Params P, int ph_lo, int ph_hi) {
    extern __shared__ __attribute__((aligned(16))) char lds[];
#if !USE_CG_SYNC
    volatile LAS unsigned* xst = (volatile LAS unsigned*)(lds + LDS_BYTES - 16);
    if (threadIdx.x == 0) { xst[0] = 0u; xst[1] = 0u; }
    __syncthreads();
    XcdBarrier xbar = xcd_barrier_post((unsigned*)(P.ws + OFF_CTL), xst);
#endif
#ifndef DUP_SUB
#define DUP_SUB -1
#endif
#define PH(k) if (ph_lo <= (k) && (k) < ph_hi) { \
        if ((k) >= 2 && ((k) - 2) % PH_PER_LAYER == DUP_SUB) { \
            if (DUP_SUB == 9) phase_peer<true>(P, ((k) - 2) / PH_PER_LAYER, P.out, P.out, false); \
            else if (DUP_SUB == 2) { if (blockIdx.x < 16) gdn_scan_chain(P, blockIdx.x, lds); } \
            else if (DUP_SUB == 5) { if ((k) < 2 + PH_PER_LAYER) run_phase(P, (k), lds); } \
            else run_phase(P, (k), lds); } \
        if ((k) < 2 && DUP_SUB == 100 + (k)) run_phase(P, (k), lds); \
        run_phase(P, (k), lds); if (DUP_SUB == 99) GRID_SYNC(); if ((k) + 1 < ph_hi) GRID_SYNC(); }
    PH(0) PH(1) PH(2) PH(3) PH(4) PH(5) PH(6) PH(7) PH(8) PH(9) PH(10) PH(11)
    PH(12) PH(13) PH(14) PH(15) PH(16) PH(17) PH(18) PH(19) PH(20) PH(21)
#undef PH
}

extern "C" void kernel_launch(void* const* d_in, const int* in_sizes, int n_in, void* d_out, int out_size, void* d_ws, size_t ws_size, hipStream_t stream) {
    static int grid = 0;
    if (grid == 0) {
        int dev = 0, cus = 0, per_cu = 0;
        hipGetDevice(&dev);
        hipDeviceGetAttribute(&cus, hipDeviceAttributeMultiprocessorCount, dev);
        hipFuncSetAttribute((const void*)mk_fwd, hipFuncAttributeMaxDynamicSharedMemorySize, LDS_BYTES);
        hipOccupancyMaxActiveBlocksPerMultiprocessor(&per_cu, (const void*)mk_fwd, NTHR, LDS_BYTES);
        if (per_cu < 1) { fprintf(stderr, "occupancy query says %d blocks per CU\n", per_cu); per_cu = 1; }
        grid = cus;
        if (ws_size < OFF_END) { fprintf(stderr, "workspace too small: %zu < %zu\n", ws_size, (size_t)OFF_END); }
    }
    Params p{};
    for (int i = 0; i < 29; ++i) p.in[i] = (const float*)d_in[i];
    p.out = (float*)d_out; p.ws = (char*)d_ws;
#if MK_ONE_LAUNCH
    int lo = 0, hi = NPHASE;
    (void)hipMemsetAsync((char*)d_ws + OFF_CTL, 0, 65536, stream);
#if USE_CG_SYNC
    void* args[] = {&p, &lo, &hi};
    hipError_t e = hipLaunchCooperativeKernel((const void*)mk_fwd, dim3(grid), dim3(NTHR), args, LDS_BYTES, stream);
    if (e != hipSuccess) fprintf(stderr, "cooperative launch failed: %s\n", hipGetErrorString(e));
#else
    hipLaunchKernelGGL(mk_fwd, dim3(grid), dim3(NTHR), LDS_BYTES, stream, p, lo, hi);
#endif
#else
    for (int ph = 0; ph < NPHASE; ++ph) hipLaunchKernelGGL(mk_fwd, dim3(grid), dim3(NTHR), LDS_BYTES, stream, p, ph, ph + 1);
#endif
}
```

```cpp
#include <hip/hip_runtime.h>
#include <hip/hip_cooperative_groups.h>
#include <stdint.h>
#include <stdio.h>
namespace cg = cooperative_groups;

#ifndef MK_ONE_LAUNCH
#define MK_ONE_LAUNCH 1
#endif

#define DI __device__ __forceinline__
typedef unsigned short u16;
typedef __attribute__((ext_vector_type(8))) short bf16x8;
typedef __attribute__((ext_vector_type(4))) short bf16x4;
typedef __attribute__((ext_vector_type(16))) float f32x16;
typedef __attribute__((ext_vector_type(4))) float f32x4;
typedef __attribute__((ext_vector_type(2))) float f32x2;

constexpr int NT = 32768, DM = 1024, SEQ = 8192, NBATCH = 4;
constexpr int NTHR = 512;
constexpr int INW = 2824;
constexpr int PROJW = 2816;
constexpr float LOG2E = 1.4426950408889634f;

constexpr size_t OFF_CTL   = 0;
constexpr size_t OFF_WINT  = 65536;
constexpr size_t OFF_WOUTT = OFF_WINT  + (size_t)2 * PROJW * 1024 * 2;
constexpr size_t OFF_WQT   = OFF_WOUTT + (size_t)2 * 1024 * 1024 * 2;
constexpr size_t OFF_GLUT  = OFF_WQT   + (size_t)2 * 1024 * 1024 * 2;
constexpr size_t OFF_KEYS  = OFF_GLUT  + (size_t)2 * 512 * 256 * 2;
constexpr size_t OFF_WAB   = OFF_KEYS  + (size_t)2 * 8 * 2 * 128 * 64 * 2;
constexpr size_t OFF_S5P   = OFF_WAB   + (size_t)2 * 8 * 1024 * 4;
constexpr size_t S5P_LAYER = 262144;
constexpr size_t S5P_ABAR = 0, S5P_A64 = 8192, S5P_BRE = 16384, S5P_BIM = 16384 + 65536, S5P_CM = 16384 + 131072;
constexpr size_t OFF_SCAL  = OFF_S5P   + 2 * S5P_LAYER;
constexpr size_t OFF_UTAB  = OFF_SCAL  + 256;
constexpr size_t OFF_VTAB  = OFF_UTAB  + (size_t)2 * 16384 * 1024;
constexpr size_t OFF_USCALE = OFF_VTAB + (size_t)2 * 16384 * 1024;
constexpr size_t OFF_V4TAB = OFF_USCALE + (size_t)2 * 16384 * 4;
constexpr size_t OFF_V4SC  = OFF_V4TAB + (size_t)2 * 16384 * 512;
constexpr size_t OFF_V8SC  = OFF_V4SC + (size_t)2 * 16384 * 4;
constexpr size_t OFF_ABUF  = OFF_V8SC + (size_t)2 * 16384 * 4;
constexpr size_t OFF_GG    = OFF_ABUF  + (size_t)NT * 1024 * 2;
constexpr size_t OFF_BETA  = OFF_GG    + (size_t)NT * 4 * 4;
constexpr size_t OFF_PROJ  = OFF_BETA  + (size_t)NT * 4 * 4;
constexpr size_t OFF_QKV   = OFF_PROJ;
constexpr size_t OFF_Z     = OFF_QKV   + (size_t)NT * 768 * 2;
constexpr size_t OFF_US    = OFF_Z     + (size_t)NT * 256 * 2;
constexpr size_t OFF_QC    = OFF_US    + (size_t)NT * 256 * 2;
constexpr size_t OFF_KC    = OFF_QC    + (size_t)NT * 512 * 2;
constexpr size_t OFF_VT    = OFF_KC    + (size_t)NT * 512 * 2;
constexpr size_t OFF_GREC  = OFF_VT    + (size_t)NT * 512 * 2;
constexpr size_t GREC_BYTES = 40960;
constexpr size_t OFF_EGL   = OFF_GREC  + (size_t)2048 * GREC_BYTES;
constexpr size_t OFF_S5ST  = OFF_EGL   + 2048 * 4;
constexpr size_t OFF_YS5   = OFF_S5ST  + (size_t)8192 * 64 * 8;
constexpr size_t OFF_END   = OFF_YS5   + (size_t)NT * 256 * 2;
constexpr size_t OFF_GDNO  = OFF_QKV;
constexpr size_t OFF_PQ    = OFF_PROJ;
constexpr size_t OFF_PICKE = OFF_GREC;
constexpr size_t OFF_PICKG = OFF_GREC + (size_t)NT * 128 * 2;
constexpr size_t OFF_COEF  = OFF_PICKG + (size_t)NT * 128 * 4;
constexpr size_t OFF_OFFS  = OFF_COEF + (size_t)NT * 128 * 4;
constexpr size_t OFF_XQ    = OFF_OFFS + (size_t)NT * 16;
constexpr size_t OFF_PSV   = OFF_PROJ + (size_t)NT * 1024 * 2;
constexpr size_t OFF_PSU   = OFF_YS5;
constexpr size_t OFF_SX    = OFF_XQ + (size_t)NT * 1024;
static_assert(OFF_SX + (size_t)NT * 4 <= OFF_GREC + (size_t)2048 * GREC_BYTES, "peer scratch must fit in the dead GDN record region");
static_assert(OFF_END < (size_t)512 * 1024 * 1024, "workspace");

constexpr int LDS_BYTES = 148480 + 16;

struct Params {
    const float* in[29];
    float* out;
    char* ws;
};

DI u16 f2bf(float x) { unsigned u = __float_as_uint(x); u += 0x7fffu + ((u >> 16) & 1u); return (u16)(u >> 16); }
DI float bf2f(u16 v) { return __uint_as_float(((unsigned)v) << 16); }
DI unsigned pack2(float a, float b) { unsigned r; asm("v_cvt_pk_bf16_f32 %0, %1, %2" : "=v"(r) : "v"(a), "v"(b)); return r; }
DI float wave_sum(float v) { for (int o = 32; o > 0; o >>= 1) v += __shfl_xor(v, o); return v; }
DI float gelu_tanh(float x) { float u = 0.7978845608028654f * (x + 0.044715f * x * x * x); float e = __expf(2.f * u); float th = 1.f - 2.f / (e + 1.f); return 0.5f * x * (1.f + th); }
DI float sigmoidf_(float x) { return 1.f / (1.f + __expf(-x)); }
#define MFMA32(a, b, c) __builtin_amdgcn_mfma_f32_32x32x16_bf16((a), (b), (c), 0, 0, 0)
#define MFMA16(a, b, c) __builtin_amdgcn_mfma_f32_16x16x32_bf16((a), (b), (c), 0, 0, 0)
DI bf16x8 ld8(const void* p) { return *(const bf16x8*)p; }
DI bf16x8 cat4(bf16x4 lo, bf16x4 hi) { return __builtin_shufflevector(lo, hi, 0, 1, 2, 3, 4, 5, 6, 7); }
DI bf16x8 pack8(float a0, float a1, float a2, float a3, float a4, float a5, float a6, float a7) {
    uint4 u; u.x = pack2(a0, a1); u.y = pack2(a2, a3); u.z = pack2(a4, a5); u.w = pack2(a6, a7);
    return __builtin_bit_cast(bf16x8, u);
}

template <class CM>
DI void transpose_tile(const float* __restrict__ src, int src_ld, u16* __restrict__ dst, int K, int n0, int k0, CM colmap, float* tl) {
    const int tid = threadIdx.x;
    {
        const int nn = tid & 63;
        const int sc = colmap(n0 + nn);
#pragma unroll
        for (int i = 0; i < 8; ++i) { const int kk = (tid >> 6) + 8 * i; tl[kk * 65 + nn] = src[(size_t)(k0 + kk) * src_ld + sc]; }
    }
    __syncthreads();
    {
        const int kk = tid & 63;
#pragma unroll
        for (int i = 0; i < 8; ++i) { const int nn = (tid >> 6) + 8 * i; dst[(size_t)(n0 + nn) * K + k0 + kk] = f2bf(tl[kk * 65 + nn]); }
    }
    __syncthreads();
}

DI void phase_prep(const Params& P, char* lds) {
    float* tl = (float*)lds;
    char* ws = P.ws;
    const int bid = blockIdx.x, nb = gridDim.x, tid = threadIdx.x;
    for (int j = bid; j < 2496; j += nb) {
        if (j < 1408) {
            const int l = j / 704, r = j % 704, nt = r / 16, kt = r % 16;
            transpose_tile(P.in[2] + (size_t)l * 1024 * INW, INW, (u16*)(ws + OFF_WINT) + (size_t)l * PROJW * 1024, 1024, nt * 64, kt * 64,
                           [](int n) { return n < 1024 ? n : n + 8; }, tl);
        } else if (j < 1920) {
            const int q = j - 1408; const int l = q / 256, r = q % 256, nt = r / 16, kt = r % 16;
            transpose_tile(P.in[22] + (size_t)l * 1024 * 1024, 1024, (u16*)(ws + OFF_WOUTT) + (size_t)l * 1024 * 1024, 1024, nt * 64, kt * 64, [](int n) { return n; }, tl);
        } else if (j < 2432) {
            const int q = j - 1920; const int l = q / 256, r = q % 256, nt = r / 16, kt = r % 16;
            transpose_tile(P.in[24] + (size_t)l * 1024 * 1024, 1024, (u16*)(ws + OFF_WQT) + (size_t)l * 1024 * 1024, 1024, nt * 64, kt * 64, [](int n) { return n; }, tl);
        } else {
            const int q = j - 2432; const int l = q / 32, r = q % 32, nt = r / 4, kt = r % 4;
            transpose_tile(P.in[15] + (size_t)l * 256 * 512, 512, (u16*)(ws + OFF_GLUT) + (size_t)l * 512 * 256, 256, nt * 64, kt * 64,
                           [](int n) { const int tile = n >> 8, wi = n & 255; return wi < 128 ? 128 * tile + wi : 256 + 128 * tile + (wi - 128); }, tl);
        }
    }
    const size_t gtid = (size_t)bid * NTHR + tid, gsz = (size_t)nb * NTHR;
    for (size_t i = gtid; i < (size_t)2 * 8 * 2 * 128 * 64; i += gsz) ((u16*)(ws + OFF_KEYS))[i] = f2bf(P.in[25][i]);
    for (size_t i = gtid; i < (size_t)2 * 8 * 1024; i += gsz) {
        const int l = (int)(i / 8192), j = (int)((i / 1024) % 8), k = (int)(i % 1024);
        ((float*)(ws + OFF_WAB))[i] = P.in[2][(size_t)l * 1024 * INW + (size_t)k * INW + 1024 + j];
    }
    {
        const int wv = tid >> 6, lane = tid & 63;
        for (int row = bid * 8 + wv; row < 2 * 16384; row += nb * 8) {
            const float4* s = (const float4*)(P.in[26] + (size_t)row * 1024) + lane * 4;
            float4 v[4]; float am = 0.f;
#pragma unroll
            for (int q = 0; q < 4; ++q) { v[q] = s[q]; am = fmaxf(am, fmaxf(fmaxf(fabsf(v[q].x), fabsf(v[q].y)), fmaxf(fabsf(v[q].z), fabsf(v[q].w)))); }
            for (int o = 32; o > 0; o >>= 1) am = fmaxf(am, __shfl_xor(am, o));
            const float sc = am > 0.f ? 127.f / am : 0.f;
            uint4 o4; unsigned* op = (unsigned*)&o4;
#pragma unroll
            for (int q = 0; q < 4; ++q) {
                const int a = (int)rintf(v[q].x * sc), b = (int)rintf(v[q].y * sc), c = (int)rintf(v[q].z * sc), d = (int)rintf(v[q].w * sc);
                op[q] = (unsigned)(a & 0xff) | ((unsigned)(b & 0xff) << 8) | ((unsigned)(c & 0xff) << 16) | ((unsigned)(d & 0xff) << 24);
            }
            ((uint4*)(ws + OFF_UTAB))[(size_t)row * 64 + lane] = o4;
            if (lane == 0) ((float*)(ws + OFF_USCALE))[row] = am * (1.f / 127.f);
        }
        for (int row = bid * 8 + wv; row < 2 * 16384; row += nb * 8) {
            const float4* s = (const float4*)(P.in[27] + (size_t)row * 1024) + lane * 4;
            float4 v[4]; float am = 0.f;
#pragma unroll
            for (int q = 0; q < 4; ++q) { v[q] = s[q]; am = fmaxf(am, fmaxf(fmaxf(fabsf(v[q].x), fabsf(v[q].y)), fmaxf(fabsf(v[q].z), fabsf(v[q].w)))); }
            for (int o = 32; o > 0; o >>= 1) am = fmaxf(am, __shfl_xor(am, o));
            const float sc8 = am > 0.f ? 127.f / am : 0.f;
            uint4 o8; unsigned* op = (unsigned*)&o8;
#pragma unroll
            for (int q = 0; q < 4; ++q) {
                const int a = (int)rintf(v[q].x * sc8), b = (int)rintf(v[q].y * sc8), c = (int)rintf(v[q].z * sc8), d = (int)rintf(v[q].w * sc8);
                op[q] = (unsigned)(a & 0xff) | ((unsigned)(b & 0xff) << 8) | ((unsigned)(c & 0xff) << 16) | ((unsigned)(d & 0xff) << 24);
            }
            ((uint4*)(ws + OFF_VTAB))[(size_t)row * 64 + lane] = o8;
            if (lane == 0) ((float*)(ws + OFF_V8SC))[row] = am * (1.f / 127.f);
            const float sc4 = am > 0.f ? 7.f / am : 0.f;
            unsigned d[2];
#pragma unroll
            for (int h2 = 0; h2 < 2; ++h2) {
                const float4 a = v[2 * h2], b = v[2 * h2 + 1];
                const unsigned n0 = (unsigned)((int)rintf(a.x * sc4) + 8), n1 = (unsigned)((int)rintf(a.y * sc4) + 8), n2 = (unsigned)((int)rintf(a.z * sc4) + 8), n3 = (unsigned)((int)rintf(a.w * sc4) + 8);
                const unsigned n4 = (unsigned)((int)rintf(b.x * sc4) + 8), n5 = (unsigned)((int)rintf(b.y * sc4) + 8), n6 = (unsigned)((int)rintf(b.z * sc4) + 8), n7 = (unsigned)((int)rintf(b.w * sc4) + 8);
                d[h2] = n0 | (n4 << 4) | (n1 << 8) | (n5 << 12) | (n2 << 16) | (n6 << 20) | (n3 << 24) | (n7 << 28);
            }
            ((uint2*)(ws + OFF_V4TAB))[(size_t)row * 64 + lane] = make_uint2(d[0], d[1]);
            if (lane == 0) ((float*)(ws + OFF_V4SC))[row] = am * (1.f / 7.f);
        }
    }
    for (size_t i = gtid; i < (size_t)2 * 16 * 64; i += gsz) {
        const int l = (int)(i / 1024), g = (int)((i / 64) % 16), n = (int)(i % 64);
        const float step = __expf(P.in[14][l * 16 + g]);
        const float lr = P.in[7][i], li = P.in[8][i];
        const float er = expf(lr * step); const float ar = er * cosf(li * step), ai = er * sinf(li * step);
        const float e64 = expf(64.f * lr * step); const float a64r = e64 * cosf(64.f * li * step), a64i = e64 * sinf(64.f * li * step);
        char* sp = ws + OFF_S5P + l * S5P_LAYER;
        ((float2*)(sp + S5P_ABAR))[g * 64 + n] = make_float2(ar, ai);
        ((float2*)(sp + S5P_A64))[g * 64 + n] = make_float2(a64r, a64i);
        const float xr = ar - 1.f, xi = ai; const float den = 1.f / (lr * lr + li * li);
        const float cr = (xr * lr + xi * li) * den, ci = (xi * lr - xr * li) * den;
        for (int c = 0; c < 16; ++c) {
            const float br = P.in[9][i * 16 + c], bi = P.in[10][i * 16 + c];
            ((float*)(sp + S5P_BRE))[(g * 64 + n) * 16 + c] = cr * br - ci * bi;
            ((float*)(sp + S5P_BIM))[(g * 64 + n) * 16 + c] = cr * bi + ci * br;
        }
    }
    for (size_t i = gtid; i < (size_t)2 * 16 * 16 * 128; i += gsz) {
        const int l = (int)(i / 32768), g = (int)((i / 2048) % 16), c = (int)((i / 128) % 16), k = (int)(i % 128);
        const size_t si = ((size_t)(l * 16 + g) * 16 + c) * 64 + (k & 63);
        const float v = k < 64 ? P.in[11][si] : -P.in[12][si];
        ((u16*)(ws + OFF_S5P + l * S5P_LAYER + S5P_CM))[(g * 16 + c) * 128 + k] = f2bf(v);
    }
    if (bid == 0 && tid < 2) {
        const int l = tid; float s1 = 0.f, s2 = 0.f;
        for (int d = 0; d < 64; ++d) { s1 += P.in[17][l * 64 + d] * P.in[18][l * 64 + d]; s2 += P.in[19][l * 64 + d] * P.in[20][l * 64 + d]; }
        const float lam_init = 0.8f - 0.6f * expf(-0.3f * (float)l);
        ((float*)(ws + OFF_SCAL))[l] = expf(s1) - expf(s2) + lam_init;
    }
}

DI void rms_token(const Params& P, int t, int lane, float4 (&v)[4], const float* gain, u16* dst, int ab_layer  , bool want_q = false) {
    float ss = 0.f;
#pragma unroll
    for (int i = 0; i < 4; ++i) ss += v[i].x * v[i].x + v[i].y * v[i].y + v[i].z * v[i].z + v[i].w * v[i].w;
    ss = wave_sum(ss);
    const float rstd = rsqrtf(ss * (1.f / DM) + 1e-6f);
    const float4* g4 = (const float4*)gain;
#pragma unroll
    for (int i = 0; i < 4; ++i) {
        const float4 g = g4[lane + 64 * i];
        v[i].x *= rstd * g.x; v[i].y *= rstd * g.y; v[i].z *= rstd * g.z; v[i].w *= rstd * g.w;
        uint2 o; o.x = pack2(v[i].x, v[i].y); o.y = pack2(v[i].z, v[i].w);
        *(uint2*)(dst + (size_t)t * DM + (lane + 64 * i) * 4) = o;
    }
    if (want_q) {
        float am = 0.f;
#pragma unroll
        for (int i = 0; i < 4; ++i) am = fmaxf(am, fmaxf(fmaxf(fabsf(v[i].x), fabsf(v[i].y)), fmaxf(fabsf(v[i].z), fabsf(v[i].w))));
        for (int o = 32; o > 0; o >>= 1) am = fmaxf(am, __shfl_xor(am, o));
        const float sc = am > 0.f ? 127.f / am : 0.f;
#pragma unroll
        for (int i = 0; i < 4; ++i) {
            const int a0 = (int)rintf(v[i].x * sc), a1 = (int)rintf(v[i].y * sc), a2 = (int)rintf(v[i].z * sc), a3 = (int)rintf(v[i].w * sc);
            ((unsigned*)(P.ws + OFF_XQ))[(size_t)t * 256 + lane + 64 * i] = (unsigned)(a0 & 0xff) | ((unsigned)(a1 & 0xff) << 8) | ((unsigned)(a2 & 0xff) << 16) | ((unsigned)(a3 & 0xff) << 24);
        }
        if (lane == 0) ((float*)(P.ws + OFF_SX))[t] = am * (1.f / 127.f);
    }
    if (ab_layer >= 0) {
        const float4* wab = (const float4*)(P.ws + OFF_WAB) + ab_layer * 8 * 256;
        float acc[8];
#pragma unroll
        for (int j = 0; j < 8; ++j) {
            float a = 0.f;
#pragma unroll
            for (int i = 0; i < 4; ++i) { const float4 w = wab[j * 256 + lane + 64 * i]; a += v[i].x * w.x + v[i].y * w.y + v[i].z * w.z + v[i].w * w.w; }
            acc[j] = wave_sum(a);
        }
        if (lane < 4) {
            const float a = lane == 0 ? acc[0] : lane == 1 ? acc[1] : lane == 2 ? acc[2] : acc[3];
            const float b = lane == 0 ? acc[4] : lane == 1 ? acc[5] : lane == 2 ? acc[6] : acc[7];
            const float xx = a + P.in[5][ab_layer * 4 + lane];
            const float sp = xx > 20.f ? xx : log1pf(__expf(xx));
            ((float*)(P.ws + OFF_GG))[t * 4 + lane] = -__expf(P.in[4][ab_layer * 4 + lane]) * sp;
            ((float*)(P.ws + OFF_BETA))[t * 4 + lane] = sigmoidf_(b);
        }
    }
}

DI void phase_rms(const Params& P, const float* src, const float* gain, u16* dst, int ab_layer, bool want_q = false) {
    const int w = threadIdx.x >> 6, lane = threadIdx.x & 63;
    for (int t = blockIdx.x * 8 + w; t < NT; t += gridDim.x * 8) {
        const float4* s4 = (const float4*)(src + (size_t)t * DM);
        float4 v[4];
#pragma unroll
        for (int i = 0; i < 4; ++i) v[i] = s4[lane + 64 * i];
        rms_token(P, t, lane, v, gain, dst, ab_layer, want_q);
    }
}

namespace pg8 {
#define PG8_LAS __attribute__((address_space(3)))
typedef unsigned short bf16_t;
typedef short bf16x8 __attribute__((ext_vector_type(8)));
typedef float f32x4 __attribute__((ext_vector_type(4)));
typedef unsigned u32x4 __attribute__((ext_vector_type(4)));
constexpr int BM = 256, BK = 64, HALF = 128, HTB = HALF * BK * 2  , STAGE_BYTES = 8 * HTB, NXCD = 8, WGM = 8;

__host__ __device__ __forceinline__ int lds_byte(int r, int c) { const int st = (r >> 4) * 2 + (c >> 5), rr = r & 15, cc = c & 31, ob = rr * 64 + cc * 2; return st * 1024 + (ob ^ (((ob >> 9) & 1) << 5)); }
__host__ __device__ __forceinline__ void stage_rc(int b, int& R, int& C) { const int st = b / 1024, sb = b % 1024, swz = sb ^ (((sb >> 9) & 1) << 5); R = (st >> 1) * 16 + swz / 64; C = (st & 1) * 32 + (swz % 64) / 2; }
__host__ __device__ __forceinline__ int perm32(int rho) { const int n = rho >> 4, i = rho & 15; return 8 * (i >> 2) + 4 * n + (i & 3); }

struct Unit { int pm, pn; };
struct Gemm { const bf16_t* A; const bf16_t* Bt; int M, N, K; };

struct StaticOrder {
    int nM, nN, nwg, G, c;
    __host__ __device__ void init(int M, int N, int G_, int c_) { nM = M / BM; nN = N / BM; nwg = nM * nN; G = G_; c = c_; }
    __host__ __device__ bool next(int i, Unit& u) const {
        const long L = (long)i * G + c; if (L >= nwg) return false;
        int wgid = (int)L; { const int q = nwg / NXCD, r = nwg % NXCD, xcd = wgid % NXCD, off = wgid / NXCD; wgid = (xcd < r ? xcd * (q + 1) : r * (q + 1) + (xcd - r) * q) + off; }
        const int nig = WGM * nN, gid = wgid / nig, fm = gid * WGM, gsz = (nM - fm) < WGM ? (nM - fm) : WGM;
        u.pm = fm + ((wgid % nig) % gsz); u.pn = (wgid % nig) / gsz; return true;
    }
    __device__ __forceinline__ void a_ready(const Unit&) const {}
    __device__ __forceinline__ void done(const Unit&) const {}
};
struct CountedOrder : StaticOrder {
    const unsigned* ready; unsigned need; unsigned* tmo;
    __device__ __forceinline__ void a_ready(const Unit& u) const {
        if (threadIdx.x < 64) {
            const unsigned long long t0 = __builtin_amdgcn_s_memrealtime(); unsigned polls = 0;
            while ((unsigned)__builtin_amdgcn_readfirstlane(__hip_atomic_load(ready + 64 * u.pm, __ATOMIC_RELAXED, __HIP_MEMORY_SCOPE_AGENT)) < need) {
                if ((++polls & 255u) == 0u && __builtin_amdgcn_readfirstlane(__hip_atomic_load(tmo, __ATOMIC_RELAXED, __HIP_MEMORY_SCOPE_AGENT)) != 0u) break;
                if (__builtin_amdgcn_s_memrealtime() - t0 > 2000000ull) {
                    if (threadIdx.x == 0) { unsigned expect = 0u; __hip_atomic_compare_exchange_strong(tmo + 1, &expect, 0x600u | (unsigned)(u.pm & 0xff), __ATOMIC_RELAXED, __ATOMIC_RELAXED, __HIP_MEMORY_SCOPE_AGENT); __hip_atomic_store(tmo, 1u, __ATOMIC_RELAXED, __HIP_MEMORY_SCOPE_AGENT); }
                    break; }
                __builtin_amdgcn_s_sleep(2); }
            __builtin_amdgcn_fence(__ATOMIC_ACQUIRE, "agent");
            asm volatile("s_waitcnt vmcnt(0)" ::: "memory");
        }
#if !defined(BROKEN_HOOK_NO_BARRIER)
        asm volatile("" ::: "memory"); __builtin_amdgcn_s_barrier(); asm volatile("" ::: "memory");
#endif
    }
};

__device__ __forceinline__ unsigned cvt_pk_bf16(float lo, float hi) { unsigned r; asm volatile("v_cvt_pk_bf16_f32 %0, %1, %2" : "=v"(r) : "v"(lo), "v"(hi)); return r; }
typedef float f32x2 __attribute__((ext_vector_type(2)));
__device__ __forceinline__ f32x2 gelu_pk(f32x2 v) {
    const f32x2 av = __builtin_elementwise_abs(v), d = av * 0.2316418882f + 1.0f;
    f32x2 t; t.x = __builtin_amdgcn_rcpf(d.x); t.y = __builtin_amdgcn_rcpf(d.y);
    f32x2 q = t * 0.5307027145f + (-0.7265760135f); q = q * t + 0.7107068705f; q = q * t + (-0.142248368f); q = q * t + 0.127414796f; q = q * t;
    const f32x2 s = (v * v) * (-0.72134752044f);
    f32x2 e; e.x = __builtin_amdgcn_exp2f(s.x); e.y = __builtin_amdgcn_exp2f(s.y);
    const f32x2 m = v * (q * e), r = v - m;
    f32x2 o; o.x = v.x < 0.f ? m.x : r.x; o.y = v.y < 0.f ? m.y : r.y; return o;
}

struct EpiF32 {
    static constexpr bool PERM = false, AFTER_DRAIN = false;
    float* C; int ldc; const float* bias;
    __device__ __forceinline__ void operator()(const f32x4 (&acc)[2][2][4][2], const Unit& u, int wr, int wc, int fr, int fq) const {
        const int row0 = u.pm * BM + wr * 64 + fr, col0 = u.pn * BM + wc * 32 + 4 * fq;
        f32x4 bv[2][2];
#pragma unroll
        for (int bj = 0; bj < 2; ++bj)
#pragma unroll
            for (int n = 0; n < 2; ++n) bv[bj][n] = bias ? *(const f32x4*)(bias + col0 + bj * HALF + n * 16) : (f32x4){0.f, 0.f, 0.f, 0.f};
#pragma unroll
        for (int ai = 0; ai < 2; ++ai)
#pragma unroll
            for (int m = 0; m < 4; ++m) { float* rowp = C + (size_t)(row0 + ai * HALF + m * 16) * ldc + col0;
#pragma unroll
                for (int bj = 0; bj < 2; ++bj)
#pragma unroll
                    for (int n = 0; n < 2; ++n) *(f32x4*)(rowp + bj * HALF + n * 16) = acc[ai][bj][m][n] + bv[bj][n]; }
    }
};
template <int ACT  > struct EpiBf16 {
    static constexpr bool PERM = true, AFTER_DRAIN = false;
    bf16_t* O; int ldc; const float* bias; int split_cols; size_t split_stride;
    __device__ __forceinline__ void operator()(const f32x4 (&acc)[2][2][4][2], const Unit& u, int wr, int wc, int fr, int fq) const {
        const int row0 = u.pm * BM + wr * 64 + fr; int colt = u.pn * BM; bf16_t* base = O;
        if (split_cols) { const int t = colt / split_cols; base += (size_t)t * split_stride; colt -= t * split_cols; }
        const int col0 = colt + wc * 32 + 8 * fq, bcol0 = u.pn * BM + wc * 32 + 8 * fq;
        f32x4 bv[2][2];
#pragma unroll
        for (int bj = 0; bj < 2; ++bj)
#pragma unroll
            for (int n = 0; n < 2; ++n) bv[bj][n] = bias ? *(const f32x4*)(bias + bcol0 + bj * HALF + 4 * n) : (f32x4){0.f, 0.f, 0.f, 0.f};
#pragma unroll
        for (int ai = 0; ai < 2; ++ai)
#pragma unroll
            for (int m = 0; m < 4; ++m) { bf16_t* rowp = base + (size_t)(row0 + ai * HALF + m * 16) * ldc + col0;
#pragma unroll
                for (int bj = 0; bj < 2; ++bj) { f32x4 v0 = acc[ai][bj][m][0] + bv[bj][0], v1 = acc[ai][bj][m][1] + bv[bj][1];
                    if (ACT == 1) { f32x2 a = gelu_pk((f32x2){v0[0], v0[1]}), b = gelu_pk((f32x2){v0[2], v0[3]}), c = gelu_pk((f32x2){v1[0], v1[1]}), d = gelu_pk((f32x2){v1[2], v1[3]});
                        v0 = (f32x4){a.x, a.y, b.x, b.y}; v1 = (f32x4){c.x, c.y, d.x, d.y}; }
                    if (ACT == 2) {
#pragma unroll
                        for (int j = 0; j < 4; ++j) { v0[j] = 0.5f * v0[j] * (1.0f + erff(v0[j] * 0.70710678f)); v1[j] = 0.5f * v1[j] * (1.0f + erff(v1[j] * 0.70710678f)); } }
                    u32x4 w; w.x = cvt_pk_bf16(v0[0], v0[1]); w.y = cvt_pk_bf16(v0[2], v0[3]); w.z = cvt_pk_bf16(v1[0], v1[1]); w.w = cvt_pk_bf16(v1[2], v1[3]);
                    *(u32x4*)(rowp + bj * HALF) = w; } }
    }
};


template <class Epi, class Sched, bool STAMP = false>
__device__ __forceinline__ void gemm_phase(PG8_LAS unsigned char* lds, const Gemm g, const Sched& S, const Epi& E, unsigned long long* stamps) {
    const int tid = threadIdx.x, wid = __builtin_amdgcn_readfirstlane(tid >> 6), lane = tid & 63, wr = wid >> 2, wc = wid & 3, fr = lane & 15, fq = lane >> 4;
    const int K = g.K, nt = K / BK;
    int ts_lo = 0, ts_hi = 0, nts = 0; const unsigned long long rt_entry = STAMP ? (unsigned long long)wall_clock64() : 0ull;
#define PG8_STAMP() do { if (STAMP && wid == 0 && nts < 64) { const unsigned long long _c = (unsigned long long)clock64(); \
        ts_lo = (lane == nts) ? (int)(unsigned)_c : ts_lo; ts_hi = (lane == nts) ? (int)(unsigned)(_c >> 32) : ts_hi; ++nts; } } while (0)
    PG8_STAMP();
    unsigned voffA[2], voffB[2];
#pragma unroll
    for (int i = 0; i < 2; ++i) { int R, C; stage_rc(tid * 16 + i * 8192, R, C); const int Rb = Epi::PERM ? ((R & ~31) + perm32(R & 31)) : R;
        voffA[i] = (unsigned)(R * K + C) * 2u; voffB[i] = (unsigned)(Rb * K + C) * 2u; }
    const size_t kstep = (size_t)(BK * 2);
    const size_t hstep = (size_t)HALF * K * 2;
    const size_t tstep = 2 * hstep;
    const unsigned ldsw = (unsigned)wid * 1024u;
    const int aoff = lds_byte(wr * 64 + fr, fq * 8), boff = lds_byte(wc * 32 + fr, fq * 8);
#define PG8_SA(b, h) (((b) * 2 + (h)) * HTB)
#define PG8_SB(b, h) ((4 + (b) * 2 + (h)) * HTB)
#define PG8_STAGE(bufoff, gbase, voff) do { _Pragma("unroll") for (int _i = 0; _i < 2; ++_i) \
        __builtin_amdgcn_global_load_lds((const unsigned*)((const char*)(gbase) + (voff)[_i]), (PG8_LAS unsigned*)(lds + (bufoff) + ldsw + _i * 8192), 16, 0, 0); } while (0)
#define PG8_LDA(dst, b, h) do { _Pragma("unroll") for (int m = 0; m < 4; ++m) _Pragma("unroll") for (int k = 0; k < 2; ++k) dst[m][k] = *(const PG8_LAS bf16x8*)(lds + PG8_SA(b, h) + aoff + m * 2048 + k * 1024); } while (0)
#define PG8_LDB(dst, b, h) do { _Pragma("unroll") for (int n = 0; n < 2; ++n) _Pragma("unroll") for (int k = 0; k < 2; ++k) dst[n][k] = *(const PG8_LAS bf16x8*)(lds + PG8_SB(b, h) + boff + n * 2048 + k * 1024); } while (0)
#define PG8_MMA(ai, bj, At, Bt) do { __builtin_amdgcn_s_setprio(1); _Pragma("unroll") for (int m = 0; m < 4; ++m) _Pragma("unroll") for (int n = 0; n < 2; ++n) _Pragma("unroll") for (int k = 0; k < 2; ++k) \
        acc[ai][bj][m][n] = __builtin_amdgcn_mfma_f32_16x16x32_bf16(Bt[n][k], At[m][k], acc[ai][bj][m][n], 0, 0, 0); __builtin_amdgcn_s_setprio(0); } while (0)
#define PG8_WAIT_V(n) asm volatile("s_waitcnt vmcnt(" #n ")" ::: "memory")
#define PG8_WAIT_L(n) asm volatile("s_waitcnt lgkmcnt(" #n ")" ::: "memory")
#define PG8_BAR __builtin_amdgcn_s_barrier()
#define PG8_SCHED __builtin_amdgcn_sched_barrier(0)
    Unit cur, nxt; int ui = 0;
    if (!S.next(0, cur)) return;
    f32x4 acc[2][2][4][2];
#pragma unroll
    for (int a = 0; a < 2; ++a)
#pragma unroll
        for (int b = 0; b < 2; ++b)
#pragma unroll
            for (int m = 0; m < 4; ++m)
#pragma unroll
                for (int n = 0; n < 2; ++n) acc[a][b][m][n] = (f32x4){0.f, 0.f, 0.f, 0.f};
    bf16x8 At[4][2], B0[2][2], B1[2][2];
    const char* cA = (const char*)g.A + (size_t)cur.pm * tstep; const char* cB = (const char*)g.Bt + (size_t)cur.pn * tstep;
    S.a_ready(cur);
    PG8_STAGE(PG8_SB(0, 0), cB, voffB); PG8_STAGE(PG8_SA(0, 0), cA, voffA); PG8_STAGE(PG8_SB(0, 1), cB + hstep, voffB); PG8_STAGE(PG8_SA(0, 1), cA + hstep, voffA);
    if (wr == 1) PG8_BAR;
    PG8_WAIT_V(4); PG8_BAR;
    PG8_STAGE(PG8_SB(1, 0), cB + kstep, voffB); PG8_STAGE(PG8_SA(1, 0), cA + kstep, voffA); PG8_STAGE(PG8_SB(1, 1), cB + hstep + kstep, voffB);
    PG8_WAIT_V(6); PG8_BAR;
    PG8_STAMP();
    for (;;) {
        const bool has_next = S.next(ui + 1, nxt);
        const char* nA = has_next ? (const char*)g.A + (size_t)nxt.pm * tstep : cA; const char* nB = has_next ? (const char*)g.Bt + (size_t)nxt.pn * tstep : cB;
        for (int t = 0; t < nt; t += 2) {
            const bool last = (t == nt - 2);
            const char* a1 = cA + (size_t)(t + 1) * kstep;
            const char* a2 = last ? nA : cA + (size_t)(t + 2) * kstep; const char* b2 = last ? nB : cB + (size_t)(t + 2) * kstep;
            const char* a3 = a2 + kstep; const char* b3 = b2 + kstep;
            if (last && has_next) S.a_ready(nxt);
            PG8_LDB(B0, 0, 0); PG8_SCHED; PG8_LDA(At, 0, 0); PG8_STAGE(PG8_SA(1, 1), a1 + hstep, voffA);
            PG8_WAIT_L(8); PG8_BAR; PG8_WAIT_L(0); PG8_MMA(0, 0, At, B0); PG8_BAR; PG8_SCHED;
            PG8_LDB(B1, 0, 1); PG8_STAGE(PG8_SB(0, 0), b2, voffB);
            PG8_BAR; PG8_WAIT_L(0); PG8_MMA(0, 1, At, B1); PG8_BAR;
            PG8_LDA(At, 0, 1); PG8_STAGE(PG8_SA(0, 0), a2, voffA);
            PG8_BAR; PG8_WAIT_L(0); PG8_MMA(1, 0, At, B0); PG8_BAR; PG8_SCHED;
            PG8_STAGE(PG8_SB(0, 1), b2 + hstep, voffB);
            PG8_WAIT_V(6); PG8_BAR; PG8_MMA(1, 1, At, B1); PG8_BAR;
            PG8_LDB(B0, 1, 0); PG8_SCHED; PG8_LDA(At, 1, 0); PG8_STAGE(PG8_SA(0, 1), a2 + hstep, voffA);
            PG8_WAIT_L(8); PG8_BAR; PG8_WAIT_L(0); PG8_MMA(0, 0, At, B0); PG8_BAR; PG8_SCHED;
            PG8_LDB(B1, 1, 1); PG8_STAGE(PG8_SB(1, 0), b3, voffB);
            PG8_BAR; PG8_WAIT_L(0); PG8_MMA(0, 1, At, B1); PG8_BAR;
            PG8_LDA(At, 1, 1); PG8_STAGE(PG8_SA(1, 0), a3, voffA);
            PG8_BAR; PG8_WAIT_L(0); PG8_MMA(1, 0, At, B0); PG8_BAR; PG8_SCHED;
            PG8_STAGE(PG8_SB(1, 1), b3 + hstep, voffB);
            PG8_WAIT_V(6); PG8_BAR; PG8_MMA(1, 1, At, B1); PG8_BAR;
        }
        PG8_STAMP();
        if constexpr (!Epi::AFTER_DRAIN) { E(acc, cur, wr, wc, fr, fq); S.done(cur); }
        PG8_STAMP();
        if (!has_next) break;
#pragma unroll
        for (int a = 0; a < 2; ++a)
#pragma unroll
            for (int b = 0; b < 2; ++b)
#pragma unroll
                for (int m = 0; m < 4; ++m)
#pragma unroll
                    for (int n = 0; n < 2; ++n) acc[a][b][m][n] = (f32x4){0.f, 0.f, 0.f, 0.f};
        cur = nxt; cA = nA; cB = nB; ++ui;
    }
    PG8_WAIT_V(0);
    if (wr == 0) PG8_BAR;
    PG8_BAR;
    if constexpr (Epi::AFTER_DRAIN) { E.fused(acc, cur, wr, wc, fr, fq, lds, wid, lane); S.done(cur); }
    PG8_STAMP();
    if (STAMP && wid == 0) { stamps[lane] = lane < nts ? (((unsigned long long)(unsigned)ts_hi << 32) | (unsigned)ts_lo) : 0ull;
        if (lane == 62) stamps[62] = rt_entry; if (lane == 63) stamps[63] = (unsigned long long)wall_clock64(); }
#undef PG8_STAMP
#undef PG8_SA
#undef PG8_SB
#undef PG8_STAGE
#undef PG8_LDA
#undef PG8_LDB
#undef PG8_MMA
#undef PG8_WAIT_V
#undef PG8_WAIT_L
#undef PG8_BAR
#undef PG8_SCHED
}
}

struct EpiInProj8 {
    static constexpr bool PERM = true, AFTER_DRAIN = false;
    char* ws;
    DI void operator()(const pg8::f32x4 (&acc)[2][2][4][2], const pg8::Unit& u, int wr, int wc, int fr, int fq) const {
        const int row0 = u.pm * 256 + wr * 64 + fr; const int pn = u.pn;
        if (pn >= 9) {
            u16* vt = (u16*)(ws + OFF_VT);
#pragma unroll
            for (int ai = 0; ai < 2; ++ai)
#pragma unroll
                for (int m = 0; m < 4; ++m) {
                    const int tok = row0 + ai * 128 + m * 16; const int b = tok >> 13, l = tok & 8191;
#pragma unroll
                    for (int bj = 0; bj < 2; ++bj)
#pragma unroll
                        for (int n = 0; n < 2; ++n)
#pragma unroll
                            for (int j = 0; j < 4; ++j) {
                                const int c = (pn - 9) * 256 + wc * 32 + 8 * fq + bj * 128 + 4 * n + j; const int head = c >> 7, dv = c & 127;
                                vt[((size_t)((b * 4 + head) * 128 + dv)) * SEQ + l] = f2bf(acc[ai][bj][m][n][j]);
                            }
                }
            return;
        }
        u16* base; int pitch, c0; float sc = 1.f;
        if (pn < 3) { base = (u16*)(ws + OFF_QKV); pitch = 768; c0 = pn * 256; }
        else if (pn == 3) { base = (u16*)(ws + OFF_Z); pitch = 256; c0 = 0; }
        else if (pn == 4) { base = (u16*)(ws + OFF_US); pitch = 256; c0 = 0; }
        else if (pn < 7) { base = (u16*)(ws + OFF_QC); pitch = 512; c0 = (pn - 5) * 256; sc = 0.125f * LOG2E; }
        else { base = (u16*)(ws + OFF_KC); pitch = 512; c0 = (pn - 7) * 256; }
        const int col0 = c0 + wc * 32 + 8 * fq;
#pragma unroll
        for (int ai = 0; ai < 2; ++ai)
#pragma unroll
            for (int m = 0; m < 4; ++m) {
                u16* rowp = base + (size_t)(row0 + ai * 128 + m * 16) * pitch + col0;
#pragma unroll
                for (int bj = 0; bj < 2; ++bj) {
                    const pg8::f32x4 v0 = acc[ai][bj][m][0] * sc, v1 = acc[ai][bj][m][1] * sc;
                    uint4 w; w.x = pack2(v0[0], v0[1]); w.y = pack2(v0[2], v0[3]); w.z = pack2(v1[0], v1[1]); w.w = pack2(v1[2], v1[3]);
                    *(uint4*)(rowp + bj * 128) = w;
                }
            }
    }
};
struct EpiResidual8 {
    static constexpr bool PERM = false, AFTER_DRAIN = false;
    const float* hin; float* hout;
    DI void operator()(const pg8::f32x4 (&acc)[2][2][4][2], const pg8::Unit& u, int wr, int wc, int fr, int fq) const {
        const int row0 = u.pm * 256 + wr * 64 + fr, col0 = u.pn * 256 + wc * 32 + 4 * fq;
#pragma unroll
        for (int ai = 0; ai < 2; ++ai)
#pragma unroll
            for (int m = 0; m < 4; ++m) {
                const size_t ro = (size_t)(row0 + ai * 128 + m * 16) * DM + col0;
#pragma unroll
                for (int bj = 0; bj < 2; ++bj)
#pragma unroll
                    for (int n = 0; n < 2; ++n) {
                        const pg8::f32x4 h = *(const pg8::f32x4*)(hin + ro + bj * 128 + n * 16);
                        *(pg8::f32x4*)(hout + ro + bj * 128 + n * 16) = h + acc[ai][bj][m][n];
                    }
            }
    }
};
struct EpiGlu8 {
    static constexpr bool PERM = true, AFTER_DRAIN = false;
    u16* mix; const float* bias;
    DI void operator()(const pg8::f32x4 (&acc)[2][2][4][2], const pg8::Unit& u, int wr, int wc, int fr, int fq) const {
        const int row0 = u.pm * 256 + wr * 64 + fr, col0 = u.pn * 128 + wc * 32 + 8 * fq;
#pragma unroll
        for (int n = 0; n < 2; ++n) {
            const pg8::f32x4 bv = *(const pg8::f32x4*)(bias + col0 + 4 * n), bg = *(const pg8::f32x4*)(bias + 256 + col0 + 4 * n);
#pragma unroll
            for (int ai = 0; ai < 2; ++ai)
#pragma unroll
                for (int m = 0; m < 4; ++m) {
                    const pg8::f32x4 val = acc[ai][0][m][n] + bv, gt = acc[ai][1][m][n] + bg;
                    uint2 w; w.x = pack2(val[0] * sigmoidf_(gt[0]), val[1] * sigmoidf_(gt[1])); w.y = pack2(val[2] * sigmoidf_(gt[2]), val[3] * sigmoidf_(gt[3]));
                    *(uint2*)(mix + (size_t)(row0 + ai * 128 + m * 16) * DM + 256 + col0 + 4 * n) = w;
                }
        }
    }
};
template <class Epi>
DI void phase_gemm(const u16* A, int lda, const u16* Bt, int ldb, int M, int N, int K, Epi epi, char* lds) {
    pg8::Gemm g{A, Bt, M, N, K};
    pg8::StaticOrder S; S.init(M, N, (int)gridDim.x, (int)blockIdx.x);
    pg8::gemm_phase<Epi, pg8::StaticOrder, false>((PG8_LAS unsigned char*)lds, g, S, epi, nullptr);
}

template <int CTRL> DI float dppf(float v) { return __int_as_float(__builtin_amdgcn_update_dpp(0, __float_as_int(v), CTRL, 0xF, 0xF, true)); }
DI void gdn_prep_item(const Params& P, int layer, int item, char* lds) {
    const int tid = threadIdx.x, lane = tid & 63, w = tid >> 6;
    const int b = item >> 9, head = (item >> 7) & 3, ch = item & 127;
    const int t0 = b * SEQ + ch * 64;
    u16* raw = (u16*)lds;
    float* qs = (float*)(lds + 25856);
    float* ks = qs + 64 * 68;
    float* vs = ks + 64 * 68;
    float* Lp = vs + 64 * 68;
    u16* qb = (u16*)(Lp + 64 * 68);
    u16* kb = qb + 64 * 72;
    float* Gs = (float*)(kb + 64 * 72);
    float* bs = Gs + 64;
    u16* Xs = raw;
    const u16* qkv = (const u16*)(P.ws + OFF_QKV);
    u16* rec = (u16*)(P.ws + OFF_GREC + (size_t)item * GREC_BYTES);
    for (int i = tid; i < 67 * 24; i += NTHR) {
        const int row = i / 24, c8 = i % 24; const int part = c8 >> 3, cc = (c8 & 7) * 8;
        const int l = ch * 64 + row - 3;
        uint4 v = make_uint4(0, 0, 0, 0);
        if (l >= 0) v = *(const uint4*)(qkv + (size_t)(b * SEQ + l) * 768 + part * 256 + head * 64 + cc);
        *(uint4*)(raw + row * 192 + part * 64 + cc) = v;
    }
    if (tid < 64) {
        bs[tid] = ((const float*)(P.ws + OFF_BETA))[(t0 + tid) * 4 + head];
        float g = ((const float*)(P.ws + OFF_GG))[(t0 + tid) * 4 + head];
#pragma unroll
        for (int o = 1; o < 64; o <<= 1) { const float tt = __shfl_up(g, o); if (lane >= o) g += tt; }
        Gs[tid] = g;
    }
    __syncthreads();
    {
        const float* cw = P.in[3] + (size_t)layer * 4 * 768;
#pragma unroll 1
        for (int it = 0; it < 3; ++it) {
            const int id = tid + NTHR * it; const int t = id / 24, c8 = id % 24; const int part = c8 >> 3, d0 = (c8 & 7) * 8;
            float a[8];
#pragma unroll
            for (int k = 0; k < 8; ++k) a[k] = 0.f;
#pragma unroll
            for (int j = 0; j < 4; ++j) {
                const uint4 rv = *(const uint4*)(raw + (t + j) * 192 + part * 64 + d0);
                const float4 w0 = *(const float4*)(cw + j * 768 + part * 256 + head * 64 + d0), w1 = *(const float4*)(cw + j * 768 + part * 256 + head * 64 + d0 + 4);
                a[0] += w0.x * bf2f((u16)(rv.x & 0xffff)); a[1] += w0.y * bf2f((u16)(rv.x >> 16));
                a[2] += w0.z * bf2f((u16)(rv.y & 0xffff)); a[3] += w0.w * bf2f((u16)(rv.y >> 16));
                a[4] += w1.x * bf2f((u16)(rv.z & 0xffff)); a[5] += w1.y * bf2f((u16)(rv.z >> 16));
                a[6] += w1.z * bf2f((u16)(rv.w & 0xffff)); a[7] += w1.w * bf2f((u16)(rv.w >> 16));
            }
            float ss = 0.f;
#pragma unroll
            for (int k = 0; k < 8; ++k) { a[k] = a[k] * sigmoidf_(a[k]); ss += a[k] * a[k]; }
            ss += dppf<0xB1>(ss); ss += dppf<0x4E>(ss); ss += dppf<0x141>(ss);
            const float sc = part == 2 ? 1.f : rsqrtf(ss + 1e-6f) * (part == 0 ? 0.125f : 1.f);
#pragma unroll
            for (int k = 0; k < 8; ++k) a[k] *= sc;
            float* dst = (part == 0 ? qs : part == 1 ? ks : vs) + t * 68 + d0;
            *(float4*)dst = make_float4(a[0], a[1], a[2], a[3]); *(float4*)(dst + 4) = make_float4(a[4], a[5], a[6], a[7]);
            if (part < 2) {
                uint4 pk; pk.x = pack2(a[0], a[1]); pk.y = pack2(a[2], a[3]); pk.z = pack2(a[4], a[5]); pk.w = pack2(a[6], a[7]);
                *(uint4*)((part == 0 ? qb : kb) + t * 72 + d0) = pk;
            }
        }
    }
    __syncthreads();
    {
        const int r = lane & 31, hh = lane >> 5; const int bi = (w >> 1) & 1, bj = w & 1; const bool isqk = w >= 4;
        const u16* Am = (isqk ? qb : kb) + (bi * 32 + r) * 72 + hh * 8;
        const u16* Bm = kb + (bj * 32 + r) * 72 + hh * 8;
        f32x16 acc;
#pragma unroll
        for (int e = 0; e < 16; ++e) acc[e] = 0.f;
#pragma unroll
        for (int s = 0; s < 4; ++s) acc = MFMA32(ld8(Am + s * 16), ld8(Bm + s * 16), acc);
        const int cidx = bj * 32 + r; const float Gc = Gs[cidx], bc = bs[cidx];
#pragma unroll
        for (int e = 0; e < 16; ++e) {
            const int ridx = bi * 32 + (e & 3) + 8 * (e >> 2) + 4 * hh;
            if (isqk) {
                rec[2 * 4096 + ridx * 64 + cidx] = f2bf(cidx <= ridx ? acc[e] * __expf(Gs[ridx] - Gc) : 0.f);
            } else {
                Lp[ridx * 68 + (cidx & 3) * 16 + (cidx >> 2)] = (ridx < cidx) ? bc * acc[e] * __expf(Gc - Gs[ridx]) : 0.f;
            }
        }
    }
    __syncthreads();
    {
        const int c = tid >> 2, q = tid & 3; const bool isw = c >= 64; const int cc = c & 63;
        float rhs[16];
#pragma unroll
        for (int m = 0; m < 16; ++m) {
            const int i = 4 * m + q; const float bi_ = bs[i];
            rhs[m] = isw ? ks[i * 68 + cc] * bi_ * __expf(Gs[i]) : vs[i * 68 + cc] * bi_;
        }
        const float* Lq = Lp + q * 16;
#define SOLVE_STEP(j_, CTRL_) do { \
            const float xj = dppf<CTRL_>(rhs[(j_) >> 2]); \
            const float4* l4 = (const float4*)(Lq + (j_) * 68); \
            const float4 la = l4[0], lb = l4[1], lc = l4[2], ld = l4[3]; \
            rhs[0] -= la.x * xj; rhs[1] -= la.y * xj; rhs[2] -= la.z * xj; rhs[3] -= la.w * xj; \
            rhs[4] -= lb.x * xj; rhs[5] -= lb.y * xj; rhs[6] -= lb.z * xj; rhs[7] -= lb.w * xj; \
            rhs[8] -= lc.x * xj; rhs[9] -= lc.y * xj; rhs[10] -= lc.z * xj; rhs[11] -= lc.w * xj; \
            rhs[12] -= ld.x * xj; rhs[13] -= ld.y * xj; rhs[14] -= ld.z * xj; rhs[15] -= ld.w * xj; } while (0)
#pragma unroll
        for (int jj = 0; jj < 16; ++jj) {
            SOLVE_STEP(4 * jj + 0, 0x00); SOLVE_STEP(4 * jj + 1, 0x55); SOLVE_STEP(4 * jj + 2, 0xAA); SOLVE_STEP(4 * jj + 3, 0xFF);
        }
#undef SOLVE_STEP
        __syncthreads();
#pragma unroll
        for (int m = 0; m < 16; ++m) Xs[(4 * m + q) * 136 + c] = f2bf(rhs[m]);
    }
    __syncthreads();
    {
#pragma unroll
        for (int it = 0; it < 2; ++it) {
            const int id = tid + NTHR * it; const int i = id >> 4, c8 = (id & 15) * 8;
            *(uint4*)(rec + (c8 >> 6) * 4096 + i * 64 + (c8 & 63)) = *(const uint4*)(Xs + i * 136 + c8);
        }
        {
            const int t = tid >> 3, d0 = (tid & 7) * 8; const float eg = __expf(Gs[t]);
            const float4 x0 = *(const float4*)(qs + t * 68 + d0), x1 = *(const float4*)(qs + t * 68 + d0 + 4);
            uint4 pk; pk.x = pack2(x0.x * eg, x0.y * eg); pk.y = pack2(x0.z * eg, x0.w * eg); pk.z = pack2(x1.x * eg, x1.y * eg); pk.w = pack2(x1.z * eg, x1.w * eg);
            *(uint4*)(rec + 3 * 4096 + t * 64 + d0) = pk;
        }
        {
            const int d = tid & 63, tb = (tid >> 6) * 8; const float Gl = Gs[63];
            float kv[8];
#pragma unroll
            for (int k = 0; k < 8; ++k) kv[k] = ks[(tb + k) * 68 + d] * __expf(Gl - Gs[tb + k]);
            uint4 pk; pk.x = pack2(kv[0], kv[1]); pk.y = pack2(kv[2], kv[3]); pk.z = pack2(kv[4], kv[5]); pk.w = pack2(kv[6], kv[7]);
            *(uint4*)(rec + 4 * 4096 + d * 64 + tb) = pk;
            if (tid == 0) ((float*)(P.ws + OFF_EGL))[item] = __expf(Gl);
        }
    }
    __syncthreads();
}

constexpr int RP = 72;
DI void gdn_scan_chain(const Params& P, int chain, char* lds) {
    const int tid = threadIdx.x, lane = tid & 63, w = tid >> 6;
    const int b = chain >> 2, head = chain & 3;
    u16* buf0 = (u16*)lds;
    u16* buf1 = buf0 + 320 * RP;
    const char* recbase = P.ws + OFF_GREC + (size_t)(chain * 128) * GREC_BYTES;
    const float* egl = (const float*)(P.ws + OFF_EGL) + chain * 128;
    float* gout = (float*)(P.ws + OFF_GDNO);
    uint4 rg0, rg1, rg2, rg3, rg4;
#define SCAN_ISSUE(c_) do { const uint4* src_ = (const uint4*)(recbase + (size_t)(c_) * GREC_BYTES) + tid; \
        rg0 = src_[0]; rg1 = src_[NTHR]; rg2 = src_[2 * NTHR]; rg3 = src_[3 * NTHR]; rg4 = src_[4 * NTHR]; } while (0)
#define SCAN_PUT(buf_, i_, v_) do { const int id_ = tid + NTHR * (i_); *(uint4*)((buf_) + (id_ >> 3) * RP + (id_ & 7) * 8) = (v_); } while (0)
#define SCAN_COMMIT(buf_) do { SCAN_PUT(buf_, 0, rg0); SCAN_PUT(buf_, 1, rg1); SCAN_PUT(buf_, 2, rg2); SCAN_PUT(buf_, 3, rg3); SCAN_PUT(buf_, 4, rg4); } while (0)
    f32x4 S[4];
#pragma unroll
    for (int m = 0; m < 4; ++m) S[m] = (f32x4){0.f, 0.f, 0.f, 0.f};
    const int r16 = lane & 15, g = lane >> 4;
    SCAN_ISSUE(0); SCAN_COMMIT(buf0);
    __syncthreads();
    for (int c = 0; c < 128; ++c) {
        u16* cur = (c & 1) ? buf1 : buf0; u16* nxt = (c & 1) ? buf0 : buf1;
        if (c + 1 < 128) SCAN_ISSUE(c + 1);
        if (w < 4) {
            const float dec = egl[c];
            const u16* Ub = cur;
            const u16* Wb = cur + 64 * RP;
            const u16* QKb = cur + 128 * RP;
            const u16* QGb = cur + 192 * RP;
            const u16* KDb = cur + 256 * RP;
            bf16x8 Sb[2];
#pragma unroll
            for (int s = 0; s < 2; ++s) Sb[s] = pack8(S[2 * s][0], S[2 * s][1], S[2 * s][2], S[2 * s][3], S[2 * s + 1][0], S[2 * s + 1][1], S[2 * s + 1][2], S[2 * s + 1][3]);
            f32x4 vn[4], o[4];
#pragma unroll
            for (int mb = 0; mb < 4; ++mb) {
                f32x4 a = (f32x4){0.f, 0.f, 0.f, 0.f}, oo = (f32x4){0.f, 0.f, 0.f, 0.f};
#pragma unroll
                for (int s = 0; s < 2; ++s) {
                    const u16* pw = Wb + (16 * mb + r16) * RP + 32 * s + 4 * g;
                    const u16* pq = QGb + (16 * mb + r16) * RP + 32 * s + 4 * g;
                    a = MFMA16(cat4(*(const bf16x4*)pw, *(const bf16x4*)(pw + 16)), Sb[s], a);
                    oo = MFMA16(cat4(*(const bf16x4*)pq, *(const bf16x4*)(pq + 16)), Sb[s], oo);
                }
#pragma unroll
                for (int e = 0; e < 4; ++e) vn[mb][e] = bf2f(Ub[(16 * mb + 4 * g + e) * RP + 16 * w + r16]) - a[e];
                o[mb] = oo;
            }
            bf16x8 Vb[2];
#pragma unroll
            for (int s = 0; s < 2; ++s) Vb[s] = pack8(vn[2 * s][0], vn[2 * s][1], vn[2 * s][2], vn[2 * s][3], vn[2 * s + 1][0], vn[2 * s + 1][1], vn[2 * s + 1][2], vn[2 * s + 1][3]);
#pragma unroll
            for (int mb = 0; mb < 4; ++mb) {
                f32x4 oo = o[mb];
                f32x4 sn = S[mb] * dec;
#pragma unroll
                for (int s = 0; s < 2; ++s) {
                    const u16* pk = QKb + (16 * mb + r16) * RP + 32 * s + 4 * g;
                    const u16* pd = KDb + (16 * mb + r16) * RP + 32 * s + 4 * g;
                    oo = MFMA16(cat4(*(const bf16x4*)pk, *(const bf16x4*)(pk + 16)), Vb[s], oo);
                    sn = MFMA16(cat4(*(const bf16x4*)pd, *(const bf16x4*)(pd + 16)), Vb[s], sn);
                }
                S[mb] = sn;
#pragma unroll
                for (int e = 0; e < 4; ++e)
                    gout[(size_t)(b * SEQ + c * 64 + 16 * mb + 4 * g + e) * 256 + head * 64 + 16 * w + r16] = oo[e];
            }
        }
        if (c + 1 < 128) SCAN_COMMIT(nxt);
        __syncthreads();
    }
}

DI void phase_gdn_norm(const Params& P, int layer) {
    const int w = threadIdx.x >> 6, lane = threadIdx.x & 63;
    const float* gout = (const float*)(P.ws + OFF_GDNO);
    const u16* z = (const u16*)(P.ws + OFF_Z);
    u16* mix = (u16*)(P.ws + OFF_ABUF);
    const float4 ng = ((const float4*)(P.in[6] + layer * 64))[lane & 15];
    for (int t = blockIdx.x * 8 + w; t < NT; t += gridDim.x * 8) {
        const float4 o = ((const float4*)(gout + (size_t)t * 256))[lane];
        float ss = o.x * o.x + o.y * o.y + o.z * o.z + o.w * o.w;
        ss += __shfl_xor(ss, 1); ss += __shfl_xor(ss, 2); ss += __shfl_xor(ss, 4); ss += __shfl_xor(ss, 8);
        const float rstd = rsqrtf(ss * (1.f / 64.f) + 1e-6f);
        const uint2 zz = *(const uint2*)(z + (size_t)t * 256 + lane * 4);
        const float z0 = bf2f((u16)(zz.x & 0xffff)), z1 = bf2f((u16)(zz.x >> 16)), z2 = bf2f((u16)(zz.y & 0xffff)), z3 = bf2f((u16)(zz.y >> 16));
        uint2 r;
        r.x = pack2(o.x * rstd * ng.x * z0 * sigmoidf_(z0), o.y * rstd * ng.y * z1 * sigmoidf_(z1));
        r.y = pack2(o.z * rstd * ng.z * z2 * sigmoidf_(z2), o.w * rstd * ng.w * z3 * sigmoidf_(z3));
        *(uint2*)(mix + (size_t)t * DM + lane * 4) = r;
    }
}

template <bool FINAL>
DI void s5_item(const Params& P, int layer, int item, char* wlds, int lane) {
    const int b = item >> 11, g = (item >> 7) & 15, ch = item & 127;
    const int t0 = b * SEQ + ch * 64;
    const char* sp = P.ws + OFF_S5P + layer * S5P_LAYER;
    float* ut = (float*)wlds;
    u16* Xs = (u16*)(wlds + 4096);
    {
        const u16* src = (const u16*)(P.ws + OFF_US) + (size_t)(t0 + lane) * 256 + g * 16;
        const uint4 a = *(const uint4*)src, c = *(const uint4*)(src + 8);
        const unsigned uu[8] = {a.x, a.y, a.z, a.w, c.x, c.y, c.z, c.w};
#pragma unroll
        for (int i = 0; i < 8; ++i) { ut[lane * 16 + 2 * i] = bf2f((u16)(uu[i] & 0xffff)); ut[lane * 16 + 2 * i + 1] = bf2f((u16)(uu[i] >> 16)); }
    }
    float Br[16], Bi[16];
    {
        const float4* br = (const float4*)(sp + S5P_BRE) + (g * 64 + lane) * 4; const float4* bi = (const float4*)(sp + S5P_BIM) + (g * 64 + lane) * 4;
#pragma unroll
        for (int i = 0; i < 4; ++i) { const float4 x = br[i], y = bi[i]; Br[4 * i] = x.x; Br[4 * i + 1] = x.y; Br[4 * i + 2] = x.z; Br[4 * i + 3] = x.w; Bi[4 * i] = y.x; Bi[4 * i + 1] = y.y; Bi[4 * i + 2] = y.z; Bi[4 * i + 3] = y.w; }
    }
    const float2 ab = ((const float2*)(sp + S5P_ABAR))[g * 64 + lane];
    float2* st = (float2*)(P.ws + OFF_S5ST) + (size_t)item * 64 + lane;
    float xr = 0.f, xi = 0.f;
    if (FINAL) { const float2 c0 = *st; xr = c0.x; xi = c0.y; }
    bf16x8 cf[4];
    if (FINAL) {
        const u16* cm = (const u16*)(sp + S5P_CM) + (g * 16 + (lane & 15)) * 128 + 8 * (lane >> 4);
#pragma unroll
        for (int s = 0; s < 4; ++s) cf[s] = ld8(cm + 32 * s);
    }
    __builtin_amdgcn_wave_barrier();
    asm volatile("s_waitcnt lgkmcnt(0)" ::: "memory");
    for (int half = 0; half < 2; ++half) {
        for (int tt = 0; tt < 32; ++tt) {
            const int t = half * 32 + tt;
            const float4* u4 = (const float4*)(ut + t * 16);
            float br_ = 0.f, bi_ = 0.f;
#pragma unroll
            for (int q = 0; q < 4; ++q) {
                const float4 u = u4[q];
                br_ += Br[4 * q] * u.x + Br[4 * q + 1] * u.y + Br[4 * q + 2] * u.z + Br[4 * q + 3] * u.w;
                bi_ += Bi[4 * q] * u.x + Bi[4 * q + 1] * u.y + Bi[4 * q + 2] * u.z + Bi[4 * q + 3] * u.w;
            }
            const float nr = ab.x * xr - ab.y * xi + br_, ni = ab.x * xi + ab.y * xr + bi_;
            xr = nr; xi = ni;
            if (FINAL) { Xs[tt * 136 + lane] = f2bf(xr); Xs[tt * 136 + 64 + lane] = f2bf(xi); }
        }
        if (FINAL) {
            asm volatile("s_waitcnt lgkmcnt(0)" ::: "memory");
            __builtin_amdgcn_wave_barrier();
            const int r16 = lane & 15, gg = lane >> 4;
            const float dsv = P.in[13][layer * 256 + g * 16 + r16];
#pragma unroll
            for (int mb = 0; mb < 2; ++mb) {
                f32x4 acc = (f32x4){0.f, 0.f, 0.f, 0.f};
#pragma unroll
                for (int s = 0; s < 4; ++s) acc = MFMA16(ld8(Xs + (16 * mb + r16) * 136 + 32 * s + 8 * gg), cf[s], acc);
#pragma unroll
                for (int e = 0; e < 4; ++e) {
                    const int tk = half * 32 + 16 * mb + 4 * gg + e;
                    const float y = acc[e] + dsv * ut[tk * 16 + r16];
                    ((u16*)(P.ws + OFF_YS5))[(size_t)(t0 + tk) * 256 + g * 16 + r16] = f2bf(gelu_tanh(y));
                }
            }
            asm volatile("s_waitcnt lgkmcnt(0)" ::: "memory");
            __builtin_amdgcn_wave_barrier();
        }
    }
    if (!FINAL) *st = make_float2(xr, xi);
    asm volatile("s_waitcnt lgkmcnt(0)" ::: "memory");
    __builtin_amdgcn_wave_barrier();
}
template <bool FINAL>
DI void phase_s5(const Params& P, int layer, char* lds) {
    const int w = threadIdx.x >> 6, lane = threadIdx.x & 63;
    char* wl = lds + w * 12800;
    for (int it = blockIdx.x * 8 + w; it < 8192; it += gridDim.x * 8) s5_item<FINAL>(P, layer, it, wl, lane);
}
constexpr int KP = 136;
constexpr int VP = 72;
constexpr int ATT_STAGE = 64 * KP + 128 * VP;
DI void attn_item(const Params& P, int layer, int b, int head, int qb, char* lds) {
    const int tid = threadIdx.x, lane = tid & 63, w = tid >> 6;
    const int m = w >> 2, wq = w & 3, r = lane & 31, hh = lane >> 5;
    u16* st0 = (u16*)lds;
    const u16* QC = (const u16*)(P.ws + OFF_QC);
    const u16* KC = (const u16*)(P.ws + OFF_KC);
    const u16* VT = (const u16*)(P.ws + OFF_VT);
    const int qw0 = qb * 128 + 32 * wq;
    const int q = qw0 + r;
    bf16x8 qf[4];
    {
        const u16* qp = QC + (size_t)(b * SEQ + q) * 512 + head * 128 + m * 64 + hh * 8;
#pragma unroll
        for (int s = 0; s < 4; ++s) qf[s] = ld8(qp + 16 * s);
    }
    f32x16 o[4];
#pragma unroll
    for (int d = 0; d < 4; ++d)
#pragma unroll
        for (int e = 0; e < 16; ++e) o[d][e] = 0.f;
    float mrun = -INFINITY, lrun = 0.f;
    const int nkv = 2 * (qb + 1);
    const int kkey = tid >> 4, kch = tid & 15;
    const int vdv = tid >> 3, vch = tid & 7;
    const u16* kg = KC + (size_t)(b * SEQ + kkey) * 512 + head * 128 + kch * 8;
    const u16* vg = VT + ((size_t)((b * 4 + head) * 128 + vdv)) * SEQ + vch * 8;
    uint4 ra_k0, ra_k1, ra_v0, ra_v1;
#define ATT_ISSUE(S_, j_) do { S_##_k0 = *(const uint4*)(kg + (size_t)(64 * (j_)) * 512); S_##_k1 = *(const uint4*)(kg + (size_t)(64 * (j_) + 32) * 512); \
        S_##_v0 = *(const uint4*)(vg + 64 * (j_)); S_##_v1 = *(const uint4*)(vg + (size_t)64 * SEQ + 64 * (j_)); } while (0)
#define ATT_COMMIT(S_, stg_) do { u16* sg_ = (stg_); *(uint4*)(sg_ + kkey * KP + kch * 8) = S_##_k0; *(uint4*)(sg_ + (kkey + 32) * KP + kch * 8) = S_##_k1; \
        u16* vb_ = sg_ + 64 * KP; \
        const int vpos_ = 16 * (vch >> 1) + 4 * (vch & 1); \
        *(uint2*)(vb_ + vdv * VP + vpos_) = make_uint2(S_##_v0.x, S_##_v0.y); *(uint2*)(vb_ + vdv * VP + vpos_ + 8) = make_uint2(S_##_v0.z, S_##_v0.w); \
        *(uint2*)(vb_ + (vdv + 64) * VP + vpos_) = make_uint2(S_##_v1.x, S_##_v1.y); *(uint2*)(vb_ + (vdv + 64) * VP + vpos_ + 8) = make_uint2(S_##_v1.z, S_##_v1.w); } while (0)
#define ATT_QK(stg_, init_) do { \
        const float in_ = (init_); \
        _Pragma("unroll") for (int e = 0; e < 16; ++e) { s0[e] = in_; s1[e] = in_; } \
        const u16* kp = (stg_) + r * KP + m * 64 + hh * 8; \
        bf16x8 ka[4], kb[4]; \
        _Pragma("unroll") for (int s = 0; s < 4; ++s) { ka[s] = ld8(kp + 16 * s); kb[s] = ld8(kp + 32 * KP + 16 * s); } \
        __builtin_amdgcn_sched_barrier(0); \
        _Pragma("unroll") for (int s = 0; s < 4; ++s) { \
            s0 = MFMA32(ka[s], qf[s], s0); \
            s1 = MFMA32(kb[s], qf[s], s1); } } while (0)
#define ATT_MASK(j_) do { \
        if (64 * (j_) + 63 > qw0) { \
            _Pragma("unroll") for (int e = 0; e < 16; ++e) { \
                const int key = 64 * (j_) + (e & 3) + 8 * (e >> 2) + 4 * hh; \
                if (key > q) s0[e] = -INFINITY; \
                if (key + 32 > q) s1[e] = -INFINITY; } } } while (0)
#define ATT_PACK() do { \
        pf[0] = pack8(s0[0], s0[1], s0[2], s0[3], s0[4], s0[5], s0[6], s0[7]); \
        pf[1] = pack8(s0[8], s0[9], s0[10], s0[11], s0[12], s0[13], s0[14], s0[15]); \
        pf[2] = pack8(s1[0], s1[1], s1[2], s1[3], s1[4], s1[5], s1[6], s1[7]); \
        pf[3] = pack8(s1[8], s1[9], s1[10], s1[11], s1[12], s1[13], s1[14], s1[15]); } while (0)
#define ATT_SM_HEAVY(j_) do { \
        ATT_MASK(j_); \
        float mx = s0[0]; \
        _Pragma("unroll") for (int e = 1; e < 16; ++e) mx = fmaxf(mx, s0[e]); \
        _Pragma("unroll") for (int e = 0; e < 16; ++e) mx = fmaxf(mx, s1[e]); \
        mx = fmaxf(mx, __shfl_xor(mx, 32)); \
        float mnew = mrun; \
        if (__builtin_amdgcn_ballot_w64(mx > mrun + 8.f) != 0ull) { \
            mnew = fmaxf(mrun, mx); \
            const float alpha = __builtin_amdgcn_exp2f(mrun - mnew); \
            mrun = mnew; lrun *= alpha; \
            _Pragma("unroll") for (int d = 0; d < 4; ++d) o[d] = o[d] * alpha; } \
        float psum = 0.f; \
        _Pragma("unroll") for (int e = 0; e < 16; ++e) { s0[e] = __builtin_amdgcn_exp2f(s0[e] - mnew); psum += s0[e]; } \
        _Pragma("unroll") for (int e = 0; e < 16; ++e) { s1[e] = __builtin_amdgcn_exp2f(s1[e] - mnew); psum += s1[e]; } \
        lrun += psum; \
        ATT_PACK(); } while (0)
#define ATT_SM_LIGHT(j_) do { \
        ATT_MASK(j_); \
        _Pragma("unroll") for (int e = 0; e < 16; ++e) { s0[e] = __builtin_amdgcn_exp2f(s0[e]); s1[e] = __builtin_amdgcn_exp2f(s1[e]); } \
        { float ps_ = 0.f; _Pragma("unroll") for (int e = 0; e < 16; ++e) ps_ += s0[e] + s1[e]; lrun += ps_; } \
        ATT_PACK(); } while (0)
#define ATT_LDV(dst_, d_) do { _Pragma("unroll") for (int kk = 0; kk < 4; ++kk) dst_[kk] = ld8(vp + (d_) * 32 * VP + 16 * kk); } while (0)
#define ATT_MM4(d_, src_) do { __builtin_amdgcn_s_setprio(1); _Pragma("unroll") for (int kk = 0; kk < 4; ++kk) o[d_] = MFMA32(src_[kk], pf[kk], o[d_]); __builtin_amdgcn_s_setprio(0); } while (0)
#define ATT_PV(stg_) do { \
        const u16* vp = (stg_) + 64 * KP + r * VP + 8 * hh; \
        bf16x8 va[4], vb[4]; \
        ATT_LDV(va, 0); __builtin_amdgcn_sched_barrier(0); \
        ATT_LDV(vb, 1); __builtin_amdgcn_sched_barrier(0); ATT_MM4(0, va); __builtin_amdgcn_sched_barrier(0); \
        ATT_LDV(va, 2); __builtin_amdgcn_sched_barrier(0); ATT_MM4(1, vb); __builtin_amdgcn_sched_barrier(0); \
        ATT_LDV(vb, 3); __builtin_amdgcn_sched_barrier(0); ATT_MM4(2, va); __builtin_amdgcn_sched_barrier(0); \
        ATT_MM4(3, vb); } while (0)
    bf16x8 pf[4];
    bool pend = false;
    bool first_ = true;
    ATT_ISSUE(ra, 0); ATT_COMMIT(ra, st0);
    asm volatile("" :: "v"(qf[0]), "v"(qf[1]), "v"(qf[2]), "v"(qf[3]));
    __syncthreads();
    int sc = 0;
#define ATT_ITER(j_, IS_, CS_) do { \
        u16* cur = st0 + sc * ATT_STAGE; \
        const int sp = sc == 0 ? 2 : sc - 1, sn = sc == 2 ? 0 : sc + 1; \
        u16* prv = st0 + sp * ATT_STAGE; u16* nxt = st0 + sn * ATT_STAGE; \
        if ((j_) + 1 < nkv) ATT_ISSUE(ra, (j_) + 1); \
        const bool act = 64 * (j_) <= qw0 + 31; \
        const bool heavy = (((j_) & 15) == 0) || first_; \
        f32x16 s0, s1; \
        if (act) { if (heavy) { ATT_QK(cur, 0.f); } else { ATT_QK(cur, -mrun); } }        \
        if (pend) { ATT_PV(prv); pend = false; }                                              \
        if (act) { if (heavy) { ATT_SM_HEAVY(j_); } else { ATT_SM_LIGHT(j_); } first_ = false; pend = true; }     \
        if ((j_) + 1 < nkv) ATT_COMMIT(ra, nxt); \
        __syncthreads(); \
        sc = sn; } while (0)
    for (int j = 0; j < nkv; j += 2) {
        ATT_ITER(j, ra, rb);
        ATT_ITER(j + 1, rb, ra);
    }
    if (pend) { const int sl = sc == 0 ? 2 : sc - 1; ATT_PV(st0 + sl * ATT_STAGE); }
    __syncthreads();
    const float ltot = lrun + __shfl_xor(lrun, 32);
    const float inv = 1.f / ltot;
    float* ex = (float*)lds;
    if (m == 1) {
#pragma unroll
        for (int d = 0; d < 4; ++d)
#pragma unroll
            for (int e = 0; e < 16; ++e) ex[(wq * 64 + d * 16 + e) * 64 + lane] = o[d][e] * inv;
    }
    __syncthreads();
    if (m == 0) {
        const float lam = ((const float*)(P.ws + OFF_SCAL))[layer];
        const float lam_init = 0.8f - 0.6f * __expf(-0.3f * (float)layer);
        float ss = 0.f;
#pragma unroll
        for (int d = 0; d < 4; ++d)
#pragma unroll
            for (int e = 0; e < 16; ++e) { const float v = o[d][e] * inv - lam * ex[(wq * 64 + d * 16 + e) * 64 + lane]; o[d][e] = v; ss += v * v; }
        ss += __shfl_xor(ss, 32);
        const float scl = rsqrtf(ss * (1.f / 128.f) + 1e-6f) * (1.f - lam_init);
        const float* ng = P.in[21] + layer * 128;
        u16* mix = (u16*)(P.ws + OFF_ABUF) + (size_t)(b * SEQ + q) * DM + 512 + head * 128;
#pragma unroll
        for (int d = 0; d < 4; ++d)
#pragma unroll
            for (int qd = 0; qd < 4; ++qd) {
                const int dv0 = 32 * d + 8 * qd + 4 * hh;
                const float4 g4 = *(const float4*)(ng + dv0);
                uint2 pk; pk.x = pack2(o[d][4 * qd] * scl * g4.x, o[d][4 * qd + 1] * scl * g4.y); pk.y = pack2(o[d][4 * qd + 2] * scl * g4.z, o[d][4 * qd + 3] * scl * g4.w);
                *(uint2*)(mix + dv0) = pk;
            }
    }
    __syncthreads();
#undef ATT_ISSUE
#undef ATT_COMMIT
#undef ATT_QK
#undef ATT_MASK
#undef ATT_PACK
#undef ATT_SM_HEAVY
#undef ATT_SM_LIGHT
#undef ATT_PV
#undef ATT_ITER
#undef ATT_LDV
#undef ATT_MM4
}
DI void phase_attn(const Params& P, int layer, char* lds, int cidx = 0) {
    unsigned* ctr = (unsigned*)(P.ws + OFF_CTL + 16384 + (layer + 2 * cidx) * 256);
    volatile int* slot = (volatile int*)(lds + LDS_BYTES - 32);
    for (;;) {
        if (threadIdx.x == 0) *slot = (int)atomicAdd(ctr, 1u);
        __syncthreads();
        const int idx = *slot;
        __syncthreads();
        if (idx >= 1024) break;
        const int qb = 63 - (idx >> 4), bh = idx & 15;
        attn_item(P, layer, bh >> 2, bh & 3, qb, lds);
    }
}

DI void sort16_desc(float (&a)[16]) {
#pragma unroll
    for (int k = 2; k <= 16; k <<= 1)
#pragma unroll
        for (int j = k >> 1; j > 0; j >>= 1)
#pragma unroll
            for (int i = 0; i < 16; ++i) {
                const int l = i ^ j;
                if (l > i) {
                    const float hi = fmaxf(a[i], a[l]), lo = fminf(a[i], a[l]);
                    if ((i & k) == 0) { a[i] = hi; a[l] = lo; } else { a[i] = lo; a[l] = hi; }
                }
            }
}
DI void merge_top16(float (&a)[16], const float (&b)[16]) {
#pragma unroll
    for (int i = 0; i < 16; ++i) a[i] = fmaxf(a[i], b[15 - i]);
#pragma unroll
    for (int j = 8; j > 0; j >>= 1)
#pragma unroll
        for (int i = 0; i < 16; ++i) {
            const int l = i ^ j;
            if (l > i) { const float hi = fmaxf(a[i], a[l]), lo = fminf(a[i], a[l]); a[i] = hi; a[l] = lo; }
        }
}
DI void phase_topk(const Params& P, int layer, char* lds) {
    const int w = threadIdx.x >> 6, lane = threadIdx.x & 63, r = lane & 31, hh = lane >> 5;
    const u16* PQ = (const u16*)(P.ws + OFF_PQ);
    const u16* KEYS = (const u16*)(P.ws + OFF_KEYS) + (size_t)layer * 8 * 2 * 128 * 64;
    u16* pe = (u16*)(P.ws + OFF_PICKE); float* pg = (float*)(P.ws + OFF_PICKG);
    unsigned* Hs = (unsigned*)lds;
    unsigned char* mytab = (unsigned char*)(lds + 4096 + threadIdx.x * 32);
    for (int it0 = blockIdx.x * 8; it0 < 8192; it0 += gridDim.x * 8) {
        const int it = it0 + w;
        const int tile = it >> 3, h = it & 7; const int tok = tile * 32 + r;
        float sv[2][16];
#pragma unroll
        for (int p = 0; p < 2; ++p) {
            bf16x8 bq[4];
            const u16* qp = PQ + (size_t)tok * 1024 + h * 128 + p * 64 + hh * 8;
#pragma unroll
            for (int s = 0; s < 4; ++s) bq[s] = ld8(qp + 16 * s);
            float blk[4][16];
#pragma unroll
            for (int kb = 0; kb < 4; ++kb) {
                f32x16 acc;
#pragma unroll
                for (int e = 0; e < 16; ++e) acc[e] = 0.f;
                const u16* kp = KEYS + ((size_t)((h * 2 + p) * 128 + 32 * kb + r)) * 64 + hh * 8;
#pragma unroll
                for (int s = 0; s < 4; ++s) acc = MFMA32(ld8(kp + 16 * s), bq[s], acc);
#pragma unroll
                for (int e = 0; e < 16; ++e) {
                    const unsigned key = 32 * kb + (e & 3) + 8 * (e >> 2) + 4 * hh;
                    blk[kb][e] = __uint_as_float((__float_as_uint(acc[e]) & ~0x7Fu) | key);
                }
                sort16_desc(blk[kb]);
            }
            merge_top16(blk[0], blk[1]); merge_top16(blk[2], blk[3]); merge_top16(blk[0], blk[2]);
            float oth[16];
#pragma unroll
            for (int k = 0; k < 16; ++k) oth[k] = __shfl_xor(blk[0][k], 32);
            merge_top16(blk[0], oth);
#pragma unroll
            for (int k = 0; k < 16; ++k) sv[p][k] = blk[0][k];
        }
        {
            uint4 t0, t1; unsigned* a0 = (unsigned*)&t0; unsigned* a1 = (unsigned*)&t1;
#pragma unroll
            for (int q = 0; q < 4; ++q) {
                a0[q] = (__float_as_uint(sv[0][4 * q]) & 0x7Fu) | ((__float_as_uint(sv[0][4 * q + 1]) & 0x7Fu) << 8) | ((__float_as_uint(sv[0][4 * q + 2]) & 0x7Fu) << 16) | ((__float_as_uint(sv[0][4 * q + 3]) & 0x7Fu) << 24);
                a1[q] = (__float_as_uint(sv[1][4 * q]) & 0x7Fu) | ((__float_as_uint(sv[1][4 * q + 1]) & 0x7Fu) << 8) | ((__float_as_uint(sv[1][4 * q + 2]) & 0x7Fu) << 16) | ((__float_as_uint(sv[1][4 * q + 3]) & 0x7Fu) << 24);
            }
            *(uint4*)mytab = t0; *(uint4*)(mytab + 16) = t1;
        }
        float top[16], b1[16], b2[16], b3[16];
#pragma unroll
        for (int k = 0; k < 16; ++k) { b1[k] = -INFINITY; b2[k] = -INFINITY; b3[k] = -INFINITY; }
        {
            int cnt = 0;
#pragma unroll
            for (int i = 0; i < 16; ++i)
#pragma unroll
                for (int j = 0; j < 16; ++j)
                    if ((i + 1) * (j + 1) <= 16) {
                        const float sm = __uint_as_float(__float_as_uint(sv[0][i]) & ~0x7Fu) + __uint_as_float(__float_as_uint(sv[1][j]) & ~0x7Fu);
                        const float pk = __uint_as_float((__float_as_uint(sm) & ~0xFFu) | (unsigned)(i * 16 + j));
                        if (i == 0) top[j] = pk;
                        else { if (cnt < 16) b1[cnt] = pk; else if (cnt < 32) b2[cnt - 16] = pk; else b3[cnt - 32] = pk; ++cnt; }
                    }
        }
        sort16_desc(b1); sort16_desc(b2);
        { const float hi = fmaxf(b3[0], b3[1]), lo = fminf(b3[0], b3[1]); b3[0] = hi; b3[1] = lo; }
        merge_top16(top, b1); merge_top16(b2, b3); merge_top16(top, b2);
        float ev[16]; float den = 0.f;
        const float mx = __uint_as_float(__float_as_uint(top[0]) & ~0xFFu);
#pragma unroll
        for (int k = 0; k < 16; ++k) { ev[k] = __expf(__uint_as_float(__float_as_uint(top[k]) & ~0xFFu) - mx); den += ev[k]; }
        const float rden = 1.f / den;
        unsigned ex[16]; unsigned c_lo = 0, c_hi = 0;
#pragma unroll
        for (int k = 0; k < 16; ++k) {
            const unsigned code = __float_as_uint(top[k]) & 0xFFu;
            ex[k] = (unsigned)mytab[code >> 4] * 128u + (unsigned)mytab[16 + (code & 15u)];
        }
        unsigned rk[16];
#pragma unroll
        for (int k = 0; k < 16; ++k) {
            const unsigned pt = ex[k] >> 11; const unsigned sh = 8u * (pt & 3u); const bool islo = pt < 4u;
            rk[k] = ((islo ? c_lo : c_hi) >> sh) & 0xFFu;
            c_lo += islo ? (1u << sh) : 0u; c_hi += islo ? 0u : (1u << sh);
        }
        if (hh == 0) { Hs[(r * 8 + h) * 2] = c_lo; Hs[(r * 8 + h) * 2 + 1] = c_hi; }
        __syncthreads();
        unsigned tot_lo = 0, tot_hi = 0, bef_lo = 0, bef_hi = 0;
#pragma unroll
        for (int hq = 0; hq < 8; ++hq) {
            const unsigned a = Hs[(r * 8 + hq) * 2], b = Hs[(r * 8 + hq) * 2 + 1];
            tot_lo += a; tot_hi += b;
            if (hq < h) { bef_lo += a; bef_hi += b; }
        }
        unsigned offp[9]; offp[0] = 0;
#pragma unroll
        for (int pt = 0; pt < 8; ++pt) offp[pt + 1] = offp[pt] + (((pt < 4 ? tot_lo : tot_hi) >> (8 * (pt & 3))) & 0xFFu);
        if (h == 0 && hh == 0) {
            uint4 ob; ob.x = offp[0] | (offp[1] << 8) | (offp[2] << 16) | (offp[3] << 24); ob.y = offp[4] | (offp[5] << 8) | (offp[6] << 16) | (offp[7] << 24); ob.z = offp[8]; ob.w = 0;
            ((uint4*)(P.ws + OFF_OFFS))[tok] = ob;
        }
        const unsigned base_lo = (offp[0] | (offp[1] << 8) | (offp[2] << 16) | (offp[3] << 24)) + bef_lo;
        const unsigned base_hi = (offp[4] | (offp[5] << 8) | (offp[6] << 16) | (offp[7] << 24)) + bef_hi;
#pragma unroll
        for (int k = 0; k < 16; ++k) {
            if ((k >> 3) == hh) {
                const unsigned pt = ex[k] >> 11; const unsigned sh = 8u * (pt & 3u);
                const unsigned pos = (((pt < 4u ? base_lo : base_hi) >> sh) & 0xFFu) + rk[k];
                pe[(size_t)tok * 128 + pos] = (u16)ex[k];
                pg[(size_t)tok * 128 + pos] = ev[k] * rden;
                ((float*)(P.ws + OFF_PSU))[(size_t)tok * 128 + pos] = ((const float*)(P.ws + OFF_USCALE))[layer * 16384 + ex[k]];
                ((float*)(P.ws + OFF_PSV))[(size_t)tok * 128 + pos] = ((const float*)(P.ws + OFF_V8SC))[layer * 16384 + ex[k]];
            }
        }
        __syncthreads();
    }
}

DI void fp8x16_to_f32(const uint4& u, float (&f)[16]) {
    const unsigned uu[4] = {u.x, u.y, u.z, u.w};
#pragma unroll
    for (int q = 0; q < 4; ++q) {
        const f32x2 lo = __builtin_amdgcn_cvt_pk_f32_fp8((int)uu[q], false), hi = __builtin_amdgcn_cvt_pk_f32_fp8((int)uu[q], true);
        f[4 * q] = lo[0]; f[4 * q + 1] = lo[1]; f[4 * q + 2] = hi[0]; f[4 * q + 3] = hi[1];
    }
}
template <int CTRL> DI int dpp_i(int v) { return __builtin_amdgcn_update_dpp(0, v, CTRL, 0xF, 0xF, true); }
template <int CTRL> DI float dpp_f(float v) { return __int_as_float(__builtin_amdgcn_update_dpp(0, __float_as_int(v), CTRL, 0xF, 0xF, true)); }
DI float wave_sum_fast(float v) {
    v += dpp_f<0xB1>(v); v += dpp_f<0x4E>(v); v += dpp_f<0x124>(v); v += dpp_f<0x128>(v);
    v += __shfl_xor(v, 16); v += __shfl_xor(v, 32); return v;
}
DI int rowreduce4(int p0, int p1, int p2, int p3, bool odd, bool bit1) {
    const int a01 = odd ? p1 : p0, b01 = odd ? p0 : p1;
    const int r01 = a01 + dpp_i<0xB1>(b01);
    const int a23 = odd ? p3 : p2, b23 = odd ? p2 : p3;
    const int r23 = a23 + dpp_i<0xB1>(b23);
    const int a = bit1 ? r23 : r01, b = bit1 ? r01 : r23;
    int r = a + dpp_i<0x4E>(b);
    r += dpp_i<0x124>(r);
    r += dpp_i<0x128>(r);
    return r;
}
DI int dot16_i8(const uint4& u, const int (&xq)[4]) {
    int p = __builtin_amdgcn_sdot4((int)u.x, xq[0], 0, false);
    p = __builtin_amdgcn_sdot4((int)u.y, xq[1], p, false);
    p = __builtin_amdgcn_sdot4((int)u.z, xq[2], p, false);
    p = __builtin_amdgcn_sdot4((int)u.w, xq[3], p, false);
    return p;
}
#define PEER_LOAD8(buf_, tab_, ev_, base_) do { _Pragma("unroll") for (int i_ = 0; i_ < 8; ++i_) { \
        const int e_ = __builtin_amdgcn_readlane((ev_), (base_) + i_); buf_[i_] = *(const uint4*)((tab_) + (size_t)e_ * 1024 + lane * 16); } } while (0)

#define RL(v_, i_) __builtin_amdgcn_readlane((int)(v_), (i_))
#define PEER_OFFS(p_, j_, BASE_, N_) do { \
        const unsigned ox_ = (unsigned)RL(myoff.x, j_), oy_ = (unsigned)RL(myoff.y, j_), oz_ = (unsigned)RL(myoff.z, j_); \
        const int p0_ = (p_), p1_ = (p_) + 1; \
        const unsigned lo_ = p0_ < 4 ? (ox_ >> (8 * p0_)) & 255u : (oy_ >> (8 * (p0_ - 4))) & 255u; \
        const unsigned hi_ = p1_ < 4 ? (ox_ >> (8 * p1_)) & 255u : p1_ < 8 ? (oy_ >> (8 * (p1_ - 4))) & 255u : (oz_ & 255u); \
        BASE_ = (int)lo_; N_ = (int)(hi_ - lo_); } while (0)
typedef __attribute__((ext_vector_type(4))) unsigned u32x4_t;
typedef __attribute__((ext_vector_type(2))) unsigned u32x2_t;
#define PEER_ROWS8B(buf_, rs_, ev_, b_) do { _Pragma("unroll") for (int k_ = 0; k_ < 8; ++k_) { \
        int li_ = 8 * (b_) + k_; li_ = li_ > 63 ? 63 : li_; const int eo_ = RL(ev_, li_); \
        buf_[k_] = __builtin_bit_cast(uint4, __builtin_amdgcn_raw_buffer_load_b128(rs_, lane * 16, eo_, 0)); } } while (0)
#define PEER_ROWS8(buf_, tab_, ev_, b_) do { _Pragma("unroll") for (int k_ = 0; k_ < 8; ++k_) { \
        int li_ = 8 * (b_) + k_; li_ = li_ > 63 ? 63 : li_; const int e_ = RL(ev_, li_); buf_[k_] = *(const uint4*)((tab_) + (size_t)e_ * 1024 + lane * 16); } } while (0)

struct PeerMeta { int e; float g, su, sx, sv; int slot; int idx; int valid; };
DI void phase_peer_u(const Params& P, int layer, char* lds) {
    const int w = threadIdx.x >> 6, lane = threadIdx.x & 63;
    const uint8_t* UT = (const uint8_t*)(P.ws + OFF_UTAB) + (size_t)layer * 16384 * 1024;
    const __amdgpu_buffer_rsrc_t urs = __builtin_amdgcn_make_buffer_rsrc((void*)UT, 0, 16384 * 1024, 0x00020000);
    const u16* pe = (const u16*)(P.ws + OFF_PICKE); const float* pg = (const float*)(P.ws + OFF_PICKG); const float* psu = (const float*)(P.ws + OFF_PSU); const float* psv = (const float*)(P.ws + OFF_PSV);
    float* coefb = (float*)(P.ws + OFF_COEF);
    const uint4* XQ4 = (const uint4*)(P.ws + OFF_XQ); const float* SXp = (const float*)(P.ws + OFF_SX);
    const int stride = gridDim.x * 8, t_first = blockIdx.x * 8 + w;
    const int ntok = t_first < NT ? (NT - t_first + stride - 1) / stride : 0;
    uint4* xql = (uint4*)(lds + w * 16384);
#pragma unroll 1
    for (int jg = 0; jg < ntok; jg += 16) {
        const int ng = (ntok - jg) < 16 ? (ntok - jg) : 16;
        for (int j = 0; j < ng; ++j) xql[j * 64 + lane] = XQ4[(size_t)(t_first + (jg + j) * stride) * 64 + lane];
        uint4 myoff = make_uint4(0, 0, 0, 0); float sxv = 0.f;
        if (lane < ng) { const int t = t_first + (jg + lane) * stride; myoff = ((const uint4*)(P.ws + OFF_OFFS))[t]; sxv = SXp[t]; }
#pragma unroll 1
        for (int p = 0; p < 8; ++p) {
            int nj, basej;
            {
                const unsigned lo = p < 4 ? (myoff.x >> (8 * p)) & 255u : (myoff.y >> (8 * (p - 4))) & 255u;
                const int p1 = p + 1;
                const unsigned hi = p1 < 4 ? (myoff.x >> (8 * p1)) & 255u : p1 < 8 ? (myoff.y >> (8 * (p1 - 4))) & 255u : (myoff.z & 255u);
                basej = (int)lo; nj = lane < ng ? (int)(hi - lo) : 0;
            }
            int pend = nj;
#pragma unroll
            for (int o = 1; o < 16; o <<= 1) { const int tt = __shfl_up(pend, o); if (lane >= o) pend += tt; }
            const int pref = pend - nj;
            const int L = RL(pend, 15);
            if (L == 0) continue;
            const int nsb = (L + 63) >> 6;
#define U_META(sb_, M_) do { \
                const int f_ = 64 * (sb_) + 4 * (lane & 15) + (lane >> 4);        \
                M_.valid = f_ < L; const int fc_ = M_.valid ? f_ : L - 1; \
                int j_ = 0; \
                _Pragma("unroll") for (int jj_ = 0; jj_ < 15; ++jj_) j_ += (jj_ < ng - 1 && fc_ >= RL(pend, jj_)) ? 1 : 0; \
                const int pj_ = __shfl(pref, j_), bj_ = __shfl(basej, j_); \
                M_.slot = j_; M_.idx = (t_first + (jg + j_) * stride) * 128 + bj_ + (fc_ - pj_); \
                M_.e = (int)(((unsigned)pe[M_.idx] << 10) | ((unsigned)j_ << 28)); M_.g = pg[M_.idx]; M_.su = psu[M_.idx]; M_.sv = psv[M_.idx]; M_.sx = __shfl(sxv, j_); } while (0)
#define U_LOADB(buf_, M_, b_) do { _Pragma("unroll") for (int h_ = 0; h_ < 2; ++h_) { \
                const int pk_ = __builtin_amdgcn_ds_bpermute(((lane & 48) + 2 * (b_) + h_) << 2, M_.e); \
                const int vo_ = (pk_ & 0x0FFFFFFF) + (lane & 15) * 16; \
                _Pragma("unroll") for (int c_ = 0; c_ < 4; ++c_) buf_[4 * h_ + c_] = __builtin_bit_cast(uint4, __builtin_amdgcn_raw_buffer_load_b128(urs, vo_ + 256 * c_, 0, 0)); } } while (0)
            PeerMeta cur, nxt;
            U_META(0, cur);
            uint4 bufA[8], bufB[8], bufC[8], bufD[8];
            U_LOADB(bufA, cur, 0); U_LOADB(bufB, cur, 1); U_LOADB(bufC, cur, 2);
            int xslot = -1; uint4 xc0 = make_uint4(0, 0, 0, 0), xc1 = xc0, xc2 = xc0, xc3 = xc0;
#pragma unroll 1
            for (int sb = 0; sb < nsb; ++sb) {
                const bool has_next = sb + 1 < nsb;
                if (has_next) U_META(sb + 1, nxt); else nxt = cur;
                int md = 0;
#define U_DOT4(acc_, r_, x_) do { acc_ = __builtin_amdgcn_sdot4((int)(r_).x, (int)(x_).x, acc_, false); acc_ = __builtin_amdgcn_sdot4((int)(r_).y, (int)(x_).y, acc_, false); \
                    acc_ = __builtin_amdgcn_sdot4((int)(r_).z, (int)(x_).z, acc_, false); acc_ = __builtin_amdgcn_sdot4((int)(r_).w, (int)(x_).w, acc_, false); } while (0)
#define U_STEP(k_, cur_, pf_) do { \
                    if ((k_) + 3 < 8) { U_LOADB(pf_, cur, (k_) + 3); } else if (has_next) { U_LOADB(pf_, nxt, (k_) + 3 - 8); } \
                    asm volatile("" ::: "memory"); __builtin_amdgcn_sched_barrier(0); \
                    _Pragma("unroll") for (int h_ = 0; h_ < 2; ++h_) { \
                        const int q_ = 2 * (k_) + h_; \
                        const int pk_ = __builtin_amdgcn_ds_bpermute(((lane & 48) + q_) << 2, cur.e); \
                        const int sl_ = (int)((unsigned)pk_ >> 28); \
                        if (__builtin_amdgcn_ballot_w64(sl_ != xslot) != 0ull) {        \
                            const uint4* xp_ = xql + sl_ * 64 + (lane & 15); \
                            xc0 = xp_[0]; xc1 = xp_[16]; xc2 = xp_[32]; xc3 = xp_[48]; xslot = sl_; } \
                        int a0_ = 0, a1_ = 0; \
                        U_DOT4(a0_, cur_[4 * h_ + 0], xc0); U_DOT4(a1_, cur_[4 * h_ + 1], xc1); U_DOT4(a0_, cur_[4 * h_ + 2], xc2); U_DOT4(a1_, cur_[4 * h_ + 3], xc3); \
                        int r_ = a0_ + a1_; \
                        r_ += dpp_i<0xB1>(r_); r_ += dpp_i<0x4E>(r_); r_ += dpp_i<0x124>(r_); r_ += dpp_i<0x128>(r_); \
                        md = ((lane & 15) == q_) ? r_ : md; } \
                    asm volatile("" ::: "memory"); __builtin_amdgcn_sched_barrier(0); } while (0)
                U_STEP(0, bufA, bufD); U_STEP(1, bufB, bufA); U_STEP(2, bufC, bufB); U_STEP(3, bufD, bufC);
                U_STEP(4, bufA, bufD); U_STEP(5, bufB, bufA); U_STEP(6, bufC, bufB); U_STEP(7, bufD, bufC);
#undef U_STEP
#undef U_DOT4
                const float dot = (float)md * cur.su * cur.sx;
                const float coef = cur.g * gelu_tanh(dot) * cur.sv;
                if (cur.valid) coefb[cur.idx] = coef;
                cur = nxt;
            }
#undef U_LOADB
#undef U_META
        }
    }
}

DI void peer_token_epilogue(const Params& P, int layer, int t, int lane, const f32x2 (&y2)[8], const float* hin, float* hout, bool last, const float* wab_lds) {
    u16* abuf = (u16*)(P.ws + OFF_ABUF);
    float4 v[4];
    const float4* h4 = (const float4*)(hin + (size_t)t * DM + lane * 16);
#pragma unroll
    for (int i = 0; i < 4; ++i) { v[i] = h4[i]; v[i].x += y2[2 * i][0]; v[i].y += y2[2 * i][1]; v[i].z += y2[2 * i + 1][0]; v[i].w += y2[2 * i + 1][1]; }
    float ss = 0.f;
#pragma unroll
    for (int i = 0; i < 4; ++i) ss += v[i].x * v[i].x + v[i].y * v[i].y + v[i].z * v[i].z + v[i].w * v[i].w;
    ss = wave_sum_fast(ss);
    const float rstd = rsqrtf(ss * (1.f / DM) + 1e-6f);
    if (last) {
        const float4* g4 = (const float4*)(P.in[28]) + lane * 4;
        float4* o4 = (float4*)(hout + (size_t)t * DM + lane * 16);
#pragma unroll
        for (int i = 0; i < 4; ++i) { const float4 g = g4[i]; o4[i] = make_float4(v[i].x * rstd * g.x, v[i].y * rstd * g.y, v[i].z * rstd * g.z, v[i].w * rstd * g.w); }
    } else {
        float4* o4 = (float4*)(hout + (size_t)t * DM + lane * 16);
#pragma unroll
        for (int i = 0; i < 4; ++i) o4[i] = v[i];
        const float4* g4 = (const float4*)(P.in[1] + (layer + 1) * DM) + lane * 4;
        float vn[16];
#pragma unroll
        for (int i = 0; i < 4; ++i) { const float4 g = g4[i]; vn[4 * i] = v[i].x * rstd * g.x; vn[4 * i + 1] = v[i].y * rstd * g.y; vn[4 * i + 2] = v[i].z * rstd * g.z; vn[4 * i + 3] = v[i].w * rstd * g.w; }
        uint4 o0, o1;
        o0.x = pack2(vn[0], vn[1]); o0.y = pack2(vn[2], vn[3]); o0.z = pack2(vn[4], vn[5]); o0.w = pack2(vn[6], vn[7]);
        o1.x = pack2(vn[8], vn[9]); o1.y = pack2(vn[10], vn[11]); o1.z = pack2(vn[12], vn[13]); o1.w = pack2(vn[14], vn[15]);
        *(uint4*)(abuf + (size_t)t * DM + lane * 16) = o0; *(uint4*)(abuf + (size_t)t * DM + lane * 16 + 8) = o1;
        const float4* wab = (const float4*)wab_lds;
        float myacc = 0.f;
#pragma unroll 1
        for (int j = 0; j < 8; ++j) {
            float a = 0.f;
#pragma unroll
            for (int i = 0; i < 4; ++i) { const float4 ww = wab[j * 256 + lane * 4 + i]; a += vn[4 * i] * ww.x + vn[4 * i + 1] * ww.y + vn[4 * i + 2] * ww.z + vn[4 * i + 3] * ww.w; }
            a = wave_sum_fast(a);
            myacc = (lane == j) ? a : myacc;
        }
        const float bb = __shfl(myacc, (lane + 4) & 63);
        if (lane < 4) {
            const int L1 = layer + 1;
            const float a = myacc;
            const float xx = a + P.in[5][L1 * 4 + lane];
            const float sp = xx > 20.f ? xx : log1pf(__expf(xx));
            ((float*)(P.ws + OFF_GG))[t * 4 + lane] = -__expf(P.in[4][L1 * 4 + lane]) * sp;
            ((float*)(P.ws + OFF_BETA))[t * 4 + lane] = sigmoidf_(bb);
        }
    }
}

#ifndef V4_THR
#define V4_THR 0.25f
#endif
DI int peer_v_compact(int& e, float& c, bool small, int lane) {
    unsigned long long m = __builtin_amdgcn_ballot_w64(small);
    const unsigned long long lt = (1ull << lane) - 1ull;
    const int n8 = 64 - __popcll(m), n8r = (n8 + 7) & ~7;
    const int rank4 = __popcll(m & lt);
    if (small && rank4 < n8r - n8) small = false;
    m = __builtin_amdgcn_ballot_w64(small);
    const int pos = small ? n8r + __popcll(m & lt) : __popcll(~m & lt);
    e = __builtin_amdgcn_ds_permute(pos * 4, e);
    c = __int_as_float(__builtin_amdgcn_ds_permute(pos * 4, __float_as_int(c)));
    return n8r;
}
DI float wave_max(float v) {
    v = fmaxf(v, dpp_f<0xB1>(v)); v = fmaxf(v, dpp_f<0x4E>(v)); v = fmaxf(v, dpp_f<0x124>(v)); v = fmaxf(v, dpp_f<0x128>(v));
    v = fmaxf(v, __shfl_xor(v, 16)); v = fmaxf(v, __shfl_xor(v, 32)); return v;
}
#define VDOT_PAIR1(Y_, j_, a_, b_, sl_, sh_) do { \
        const int p01_ = (int)__builtin_amdgcn_perm((unsigned)(b_), (unsigned)(a_), 0x05010400u), p23_ = (int)__builtin_amdgcn_perm((unsigned)(b_), (unsigned)(a_), 0x07030602u); \
        Y_[4 * (j_)] = __builtin_amdgcn_sdot4(p01_, sl_, Y_[4 * (j_)], false); Y_[4 * (j_) + 1] = __builtin_amdgcn_sdot4(p01_, sh_, Y_[4 * (j_) + 1], false); \
        Y_[4 * (j_) + 2] = __builtin_amdgcn_sdot4(p23_, sl_, Y_[4 * (j_) + 2], false); Y_[4 * (j_) + 3] = __builtin_amdgcn_sdot4(p23_, sh_, Y_[4 * (j_) + 3], false); } while (0)
#define VDOT_PAIR(Y_, a0_, a1_, a2_, a3_, b0_, b1_, b2_, b3_, sl_, sh_) do { \
        VDOT_PAIR1(Y_, 0, a0_, b0_, sl_, sh_); VDOT_PAIR1(Y_, 1, a1_, b1_, sl_, sh_); VDOT_PAIR1(Y_, 2, a2_, b2_, sl_, sh_); VDOT_PAIR1(Y_, 3, a3_, b3_, sl_, sh_); } while (0)
struct VMeta { int e0, e1, cq0, cq1, nb0, nb1, zs; float f8, f4; };
DI VMeta peer_v_meta(int e0, int e1, float c0, float c1, int lane) {
    VMeta M;
    const float am = wave_max(fmaxf(fabsf(c0), fabsf(c1)));
    M.nb0 = peer_v_compact(e0, c0, fabsf(c0) < V4_THR * am, lane);
    M.nb1 = peer_v_compact(e1, c1, fabsf(c1) < V4_THR * am, lane);
    const bool q0 = lane >= M.nb0, q1 = lane >= M.nb1;
    if (q0) c0 *= (127.f / 7.f);
    if (q1) c1 *= (127.f / 7.f);
    const float m8 = wave_max(fmaxf(q0 ? 0.f : fabsf(c0), q1 ? 0.f : fabsf(c1)));
    const float m4 = wave_max(fmaxf(q0 ? fabsf(c0) : 0.f, q1 ? fabsf(c1) : 0.f));
    const float r8 = m8 > 0.f ? 127.f / m8 : 0.f, r4 = m4 > 0.f ? 127.f / m4 : 0.f;
    M.cq0 = (int)rintf(c0 * (q0 ? r4 : r8)); M.cq1 = (int)rintf(c1 * (q1 ? r4 : r8));
    int zs = (q0 ? M.cq0 : 0) + (q1 ? M.cq1 : 0);
    for (int o = 32; o > 0; o >>= 1) zs += __shfl_xor(zs, o);
    M.zs = zs; M.e0 = e0; M.e1 = e1; M.f8 = m8 * (1.f / 127.f); M.f4 = m4 * (1.f / 127.f);
    return M;
}
DI void phase_peer_v(const Params& P, int layer, const float* hin, float* hout, bool last, char* lds) {
    const int w = threadIdx.x >> 6, lane = threadIdx.x & 63;
    if (!last) { const float4* src = (const float4*)(P.ws + OFF_WAB) + (layer + 1) * 8 * 256; for (int i = threadIdx.x; i < 2048; i += NTHR) ((float4*)lds)[i] = src[i]; }
    __syncthreads();
    const uint8_t* VTb = (const uint8_t*)(P.ws + OFF_VTAB) + (size_t)layer * 16384 * 1024;
    const uint8_t* V4b = (const uint8_t*)(P.ws + OFF_V4TAB) + (size_t)layer * 16384 * 512;
    const __amdgpu_buffer_rsrc_t v8rs = __builtin_amdgcn_make_buffer_rsrc((void*)VTb, 0, 16384 * 1024, 0x00020000);
    const __amdgpu_buffer_rsrc_t v4rs = __builtin_amdgcn_make_buffer_rsrc((void*)V4b, 0, 16384 * 512, 0x00020000);
    const u16* pe = (const u16*)(P.ws + OFF_PICKE); const float* coefb = (const float*)(P.ws + OFF_COEF);
    const int stride = gridDim.x * 8;
    int t = blockIdx.x * 8 + w;
    if (t >= NT) return;
    uint4 bufA[8], bufB[8], bufC[8], bufD[8];
#define V_IS4(M_, k_) (8 * ((k_) & 7) >= (((k_) >> 3) ? M_.nb1 : M_.nb0))
#define V_LOAD(buf_, M_, k_) do { \
        if (V_IS4(M_, k_)) { _Pragma("unroll") for (int i_ = 0; i_ < 8; ++i_) { const int e_ = RL(((k_) >> 3) ? M_.e1 : M_.e0, 8 * ((k_) & 7) + i_); \
                const uint2 t_ = *(const uint2*)(V4b + (size_t)e_ * 512 + lane * 8); buf_[i_].x = t_.x; buf_[i_].y = t_.y; } } \
        else { _Pragma("unroll") for (int i_ = 0; i_ < 8; ++i_) { const int e_ = RL(((k_) >> 3) ? M_.e1 : M_.e0, 8 * ((k_) & 7) + i_); \
                buf_[i_] = *(const uint4*)(VTb + (size_t)e_ * 1024 + lane * 16); } } } while (0)
    VMeta cur = peer_v_meta(pe[(size_t)t * 128 + lane], pe[(size_t)t * 128 + 64 + lane], coefb[(size_t)t * 128 + lane], coefb[(size_t)t * 128 + 64 + lane], lane);
    V_LOAD(bufA, cur, 0); V_LOAD(bufB, cur, 1); V_LOAD(bufC, cur, 2);
#pragma unroll 1
    for (; t < NT; t += stride) {
        const int tn = t + stride; const bool has_next = tn < NT;
        int ne0 = 0, ne1 = 0; float nc0 = 0.f, nc1 = 0.f;
        if (has_next) { ne0 = pe[(size_t)tn * 128 + lane]; ne1 = pe[(size_t)tn * 128 + 64 + lane]; nc0 = coefb[(size_t)tn * 128 + lane]; nc1 = coefb[(size_t)tn * 128 + 64 + lane]; }
        int y8[16], y4[16];
#pragma unroll
        for (int i = 0; i < 16; ++i) { y8[i] = 0; y4[i] = 0; }
#define V_STEP(k_, cur_, pf_) do { \
            if ((k_) + 3 < 16) { V_LOAD(pf_, cur, (k_) + 3); } \
            asm volatile("" ::: "memory"); __builtin_amdgcn_sched_barrier(0); \
            if (V_IS4(cur, k_)) { \
                _Pragma("unroll") for (int i = 0; i < 8; i += 2) { \
                    const int ca_ = RL(((k_) >> 3) ? cur.cq1 : cur.cq0, 8 * ((k_) & 7) + i) & 0xFF, cb_ = RL(((k_) >> 3) ? cur.cq1 : cur.cq0, 8 * ((k_) & 7) + i + 1) & 0xFF; \
                    const int sl_ = ca_ | (cb_ << 8), sh_ = sl_ << 16; \
                    const unsigned xa0 = cur_[i].x, xa1 = cur_[i].y, xb0 = cur_[i + 1].x, xb1 = cur_[i + 1].y; \
                    VDOT_PAIR(y4, xa0 & 0x0F0F0F0Fu, (xa0 >> 4) & 0x0F0F0F0Fu, xa1 & 0x0F0F0F0Fu, (xa1 >> 4) & 0x0F0F0F0Fu, \
                              xb0 & 0x0F0F0F0Fu, (xb0 >> 4) & 0x0F0F0F0Fu, xb1 & 0x0F0F0F0Fu, (xb1 >> 4) & 0x0F0F0F0Fu, sl_, sh_); } \
            } else { \
                _Pragma("unroll") for (int i = 0; i < 8; i += 2) { \
                    const int ca_ = RL(((k_) >> 3) ? cur.cq1 : cur.cq0, 8 * ((k_) & 7) + i) & 0xFF, cb_ = RL(((k_) >> 3) ? cur.cq1 : cur.cq0, 8 * ((k_) & 7) + i + 1) & 0xFF; \
                    const int sl_ = ca_ | (cb_ << 8), sh_ = sl_ << 16; \
                    VDOT_PAIR(y8, cur_[i].x, cur_[i].y, cur_[i].z, cur_[i].w, cur_[i + 1].x, cur_[i + 1].y, cur_[i + 1].z, cur_[i + 1].w, sl_, sh_); } } \
            asm volatile("" ::: "memory"); __builtin_amdgcn_sched_barrier(0); } while (0)
        V_STEP(0, bufA, bufD); V_STEP(1, bufB, bufA); V_STEP(2, bufC, bufB); V_STEP(3, bufD, bufC);
        V_STEP(4, bufA, bufD); V_STEP(5, bufB, bufA); V_STEP(6, bufC, bufB); V_STEP(7, bufD, bufC);
        V_STEP(8, bufA, bufD); V_STEP(9, bufB, bufA); V_STEP(10, bufC, bufB); V_STEP(11, bufD, bufC);
        V_STEP(12, bufA, bufD); V_STEP(13, bufB, bufA); V_STEP(14, bufC, bufB); V_STEP(15, bufD, bufC);
#undef V_STEP
        f32x2 y2[8];
#pragma unroll
        for (int i = 0; i < 8; ++i) y2[i] = (f32x2){(float)y8[2 * i] * cur.f8 + (float)(y4[2 * i] - 8 * cur.zs) * cur.f4, (float)y8[2 * i + 1] * cur.f8 + (float)(y4[2 * i + 1] - 8 * cur.zs) * cur.f4};
        if (has_next) {
            cur = peer_v_meta(ne0, ne1, nc0, nc1, lane);
            V_LOAD(bufA, cur, 0); V_LOAD(bufB, cur, 1); V_LOAD(bufC, cur, 2);
        }
        asm volatile("" ::: "memory"); __builtin_amdgcn_sched_barrier(0);
        peer_token_epilogue(P, layer, t, lane, y2, hin, hout, last, (const float*)lds);
    }
#undef V_LOAD
#undef V_IS4
}

#define XB_TMO      128
#define XB_XCNT(j)  (256  + 64 * (j))
#define XB_XSUB(j)  (1280 + 64 * (j))
#define XB_XGEN(j)  (2304 + 64 * (j))
#define XB_TOP      3328
#define XB_TOPGEN   3392
#define XCD_BAR_WORDS 3456
#define XB_SPIN_CAP (1u << 22)
#define LAS __attribute__((address_space(3)))
DI unsigned xb_ld(unsigned* p)              { return __hip_atomic_load(p, __ATOMIC_RELAXED, __HIP_MEMORY_SCOPE_AGENT); }
DI unsigned xb_add(unsigned* p, unsigned v) { return __hip_atomic_fetch_add(p, v, __ATOMIC_RELAXED, __HIP_MEMORY_SCOPE_AGENT); }
DI unsigned xb_xcc_id() { return (unsigned)__builtin_amdgcn_s_getreg((3 << 11) | 20) & 0xFu; }
#define XB_SPIN(cond, bar) do { unsigned _sp = 0; while (cond) { __builtin_amdgcn_s_sleep(1); \
    if ((++_sp & 255u) == 0u) { if (xb_ld(&(bar)[XB_TMO])) break; if (_sp > XB_SPIN_CAP) { atomicAdd(&(bar)[XB_TMO], 1u); break; } } } } while (0)
struct XcdBarrier { unsigned* bar; unsigned x; volatile LAS unsigned* st; };
DI XcdBarrier xcd_barrier_post(unsigned* bar, volatile LAS unsigned* st) {
    XcdBarrier b; b.bar = bar; b.x = xb_xcc_id(); b.st = st;
    if (threadIdx.x == 0) (void)xb_add(&bar[XB_XCNT(b.x)], 1u);
    return b;
}
DI void xcd_barrier_complete(unsigned* bar, unsigned x, unsigned& nloc, unsigned& nx) {
    const unsigned G = gridDim.x * gridDim.y * gridDim.z;
    unsigned sum, cnt, mine, sp = 0u;
    for (;;) {
        sum = 0u; cnt = 0u; mine = 0u;
#pragma unroll
        for (unsigned j = 0; j < 16; ++j) { const unsigned c = xb_ld(&bar[XB_XCNT(j)]); sum += c; cnt += (c > 0u) ? 1u : 0u; mine = (j == x) ? c : mine; }
        if (sum == G) break;
        __builtin_amdgcn_s_sleep(1);
        if ((++sp & 255u) == 0u) { if (xb_ld(&bar[XB_TMO])) break; if (sp > XB_SPIN_CAP) { atomicAdd(&bar[XB_TMO], 1u); break; } }
    }
    nloc = mine > 0u ? mine : 1u; nx = cnt > 0u ? cnt : 1u;
}
DI void xcd_barrier(const XcdBarrier& b) {
    asm volatile("s_waitcnt vmcnt(0)" ::: "memory");
    __syncthreads();
    if (threadIdx.x == 0) {
        unsigned* bar = b.bar;
        __builtin_amdgcn_s_waitcnt(0);
        unsigned nloc = b.st[0], nx = b.st[1];
        if (nloc == 0u) { xcd_barrier_complete(bar, b.x, nloc, nx); b.st[0] = nloc; b.st[1] = nx; }
        const unsigned old = xb_add(&bar[XB_XSUB(b.x)], 1u);
        const unsigned gen = old / nloc;
        if (old + 1u == (gen + 1u) * nloc) {
            __builtin_amdgcn_fence(__ATOMIC_RELEASE, "agent");
            asm volatile("s_waitcnt vmcnt(0)" ::: "memory");
            const unsigned og = xb_add(&bar[XB_TOP], 1u);
            const unsigned tg = og / nx;
            if (og + 1u == (tg + 1u) * nx) xb_add(&bar[XB_TOPGEN], 1u);
            else XB_SPIN(xb_ld(&bar[XB_TOPGEN]) == tg, bar);
            __builtin_amdgcn_fence(__ATOMIC_ACQUIRE, "agent");
            xb_add(&bar[XB_XGEN(b.x)], 1u);
            asm volatile("s_waitcnt vmcnt(0)" ::: "memory");
        } else {
            XB_SPIN(xb_ld(&bar[XB_XGEN(b.x)]) == gen, bar);
            __builtin_amdgcn_fence(__ATOMIC_ACQUIRE, "agent");
            asm volatile("s_waitcnt vmcnt(0)" ::: "memory");
        }
    }
    __syncthreads();
}

constexpr int PH_PER_LAYER = 11;
constexpr int NPHASE = 2 + 2 * PH_PER_LAYER;

#ifdef ONLY_SUB
#define SUB_ON(k) (ONLY_SUB == (k))
#else
#define SUB_ON(k) 1
#endif
DI void run_phase(const Params& P, int ph, char* lds) {
    char* ws = P.ws;
#if SUB_ON(100)
    if (ph == 0) { phase_prep(P, lds); return; }
#endif
#if SUB_ON(101)
    if (ph == 1) { phase_rms(P, P.in[0], P.in[1], (u16*)(ws + OFF_ABUF), 0); return; }
#endif
    if (ph < 2) return;
    const int layer = (ph - 2) / PH_PER_LAYER, sub = (ph - 2) % PH_PER_LAYER;
    const float* hin = layer == 0 ? P.in[0] : P.out;
    switch (sub) {
    #if SUB_ON(0)
    case 0: { EpiInProj8 e{ws}; phase_gemm((const u16*)(ws + OFF_ABUF), 1024, (const u16*)(ws + OFF_WINT) + (size_t)layer * PROJW * 1024, 1024, NT, PROJW, 1024, e, lds); } break;

#endif
    #if SUB_ON(1)
    case 1:
        for (int it = blockIdx.x; it < 2048; it += gridDim.x) gdn_prep_item(P, layer, it, lds);
        phase_s5<false>(P, layer, lds);
        break;

#endif
    #if SUB_ON(2)
    case 2:
        if (blockIdx.x < 16) gdn_scan_chain(P, blockIdx.x, lds);
        else if (blockIdx.x < 24) {
            const int gt = (blockIdx.x - 16) * NTHR + threadIdx.x;
            if (gt < 4096) {
                const int bg = gt >> 6, n = gt & 63;
                const float2 a = ((const float2*)(ws + OFF_S5P + layer * S5P_LAYER + S5P_A64))[(bg & 15) * 64 + n];
                float2* st = (float2*)(ws + OFF_S5ST) + (size_t)bg * 128 * 64 + n;
                float xr = 0.f, xi = 0.f;
                for (int c = 0; c < 128; ++c) {
                    const float2 sv = st[c * 64];
                    st[c * 64] = make_float2(xr, xi);
                    const float nr = a.x * xr - a.y * xi + sv.x, ni = a.x * xi + a.y * xr + sv.y;
                    xr = nr; xi = ni;
                }
            }
        }
        __syncthreads();
        phase_attn(P, layer, lds);
        break;

#endif
    #if SUB_ON(3)
    case 3: phase_s5<true>(P, layer, lds); phase_gdn_norm(P, layer); break;

#endif
    #if SUB_ON(4)
    case 4: {
        EpiGlu8 e{(u16*)(ws + OFF_ABUF), P.in[16] + layer * 512};
        phase_gemm((const u16*)(ws + OFF_YS5), 256, (const u16*)(ws + OFF_GLUT) + (size_t)layer * 512 * 256, 256, NT, 512, 256, e, lds);
    } break;

#endif
    #if SUB_ON(5)
    case 5: { EpiResidual8 e{hin, P.out}; phase_gemm((const u16*)(ws + OFF_ABUF), 1024, (const u16*)(ws + OFF_WOUTT) + (size_t)layer * 1024 * 1024, 1024, NT, 1024, 1024, e, lds); } break;

#endif
    #if SUB_ON(6)
    case 6: phase_rms(P, P.out, P.in[23] + layer * DM, (u16*)(ws + OFF_ABUF), -1, true); break;

#endif
    #if SUB_ON(7)
    case 7: { pg8::EpiBf16<0> e{(u16*)(ws + OFF_PQ), 1024, nullptr, 0, 0}; phase_gemm((const u16*)(ws + OFF_ABUF), 1024, (const u16*)(ws + OFF_WQT) + (size_t)layer * 1024 * 1024, 1024, NT, 1024, 1024, e, lds); } break;

#endif
    #if SUB_ON(8)
    case 8: phase_topk(P, layer, lds); break;

#endif
    #if SUB_ON(9)
    case 9: phase_peer_u(P, layer, lds); break;
#endif
    #if SUB_ON(10)
    case 10: phase_peer_v(P, layer, P.out, P.out, layer == 1, lds); break;
#endif
    }
}

#ifndef USE_CG_SYNC
#define USE_CG_SYNC 0
#endif
#if USE_CG_SYNC
#define GRID_SYNC() cg::this_grid().sync()
#else
#define GRID_SYNC() xcd_barrier(xbar)
#endif
__global__ void __launch_bounds__(NTHR) mk_fwd(Params P, int ph_lo, int ph_hi) {
    extern __shared__ __attribute__((aligned(16))) char lds[];
#if !USE_CG_SYNC
    volatile LAS unsigned* xst = (volatile LAS unsigned*)(lds + LDS_BYTES - 16);
    if (threadIdx.x == 0) { xst[0] = 0u; xst[1] = 0u; }
    __syncthreads();
    XcdBarrier xbar = xcd_barrier_post((unsigned*)(P.ws + OFF_CTL), xst);
#endif
#ifndef DUP_SUB
#define DUP_SUB -1
#endif
#define PH(k) if (ph_lo <= (k) && (k) < ph_hi) { \
        if ((k) >= 2 && (((k) - 2) % PH_PER_LAYER == DUP_SUB || (DUP_SUB == 20 && ((k) - 2) % PH_PER_LAYER == 2))) { \
            if (DUP_SUB == 9) phase_peer_u(P, ((k) - 2) / PH_PER_LAYER, lds); \
            else if (DUP_SUB == 2) { if (blockIdx.x < 16) gdn_scan_chain(P, blockIdx.x, lds); } \
            else if (DUP_SUB == 20 && ((k) - 2) % PH_PER_LAYER == 2) { phase_attn(P, ((k) - 2) / PH_PER_LAYER, lds, 1); } \
            else if (DUP_SUB == 5) { if ((k) < 2 + PH_PER_LAYER) run_phase(P, (k), lds); } \
            else run_phase(P, (k), lds); } \
        if ((k) < 2 && DUP_SUB == 100 + (k)) run_phase(P, (k), lds); \
        run_phase(P, (k), lds); if (DUP_SUB == 99) GRID_SYNC(); if ((k) + 1 < ph_hi) GRID_SYNC(); }
    PH(0) PH(1) PH(2) PH(3) PH(4) PH(5) PH(6) PH(7) PH(8) PH(9) PH(10) PH(11)
    PH(12) PH(13) PH(14) PH(15) PH(16) PH(17) PH(18) PH(19) PH(20) PH(21) PH(22) PH(23)
#undef PH
}

extern "C" void kernel_launch(void* const* d_in, const int* in_sizes, int n_in, void* d_out, int out_size, void* d_ws, size_t ws_size, hipStream_t stream) {
    static int grid = 0;
    if (grid == 0) {
        int dev = 0, cus = 0, per_cu = 0;
        hipGetDevice(&dev);
        hipDeviceGetAttribute(&cus, hipDeviceAttributeMultiprocessorCount, dev);
        hipFuncSetAttribute((const void*)mk_fwd, hipFuncAttributeMaxDynamicSharedMemorySize, LDS_BYTES);
        hipOccupancyMaxActiveBlocksPerMultiprocessor(&per_cu, (const void*)mk_fwd, NTHR, LDS_BYTES);
        if (per_cu < 1) { fprintf(stderr, "occupancy query says %d blocks per CU\n", per_cu); per_cu = 1; }
        grid = cus;
        if (ws_size < OFF_END) { fprintf(stderr, "workspace too small: %zu < %zu\n", ws_size, (size_t)OFF_END); }
    }
    Params p{};
    for (int i = 0; i < 29; ++i) p.in[i] = (const float*)d_in[i];
    p.out = (float*)d_out; p.ws = (char*)d_ws;
#if MK_ONE_LAUNCH
    int lo = 0, hi = NPHASE;
    (void)hipMemsetAsync((char*)d_ws + OFF_CTL, 0, 65536, stream);
#if USE_CG_SYNC
    void* args[] = {&p, &lo, &hi};
    hipError_t e = hipLaunchCooperativeKernel((const void*)mk_fwd, dim3(grid), dim3(NTHR), args, LDS_BYTES, stream);
    if (e != hipSuccess) fprintf(stderr, "cooperative launch failed: %s\n", hipGetErrorString(e));
#else
    hipLaunchKernelGGL(mk_fwd, dim3(grid), dim3(NTHR), LDS_BYTES, stream, p, lo, hi);
#endif
#else
    for (int ph = 0; ph < NPHASE; ++ph) hipLaunchKernelGGL(mk_fwd, dim3(grid), dim3(NTHR), LDS_BYTES, stream, p, ph, ph + 1);
#endif
}
```

```cpp
#include <hip/hip_runtime.h>
#include <hip/hip_cooperative_groups.h>
#include <stdint.h>
#include <stdio.h>
namespace cg = cooperative_groups;

#ifndef MK_ONE_LAUNCH
#define MK_ONE_LAUNCH 1
#endif

#define DI __device__ __forceinline__
typedef unsigned short u16;
typedef __attribute__((ext_vector_type(8))) short bf16x8;
typedef __attribute__((ext_vector_type(4))) short bf16x4;
typedef __attribute__((ext_vector_type(16))) float f32x16;
typedef __attribute__((ext_vector_type(4))) float f32x4;
typedef __attribute__((ext_vector_type(2))) float f32x2;

constexpr int NT = 32768, DM = 1024, SEQ = 8192, NBATCH = 4;
constexpr int NTHR = 512;
constexpr int INW = 2824;
constexpr int PROJW = 2816;
constexpr float LOG2E = 1.4426950408889634f;

constexpr size_t OFF_CTL   = 0;
constexpr size_t OFF_WINT  = 65536;
constexpr size_t OFF_WOUTT = OFF_WINT  + (size_t)2 * PROJW * 1024 * 2;
constexpr size_t OFF_WQT   = OFF_WOUTT + (size_t)2 * 1024 * 1024 * 2;
constexpr size_t OFF_GLUT  = OFF_WQT   + (size_t)2 * 1024 * 1024 * 2;
constexpr size_t OFF_KEYS  = OFF_GLUT  + (size_t)2 * 512 * 256 * 2;
constexpr size_t OFF_WAB   = OFF_KEYS  + (size_t)2 * 8 * 2 * 128 * 64 * 2;
constexpr size_t OFF_S5P   = OFF_WAB   + (size_t)2 * 8 * 1024 * 4;
constexpr size_t S5P_LAYER = 262144;
constexpr size_t S5P_ABAR = 0, S5P_A64 = 8192, S5P_BRE = 16384, S5P_BIM = 16384 + 65536, S5P_CM = 16384 + 131072;
constexpr size_t OFF_SCAL  = OFF_S5P   + 2 * S5P_LAYER;
constexpr size_t OFF_UTAB  = OFF_SCAL  + 256;
constexpr size_t OFF_VTAB  = OFF_UTAB  + (size_t)2 * 16384 * 1024;
constexpr size_t OFF_USCALE = OFF_VTAB + (size_t)2 * 16384 * 1024;
constexpr size_t OFF_V4TAB = OFF_USCALE + (size_t)2 * 16384 * 4;
constexpr size_t OFF_V4SC  = OFF_V4TAB + (size_t)2 * 16384 * 512;
constexpr size_t OFF_V8SC  = OFF_V4SC + (size_t)2 * 16384 * 4;
constexpr size_t OFF_ABUF  = OFF_V8SC + (size_t)2 * 16384 * 8;
constexpr size_t OFF_GG    = OFF_ABUF  + (size_t)NT * 1024 * 2;
constexpr size_t OFF_BETA  = OFF_GG    + (size_t)NT * 4 * 4;
constexpr size_t OFF_PROJ  = OFF_BETA  + (size_t)NT * 4 * 4;
constexpr size_t OFF_QKV   = OFF_PROJ;
constexpr size_t OFF_Z     = OFF_QKV   + (size_t)NT * 768 * 2;
constexpr size_t OFF_US    = OFF_Z     + (size_t)NT * 256 * 2;
constexpr size_t OFF_QC    = OFF_US    + (size_t)NT * 256 * 2;
constexpr size_t OFF_KC    = OFF_QC    + (size_t)NT * 512 * 2;
constexpr size_t OFF_VT    = OFF_KC    + (size_t)NT * 512 * 2;
constexpr size_t OFF_GREC  = OFF_VT    + (size_t)NT * 512 * 2;
constexpr size_t GREC_BYTES = 40960;
constexpr size_t OFF_EGL   = OFF_GREC  + (size_t)2048 * GREC_BYTES;
constexpr size_t OFF_S5ST  = OFF_EGL   + 2048 * 4;
constexpr size_t OFF_YS5   = OFF_S5ST  + (size_t)8192 * 64 * 8;
constexpr size_t OFF_END   = OFF_YS5   + (size_t)NT * 256 * 2;
constexpr size_t OFF_GDNO  = OFF_QKV;
constexpr size_t OFF_PQ    = OFF_PROJ;
constexpr size_t OFF_PICKE = OFF_GREC;
constexpr size_t OFF_PICKG = OFF_GREC + (size_t)NT * 128 * 2;
constexpr size_t OFF_COEF  = OFF_PICKG + (size_t)NT * 128 * 4;
constexpr size_t OFF_OFFS  = OFF_COEF + (size_t)NT * 128 * 4;
constexpr size_t OFF_XQ    = OFF_OFFS + (size_t)NT * 16;
constexpr size_t OFF_PSV   = OFF_PROJ + (size_t)NT * 1024 * 2;
constexpr size_t OFF_PSU   = OFF_YS5;
constexpr size_t OFF_SX    = OFF_XQ + (size_t)NT * 1024;
static_assert(OFF_SX + (size_t)NT * 4 <= OFF_GREC + (size_t)2048 * GREC_BYTES, "peer scratch must fit in the dead GDN record region");
static_assert(OFF_END < (size_t)512 * 1024 * 1024, "workspace");

constexpr int LDS_BYTES = 148480 + 16;

struct Params {
    const float* in[29];
    float* out;
    char* ws;
};

DI u16 f2bf(float x) { unsigned u = __float_as_uint(x); u += 0x7fffu + ((u >> 16) & 1u); return (u16)(u >> 16); }
DI float bf2f(u16 v) { return __uint_as_float(((unsigned)v) << 16); }
DI unsigned pack2(float a, float b) { unsigned r; asm("v_cvt_pk_bf16_f32 %0, %1, %2" : "=v"(r) : "v"(a), "v"(b)); return r; }
DI float wave_sum(float v) { for (int o = 32; o > 0; o >>= 1) v += __shfl_xor(v, o); return v; }
DI float gelu_tanh(float x) { float u = 0.7978845608028654f * (x + 0.044715f * x * x * x); float e = __expf(2.f * u); float th = 1.f - 2.f / (e + 1.f); return 0.5f * x * (1.f + th); }
DI float sigmoidf_(float x) { return 1.f / (1.f + __expf(-x)); }
#define MFMA32(a, b, c) __builtin_amdgcn_mfma_f32_32x32x16_bf16((a), (b), (c), 0, 0, 0)
#define MFMA16(a, b, c) __builtin_amdgcn_mfma_f32_16x16x32_bf16((a), (b), (c), 0, 0, 0)
DI bf16x8 ld8(const void* p) { return *(const bf16x8*)p; }
DI bf16x8 cat4(bf16x4 lo, bf16x4 hi) { return __builtin_shufflevector(lo, hi, 0, 1, 2, 3, 4, 5, 6, 7); }
DI bf16x8 pack8(float a0, float a1, float a2, float a3, float a4, float a5, float a6, float a7) {
    uint4 u; u.x = pack2(a0, a1); u.y = pack2(a2, a3); u.z = pack2(a4, a5); u.w = pack2(a6, a7);
    return __builtin_bit_cast(bf16x8, u);
}

template <class CM>
DI void transpose_tile(const float* __restrict__ src, int src_ld, u16* __restrict__ dst, int K, int n0, int k0, CM colmap, float* tl) {
    const int tid = threadIdx.x;
    {
        const int nn = tid & 63;
        const int sc = colmap(n0 + nn);
#pragma unroll
        for (int i = 0; i < 8; ++i) { const int kk = (tid >> 6) + 8 * i; tl[kk * 65 + nn] = src[(size_t)(k0 + kk) * src_ld + sc]; }
    }
    __syncthreads();
    {
        const int kk = tid & 63;
#pragma unroll
        for (int i = 0; i < 8; ++i) { const int nn = (tid >> 6) + 8 * i; dst[(size_t)(n0 + nn) * K + k0 + kk] = f2bf(tl[kk * 65 + nn]); }
    }
    __syncthreads();
}

DI void phase_prep(const Params& P, char* lds) {
    float* tl = (float*)lds;
    char* ws = P.ws;
    const int bid = blockIdx.x, nb = gridDim.x, tid = threadIdx.x;
    for (int j = bid; j < 2496; j += nb) {
        if (j < 1408) {
            const int l = j / 704, r = j % 704, nt = r / 16, kt = r % 16;
            transpose_tile(P.in[2] + (size_t)l * 1024 * INW, INW, (u16*)(ws + OFF_WINT) + (size_t)l * PROJW * 1024, 1024, nt * 64, kt * 64,
                           [](int n) { return n < 1024 ? n : n + 8; }, tl);
        } else if (j < 1920) {
            const int q = j - 1408; const int l = q / 256, r = q % 256, nt = r / 16, kt = r % 16;
            transpose_tile(P.in[22] + (size_t)l * 1024 * 1024, 1024, (u16*)(ws + OFF_WOUTT) + (size_t)l * 1024 * 1024, 1024, nt * 64, kt * 64, [](int n) { return n; }, tl);
        } else if (j < 2432) {
            const int q = j - 1920; const int l = q / 256, r = q % 256, nt = r / 16, kt = r % 16;
            transpose_tile(P.in[24] + (size_t)l * 1024 * 1024, 1024, (u16*)(ws + OFF_WQT) + (size_t)l * 1024 * 1024, 1024, nt * 64, kt * 64, [](int n) { return n; }, tl);
        } else {
            const int q = j - 2432; const int l = q / 32, r = q % 32, nt = r / 4, kt = r % 4;
            transpose_tile(P.in[15] + (size_t)l * 256 * 512, 512, (u16*)(ws + OFF_GLUT) + (size_t)l * 512 * 256, 256, nt * 64, kt * 64,
                           [](int n) { const int tile = n >> 8, wi = n & 255; return wi < 128 ? 128 * tile + wi : 256 + 128 * tile + (wi - 128); }, tl);
        }
    }
    const size_t gtid = (size_t)bid * NTHR + tid, gsz = (size_t)nb * NTHR;
    for (size_t i = gtid; i < (size_t)2 * 8 * 2 * 128 * 64; i += gsz) ((u16*)(ws + OFF_KEYS))[i] = f2bf(P.in[25][i]);
    for (size_t i = gtid; i < (size_t)2 * 8 * 1024; i += gsz) {
        const int l = (int)(i / 8192), j = (int)((i / 1024) % 8), k = (int)(i % 1024);
        ((float*)(ws + OFF_WAB))[i] = P.in[2][(size_t)l * 1024 * INW + (size_t)k * INW + 1024 + j];
    }
    {
        const int wv = tid >> 6, lane = tid & 63;
        for (int row = bid * 8 + wv; row < 2 * 16384; row += nb * 8) {
            const float4* s = (const float4*)(P.in[26] + (size_t)row * 1024) + lane * 4;
            float4 v[4]; float am = 0.f;
#pragma unroll
            for (int q = 0; q < 4; ++q) { v[q] = s[q]; am = fmaxf(am, fmaxf(fmaxf(fabsf(v[q].x), fabsf(v[q].y)), fmaxf(fabsf(v[q].z), fabsf(v[q].w)))); }
            for (int o = 32; o > 0; o >>= 1) am = fmaxf(am, __shfl_xor(am, o));
            const float sc = am > 0.f ? 127.f / am : 0.f;
            uint4 o4; unsigned* op = (unsigned*)&o4;
#pragma unroll
            for (int q = 0; q < 4; ++q) {
                const int a = (int)rintf(v[q].x * sc), b = (int)rintf(v[q].y * sc), c = (int)rintf(v[q].z * sc), d = (int)rintf(v[q].w * sc);
                op[q] = (unsigned)(a & 0xff) | ((unsigned)(b & 0xff) << 8) | ((unsigned)(c & 0xff) << 16) | ((unsigned)(d & 0xff) << 24);
            }
            ((uint4*)(ws + OFF_UTAB))[(size_t)row * 64 + lane] = o4;
            if (lane == 0) ((float*)(ws + OFF_V8SC))[2 * row] = am * (1.f / 127.f);
        }
        for (int row = bid * 8 + wv; row < 2 * 16384; row += nb * 8) {
            const float4* s = (const float4*)(P.in[27] + (size_t)row * 1024) + lane * 4;
            float4 v[4]; float am = 0.f;
#pragma unroll
            for (int q = 0; q < 4; ++q) { v[q] = s[q]; am = fmaxf(am, fmaxf(fmaxf(fabsf(v[q].x), fabsf(v[q].y)), fmaxf(fabsf(v[q].z), fabsf(v[q].w)))); }
            for (int o = 32; o > 0; o >>= 1) am = fmaxf(am, __shfl_xor(am, o));
            const float sc8 = am > 0.f ? 127.f / am : 0.f;
            uint4 o8; unsigned* op = (unsigned*)&o8;
#pragma unroll
            for (int q = 0; q < 4; ++q) {
                const int a = (int)rintf(v[q].x * sc8), b = (int)rintf(v[q].y * sc8), c = (int)rintf(v[q].z * sc8), d = (int)rintf(v[q].w * sc8);
                op[q] = (unsigned)(a & 0xff) | ((unsigned)(b & 0xff) << 8) | ((unsigned)(c & 0xff) << 16) | ((unsigned)(d & 0xff) << 24);
            }
            ((uint4*)(ws + OFF_VTAB))[(size_t)row * 64 + lane] = o8;
            if (lane == 0) ((float*)(ws + OFF_V8SC))[2 * row + 1] = am * (1.f / 127.f);
            const float sc4 = am > 0.f ? 7.f / am : 0.f;
            unsigned d[2];
#pragma unroll
            for (int h2 = 0; h2 < 2; ++h2) {
                const float4 a = v[2 * h2], b = v[2 * h2 + 1];
                const unsigned n0 = (unsigned)((int)rintf(a.x * sc4) + 8), n1 = (unsigned)((int)rintf(a.y * sc4) + 8), n2 = (unsigned)((int)rintf(a.z * sc4) + 8), n3 = (unsigned)((int)rintf(a.w * sc4) + 8);
                const unsigned n4 = (unsigned)((int)rintf(b.x * sc4) + 8), n5 = (unsigned)((int)rintf(b.y * sc4) + 8), n6 = (unsigned)((int)rintf(b.z * sc4) + 8), n7 = (unsigned)((int)rintf(b.w * sc4) + 8);
                d[h2] = n0 | (n4 << 4) | (n1 << 8) | (n5 << 12) | (n2 << 16) | (n6 << 20) | (n3 << 24) | (n7 << 28);
            }
            ((uint2*)(ws + OFF_V4TAB))[(size_t)row * 64 + lane] = make_uint2(d[0], d[1]);
            if (lane == 0) ((float*)(ws + OFF_V4SC))[row] = am * (1.f / 7.f);
        }
    }
    for (size_t i = gtid; i < (size_t)2 * 16 * 64; i += gsz) {
        const int l = (int)(i / 1024), g = (int)((i / 64) % 16), n = (int)(i % 64);
        const float step = __expf(P.in[14][l * 16 + g]);
        const float lr = P.in[7][i], li = P.in[8][i];
        const float er = expf(lr * step); const float ar = er * cosf(li * step), ai = er * sinf(li * step);
        const float e64 = expf(64.f * lr * step); const float a64r = e64 * cosf(64.f * li * step), a64i = e64 * sinf(64.f * li * step);
        char* sp = ws + OFF_S5P + l * S5P_LAYER;
        ((float2*)(sp + S5P_ABAR))[g * 64 + n] = make_float2(ar, ai);
        ((float2*)(sp + S5P_A64))[g * 64 + n] = make_float2(a64r, a64i);
        const float xr = ar - 1.f, xi = ai; const float den = 1.f / (lr * lr + li * li);
        const float cr = (xr * lr + xi * li) * den, ci = (xi * lr - xr * li) * den;
        for (int c = 0; c < 16; ++c) {
            const float br = P.in[9][i * 16 + c], bi = P.in[10][i * 16 + c];
            ((float*)(sp + S5P_BRE))[(g * 64 + n) * 16 + c] = cr * br - ci * bi;
            ((float*)(sp + S5P_BIM))[(g * 64 + n) * 16 + c] = cr * bi + ci * br;
        }
    }
    for (size_t i = gtid; i < (size_t)2 * 16 * 16 * 128; i += gsz) {
        const int l = (int)(i / 32768), g = (int)((i / 2048) % 16), c = (int)((i / 128) % 16), k = (int)(i % 128);
        const size_t si = ((size_t)(l * 16 + g) * 16 + c) * 64 + (k & 63);
        const float v = k < 64 ? P.in[11][si] : -P.in[12][si];
        ((u16*)(ws + OFF_S5P + l * S5P_LAYER + S5P_CM))[(g * 16 + c) * 128 + k] = f2bf(v);
    }
    if (bid == 0 && tid < 2) {
        const int l = tid; float s1 = 0.f, s2 = 0.f;
        for (int d = 0; d < 64; ++d) { s1 += P.in[17][l * 64 + d] * P.in[18][l * 64 + d]; s2 += P.in[19][l * 64 + d] * P.in[20][l * 64 + d]; }
        const float lam_init = 0.8f - 0.6f * expf(-0.3f * (float)l);
        ((float*)(ws + OFF_SCAL))[l] = expf(s1) - expf(s2) + lam_init;
    }
}

DI void rms_token(const Params& P, int t, int lane, float4 (&v)[4], const float* gain, u16* dst, int ab_layer  , bool want_q = false) {
    float ss = 0.f;
#pragma unroll
    for (int i = 0; i < 4; ++i) ss += v[i].x * v[i].x + v[i].y * v[i].y + v[i].z * v[i].z + v[i].w * v[i].w;
    ss = wave_sum(ss);
    const float rstd = rsqrtf(ss * (1.f / DM) + 1e-6f);
    const float4* g4 = (const float4*)gain;
#pragma unroll
    for (int i = 0; i < 4; ++i) {
        const float4 g = g4[lane + 64 * i];
        v[i].x *= rstd * g.x; v[i].y *= rstd * g.y; v[i].z *= rstd * g.z; v[i].w *= rstd * g.w;
        uint2 o; o.x = pack2(v[i].x, v[i].y); o.y = pack2(v[i].z, v[i].w);
        *(uint2*)(dst + (size_t)t * DM + (lane + 64 * i) * 4) = o;
    }
    if (want_q) {
        float am = 0.f;
#pragma unroll
        for (int i = 0; i < 4; ++i) am = fmaxf(am, fmaxf(fmaxf(fabsf(v[i].x), fabsf(v[i].y)), fmaxf(fabsf(v[i].z), fabsf(v[i].w))));
        for (int o = 32; o > 0; o >>= 1) am = fmaxf(am, __shfl_xor(am, o));
        const float sc = am > 0.f ? 127.f / am : 0.f;
#pragma unroll
        for (int i = 0; i < 4; ++i) {
            const int a0 = (int)rintf(v[i].x * sc), a1 = (int)rintf(v[i].y * sc), a2 = (int)rintf(v[i].z * sc), a3 = (int)rintf(v[i].w * sc);
            ((unsigned*)(P.ws + OFF_XQ))[(size_t)t * 256 + lane + 64 * i] = (unsigned)(a0 & 0xff) | ((unsigned)(a1 & 0xff) << 8) | ((unsigned)(a2 & 0xff) << 16) | ((unsigned)(a3 & 0xff) << 24);
        }
        if (lane == 0) ((float*)(P.ws + OFF_SX))[t] = am * (1.f / 127.f);
    }
    if (ab_layer >= 0) {
        const float4* wab = (const float4*)(P.ws + OFF_WAB) + ab_layer * 8 * 256;
        float acc[8];
#pragma unroll
        for (int j = 0; j < 8; ++j) {
            float a = 0.f;
#pragma unroll
            for (int i = 0; i < 4; ++i) { const float4 w = wab[j * 256 + lane + 64 * i]; a += v[i].x * w.x + v[i].y * w.y + v[i].z * w.z + v[i].w * w.w; }
            acc[j] = wave_sum(a);
        }
        if (lane < 4) {
            const float a = lane == 0 ? acc[0] : lane == 1 ? acc[1] : lane == 2 ? acc[2] : acc[3];
            const float b = lane == 0 ? acc[4] : lane == 1 ? acc[5] : lane == 2 ? acc[6] : acc[7];
            const float xx = a + P.in[5][ab_layer * 4 + lane];
            const float sp = xx > 20.f ? xx : log1pf(__expf(xx));
            ((float*)(P.ws + OFF_GG))[t * 4 + lane] = -__expf(P.in[4][ab_layer * 4 + lane]) * sp;
            ((float*)(P.ws + OFF_BETA))[t * 4 + lane] = sigmoidf_(b);
        }
    }
}

DI void phase_rms(const Params& P, const float* src, const float* gain, u16* dst, int ab_layer, bool want_q = false) {
    const int w = threadIdx.x >> 6, lane = threadIdx.x & 63;
    for (int t = blockIdx.x * 8 + w; t < NT; t += gridDim.x * 8) {
        const float4* s4 = (const float4*)(src + (size_t)t * DM);
        float4 v[4];
#pragma unroll
        for (int i = 0; i < 4; ++i) v[i] = s4[lane + 64 * i];
        rms_token(P, t, lane, v, gain, dst, ab_layer, want_q);
    }
}

namespace pg8 {
#define PG8_LAS __attribute__((address_space(3)))
typedef unsigned short bf16_t;
typedef short bf16x8 __attribute__((ext_vector_type(8)));
typedef float f32x4 __attribute__((ext_vector_type(4)));
typedef unsigned u32x4 __attribute__((ext_vector_type(4)));
constexpr int BM = 256, BK = 64, HALF = 128, HTB = HALF * BK * 2  , STAGE_BYTES = 8 * HTB, NXCD = 8, WGM = 8;

__host__ __device__ __forceinline__ int lds_byte(int r, int c) { const int st = (r >> 4) * 2 + (c >> 5), rr = r & 15, cc = c & 31, ob = rr * 64 + cc * 2; return st * 1024 + (ob ^ (((ob >> 9) & 1) << 5)); }
__host__ __device__ __forceinline__ void stage_rc(int b, int& R, int& C) { const int st = b / 1024, sb = b % 1024, swz = sb ^ (((sb >> 9) & 1) << 5); R = (st >> 1) * 16 + swz / 64; C = (st & 1) * 32 + (swz % 64) / 2; }
__host__ __device__ __forceinline__ int perm32(int rho) { const int n = rho >> 4, i = rho & 15; return 8 * (i >> 2) + 4 * n + (i & 3); }

struct Unit { int pm, pn; };
struct Gemm { const bf16_t* A; const bf16_t* Bt; int M, N, K; };

struct StaticOrder {
    int nM, nN, nwg, G, c;
    __host__ __device__ void init(int M, int N, int G_, int c_) { nM = M / BM; nN = N / BM; nwg = nM * nN; G = G_; c = c_; }
    __host__ __device__ bool next(int i, Unit& u) const {
        const long L = (long)i * G + c; if (L >= nwg) return false;
        int wgid = (int)L; { const int q = nwg / NXCD, r = nwg % NXCD, xcd = wgid % NXCD, off = wgid / NXCD; wgid = (xcd < r ? xcd * (q + 1) : r * (q + 1) + (xcd - r) * q) + off; }
        const int nig = WGM * nN, gid = wgid / nig, fm = gid * WGM, gsz = (nM - fm) < WGM ? (nM - fm) : WGM;
        u.pm = fm + ((wgid % nig) % gsz); u.pn = (wgid % nig) / gsz; return true;
    }
    __device__ __forceinline__ void a_ready(const Unit&) const {}
    __device__ __forceinline__ void done(const Unit&) const {}
};
struct CountedOrder : StaticOrder {
    const unsigned* ready; unsigned need; unsigned* tmo;
    __device__ __forceinline__ void a_ready(const Unit& u) const {
        if (threadIdx.x < 64) {
            const unsigned long long t0 = __builtin_amdgcn_s_memrealtime(); unsigned polls = 0;
            while ((unsigned)__builtin_amdgcn_readfirstlane(__hip_atomic_load(ready + 64 * u.pm, __ATOMIC_RELAXED, __HIP_MEMORY_SCOPE_AGENT)) < need) {
                if ((++polls & 255u) == 0u && __builtin_amdgcn_readfirstlane(__hip_atomic_load(tmo, __ATOMIC_RELAXED, __HIP_MEMORY_SCOPE_AGENT)) != 0u) break;
                if (__builtin_amdgcn_s_memrealtime() - t0 > 2000000ull) {
                    if (threadIdx.x == 0) { unsigned expect = 0u; __hip_atomic_compare_exchange_strong(tmo + 1, &expect, 0x600u | (unsigned)(u.pm & 0xff), __ATOMIC_RELAXED, __ATOMIC_RELAXED, __HIP_MEMORY_SCOPE_AGENT); __hip_atomic_store(tmo, 1u, __ATOMIC_RELAXED, __HIP_MEMORY_SCOPE_AGENT); }
                    break; }
                __builtin_amdgcn_s_sleep(2); }
            __builtin_amdgcn_fence(__ATOMIC_ACQUIRE, "agent");
            asm volatile("s_waitcnt vmcnt(0)" ::: "memory");
        }
#if !defined(BROKEN_HOOK_NO_BARRIER)
        asm volatile("" ::: "memory"); __builtin_amdgcn_s_barrier(); asm volatile("" ::: "memory");
#endif
    }
};

__device__ __forceinline__ unsigned cvt_pk_bf16(float lo, float hi) { unsigned r; asm volatile("v_cvt_pk_bf16_f32 %0, %1, %2" : "=v"(r) : "v"(lo), "v"(hi)); return r; }
typedef float f32x2 __attribute__((ext_vector_type(2)));
__device__ __forceinline__ f32x2 gelu_pk(f32x2 v) {
    const f32x2 av = __builtin_elementwise_abs(v), d = av * 0.2316418882f + 1.0f;
    f32x2 t; t.x = __builtin_amdgcn_rcpf(d.x); t.y = __builtin_amdgcn_rcpf(d.y);
    f32x2 q = t * 0.5307027145f + (-0.7265760135f); q = q * t + 0.7107068705f; q = q * t + (-0.142248368f); q = q * t + 0.127414796f; q = q * t;
    const f32x2 s = (v * v) * (-0.72134752044f);
    f32x2 e; e.x = __builtin_amdgcn_exp2f(s.x); e.y = __builtin_amdgcn_exp2f(s.y);
    const f32x2 m = v * (q * e), r = v - m;
    f32x2 o; o.x = v.x < 0.f ? m.x : r.x; o.y = v.y < 0.f ? m.y : r.y; return o;
}

struct EpiF32 {
    static constexpr bool PERM = false, AFTER_DRAIN = false;
    float* C; int ldc; const float* bias;
    __device__ __forceinline__ void operator()(const f32x4 (&acc)[2][2][4][2], const Unit& u, int wr, int wc, int fr, int fq) const {
        const int row0 = u.pm * BM + wr * 64 + fr, col0 = u.pn * BM + wc * 32 + 4 * fq;
        f32x4 bv[2][2];
#pragma unroll
        for (int bj = 0; bj < 2; ++bj)
#pragma unroll
            for (int n = 0; n < 2; ++n) bv[bj][n] = bias ? *(const f32x4*)(bias + col0 + bj * HALF + n * 16) : (f32x4){0.f, 0.f, 0.f, 0.f};
#pragma unroll
        for (int ai = 0; ai < 2; ++ai)
#pragma unroll
            for (int m = 0; m < 4; ++m) { float* rowp = C + (size_t)(row0 + ai * HALF + m * 16) * ldc + col0;
#pragma unroll
                for (int bj = 0; bj < 2; ++bj)
#pragma unroll
                    for (int n = 0; n < 2; ++n) *(f32x4*)(rowp + bj * HALF + n * 16) = acc[ai][bj][m][n] + bv[bj][n]; }
    }
};
template <int ACT  > struct EpiBf16 {
    static constexpr bool PERM = true, AFTER_DRAIN = false;
    bf16_t* O; int ldc; const float* bias; int split_cols; size_t split_stride;
    __device__ __forceinline__ void operator()(const f32x4 (&acc)[2][2][4][2], const Unit& u, int wr, int wc, int fr, int fq) const {
        const int row0 = u.pm * BM + wr * 64 + fr; int colt = u.pn * BM; bf16_t* base = O;
        if (split_cols) { const int t = colt / split_cols; base += (size_t)t * split_stride; colt -= t * split_cols; }
        const int col0 = colt + wc * 32 + 8 * fq, bcol0 = u.pn * BM + wc * 32 + 8 * fq;
        f32x4 bv[2][2];
#pragma unroll
        for (int bj = 0; bj < 2; ++bj)
#pragma unroll
            for (int n = 0; n < 2; ++n) bv[bj][n] = bias ? *(const f32x4*)(bias + bcol0 + bj * HALF + 4 * n) : (f32x4){0.f, 0.f, 0.f, 0.f};
#pragma unroll
        for (int ai = 0; ai < 2; ++ai)
#pragma unroll
            for (int m = 0; m < 4; ++m) { bf16_t* rowp = base + (size_t)(row0 + ai * HALF + m * 16) * ldc + col0;
#pragma unroll
                for (int bj = 0; bj < 2; ++bj) { f32x4 v0 = acc[ai][bj][m][0] + bv[bj][0], v1 = acc[ai][bj][m][1] + bv[bj][1];
                    if (ACT == 1) { f32x2 a = gelu_pk((f32x2){v0[0], v0[1]}), b = gelu_pk((f32x2){v0[2], v0[3]}), c = gelu_pk((f32x2){v1[0], v1[1]}), d = gelu_pk((f32x2){v1[2], v1[3]});
                        v0 = (f32x4){a.x, a.y, b.x, b.y}; v1 = (f32x4){c.x, c.y, d.x, d.y}; }
                    if (ACT == 2) {
#pragma unroll
                        for (int j = 0; j < 4; ++j) { v0[j] = 0.5f * v0[j] * (1.0f + erff(v0[j] * 0.70710678f)); v1[j] = 0.5f * v1[j] * (1.0f + erff(v1[j] * 0.70710678f)); } }
                    u32x4 w; w.x = cvt_pk_bf16(v0[0], v0[1]); w.y = cvt_pk_bf16(v0[2], v0[3]); w.z = cvt_pk_bf16(v1[0], v1[1]); w.w = cvt_pk_bf16(v1[2], v1[3]);
                    *(u32x4*)(rowp + bj * HALF) = w; } }
    }
};


template <class Epi, class Sched, bool STAMP = false>
__device__ __forceinline__ void gemm_phase(PG8_LAS unsigned char* lds, const Gemm g, const Sched& S, const Epi& E, unsigned long long* stamps) {
    const int tid = threadIdx.x, wid = __builtin_amdgcn_readfirstlane(tid >> 6), lane = tid & 63, wr = wid >> 2, wc = wid & 3, fr = lane & 15, fq = lane >> 4;
    const int K = g.K, nt = K / BK;
    int ts_lo = 0, ts_hi = 0, nts = 0; const unsigned long long rt_entry = STAMP ? (unsigned long long)wall_clock64() : 0ull;
#define PG8_STAMP() do { if (STAMP && wid == 0 && nts < 64) { const unsigned long long _c = (unsigned long long)clock64(); \
        ts_lo = (lane == nts) ? (int)(unsigned)_c : ts_lo; ts_hi = (lane == nts) ? (int)(unsigned)(_c >> 32) : ts_hi; ++nts; } } while (0)
    PG8_STAMP();
    unsigned voffA[2], voffB[2];
#pragma unroll
    for (int i = 0; i < 2; ++i) { int R, C; stage_rc(tid * 16 + i * 8192, R, C); const int Rb = Epi::PERM ? ((R & ~31) + perm32(R & 31)) : R;
        voffA[i] = (unsigned)(R * K + C) * 2u; voffB[i] = (unsigned)(Rb * K + C) * 2u; }
    const size_t kstep = (size_t)(BK * 2);
    const size_t hstep = (size_t)HALF * K * 2;
    const size_t tstep = 2 * hstep;
    const unsigned ldsw = (unsigned)wid * 1024u;
    const int aoff = lds_byte(wr * 64 + fr, fq * 8), boff = lds_byte(wc * 32 + fr, fq * 8);
#define PG8_SA(b, h) (((b) * 2 + (h)) * HTB)
#define PG8_SB(b, h) ((4 + (b) * 2 + (h)) * HTB)
#define PG8_STAGE(bufoff, gbase, voff) do { _Pragma("unroll") for (int _i = 0; _i < 2; ++_i) \
        __builtin_amdgcn_global_load_lds((const unsigned*)((const char*)(gbase) + (voff)[_i]), (PG8_LAS unsigned*)(lds + (bufoff) + ldsw + _i * 8192), 16, 0, 0); } while (0)
#define PG8_LDA(dst, b, h) do { _Pragma("unroll") for (int m = 0; m < 4; ++m) _Pragma("unroll") for (int k = 0; k < 2; ++k) dst[m][k] = *(const PG8_LAS bf16x8*)(lds + PG8_SA(b, h) + aoff + m * 2048 + k * 1024); } while (0)
#define PG8_LDB(dst, b, h) do { _Pragma("unroll") for (int n = 0; n < 2; ++n) _Pragma("unroll") for (int k = 0; k < 2; ++k) dst[n][k] = *(const PG8_LAS bf16x8*)(lds + PG8_SB(b, h) + boff + n * 2048 + k * 1024); } while (0)
#define PG8_MMA(ai, bj, At, Bt) do { __builtin_amdgcn_s_setprio(1); _Pragma("unroll") for (int m = 0; m < 4; ++m) _Pragma("unroll") for (int n = 0; n < 2; ++n) _Pragma("unroll") for (int k = 0; k < 2; ++k) \
        acc[ai][bj][m][n] = __builtin_amdgcn_mfma_f32_16x16x32_bf16(Bt[n][k], At[m][k], acc[ai][bj][m][n], 0, 0, 0); __builtin_amdgcn_s_setprio(0); } while (0)
#define PG8_WAIT_V(n) asm volatile("s_waitcnt vmcnt(" #n ")" ::: "memory")
#define PG8_WAIT_L(n) asm volatile("s_waitcnt lgkmcnt(" #n ")" ::: "memory")
#define PG8_BAR __builtin_amdgcn_s_barrier()
#define PG8_SCHED __builtin_amdgcn_sched_barrier(0)
    Unit cur, nxt; int ui = 0;
    if (!S.next(0, cur)) return;
    f32x4 acc[2][2][4][2];
#pragma unroll
    for (int a = 0; a < 2; ++a)
#pragma unroll
        for (int b = 0; b < 2; ++b)
#pragma unroll
            for (int m = 0; m < 4; ++m)
#pragma unroll
                for (int n = 0; n < 2; ++n) acc[a][b][m][n] = (f32x4){0.f, 0.f, 0.f, 0.f};
    bf16x8 At[4][2], B0[2][2], B1[2][2];
    const char* cA = (const char*)g.A + (size_t)cur.pm * tstep; const char* cB = (const char*)g.Bt + (size_t)cur.pn * tstep;
    S.a_ready(cur);
    PG8_STAGE(PG8_SB(0, 0), cB, voffB); PG8_STAGE(PG8_SA(0, 0), cA, voffA); PG8_STAGE(PG8_SB(0, 1), cB + hstep, voffB); PG8_STAGE(PG8_SA(0, 1), cA + hstep, voffA);
    if (wr == 1) PG8_BAR;
    PG8_WAIT_V(4); PG8_BAR;
    PG8_STAGE(PG8_SB(1, 0), cB + kstep, voffB); PG8_STAGE(PG8_SA(1, 0), cA + kstep, voffA); PG8_STAGE(PG8_SB(1, 1), cB + hstep + kstep, voffB);
    PG8_WAIT_V(6); PG8_BAR;
    PG8_STAMP();
    for (;;) {
        const bool has_next = S.next(ui + 1, nxt);
        const char* nA = has_next ? (const char*)g.A + (size_t)nxt.pm * tstep : cA; const char* nB = has_next ? (const char*)g.Bt + (size_t)nxt.pn * tstep : cB;
        for (int t = 0; t < nt; t += 2) {
            const bool last = (t == nt - 2);
            const char* a1 = cA + (size_t)(t + 1) * kstep;
            const char* a2 = last ? nA : cA + (size_t)(t + 2) * kstep; const char* b2 = last ? nB : cB + (size_t)(t + 2) * kstep;
            const char* a3 = a2 + kstep; const char* b3 = b2 + kstep;
            if (last && has_next) S.a_ready(nxt);
            PG8_LDB(B0, 0, 0); PG8_SCHED; PG8_LDA(At, 0, 0); PG8_STAGE(PG8_SA(1, 1), a1 + hstep, voffA);
            PG8_WAIT_L(8); PG8_BAR; PG8_WAIT_L(0); PG8_MMA(0, 0, At, B0); PG8_BAR; PG8_SCHED;
            PG8_LDB(B1, 0, 1); PG8_STAGE(PG8_SB(0, 0), b2, voffB);
            PG8_BAR; PG8_WAIT_L(0); PG8_MMA(0, 1, At, B1); PG8_BAR;
            PG8_LDA(At, 0, 1); PG8_STAGE(PG8_SA(0, 0), a2, voffA);
            PG8_BAR; PG8_WAIT_L(0); PG8_MMA(1, 0, At, B0); PG8_BAR; PG8_SCHED;
            PG8_STAGE(PG8_SB(0, 1), b2 + hstep, voffB);
            PG8_WAIT_V(6); PG8_BAR; PG8_MMA(1, 1, At, B1); PG8_BAR;
            PG8_LDB(B0, 1, 0); PG8_SCHED; PG8_LDA(At, 1, 0); PG8_STAGE(PG8_SA(0, 1), a2 + hstep, voffA);
            PG8_WAIT_L(8); PG8_BAR; PG8_WAIT_L(0); PG8_MMA(0, 0, At, B0); PG8_BAR; PG8_SCHED;
            PG8_LDB(B1, 1, 1); PG8_STAGE(PG8_SB(1, 0), b3, voffB);
            PG8_BAR; PG8_WAIT_L(0); PG8_MMA(0, 1, At, B1); PG8_BAR;
            PG8_LDA(At, 1, 1); PG8_STAGE(PG8_SA(1, 0), a3, voffA);
            PG8_BAR; PG8_WAIT_L(0); PG8_MMA(1, 0, At, B0); PG8_BAR; PG8_SCHED;
            PG8_STAGE(PG8_SB(1, 1), b3 + hstep, voffB);
            PG8_WAIT_V(6); PG8_BAR; PG8_MMA(1, 1, At, B1); PG8_BAR;
        }
        PG8_STAMP();
        if constexpr (!Epi::AFTER_DRAIN) { E(acc, cur, wr, wc, fr, fq); S.done(cur); }
        PG8_STAMP();
        if (!has_next) break;
#pragma unroll
        for (int a = 0; a < 2; ++a)
#pragma unroll
            for (int b = 0; b < 2; ++b)
#pragma unroll
                for (int m = 0; m < 4; ++m)
#pragma unroll
                    for (int n = 0; n < 2; ++n) acc[a][b][m][n] = (f32x4){0.f, 0.f, 0.f, 0.f};
        cur = nxt; cA = nA; cB = nB; ++ui;
    }
    PG8_WAIT_V(0);
    if (wr == 0) PG8_BAR;
    PG8_BAR;
    if constexpr (Epi::AFTER_DRAIN) { E.fused(acc, cur, wr, wc, fr, fq, lds, wid, lane); S.done(cur); }
    PG8_STAMP();
    if (STAMP && wid == 0) { stamps[lane] = lane < nts ? (((unsigned long long)(unsigned)ts_hi << 32) | (unsigned)ts_lo) : 0ull;
        if (lane == 62) stamps[62] = rt_entry; if (lane == 63) stamps[63] = (unsigned long long)wall_clock64(); }
#undef PG8_STAMP
#undef PG8_SA
#undef PG8_SB
#undef PG8_STAGE
#undef PG8_LDA
#undef PG8_LDB
#undef PG8_MMA
#undef PG8_WAIT_V
#undef PG8_WAIT_L
#undef PG8_BAR
#undef PG8_SCHED
}
}

struct EpiInProj8 {
    static constexpr bool PERM = true, AFTER_DRAIN = false;
    char* ws;
    DI void operator()(const pg8::f32x4 (&acc)[2][2][4][2], const pg8::Unit& u, int wr, int wc, int fr, int fq) const {
        const int row0 = u.pm * 256 + wr * 64 + fr; const int pn = u.pn;
        if (pn >= 9) {
            u16* vt = (u16*)(ws + OFF_VT);
#pragma unroll
            for (int ai = 0; ai < 2; ++ai)
#pragma unroll
                for (int m = 0; m < 4; ++m) {
                    const int tok = row0 + ai * 128 + m * 16; const int b = tok >> 13, l = tok & 8191;
#pragma unroll
                    for (int bj = 0; bj < 2; ++bj)
#pragma unroll
                        for (int n = 0; n < 2; ++n)
#pragma unroll
                            for (int j = 0; j < 4; ++j) {
                                const int c = (pn - 9) * 256 + wc * 32 + 8 * fq + bj * 128 + 4 * n + j; const int head = c >> 7, dv = c & 127;
                                vt[((size_t)((b * 4 + head) * 128 + dv)) * SEQ + l] = f2bf(acc[ai][bj][m][n][j]);
                            }
                }
            return;
        }
        u16* base; int pitch, c0; float sc = 1.f;
        if (pn < 3) { base = (u16*)(ws + OFF_QKV); pitch = 768; c0 = pn * 256; }
        else if (pn == 3) { base = (u16*)(ws + OFF_Z); pitch = 256; c0 = 0; }
        else if (pn == 4) { base = (u16*)(ws + OFF_US); pitch = 256; c0 = 0; }
        else if (pn < 7) { base = (u16*)(ws + OFF_QC); pitch = 512; c0 = (pn - 5) * 256; sc = 0.125f * LOG2E; }
        else { base = (u16*)(ws + OFF_KC); pitch = 512; c0 = (pn - 7) * 256; }
        const int col0 = c0 + wc * 32 + 8 * fq;
#pragma unroll
        for (int ai = 0; ai < 2; ++ai)
#pragma unroll
            for (int m = 0; m < 4; ++m) {
                u16* rowp = base + (size_t)(row0 + ai * 128 + m * 16) * pitch + col0;
#pragma unroll
                for (int bj = 0; bj < 2; ++bj) {
                    const pg8::f32x4 v0 = acc[ai][bj][m][0] * sc, v1 = acc[ai][bj][m][1] * sc;
                    uint4 w; w.x = pack2(v0[0], v0[1]); w.y = pack2(v0[2], v0[3]); w.z = pack2(v1[0], v1[1]); w.w = pack2(v1[2], v1[3]);
                    *(uint4*)(rowp + bj * 128) = w;
                }
            }
    }
};
struct EpiResidual8 {
    static constexpr bool PERM = false, AFTER_DRAIN = false;
    const float* hin; float* hout;
    DI void operator()(const pg8::f32x4 (&acc)[2][2][4][2], const pg8::Unit& u, int wr, int wc, int fr, int fq) const {
        const int row0 = u.pm * 256 + wr * 64 + fr, col0 = u.pn * 256 + wc * 32 + 4 * fq;
#pragma unroll
        for (int ai = 0; ai < 2; ++ai)
#pragma unroll
            for (int m = 0; m < 4; ++m) {
                const size_t ro = (size_t)(row0 + ai * 128 + m * 16) * DM + col0;
#pragma unroll
                for (int bj = 0; bj < 2; ++bj)
#pragma unroll
                    for (int n = 0; n < 2; ++n) {
                        const pg8::f32x4 h = *(const pg8::f32x4*)(hin + ro + bj * 128 + n * 16);
                        *(pg8::f32x4*)(hout + ro + bj * 128 + n * 16) = h + acc[ai][bj][m][n];
                    }
            }
    }
};
struct EpiGlu8 {
    static constexpr bool PERM = true, AFTER_DRAIN = false;
    u16* mix; const float* bias;
    DI void operator()(const pg8::f32x4 (&acc)[2][2][4][2], const pg8::Unit& u, int wr, int wc, int fr, int fq) const {
        const int row0 = u.pm * 256 + wr * 64 + fr, col0 = u.pn * 128 + wc * 32 + 8 * fq;
#pragma unroll
        for (int n = 0; n < 2; ++n) {
            const pg8::f32x4 bv = *(const pg8::f32x4*)(bias + col0 + 4 * n), bg = *(const pg8::f32x4*)(bias + 256 + col0 + 4 * n);
#pragma unroll
            for (int ai = 0; ai < 2; ++ai)
#pragma unroll
                for (int m = 0; m < 4; ++m) {
                    const pg8::f32x4 val = acc[ai][0][m][n] + bv, gt = acc[ai][1][m][n] + bg;
                    uint2 w; w.x = pack2(val[0] * sigmoidf_(gt[0]), val[1] * sigmoidf_(gt[1])); w.y = pack2(val[2] * sigmoidf_(gt[2]), val[3] * sigmoidf_(gt[3]));
                    *(uint2*)(mix + (size_t)(row0 + ai * 128 + m * 16) * DM + 256 + col0 + 4 * n) = w;
                }
        }
    }
};
template <class Epi>
DI void phase_gemm(const u16* A, int lda, const u16* Bt, int ldb, int M, int N, int K, Epi epi, char* lds) {
    pg8::Gemm g{A, Bt, M, N, K};
    pg8::StaticOrder S; S.init(M, N, (int)gridDim.x, (int)blockIdx.x);
    pg8::gemm_phase<Epi, pg8::StaticOrder, false>((PG8_LAS unsigned char*)lds, g, S, epi, nullptr);
}

template <int CTRL> DI float dppf(float v) { return __int_as_float(__builtin_amdgcn_update_dpp(0, __float_as_int(v), CTRL, 0xF, 0xF, true)); }
DI void gdn_prep_item(const Params& P, int layer, int item, char* lds) {
    const int tid = threadIdx.x, lane = tid & 63, w = tid >> 6;
    const int b = item >> 9, head = (item >> 7) & 3, ch = item & 127;
    const int t0 = b * SEQ + ch * 64;
    u16* raw = (u16*)lds;
    float* qs = (float*)(lds + 25856);
    float* ks = qs + 64 * 68;
    float* vs = ks + 64 * 68;
    float* Lp = vs + 64 * 68;
    u16* qb = (u16*)(Lp + 64 * 68);
    u16* kb = qb + 64 * 72;
    float* Gs = (float*)(kb + 64 * 72);
    float* bs = Gs + 64;
    u16* Xs = raw;
    u16* QKs = raw + 8704;
    const u16* qkv = (const u16*)(P.ws + OFF_QKV);
    u16* rec = (u16*)(P.ws + OFF_GREC + (size_t)item * GREC_BYTES);
    for (int i = tid; i < 67 * 24; i += NTHR) {
        const int row = i / 24, c8 = i % 24; const int part = c8 >> 3, cc = (c8 & 7) * 8;
        const int l = ch * 64 + row - 3;
        uint4 v = make_uint4(0, 0, 0, 0);
        if (l >= 0) v = *(const uint4*)(qkv + (size_t)(b * SEQ + l) * 768 + part * 256 + head * 64 + cc);
        *(uint4*)(raw + row * 192 + part * 64 + cc) = v;
    }
    if (tid < 64) {
        bs[tid] = ((const float*)(P.ws + OFF_BETA))[(t0 + tid) * 4 + head];
        float g = ((const float*)(P.ws + OFF_GG))[(t0 + tid) * 4 + head];
#pragma unroll
        for (int o = 1; o < 64; o <<= 1) { const float tt = __shfl_up(g, o); if (lane >= o) g += tt; }
        Gs[tid] = g;
    }
    __syncthreads();
    {
        const float* cw = P.in[3] + (size_t)layer * 4 * 768;
#pragma unroll 1
        for (int it = 0; it < 3; ++it) {
            const int id = tid + NTHR * it; const int t = id / 24, c8 = id % 24; const int part = c8 >> 3, d0 = (c8 & 7) * 8;
            float a[8];
#pragma unroll
            for (int k = 0; k < 8; ++k) a[k] = 0.f;
#pragma unroll
            for (int j = 0; j < 4; ++j) {
                const uint4 rv = *(const uint4*)(raw + (t + j) * 192 + part * 64 + d0);
                const float4 w0 = *(const float4*)(cw + j * 768 + part * 256 + head * 64 + d0), w1 = *(const float4*)(cw + j * 768 + part * 256 + head * 64 + d0 + 4);
                a[0] += w0.x * bf2f((u16)(rv.x & 0xffff)); a[1] += w0.y * bf2f((u16)(rv.x >> 16));
                a[2] += w0.z * bf2f((u16)(rv.y & 0xffff)); a[3] += w0.w * bf2f((u16)(rv.y >> 16));
                a[4] += w1.x * bf2f((u16)(rv.z & 0xffff)); a[5] += w1.y * bf2f((u16)(rv.z >> 16));
                a[6] += w1.z * bf2f((u16)(rv.w & 0xffff)); a[7] += w1.w * bf2f((u16)(rv.w >> 16));
            }
            float ss = 0.f;
#pragma unroll
            for (int k = 0; k < 8; ++k) { a[k] = a[k] * sigmoidf_(a[k]); ss += a[k] * a[k]; }
            ss += dppf<0xB1>(ss); ss += dppf<0x4E>(ss); ss += dppf<0x141>(ss);
            const float sc = part == 2 ? 1.f : rsqrtf(ss + 1e-6f) * (part == 0 ? 0.125f : 1.f);
#pragma unroll
            for (int k = 0; k < 8; ++k) a[k] *= sc;
            float* dst = (part == 0 ? qs : part == 1 ? ks : vs) + t * 68 + d0;
            *(float4*)dst = make_float4(a[0], a[1], a[2], a[3]); *(float4*)(dst + 4) = make_float4(a[4], a[5], a[6], a[7]);
            if (part < 2) {
                uint4 pk; pk.x = pack2(a[0], a[1]); pk.y = pack2(a[2], a[3]); pk.z = pack2(a[4], a[5]); pk.w = pack2(a[6], a[7]);
                *(uint4*)((part == 0 ? qb : kb) + t * 72 + d0) = pk;
            }
        }
    }
    __syncthreads();
    {
        const int r = lane & 31, hh = lane >> 5; const int bi = (w >> 1) & 1, bj = w & 1; const bool isqk = w >= 4;
        const u16* Am = (isqk ? qb : kb) + (bi * 32 + r) * 72 + hh * 8;
        const u16* Bm = kb + (bj * 32 + r) * 72 + hh * 8;
        f32x16 acc;
#pragma unroll
        for (int e = 0; e < 16; ++e) acc[e] = 0.f;
#pragma unroll
        for (int s = 0; s < 4; ++s) acc = MFMA32(ld8(Am + s * 16), ld8(Bm + s * 16), acc);
        const int cidx = bj * 32 + r; const float Gc = Gs[cidx], bc = bs[cidx];
#pragma unroll
        for (int e = 0; e < 16; ++e) {
            const int ridx = bi * 32 + (e & 3) + 8 * (e >> 2) + 4 * hh;
            if (isqk) {
                QKs[ridx * 64 + cidx] = f2bf(cidx <= ridx ? acc[e] * __expf(Gs[ridx] - Gc) : 0.f);
            } else {
                Lp[ridx * 68 + (cidx & 3) * 16 + (cidx >> 2)] = (ridx < cidx) ? bc * acc[e] * __expf(Gc - Gs[ridx]) : 0.f;
            }
        }
    }
    __syncthreads();
    {
        const int c = tid >> 2, q = tid & 3; const bool isw = c >= 64; const int cc = c & 63;
        float rhs[16];
#pragma unroll
        for (int m = 0; m < 16; ++m) {
            const int i = 4 * m + q; const float bi_ = bs[i];
            rhs[m] = isw ? ks[i * 68 + cc] * bi_ * __expf(Gs[i]) : vs[i * 68 + cc] * bi_;
        }
        const float* Lq = Lp + q * 16;
#define SOLVE_STEP(j_, CTRL_) do { \
            const float xj = dppf<CTRL_>(rhs[(j_) >> 2]); \
            const float4* l4 = (const float4*)(Lq + (j_) * 68); \
            const float4 la = l4[0], lb = l4[1], lc = l4[2], ld = l4[3]; \
            rhs[0] -= la.x * xj; rhs[1] -= la.y * xj; rhs[2] -= la.z * xj; rhs[3] -= la.w * xj; \
            rhs[4] -= lb.x * xj; rhs[5] -= lb.y * xj; rhs[6] -= lb.z * xj; rhs[7] -= lb.w * xj; \
            rhs[8] -= lc.x * xj; rhs[9] -= lc.y * xj; rhs[10] -= lc.z * xj; rhs[11] -= lc.w * xj; \
            rhs[12] -= ld.x * xj; rhs[13] -= ld.y * xj; rhs[14] -= ld.z * xj; rhs[15] -= ld.w * xj; } while (0)
#pragma unroll
        for (int jj = 0; jj < 16; ++jj) {
            SOLVE_STEP(4 * jj + 0, 0x00); SOLVE_STEP(4 * jj + 1, 0x55); SOLVE_STEP(4 * jj + 2, 0xAA); SOLVE_STEP(4 * jj + 3, 0xFF);
        }
#undef SOLVE_STEP
        __syncthreads();
#pragma unroll
        for (int m = 0; m < 16; ++m) Xs[(4 * m + q) * 136 + c] = f2bf(rhs[m]);
    }
    __syncthreads();
    {
#pragma unroll
        for (int it = 0; it < 2; ++it) {
            const int id = tid + NTHR * it; const int i = id >> 4, c8 = (id & 15) * 8;
            *(uint4*)(rec + (c8 >> 6) * 4096 + i * 64 + (c8 & 63)) = *(const uint4*)(Xs + i * 136 + c8);
        }
        *(uint4*)(rec + 2 * 4096 + tid * 8) = *(const uint4*)(QKs + tid * 8);
        {
            const int t = tid >> 3, d0 = (tid & 7) * 8; const float eg = __expf(Gs[t]);
            const float4 x0 = *(const float4*)(qs + t * 68 + d0), x1 = *(const float4*)(qs + t * 68 + d0 + 4);
            uint4 pk; pk.x = pack2(x0.x * eg, x0.y * eg); pk.y = pack2(x0.z * eg, x0.w * eg); pk.z = pack2(x1.x * eg, x1.y * eg); pk.w = pack2(x1.z * eg, x1.w * eg);
            *(uint4*)(rec + 3 * 4096 + t * 64 + d0) = pk;
        }
        {
            const int d = tid & 63, tb = (tid >> 6) * 8; const float Gl = Gs[63];
            float kv[8];
#pragma unroll
            for (int k = 0; k < 8; ++k) kv[k] = ks[(tb + k) * 68 + d] * __expf(Gl - Gs[tb + k]);
            uint4 pk; pk.x = pack2(kv[0], kv[1]); pk.y = pack2(kv[2], kv[3]); pk.z = pack2(kv[4], kv[5]); pk.w = pack2(kv[6], kv[7]);
            *(uint4*)(rec + 4 * 4096 + d * 64 + tb) = pk;
            if (tid == 0) ((float*)(P.ws + OFF_EGL))[item] = __expf(Gl);
        }
    }
    __syncthreads();
}

constexpr int RP = 72;
DI void gdn_scan_chain(const Params& P, int chain, char* lds) {
    const int tid = threadIdx.x, lane = tid & 63, w = tid >> 6;
    const int b = chain >> 2, head = chain & 3;
    u16* buf0 = (u16*)lds;
    u16* buf1 = buf0 + 320 * RP;
    const char* recbase = P.ws + OFF_GREC + (size_t)(chain * 128) * GREC_BYTES;
    const float* egl = (const float*)(P.ws + OFF_EGL) + chain * 128;
    float* gout = (float*)(P.ws + OFF_GDNO);
    uint4 rg0, rg1, rg2, rg3, rg4;
#define SCAN_ISSUE(c_) do { const uint4* src_ = (const uint4*)(recbase + (size_t)(c_) * GREC_BYTES) + tid; \
        rg0 = src_[0]; rg1 = src_[NTHR]; rg2 = src_[2 * NTHR]; rg3 = src_[3 * NTHR]; rg4 = src_[4 * NTHR]; } while (0)
#define SCAN_PUT(buf_, i_, v_) do { const int id_ = tid + NTHR * (i_); *(uint4*)((buf_) + (id_ >> 3) * RP + (id_ & 7) * 8) = (v_); } while (0)
#define SCAN_COMMIT(buf_) do { SCAN_PUT(buf_, 0, rg0); SCAN_PUT(buf_, 1, rg1); SCAN_PUT(buf_, 2, rg2); SCAN_PUT(buf_, 3, rg3); SCAN_PUT(buf_, 4, rg4); } while (0)
    f32x4 S[4];
#pragma unroll
    for (int m = 0; m < 4; ++m) S[m] = (f32x4){0.f, 0.f, 0.f, 0.f};
    const int r16 = lane & 15, g = lane >> 4;
    SCAN_ISSUE(0); SCAN_COMMIT(buf0);
    __syncthreads();
    for (int c = 0; c < 128; ++c) {
        u16* cur = (c & 1) ? buf1 : buf0; u16* nxt = (c & 1) ? buf0 : buf1;
        if (c + 1 < 128) SCAN_ISSUE(c + 1);
        if (w < 4) {
            const float dec = egl[c];
            const u16* Ub = cur;
            const u16* Wb = cur + 64 * RP;
            const u16* QKb = cur + 128 * RP;
            const u16* QGb = cur + 192 * RP;
            const u16* KDb = cur + 256 * RP;
            bf16x8 Sb[2];
#pragma unroll
            for (int s = 0; s < 2; ++s) Sb[s] = pack8(S[2 * s][0], S[2 * s][1], S[2 * s][2], S[2 * s][3], S[2 * s + 1][0], S[2 * s + 1][1], S[2 * s + 1][2], S[2 * s + 1][3]);
            f32x4 vn[4], o[4];
#pragma unroll
            for (int mb = 0; mb < 4; ++mb) {
                f32x4 a = (f32x4){0.f, 0.f, 0.f, 0.f}, oo = (f32x4){0.f, 0.f, 0.f, 0.f};
#pragma unroll
                for (int s = 0; s < 2; ++s) {
                    const u16* pw = Wb + (16 * mb + r16) * RP + 32 * s + 4 * g;
                    const u16* pq = QGb + (16 * mb + r16) * RP + 32 * s + 4 * g;
                    a = MFMA16(cat4(*(const bf16x4*)pw, *(const bf16x4*)(pw + 16)), Sb[s], a);
                    oo = MFMA16(cat4(*(const bf16x4*)pq, *(const bf16x4*)(pq + 16)), Sb[s], oo);
                }
#pragma unroll
                for (int e = 0; e < 4; ++e) vn[mb][e] = bf2f(Ub[(16 * mb + 4 * g + e) * RP + 16 * w + r16]) - a[e];
                o[mb] = oo;
            }
            bf16x8 Vb[2];
#pragma unroll
            for (int s = 0; s < 2; ++s) Vb[s] = pack8(vn[2 * s][0], vn[2 * s][1], vn[2 * s][2], vn[2 * s][3], vn[2 * s + 1][0], vn[2 * s + 1][1], vn[2 * s + 1][2], vn[2 * s + 1][3]);
#pragma unroll
            for (int mb = 0; mb < 4; ++mb) {
                f32x4 oo = o[mb];
                f32x4 sn = S[mb] * dec;
#pragma unroll
                for (int s = 0; s < 2; ++s) {
                    const u16* pk = QKb + (16 * mb + r16) * RP + 32 * s + 4 * g;
                    const u16* pd = KDb + (16 * mb + r16) * RP + 32 * s + 4 * g;
                    oo = MFMA16(cat4(*(const bf16x4*)pk, *(const bf16x4*)(pk + 16)), Vb[s], oo);
                    sn = MFMA16(cat4(*(const bf16x4*)pd, *(const bf16x4*)(pd + 16)), Vb[s], sn);
                }
                S[mb] = sn;
#pragma unroll
                for (int e = 0; e < 4; ++e)
                    gout[(size_t)(b * SEQ + c * 64 + 16 * mb + 4 * g + e) * 256 + head * 64 + 16 * w + r16] = oo[e];
            }
        }
        if (c + 1 < 128) SCAN_COMMIT(nxt);
        __syncthreads();
    }
}

DI void phase_gdn_norm(const Params& P, int layer) {
    const int w = threadIdx.x >> 6, lane = threadIdx.x & 63;
    const float* gout = (const float*)(P.ws + OFF_GDNO);
    const u16* z = (const u16*)(P.ws + OFF_Z);
    u16* mix = (u16*)(P.ws + OFF_ABUF);
    const float4 ng = ((const float4*)(P.in[6] + layer * 64))[lane & 15];
    for (int t = blockIdx.x * 8 + w; t < NT; t += gridDim.x * 8) {
        const float4 o = ((const float4*)(gout + (size_t)t * 256))[lane];
        float ss = o.x * o.x + o.y * o.y + o.z * o.z + o.w * o.w;
        ss += __shfl_xor(ss, 1); ss += __shfl_xor(ss, 2); ss += __shfl_xor(ss, 4); ss += __shfl_xor(ss, 8);
        const float rstd = rsqrtf(ss * (1.f / 64.f) + 1e-6f);
        const uint2 zz = *(const uint2*)(z + (size_t)t * 256 + lane * 4);
        const float z0 = bf2f((u16)(zz.x & 0xffff)), z1 = bf2f((u16)(zz.x >> 16)), z2 = bf2f((u16)(zz.y & 0xffff)), z3 = bf2f((u16)(zz.y >> 16));
        uint2 r;
        r.x = pack2(o.x * rstd * ng.x * z0 * sigmoidf_(z0), o.y * rstd * ng.y * z1 * sigmoidf_(z1));
        r.y = pack2(o.z * rstd * ng.z * z2 * sigmoidf_(z2), o.w * rstd * ng.w * z3 * sigmoidf_(z3));
        *(uint2*)(mix + (size_t)t * DM + lane * 4) = r;
    }
}

template <bool FINAL>
DI void s5_item(const Params& P, int layer, int item, char* wlds, int lane) {
    const int b = item >> 11, g = (item >> 7) & 15, ch = item & 127;
    const int t0 = b * SEQ + ch * 64;
    const char* sp = P.ws + OFF_S5P + layer * S5P_LAYER;
    float* ut = (float*)wlds;
    u16* Xs = (u16*)(wlds + 4096);
    {
        const u16* src = (const u16*)(P.ws + OFF_US) + (size_t)(t0 + lane) * 256 + g * 16;
        const uint4 a = *(const uint4*)src, c = *(const uint4*)(src + 8);
        const unsigned uu[8] = {a.x, a.y, a.z, a.w, c.x, c.y, c.z, c.w};
#pragma unroll
        for (int i = 0; i < 8; ++i) { ut[lane * 16 + 2 * i] = bf2f((u16)(uu[i] & 0xffff)); ut[lane * 16 + 2 * i + 1] = bf2f((u16)(uu[i] >> 16)); }
    }
    float Br[16], Bi[16];
    {
        const float4* br = (const float4*)(sp + S5P_BRE) + (g * 64 + lane) * 4; const float4* bi = (const float4*)(sp + S5P_BIM) + (g * 64 + lane) * 4;
#pragma unroll
        for (int i = 0; i < 4; ++i) { const float4 x = br[i], y = bi[i]; Br[4 * i] = x.x; Br[4 * i + 1] = x.y; Br[4 * i + 2] = x.z; Br[4 * i + 3] = x.w; Bi[4 * i] = y.x; Bi[4 * i + 1] = y.y; Bi[4 * i + 2] = y.z; Bi[4 * i + 3] = y.w; }
    }
    const float2 ab = ((const float2*)(sp + S5P_ABAR))[g * 64 + lane];
    float2* st = (float2*)(P.ws + OFF_S5ST) + (size_t)item * 64 + lane;
    float xr = 0.f, xi = 0.f;
    if (FINAL) { const float2 c0 = *st; xr = c0.x; xi = c0.y; }
    bf16x8 cf[4];
    if (FINAL) {
        const u16* cm = (const u16*)(sp + S5P_CM) + (g * 16 + (lane & 15)) * 128 + 8 * (lane >> 4);
#pragma unroll
        for (int s = 0; s < 4; ++s) cf[s] = ld8(cm + 32 * s);
    }
    __builtin_amdgcn_wave_barrier();
    asm volatile("s_waitcnt lgkmcnt(0)" ::: "memory");
    for (int half = 0; half < 2; ++half) {
        for (int tt = 0; tt < 32; ++tt) {
            const int t = half * 32 + tt;
            const float4* u4 = (const float4*)(ut + t * 16);
            float br_ = 0.f, bi_ = 0.f;
#pragma unroll
            for (int q = 0; q < 4; ++q) {
                const float4 u = u4[q];
                br_ += Br[4 * q] * u.x + Br[4 * q + 1] * u.y + Br[4 * q + 2] * u.z + Br[4 * q + 3] * u.w;
                bi_ += Bi[4 * q] * u.x + Bi[4 * q + 1] * u.y + Bi[4 * q + 2] * u.z + Bi[4 * q + 3] * u.w;
            }
            const float nr = ab.x * xr - ab.y * xi + br_, ni = ab.x * xi + ab.y * xr + bi_;
            xr = nr; xi = ni;
            if (FINAL) { Xs[tt * 136 + lane] = f2bf(xr); Xs[tt * 136 + 64 + lane] = f2bf(xi); }
        }
        if (FINAL) {
            asm volatile("s_waitcnt lgkmcnt(0)" ::: "memory");
            __builtin_amdgcn_wave_barrier();
            const int r16 = lane & 15, gg = lane >> 4;
            const float dsv = P.in[13][layer * 256 + g * 16 + r16];
#pragma unroll
            for (int mb = 0; mb < 2; ++mb) {
                f32x4 acc = (f32x4){0.f, 0.f, 0.f, 0.f};
#pragma unroll
                for (int s = 0; s < 4; ++s) acc = MFMA16(ld8(Xs + (16 * mb + r16) * 136 + 32 * s + 8 * gg), cf[s], acc);
#pragma unroll
                for (int e = 0; e < 4; ++e) {
                    const int tk = half * 32 + 16 * mb + 4 * gg + e;
                    const float y = acc[e] + dsv * ut[tk * 16 + r16];
                    ((u16*)(P.ws + OFF_YS5))[(size_t)(t0 + tk) * 256 + g * 16 + r16] = f2bf(gelu_tanh(y));
                }
            }
            asm volatile("s_waitcnt lgkmcnt(0)" ::: "memory");
            __builtin_amdgcn_wave_barrier();
        }
    }
    if (!FINAL) *st = make_float2(xr, xi);
    asm volatile("s_waitcnt lgkmcnt(0)" ::: "memory");
    __builtin_amdgcn_wave_barrier();
}
template <bool FINAL>
DI void phase_s5(const Params& P, int layer, char* lds) {
    const int w = threadIdx.x >> 6, lane = threadIdx.x & 63;
    char* wl = lds + w * 12800;
    for (int it = blockIdx.x * 8 + w; it < 8192; it += gridDim.x * 8) s5_item<FINAL>(P, layer, it, wl, lane);
}
constexpr int KP = 136;
constexpr int VP = 72;
constexpr int ATT_STAGE = 64 * KP + 128 * VP;
DI void attn_item(const Params& P, int layer, int b, int head, int qb, char* lds) {
    const int tid = threadIdx.x, lane = tid & 63, w = tid >> 6;
    const int m = w >> 2, wq = w & 3, r = lane & 31, hh = lane >> 5;
    u16* st0 = (u16*)lds;
    const u16* QC = (const u16*)(P.ws + OFF_QC);
    const u16* KC = (const u16*)(P.ws + OFF_KC);
    const u16* VT = (const u16*)(P.ws + OFF_VT);
    const int qw0 = qb * 128 + 32 * wq;
    const int q = qw0 + r;
    bf16x8 qf[4];
    {
        const u16* qp = QC + (size_t)(b * SEQ + q) * 512 + head * 128 + m * 64 + hh * 8;
#pragma unroll
        for (int s = 0; s < 4; ++s) qf[s] = ld8(qp + 16 * s);
    }
    f32x16 o[4];
#pragma unroll
    for (int d = 0; d < 4; ++d)
#pragma unroll
        for (int e = 0; e < 16; ++e) o[d][e] = 0.f;
    float mrun = -INFINITY, lrun = 0.f;
    const int nkv = 2 * (qb + 1);
    const int kkey = tid >> 4, kch = tid & 15;
    const int vdv = tid >> 3, vch = tid & 7;
    const u16* kg = KC + (size_t)(b * SEQ + kkey) * 512 + head * 128 + kch * 8;
    const u16* vg = VT + ((size_t)((b * 4 + head) * 128 + vdv)) * SEQ + vch * 8;
    uint4 ra_k0, ra_k1, ra_v0, ra_v1;
#define ATT_ISSUE(S_, j_) do { S_##_k0 = *(const uint4*)(kg + (size_t)(64 * (j_)) * 512); S_##_k1 = *(const uint4*)(kg + (size_t)(64 * (j_) + 32) * 512); \
        S_##_v0 = *(const uint4*)(vg + 64 * (j_)); S_##_v1 = *(const uint4*)(vg + (size_t)64 * SEQ + 64 * (j_)); } while (0)
#define ATT_COMMIT(S_, stg_) do { u16* sg_ = (stg_); *(uint4*)(sg_ + kkey * KP + kch * 8) = S_##_k0; *(uint4*)(sg_ + (kkey + 32) * KP + kch * 8) = S_##_k1; \
        u16* vb_ = sg_ + 64 * KP; \
        const int vpos_ = 16 * (vch >> 1) + 4 * (vch & 1); \
        *(uint2*)(vb_ + vdv * VP + vpos_) = make_uint2(S_##_v0.x, S_##_v0.y); *(uint2*)(vb_ + vdv * VP + vpos_ + 8) = make_uint2(S_##_v0.z, S_##_v0.w); \
        *(uint2*)(vb_ + (vdv + 64) * VP + vpos_) = make_uint2(S_##_v1.x, S_##_v1.y); *(uint2*)(vb_ + (vdv + 64) * VP + vpos_ + 8) = make_uint2(S_##_v1.z, S_##_v1.w); } while (0)
#define ATT_QK(stg_, init_) do { \
        const float in_ = (init_); \
        _Pragma("unroll") for (int e = 0; e < 16; ++e) { s0[e] = in_; s1[e] = in_; } \
        const u16* kp = (stg_) + r * KP + m * 64 + hh * 8; \
        bf16x8 ka[4], kb[4]; \
        _Pragma("unroll") for (int s = 0; s < 4; ++s) { ka[s] = ld8(kp + 16 * s); kb[s] = ld8(kp + 32 * KP + 16 * s); } \
        __builtin_amdgcn_sched_barrier(0); \
        _Pragma("unroll") for (int s = 0; s < 4; ++s) { \
            s0 = MFMA32(ka[s], qf[s], s0); \
            s1 = MFMA32(kb[s], qf[s], s1); } } while (0)
#define ATT_MASK(j_) do { \
        if (64 * (j_) + 63 > qw0) { \
            _Pragma("unroll") for (int e = 0; e < 16; ++e) { \
                const int key = 64 * (j_) + (e & 3) + 8 * (e >> 2) + 4 * hh; \
                if (key > q) s0[e] = -INFINITY; \
                if (key + 32 > q) s1[e] = -INFINITY; } } } while (0)
#define ATT_PACK() do { \
        pf[0] = pack8(s0[0], s0[1], s0[2], s0[3], s0[4], s0[5], s0[6], s0[7]); \
        pf[1] = pack8(s0[8], s0[9], s0[10], s0[11], s0[12], s0[13], s0[14], s0[15]); \
        pf[2] = pack8(s1[0], s1[1], s1[2], s1[3], s1[4], s1[5], s1[6], s1[7]); \
        pf[3] = pack8(s1[8], s1[9], s1[10], s1[11], s1[12], s1[13], s1[14], s1[15]); } while (0)
#define ATT_SM_HEAVY(j_) do { \
        ATT_MASK(j_); \
        float mx = s0[0]; \
        _Pragma("unroll") for (int e = 1; e < 16; ++e) mx = fmaxf(mx, s0[e]); \
        _Pragma("unroll") for (int e = 0; e < 16; ++e) mx = fmaxf(mx, s1[e]); \
        mx = fmaxf(mx, __shfl_xor(mx, 32)); \
        float mnew = mrun; \
        if (__builtin_amdgcn_ballot_w64(mx > mrun + 8.f) != 0ull) { \
            mnew = fmaxf(mrun, mx); \
            const float alpha = __builtin_amdgcn_exp2f(mrun - mnew); \
            mrun = mnew; lrun *= alpha; \
            _Pragma("unroll") for (int d = 0; d < 4; ++d) o[d] = o[d] * alpha; } \
        float psum = 0.f; \
        _Pragma("unroll") for (int e = 0; e < 16; ++e) { s0[e] = __builtin_amdgcn_exp2f(s0[e] - mnew); psum += s0[e]; } \
        _Pragma("unroll") for (int e = 0; e < 16; ++e) { s1[e] = __builtin_amdgcn_exp2f(s1[e] - mnew); psum += s1[e]; } \
        lrun += psum; \
        ATT_PACK(); } while (0)
#define ATT_SM_LIGHT(j_) do { \
        ATT_MASK(j_); \
        _Pragma("unroll") for (int e = 0; e < 16; ++e) { s0[e] = __builtin_amdgcn_exp2f(s0[e]); s1[e] = __builtin_amdgcn_exp2f(s1[e]); } \
        { float ps_ = 0.f; _Pragma("unroll") for (int e = 0; e < 16; ++e) ps_ += s0[e] + s1[e]; lrun += ps_; } \
        ATT_PACK(); } while (0)
#define ATT_LDV(dst_, d_) do { _Pragma("unroll") for (int kk = 0; kk < 4; ++kk) dst_[kk] = ld8(vp + (d_) * 32 * VP + 16 * kk); } while (0)
#define ATT_MM4(d_, src_) do { __builtin_amdgcn_s_setprio(1); _Pragma("unroll") for (int kk = 0; kk < 4; ++kk) o[d_] = MFMA32(src_[kk], pf[kk], o[d_]); __builtin_amdgcn_s_setprio(0); } while (0)
#define ATT_PV(stg_) do { \
        const u16* vp = (stg_) + 64 * KP + r * VP + 8 * hh; \
        bf16x8 va[4], vb[4]; \
        ATT_LDV(va, 0); __builtin_amdgcn_sched_barrier(0); \
        ATT_LDV(vb, 1); __builtin_amdgcn_sched_barrier(0); ATT_MM4(0, va); __builtin_amdgcn_sched_barrier(0); \
        ATT_LDV(va, 2); __builtin_amdgcn_sched_barrier(0); ATT_MM4(1, vb); __builtin_amdgcn_sched_barrier(0); \
        ATT_LDV(vb, 3); __builtin_amdgcn_sched_barrier(0); ATT_MM4(2, va); __builtin_amdgcn_sched_barrier(0); \
        ATT_MM4(3, vb); } while (0)
    bf16x8 pf[4];
    bool pend = false;
    bool first_ = true;
    ATT_ISSUE(ra, 0); ATT_COMMIT(ra, st0);
    asm volatile("" :: "v"(qf[0]), "v"(qf[1]), "v"(qf[2]), "v"(qf[3]));
    __syncthreads();
    int sc = 0;
#define ATT_ITER(j_, IS_, CS_) do { \
        u16* cur = st0 + sc * ATT_STAGE; \
        const int sp = sc == 0 ? 2 : sc - 1, sn = sc == 2 ? 0 : sc + 1; \
        u16* prv = st0 + sp * ATT_STAGE; u16* nxt = st0 + sn * ATT_STAGE; \
        if ((j_) + 1 < nkv) ATT_ISSUE(ra, (j_) + 1); \
        const bool act = 64 * (j_) <= qw0 + 31; \
        const bool heavy = (((j_) & 15) == 0) || first_; \
        f32x16 s0, s1; \
        if (act) { if (heavy) { ATT_QK(cur, 0.f); } else { ATT_QK(cur, -mrun); } }        \
        if (pend) { ATT_PV(prv); pend = false; }                                              \
        if (act) { if (heavy) { ATT_SM_HEAVY(j_); } else { ATT_SM_LIGHT(j_); } first_ = false; pend = true; }     \
        if ((j_) + 1 < nkv) ATT_COMMIT(ra, nxt); \
        __syncthreads(); \
        sc = sn; } while (0)
    for (int j = 0; j < nkv; j += 2) {
        ATT_ITER(j, ra, rb);
        ATT_ITER(j + 1, rb, ra);
    }
    if (pend) { const int sl = sc == 0 ? 2 : sc - 1; ATT_PV(st0 + sl * ATT_STAGE); }
    __syncthreads();
    const float ltot = lrun + __shfl_xor(lrun, 32);
    const float inv = 1.f / ltot;
    float* ex = (float*)lds;
    if (m == 1) {
#pragma unroll
        for (int d = 0; d < 4; ++d)
#pragma unroll
            for (int e = 0; e < 16; ++e) ex[(wq * 64 + d * 16 + e) * 64 + lane] = o[d][e] * inv;
    }
    __syncthreads();
    if (m == 0) {
        const float lam = ((const float*)(P.ws + OFF_SCAL))[layer];
        const float lam_init = 0.8f - 0.6f * __expf(-0.3f * (float)layer);
        float ss = 0.f;
#pragma unroll
        for (int d = 0; d < 4; ++d)
#pragma unroll
            for (int e = 0; e < 16; ++e) { const float v = o[d][e] * inv - lam * ex[(wq * 64 + d * 16 + e) * 64 + lane]; o[d][e] = v; ss += v * v; }
        ss += __shfl_xor(ss, 32);
        const float scl = rsqrtf(ss * (1.f / 128.f) + 1e-6f) * (1.f - lam_init);
        const float* ng = P.in[21] + layer * 128;
        u16* mix = (u16*)(P.ws + OFF_ABUF) + (size_t)(b * SEQ + q) * DM + 512 + head * 128;
#pragma unroll
        for (int d = 0; d < 4; ++d)
#pragma unroll
            for (int qd = 0; qd < 4; ++qd) {
                const int dv0 = 32 * d + 8 * qd + 4 * hh;
                const float4 g4 = *(const float4*)(ng + dv0);
                uint2 pk; pk.x = pack2(o[d][4 * qd] * scl * g4.x, o[d][4 * qd + 1] * scl * g4.y); pk.y = pack2(o[d][4 * qd + 2] * scl * g4.z, o[d][4 * qd + 3] * scl * g4.w);
                *(uint2*)(mix + dv0) = pk;
            }
    }
    __syncthreads();
#undef ATT_ISSUE
#undef ATT_COMMIT
#undef ATT_QK
#undef ATT_MASK
#undef ATT_PACK
#undef ATT_SM_HEAVY
#undef ATT_SM_LIGHT
#undef ATT_PV
#undef ATT_ITER
#undef ATT_LDV
#undef ATT_MM4
}
DI void phase_attn(const Params& P, int layer, char* lds, int cidx = 0) {
    unsigned* ctr = (unsigned*)(P.ws + OFF_CTL + 16384 + (layer + 2 * cidx) * 256);
    volatile int* slot = (volatile int*)(lds + LDS_BYTES - 32);
    for (;;) {
        if (threadIdx.x == 0) *slot = (int)atomicAdd(ctr, 1u);
        __syncthreads();
        const int idx = *slot;
        __syncthreads();
        if (idx >= 1024) break;
        const int qb = 63 - (idx >> 4), bh = idx & 15;
        attn_item(P, layer, bh >> 2, bh & 3, qb, lds);
    }
}

DI void sort16_desc(float (&a)[16]) {
#pragma unroll
    for (int k = 2; k <= 16; k <<= 1)
#pragma unroll
        for (int j = k >> 1; j > 0; j >>= 1)
#pragma unroll
            for (int i = 0; i < 16; ++i) {
                const int l = i ^ j;
                if (l > i) {
                    const float hi = fmaxf(a[i], a[l]), lo = fminf(a[i], a[l]);
                    if ((i & k) == 0) { a[i] = hi; a[l] = lo; } else { a[i] = lo; a[l] = hi; }
                }
            }
}
DI void merge_top16(float (&a)[16], const float (&b)[16]) {
#pragma unroll
    for (int i = 0; i < 16; ++i) a[i] = fmaxf(a[i], b[15 - i]);
#pragma unroll
    for (int j = 8; j > 0; j >>= 1)
#pragma unroll
        for (int i = 0; i < 16; ++i) {
            const int l = i ^ j;
            if (l > i) { const float hi = fmaxf(a[i], a[l]), lo = fminf(a[i], a[l]); a[i] = hi; a[l] = lo; }
        }
}
DI void phase_topk(const Params& P, int layer, char* lds) {
    const int w = threadIdx.x >> 6, lane = threadIdx.x & 63, r = lane & 31, hh = lane >> 5;
    const u16* PQ = (const u16*)(P.ws + OFF_PQ);
    const u16* KEYS = (const u16*)(P.ws + OFF_KEYS) + (size_t)layer * 8 * 2 * 128 * 64;
    unsigned* pk32 = (unsigned*)(P.ws + OFF_PICKE);
    unsigned* Hs = (unsigned*)lds;
    unsigned char* mytab = (unsigned char*)(lds + 4096 + threadIdx.x * 32);
    for (int it0 = blockIdx.x * 8; it0 < 8192; it0 += gridDim.x * 8) {
        const int it = it0 + w;
        const int tile = it >> 3, h = it & 7; const int tok = tile * 32 + r;
        float sv[2][16];
#pragma unroll
        for (int p = 0; p < 2; ++p) {
            bf16x8 bq[4];
            const u16* qp = PQ + (size_t)tok * 1024 + h * 128 + p * 64 + hh * 8;
#pragma unroll
            for (int s = 0; s < 4; ++s) bq[s] = ld8(qp + 16 * s);
            float blk[4][16];
#pragma unroll
            for (int kb = 0; kb < 4; ++kb) {
                f32x16 acc;
#pragma unroll
                for (int e = 0; e < 16; ++e) acc[e] = 0.f;
                const u16* kp = KEYS + ((size_t)((h * 2 + p) * 128 + 32 * kb + r)) * 64 + hh * 8;
#pragma unroll
                for (int s = 0; s < 4; ++s) acc = MFMA32(ld8(kp + 16 * s), bq[s], acc);
#pragma unroll
                for (int e = 0; e < 16; ++e) {
                    const unsigned key = 32 * kb + (e & 3) + 8 * (e >> 2) + 4 * hh;
                    blk[kb][e] = __uint_as_float((__float_as_uint(acc[e]) & ~0x7Fu) | key);
                }
                sort16_desc(blk[kb]);
            }
            merge_top16(blk[0], blk[1]); merge_top16(blk[2], blk[3]); merge_top16(blk[0], blk[2]);
            float oth[16];
#pragma unroll
            for (int k = 0; k < 16; ++k) oth[k] = __shfl_xor(blk[0][k], 32);
            merge_top16(blk[0], oth);
#pragma unroll
            for (int k = 0; k < 16; ++k) sv[p][k] = blk[0][k];
        }
        {
            uint4 t0, t1; unsigned* a0 = (unsigned*)&t0; unsigned* a1 = (unsigned*)&t1;
#pragma unroll
            for (int q = 0; q < 4; ++q) {
                a0[q] = (__float_as_uint(sv[0][4 * q]) & 0x7Fu) | ((__float_as_uint(sv[0][4 * q + 1]) & 0x7Fu) << 8) | ((__float_as_uint(sv[0][4 * q + 2]) & 0x7Fu) << 16) | ((__float_as_uint(sv[0][4 * q + 3]) & 0x7Fu) << 24);
                a1[q] = (__float_as_uint(sv[1][4 * q]) & 0x7Fu) | ((__float_as_uint(sv[1][4 * q + 1]) & 0x7Fu) << 8) | ((__float_as_uint(sv[1][4 * q + 2]) & 0x7Fu) << 16) | ((__float_as_uint(sv[1][4 * q + 3]) & 0x7Fu) << 24);
            }
            *(uint4*)mytab = t0; *(uint4*)(mytab + 16) = t1;
        }
        float top[16], b1[16], b2[16], b3[16];
#pragma unroll
        for (int k = 0; k < 16; ++k) { b1[k] = -INFINITY; b2[k] = -INFINITY; b3[k] = -INFINITY; }
        {
            int cnt = 0;
#pragma unroll
            for (int i = 0; i < 16; ++i)
#pragma unroll
                for (int j = 0; j < 16; ++j)
                    if ((i + 1) * (j + 1) <= 16) {
                        const float sm = __uint_as_float(__float_as_uint(sv[0][i]) & ~0x7Fu) + __uint_as_float(__float_as_uint(sv[1][j]) & ~0x7Fu);
                        const float pk = __uint_as_float((__float_as_uint(sm) & ~0xFFu) | (unsigned)(i * 16 + j));
                        if (i == 0) top[j] = pk;
                        else { if (cnt < 16) b1[cnt] = pk; else if (cnt < 32) b2[cnt - 16] = pk; else b3[cnt - 32] = pk; ++cnt; }
                    }
        }
        sort16_desc(b1); sort16_desc(b2);
        { const float hi = fmaxf(b3[0], b3[1]), lo = fminf(b3[0], b3[1]); b3[0] = hi; b3[1] = lo; }
        merge_top16(top, b1); merge_top16(b2, b3); merge_top16(top, b2);
        float ev[16]; float den = 0.f;
        const float mx = __uint_as_float(__float_as_uint(top[0]) & ~0xFFu);
#pragma unroll
        for (int k = 0; k < 16; ++k) { ev[k] = __expf(__uint_as_float(__float_as_uint(top[k]) & ~0xFFu) - mx); den += ev[k]; }
        const float rden = 1.f / den;
        unsigned ex[16]; unsigned c_lo = 0, c_hi = 0;
#pragma unroll
        for (int k = 0; k < 16; ++k) {
            const unsigned code = __float_as_uint(top[k]) & 0xFFu;
            ex[k] = (unsigned)mytab[code >> 4] * 128u + (unsigned)mytab[16 + (code & 15u)];
        }
        unsigned rk[16];
#pragma unroll
        for (int k = 0; k < 16; ++k) {
            const unsigned pt = ex[k] >> 11; const unsigned sh = 8u * (pt & 3u); const bool islo = pt < 4u;
            rk[k] = ((islo ? c_lo : c_hi) >> sh) & 0xFFu;
            c_lo += islo ? (1u << sh) : 0u; c_hi += islo ? 0u : (1u << sh);
        }
        if (hh == 0) { Hs[(r * 8 + h) * 2] = c_lo; Hs[(r * 8 + h) * 2 + 1] = c_hi; }
        __syncthreads();
        unsigned tot_lo = 0, tot_hi = 0, bef_lo = 0, bef_hi = 0;
#pragma unroll
        for (int hq = 0; hq < 8; ++hq) {
            const unsigned a = Hs[(r * 8 + hq) * 2], b = Hs[(r * 8 + hq) * 2 + 1];
            tot_lo += a; tot_hi += b;
            if (hq < h) { bef_lo += a; bef_hi += b; }
        }
        unsigned offp[9]; offp[0] = 0;
#pragma unroll
        for (int pt = 0; pt < 8; ++pt) offp[pt + 1] = offp[pt] + (((pt < 4 ? tot_lo : tot_hi) >> (8 * (pt & 3))) & 0xFFu);
        if (h == 0 && hh == 0) {
            uint4 ob; ob.x = offp[0] | (offp[1] << 8) | (offp[2] << 16) | (offp[3] << 24); ob.y = offp[4] | (offp[5] << 8) | (offp[6] << 16) | (offp[7] << 24); ob.z = offp[8]; ob.w = 0;
            ((uint4*)(P.ws + OFF_OFFS))[tok] = ob;
        }
        const unsigned base_lo = (offp[0] | (offp[1] << 8) | (offp[2] << 16) | (offp[3] << 24)) + bef_lo;
        const unsigned base_hi = (offp[4] | (offp[5] << 8) | (offp[6] << 16) | (offp[7] << 24)) + bef_hi;
#pragma unroll
        for (int k = 0; k < 16; ++k) {
            if ((k >> 3) == hh) {
                const unsigned pt = ex[k] >> 11; const unsigned sh = 8u * (pt & 3u);
                const unsigned pos = (((pt < 4u ? base_lo : base_hi) >> sh) & 0xFFu) + rk[k];
                pk32[(size_t)tok * 128 + pos] = ((unsigned)f2bf(ev[k] * rden) << 16) | ex[k];
            }
        }
        __syncthreads();
    }
}

DI void fp8x16_to_f32(const uint4& u, float (&f)[16]) {
    const unsigned uu[4] = {u.x, u.y, u.z, u.w};
#pragma unroll
    for (int q = 0; q < 4; ++q) {
        const f32x2 lo = __builtin_amdgcn_cvt_pk_f32_fp8((int)uu[q], false), hi = __builtin_amdgcn_cvt_pk_f32_fp8((int)uu[q], true);
        f[4 * q] = lo[0]; f[4 * q + 1] = lo[1]; f[4 * q + 2] = hi[0]; f[4 * q + 3] = hi[1];
    }
}
template <int CTRL> DI int dpp_i(int v) { return __builtin_amdgcn_update_dpp(0, v, CTRL, 0xF, 0xF, true); }
template <int CTRL> DI float dpp_f(float v) { return __int_as_float(__builtin_amdgcn_update_dpp(0, __float_as_int(v), CTRL, 0xF, 0xF, true)); }
DI float wave_sum_fast(float v) {
    v += dpp_f<0xB1>(v); v += dpp_f<0x4E>(v); v += dpp_f<0x124>(v); v += dpp_f<0x128>(v);
    v += __shfl_xor(v, 16); v += __shfl_xor(v, 32); return v;
}
DI int rowreduce4(int p0, int p1, int p2, int p3, bool odd, bool bit1) {
    const int a01 = odd ? p1 : p0, b01 = odd ? p0 : p1;
    const int r01 = a01 + dpp_i<0xB1>(b01);
    const int a23 = odd ? p3 : p2, b23 = odd ? p2 : p3;
    const int r23 = a23 + dpp_i<0xB1>(b23);
    const int a = bit1 ? r23 : r01, b = bit1 ? r01 : r23;
    int r = a + dpp_i<0x4E>(b);
    r += dpp_i<0x124>(r);
    r += dpp_i<0x128>(r);
    return r;
}
DI int dot16_i8(const uint4& u, const int (&xq)[4]) {
    int p = __builtin_amdgcn_sdot4((int)u.x, xq[0], 0, false);
    p = __builtin_amdgcn_sdot4((int)u.y, xq[1], p, false);
    p = __builtin_amdgcn_sdot4((int)u.z, xq[2], p, false);
    p = __builtin_amdgcn_sdot4((int)u.w, xq[3], p, false);
    return p;
}
#define PEER_LOAD8(buf_, tab_, ev_, base_) do { _Pragma("unroll") for (int i_ = 0; i_ < 8; ++i_) { \
        const int e_ = __builtin_amdgcn_readlane((ev_), (base_) + i_); buf_[i_] = *(const uint4*)((tab_) + (size_t)e_ * 1024 + lane * 16); } } while (0)

#define RL(v_, i_) __builtin_amdgcn_readlane((int)(v_), (i_))
#define PEER_OFFS(p_, j_, BASE_, N_) do { \
        const unsigned ox_ = (unsigned)RL(myoff.x, j_), oy_ = (unsigned)RL(myoff.y, j_), oz_ = (unsigned)RL(myoff.z, j_); \
        const int p0_ = (p_), p1_ = (p_) + 1; \
        const unsigned lo_ = p0_ < 4 ? (ox_ >> (8 * p0_)) & 255u : (oy_ >> (8 * (p0_ - 4))) & 255u; \
        const unsigned hi_ = p1_ < 4 ? (ox_ >> (8 * p1_)) & 255u : p1_ < 8 ? (oy_ >> (8 * (p1_ - 4))) & 255u : (oz_ & 255u); \
        BASE_ = (int)lo_; N_ = (int)(hi_ - lo_); } while (0)
typedef __attribute__((ext_vector_type(4))) unsigned u32x4_t;
typedef __attribute__((ext_vector_type(2))) unsigned u32x2_t;
#define PEER_ROWS8B(buf_, rs_, ev_, b_) do { _Pragma("unroll") for (int k_ = 0; k_ < 8; ++k_) { \
        int li_ = 8 * (b_) + k_; li_ = li_ > 63 ? 63 : li_; const int eo_ = RL(ev_, li_); \
        buf_[k_] = __builtin_bit_cast(uint4, __builtin_amdgcn_raw_buffer_load_b128(rs_, lane * 16, eo_, 0)); } } while (0)
#define PEER_ROWS8(buf_, tab_, ev_, b_) do { _Pragma("unroll") for (int k_ = 0; k_ < 8; ++k_) { \
        int li_ = 8 * (b_) + k_; li_ = li_ > 63 ? 63 : li_; const int e_ = RL(ev_, li_); buf_[k_] = *(const uint4*)((tab_) + (size_t)e_ * 1024 + lane * 16); } } while (0)

struct PeerMeta { int e; float g, su, sx, sv; int slot; int idx; int valid; };
DI void phase_peer_u(const Params& P, int layer, char* lds) {
    const int w = threadIdx.x >> 6, lane = threadIdx.x & 63;
    const uint8_t* UT = (const uint8_t*)(P.ws + OFF_UTAB) + (size_t)layer * 16384 * 1024;
    const __amdgpu_buffer_rsrc_t urs = __builtin_amdgcn_make_buffer_rsrc((void*)UT, 0, 16384 * 1024, 0x00020000);
    const unsigned* pk32 = (const unsigned*)(P.ws + OFF_PICKE);
    const float2* sc2 = (const float2*)(P.ws + OFF_V8SC) + layer * 16384;
    float* coefb = (float*)(P.ws + OFF_COEF);
    const uint4* XQ4 = (const uint4*)(P.ws + OFF_XQ); const float* SXp = (const float*)(P.ws + OFF_SX);
    const int stride = gridDim.x * 8, t_first = blockIdx.x * 8 + w;
    const int ntok = t_first < NT ? (NT - t_first + stride - 1) / stride : 0;
    uint4* xql = (uint4*)(lds + w * 16384);
#pragma unroll 1
    for (int jg = 0; jg < ntok; jg += 16) {
        const int ng = (ntok - jg) < 16 ? (ntok - jg) : 16;
        for (int j = 0; j < ng; ++j) xql[j * 64 + lane] = XQ4[(size_t)(t_first + (jg + j) * stride) * 64 + lane];
        uint4 myoff = make_uint4(0, 0, 0, 0); float sxv = 0.f;
        if (lane < ng) { const int t = t_first + (jg + lane) * stride; myoff = ((const uint4*)(P.ws + OFF_OFFS))[t]; sxv = SXp[t]; }
#pragma unroll 1
        for (int p = 0; p < 8; ++p) {
            int nj, basej;
            {
                const unsigned lo = p < 4 ? (myoff.x >> (8 * p)) & 255u : (myoff.y >> (8 * (p - 4))) & 255u;
                const int p1 = p + 1;
                const unsigned hi = p1 < 4 ? (myoff.x >> (8 * p1)) & 255u : p1 < 8 ? (myoff.y >> (8 * (p1 - 4))) & 255u : (myoff.z & 255u);
                basej = (int)lo; nj = lane < ng ? (int)(hi - lo) : 0;
            }
            int pend = nj;
#pragma unroll
            for (int o = 1; o < 16; o <<= 1) { const int tt = __shfl_up(pend, o); if (lane >= o) pend += tt; }
            const int pref = pend - nj;
            const int L = RL(pend, 15);
            if (L == 0) continue;
            const int nsb = (L + 63) >> 6;
#define U_META(sb_, M_) do { \
                const int f_ = 64 * (sb_) + 4 * (lane & 15) + (lane >> 4);        \
                M_.valid = f_ < L; const int fc_ = M_.valid ? f_ : L - 1; \
                int j_ = 0; \
                _Pragma("unroll") for (int jj_ = 0; jj_ < 15; ++jj_) j_ += (jj_ < ng - 1 && fc_ >= RL(pend, jj_)) ? 1 : 0; \
                const int pj_ = __shfl(pref, j_), bj_ = __shfl(basej, j_); \
                M_.slot = j_; M_.idx = (t_first + (jg + j_) * stride) * 128 + bj_ + (fc_ - pj_); \
                const unsigned pw_ = pk32[M_.idx]; const int ee_ = (int)(pw_ & 0xFFFFu); M_.e = (int)(((unsigned)ee_ << 10) | ((unsigned)j_ << 28)); M_.g = __uint_as_float(pw_ & 0xFFFF0000u); { const float2 s2_ = sc2[ee_]; M_.su = s2_.x; M_.sv = s2_.y; } M_.sx = __shfl(sxv, j_); } while (0)
#define U_LOADB(buf_, M_, b_) do { _Pragma("unroll") for (int h_ = 0; h_ < 2; ++h_) { \
                const int pk_ = __builtin_amdgcn_ds_bpermute(((lane & 48) + 2 * (b_) + h_) << 2, M_.e); \
                const int vo_ = (pk_ & 0x0FFFFFFF) + (lane & 15) * 16; \
                _Pragma("unroll") for (int c_ = 0; c_ < 4; ++c_) buf_[4 * h_ + c_] = __builtin_bit_cast(uint4, __builtin_amdgcn_raw_buffer_load_b128(urs, vo_ + 256 * c_, 0, 0)); } } while (0)
            PeerMeta cur, nxt;
            U_META(0, cur);
            uint4 bufA[8], bufB[8], bufC[8], bufD[8];
            U_LOADB(bufA, cur, 0); U_LOADB(bufB, cur, 1); U_LOADB(bufC, cur, 2);
            int xslot = -1; uint4 xc0 = make_uint4(0, 0, 0, 0), xc1 = xc0, xc2 = xc0, xc3 = xc0;
#pragma unroll 1
            for (int sb = 0; sb < nsb; ++sb) {
                const bool has_next = sb + 1 < nsb;
                if (has_next) U_META(sb + 1, nxt); else nxt = cur;
                int md = 0;
#define U_DOT4(acc_, r_, x_) do { acc_ = __builtin_amdgcn_sdot4((int)(r_).x, (int)(x_).x, acc_, false); acc_ = __builtin_amdgcn_sdot4((int)(r_).y, (int)(x_).y, acc_, false); \
                    acc_ = __builtin_amdgcn_sdot4((int)(r_).z, (int)(x_).z, acc_, false); acc_ = __builtin_amdgcn_sdot4((int)(r_).w, (int)(x_).w, acc_, false); } while (0)
#define U_STEP(k_, cur_, pf_) do { \
                    if ((k_) + 3 < 8) { U_LOADB(pf_, cur, (k_) + 3); } else if (has_next) { U_LOADB(pf_, nxt, (k_) + 3 - 8); } \
                    asm volatile("" ::: "memory"); __builtin_amdgcn_sched_barrier(0); \
                    _Pragma("unroll") for (int h_ = 0; h_ < 2; ++h_) { \
                        const int q_ = 2 * (k_) + h_; \
                        const int pk_ = __builtin_amdgcn_ds_bpermute(((lane & 48) + q_) << 2, cur.e); \
                        const int sl_ = (int)((unsigned)pk_ >> 28); \
                        if (__builtin_amdgcn_ballot_w64(sl_ != xslot) != 0ull) {        \
                            const uint4* xp_ = xql + sl_ * 64 + (lane & 15); \
                            xc0 = xp_[0]; xc1 = xp_[16]; xc2 = xp_[32]; xc3 = xp_[48]; xslot = sl_; } \
                        int a0_ = 0, a1_ = 0; \
                        U_DOT4(a0_, cur_[4 * h_ + 0], xc0); U_DOT4(a1_, cur_[4 * h_ + 1], xc1); U_DOT4(a0_, cur_[4 * h_ + 2], xc2); U_DOT4(a1_, cur_[4 * h_ + 3], xc3); \
                        int r_ = a0_ + a1_; \
                        r_ += dpp_i<0xB1>(r_); r_ += dpp_i<0x4E>(r_); r_ += dpp_i<0x124>(r_); r_ += dpp_i<0x128>(r_); \
                        md = ((lane & 15) == q_) ? r_ : md; } \
                    asm volatile("" ::: "memory"); __builtin_amdgcn_sched_barrier(0); } while (0)
                U_STEP(0, bufA, bufD); U_STEP(1, bufB, bufA); U_STEP(2, bufC, bufB); U_STEP(3, bufD, bufC);
                U_STEP(4, bufA, bufD); U_STEP(5, bufB, bufA); U_STEP(6, bufC, bufB); U_STEP(7, bufD, bufC);
#undef U_STEP
#undef U_DOT4
                const float dot = (float)md * cur.su * cur.sx;
                const float coef = cur.g * gelu_tanh(dot) * cur.sv;
                if (cur.valid) coefb[cur.idx] = coef;
                cur = nxt;
            }
#undef U_LOADB
#undef U_META
        }
    }
}

DI void peer_token_epilogue(const Params& P, int layer, int t, int lane, const f32x2 (&y2)[8], const float* hin, float* hout, bool last, const float* wab_lds) {
    u16* abuf = (u16*)(P.ws + OFF_ABUF);
    float4 v[4];
    const float4* h4 = (const float4*)(hin + (size_t)t * DM + lane * 16);
#pragma unroll
    for (int i = 0; i < 4; ++i) { v[i] = h4[i]; v[i].x += y2[2 * i][0]; v[i].y += y2[2 * i][1]; v[i].z += y2[2 * i + 1][0]; v[i].w += y2[2 * i + 1][1]; }
    float ss = 0.f;
#pragma unroll
    for (int i = 0; i < 4; ++i) ss += v[i].x * v[i].x + v[i].y * v[i].y + v[i].z * v[i].z + v[i].w * v[i].w;
    ss = wave_sum_fast(ss);
    const float rstd = rsqrtf(ss * (1.f / DM) + 1e-6f);
    if (last) {
        const float4* g4 = (const float4*)(P.in[28]) + lane * 4;
        float4* o4 = (float4*)(hout + (size_t)t * DM + lane * 16);
#pragma unroll
        for (int i = 0; i < 4; ++i) { const float4 g = g4[i]; o4[i] = make_float4(v[i].x * rstd * g.x, v[i].y * rstd * g.y, v[i].z * rstd * g.z, v[i].w * rstd * g.w); }
    } else {
        float4* o4 = (float4*)(hout + (size_t)t * DM + lane * 16);
#pragma unroll
        for (int i = 0; i < 4; ++i) o4[i] = v[i];
        const float4* g4 = (const float4*)(P.in[1] + (layer + 1) * DM) + lane * 4;
        float vn[16];
#pragma unroll
        for (int i = 0; i < 4; ++i) { const float4 g = g4[i]; vn[4 * i] = v[i].x * rstd * g.x; vn[4 * i + 1] = v[i].y * rstd * g.y; vn[4 * i + 2] = v[i].z * rstd * g.z; vn[4 * i + 3] = v[i].w * rstd * g.w; }
        uint4 o0, o1;
        o0.x = pack2(vn[0], vn[1]); o0.y = pack2(vn[2], vn[3]); o0.z = pack2(vn[4], vn[5]); o0.w = pack2(vn[6], vn[7]);
        o1.x = pack2(vn[8], vn[9]); o1.y = pack2(vn[10], vn[11]); o1.z = pack2(vn[12], vn[13]); o1.w = pack2(vn[14], vn[15]);
        *(uint4*)(abuf + (size_t)t * DM + lane * 16) = o0; *(uint4*)(abuf + (size_t)t * DM + lane * 16 + 8) = o1;
        const float4* wab = (const float4*)wab_lds;
        float myacc = 0.f;
#pragma unroll 1
        for (int j = 0; j < 8; ++j) {
            float a = 0.f;
#pragma unroll
            for (int i = 0; i < 4; ++i) { const float4 ww = wab[j * 256 + lane * 4 + i]; a += vn[4 * i] * ww.x + vn[4 * i + 1] * ww.y + vn[4 * i + 2] * ww.z + vn[4 * i + 3] * ww.w; }
            a = wave_sum_fast(a);
            myacc = (lane == j) ? a : myacc;
        }
        const float bb = __shfl(myacc, (lane + 4) & 63);
        if (lane < 4) {
            const int L1 = layer + 1;
            const float a = myacc;
            const float xx = a + P.in[5][L1 * 4 + lane];
            const float sp = xx > 20.f ? xx : log1pf(__expf(xx));
            ((float*)(P.ws + OFF_GG))[t * 4 + lane] = -__expf(P.in[4][L1 * 4 + lane]) * sp;
            ((float*)(P.ws + OFF_BETA))[t * 4 + lane] = sigmoidf_(bb);
        }
    }
}

#ifndef V4_THR
#define V4_THR 0.25f
#endif
DI int peer_v_compact(int& e, float& c, bool small, int lane) {
    unsigned long long m = __builtin_amdgcn_ballot_w64(small);
    const unsigned long long lt = (1ull << lane) - 1ull;
    const int n8 = 64 - __popcll(m), n8r = (n8 + 7) & ~7;
    const int rank4 = __popcll(m & lt);
    if (small && rank4 < n8r - n8) small = false;
    m = __builtin_amdgcn_ballot_w64(small);
    const int pos = small ? n8r + __popcll(m & lt) : __popcll(~m & lt);
    e = __builtin_amdgcn_ds_permute(pos * 4, e);
    c = __int_as_float(__builtin_amdgcn_ds_permute(pos * 4, __float_as_int(c)));
    return n8r;
}
DI float wave_max(float v) {
    v = fmaxf(v, dpp_f<0xB1>(v)); v = fmaxf(v, dpp_f<0x4E>(v)); v = fmaxf(v, dpp_f<0x124>(v)); v = fmaxf(v, dpp_f<0x128>(v));
    v = fmaxf(v, __shfl_xor(v, 16)); v = fmaxf(v, __shfl_xor(v, 32)); return v;
}
#define VDOT_PAIR1(Y_, j_, a_, b_, sl_, sh_) do { \
        const int p01_ = (int)__builtin_amdgcn_perm((unsigned)(b_), (unsigned)(a_), 0x05010400u), p23_ = (int)__builtin_amdgcn_perm((unsigned)(b_), (unsigned)(a_), 0x07030602u); \
        Y_[4 * (j_)] = __builtin_amdgcn_sdot4(p01_, sl_, Y_[4 * (j_)], false); Y_[4 * (j_) + 1] = __builtin_amdgcn_sdot4(p01_, sh_, Y_[4 * (j_) + 1], false); \
        Y_[4 * (j_) + 2] = __builtin_amdgcn_sdot4(p23_, sl_, Y_[4 * (j_) + 2], false); Y_[4 * (j_) + 3] = __builtin_amdgcn_sdot4(p23_, sh_, Y_[4 * (j_) + 3], false); } while (0)
#define VDOT_PAIR(Y_, a0_, a1_, a2_, a3_, b0_, b1_, b2_, b3_, sl_, sh_) do { \
        VDOT_PAIR1(Y_, 0, a0_, b0_, sl_, sh_); VDOT_PAIR1(Y_, 1, a1_, b1_, sl_, sh_); VDOT_PAIR1(Y_, 2, a2_, b2_, sl_, sh_); VDOT_PAIR1(Y_, 3, a3_, b3_, sl_, sh_); } while (0)
struct VMeta { int e0, e1, cq0, cq1, nb0, nb1, zs; float f8, f4; };
DI VMeta peer_v_meta(int e0, int e1, float c0, float c1, int lane) {
    VMeta M;
    const float am = wave_max(fmaxf(fabsf(c0), fabsf(c1)));
    M.nb0 = peer_v_compact(e0, c0, fabsf(c0) < V4_THR * am, lane);
    M.nb1 = peer_v_compact(e1, c1, fabsf(c1) < V4_THR * am, lane);
    const bool q0 = lane >= M.nb0, q1 = lane >= M.nb1;
    if (q0) c0 *= (127.f / 7.f);
    if (q1) c1 *= (127.f / 7.f);
    const float m8 = wave_max(fmaxf(q0 ? 0.f : fabsf(c0), q1 ? 0.f : fabsf(c1)));
    const float m4 = wave_max(fmaxf(q0 ? fabsf(c0) : 0.f, q1 ? fabsf(c1) : 0.f));
    const float r8 = m8 > 0.f ? 127.f / m8 : 0.f, r4 = m4 > 0.f ? 127.f / m4 : 0.f;
    M.cq0 = (int)rintf(c0 * (q0 ? r4 : r8)); M.cq1 = (int)rintf(c1 * (q1 ? r4 : r8));
    int zs = (q0 ? M.cq0 : 0) + (q1 ? M.cq1 : 0);
    for (int o = 32; o > 0; o >>= 1) zs += __shfl_xor(zs, o);
    M.zs = zs; M.e0 = e0; M.e1 = e1; M.f8 = m8 * (1.f / 127.f); M.f4 = m4 * (1.f / 127.f);
    return M;
}
DI void phase_peer_v(const Params& P, int layer, const float* hin, float* hout, bool last, char* lds) {
    const int w = threadIdx.x >> 6, lane = threadIdx.x & 63;
    if (!last) { const float4* src = (const float4*)(P.ws + OFF_WAB) + (layer + 1) * 8 * 256; for (int i = threadIdx.x; i < 2048; i += NTHR) ((float4*)lds)[i] = src[i]; }
    __syncthreads();
    const uint8_t* VTb = (const uint8_t*)(P.ws + OFF_VTAB) + (size_t)layer * 16384 * 1024;
    const uint8_t* V4b = (const uint8_t*)(P.ws + OFF_V4TAB) + (size_t)layer * 16384 * 512;
    const __amdgpu_buffer_rsrc_t v8rs = __builtin_amdgcn_make_buffer_rsrc((void*)VTb, 0, 16384 * 1024, 0x00020000);
    const __amdgpu_buffer_rsrc_t v4rs = __builtin_amdgcn_make_buffer_rsrc((void*)V4b, 0, 16384 * 512, 0x00020000);
    const unsigned* pk32 = (const unsigned*)(P.ws + OFF_PICKE); const float* coefb = (const float*)(P.ws + OFF_COEF);
    const int stride = gridDim.x * 8;
    int t = blockIdx.x * 8 + w;
    if (t >= NT) return;
    uint4 bufA[8], bufB[8], bufC[8], bufD[8];
#define V_IS4(M_, k_) (8 * ((k_) & 7) >= (((k_) >> 3) ? M_.nb1 : M_.nb0))
#define V_LOAD(buf_, M_, k_) do { \
        if (V_IS4(M_, k_)) { _Pragma("unroll") for (int i_ = 0; i_ < 8; ++i_) { const int e_ = RL(((k_) >> 3) ? M_.e1 : M_.e0, 8 * ((k_) & 7) + i_); \
                const uint2 t_ = *(const uint2*)(V4b + (size_t)e_ * 512 + lane * 8); buf_[i_].x = t_.x; buf_[i_].y = t_.y; } } \
        else { _Pragma("unroll") for (int i_ = 0; i_ < 8; ++i_) { const int e_ = RL(((k_) >> 3) ? M_.e1 : M_.e0, 8 * ((k_) & 7) + i_); \
                buf_[i_] = *(const uint4*)(VTb + (size_t)e_ * 1024 + lane * 16); } } } while (0)
    VMeta cur = peer_v_meta((int)(pk32[(size_t)t * 128 + lane] & 0xFFFFu), (int)(pk32[(size_t)t * 128 + 64 + lane] & 0xFFFFu), coefb[(size_t)t * 128 + lane], coefb[(size_t)t * 128 + 64 + lane], lane);
    V_LOAD(bufA, cur, 0); V_LOAD(bufB, cur, 1); V_LOAD(bufC, cur, 2);
#pragma unroll 1
    for (; t < NT; t += stride) {
        const int tn = t + stride; const bool has_next = tn < NT;
        int ne0 = 0, ne1 = 0; float nc0 = 0.f, nc1 = 0.f;
        if (has_next) { ne0 = (int)(pk32[(size_t)tn * 128 + lane] & 0xFFFFu); ne1 = (int)(pk32[(size_t)tn * 128 + 64 + lane] & 0xFFFFu); nc0 = coefb[(size_t)tn * 128 + lane]; nc1 = coefb[(size_t)tn * 128 + 64 + lane]; }
        int y8[16], y4[16];
#pragma unroll
        for (int i = 0; i < 16; ++i) { y8[i] = 0; y4[i] = 0; }
#define V_STEP(k_, cur_, pf_) do { \
            if ((k_) + 3 < 16) { V_LOAD(pf_, cur, (k_) + 3); } \
            asm volatile("" ::: "memory"); __builtin_amdgcn_sched_barrier(0); \
            if (V_IS4(cur, k_)) { \
                _Pragma("unroll") for (int i = 0; i < 8; i += 2) { \
                    const int ca_ = RL(((k_) >> 3) ? cur.cq1 : cur.cq0, 8 * ((k_) & 7) + i) & 0xFF, cb_ = RL(((k_) >> 3) ? cur.cq1 : cur.cq0, 8 * ((k_) & 7) + i + 1) & 0xFF; \
                    const int sl_ = ca_ | (cb_ << 8), sh_ = sl_ << 16; \
                    const unsigned xa0 = cur_[i].x, xa1 = cur_[i].y, xb0 = cur_[i + 1].x, xb1 = cur_[i + 1].y; \
                    VDOT_PAIR(y4, xa0 & 0x0F0F0F0Fu, (xa0 >> 4) & 0x0F0F0F0Fu, xa1 & 0x0F0F0F0Fu, (xa1 >> 4) & 0x0F0F0F0Fu, \
                              xb0 & 0x0F0F0F0Fu, (xb0 >> 4) & 0x0F0F0F0Fu, xb1 & 0x0F0F0F0Fu, (xb1 >> 4) & 0x0F0F0F0Fu, sl_, sh_); } \
            } else { \
                _Pragma("unroll") for (int i = 0; i < 8; i += 2) { \
                    const int ca_ = RL(((k_) >> 3) ? cur.cq1 : cur.cq0, 8 * ((k_) & 7) + i) & 0xFF, cb_ = RL(((k_) >> 3) ? cur.cq1 : cur.cq0, 8 * ((k_) & 7) + i + 1) & 0xFF; \
                    const int sl_ = ca_ | (cb_ << 8), sh_ = sl_ << 16; \
                    VDOT_PAIR(y8, cur_[i].x, cur_[i].y, cur_[i].z, cur_[i].w, cur_[i + 1].x, cur_[i + 1].y, cur_[i + 1].z, cur_[i + 1].w, sl_, sh_); } } \
            asm volatile("" ::: "memory"); __builtin_amdgcn_sched_barrier(0); } while (0)
        V_STEP(0, bufA, bufD); V_STEP(1, bufB, bufA); V_STEP(2, bufC, bufB); V_STEP(3, bufD, bufC);
        V_STEP(4, bufA, bufD); V_STEP(5, bufB, bufA); V_STEP(6, bufC, bufB); V_STEP(7, bufD, bufC);
        V_STEP(8, bufA, bufD); V_STEP(9, bufB, bufA); V_STEP(10, bufC, bufB); V_STEP(11, bufD, bufC);
        V_STEP(12, bufA, bufD); V_STEP(13, bufB, bufA); V_STEP(14, bufC, bufB); V_STEP(15, bufD, bufC);
#undef V_STEP
        f32x2 y2[8];
#pragma unroll
        for (int i = 0; i < 8; ++i) y2[i] = (f32x2){(float)y8[2 * i] * cur.f8 + (float)(y4[2 * i] - 8 * cur.zs) * cur.f4, (float)y8[2 * i + 1] * cur.f8 + (float)(y4[2 * i + 1] - 8 * cur.zs) * cur.f4};
        if (has_next) {
            cur = peer_v_meta(ne0, ne1, nc0, nc1, lane);
            V_LOAD(bufA, cur, 0); V_LOAD(bufB, cur, 1); V_LOAD(bufC, cur, 2);
        }
        asm volatile("" ::: "memory"); __builtin_amdgcn_sched_barrier(0);
        peer_token_epilogue(P, layer, t, lane, y2, hin, hout, last, (const float*)lds);
    }
#undef V_LOAD
#undef V_IS4
}

#define XB_TMO      128
#define XB_XCNT(j)  (256  + 64 * (j))
#define XB_XSUB(j)  (1280 + 64 * (j))
#define XB_XGEN(j)  (2304 + 64 * (j))
#define XB_TOP      3328
#define XB_TOPGEN   3392
#define XCD_BAR_WORDS 3456
#define XB_SPIN_CAP (1u << 22)
#define LAS __attribute__((address_space(3)))
DI unsigned xb_ld(unsigned* p)              { return __hip_atomic_load(p, __ATOMIC_RELAXED, __HIP_MEMORY_SCOPE_AGENT); }
DI unsigned xb_add(unsigned* p, unsigned v) { return __hip_atomic_fetch_add(p, v, __ATOMIC_RELAXED, __HIP_MEMORY_SCOPE_AGENT); }
DI unsigned xb_xcc_id() { return (unsigned)__builtin_amdgcn_s_getreg((3 << 11) | 20) & 0xFu; }
#define XB_SPIN(cond, bar) do { unsigned _sp = 0; while (cond) { __builtin_amdgcn_s_sleep(1); \
    if ((++_sp & 255u) == 0u) { if (xb_ld(&(bar)[XB_TMO])) break; if (_sp > XB_SPIN_CAP) { atomicAdd(&(bar)[XB_TMO], 1u); break; } } } } while (0)
struct XcdBarrier { unsigned* bar; unsigned x; volatile LAS unsigned* st; };
DI XcdBarrier xcd_barrier_post(unsigned* bar, volatile LAS unsigned* st) {
    XcdBarrier b; b.bar = bar; b.x = xb_xcc_id(); b.st = st;
    if (threadIdx.x == 0) (void)xb_add(&bar[XB_XCNT(b.x)], 1u);
    return b;
}
DI void xcd_barrier_complete(unsigned* bar, unsigned x, unsigned& nloc, unsigned& nx) {
    const unsigned G = gridDim.x * gridDim.y * gridDim.z;
    unsigned sum, cnt, mine, sp = 0u;
    for (;;) {
        sum = 0u; cnt = 0u; mine = 0u;
#pragma unroll
        for (unsigned j = 0; j < 16; ++j) { const unsigned c = xb_ld(&bar[XB_XCNT(j)]); sum += c; cnt += (c > 0u) ? 1u : 0u; mine = (j == x) ? c : mine; }
        if (sum == G) break;
        __builtin_amdgcn_s_sleep(1);
        if ((++sp & 255u) == 0u) { if (xb_ld(&bar[XB_TMO])) break; if (sp > XB_SPIN_CAP) { atomicAdd(&bar[XB_TMO], 1u); break; } }
    }
    nloc = mine > 0u ? mine : 1u; nx = cnt > 0u ? cnt : 1u;
}
DI void xcd_barrier(const XcdBarrier& b) {
    asm volatile("s_waitcnt vmcnt(0)" ::: "memory");
    __syncthreads();
    if (threadIdx.x == 0) {
        unsigned* bar = b.bar;
        __builtin_amdgcn_s_waitcnt(0);
        unsigned nloc = b.st[0], nx = b.st[1];
        if (nloc == 0u) { xcd_barrier_complete(bar, b.x, nloc, nx); b.st[0] = nloc; b.st[1] = nx; }
        const unsigned old = xb_add(&bar[XB_XSUB(b.x)], 1u);
        const unsigned gen = old / nloc;
        if (old + 1u == (gen + 1u) * nloc) {
            __builtin_amdgcn_fence(__ATOMIC_RELEASE, "agent");
            asm volatile("s_waitcnt vmcnt(0)" ::: "memory");
            const unsigned og = xb_add(&bar[XB_TOP], 1u);
            const unsigned tg = og / nx;
            if (og + 1u == (tg + 1u) * nx) xb_add(&bar[XB_TOPGEN], 1u);
            else XB_SPIN(xb_ld(&bar[XB_TOPGEN]) == tg, bar);
            __builtin_amdgcn_fence(__ATOMIC_ACQUIRE, "agent");
            xb_add(&bar[XB_XGEN(b.x)], 1u);
            asm volatile("s_waitcnt vmcnt(0)" ::: "memory");
        } else {
            XB_SPIN(xb_ld(&bar[XB_XGEN(b.x)]) == gen, bar);
            __builtin_amdgcn_fence(__ATOMIC_ACQUIRE, "agent");
            asm volatile("s_waitcnt vmcnt(0)" ::: "memory");
        }
    }
    __syncthreads();
}

constexpr int PH_PER_LAYER = 11;
constexpr int NPHASE = 2 + 2 * PH_PER_LAYER;

#ifdef ONLY_SUB
#define SUB_ON(k) (ONLY_SUB == (k))
#else
#define SUB_ON(k) 1
#endif
DI void run_phase(const Params& P, int ph, char* lds) {
    char* ws = P.ws;
#if SUB_ON(100)
    if (ph == 0) { phase_prep(P, lds); return; }
#endif
#if SUB_ON(101)
    if (ph == 1) { phase_rms(P, P.in[0], P.in[1], (u16*)(ws + OFF_ABUF), 0); return; }
#endif
    if (ph < 2) return;
    const int layer = (ph - 2) / PH_PER_LAYER, sub = (ph - 2) % PH_PER_LAYER;
    const float* hin = layer == 0 ? P.in[0] : P.out;
    switch (sub) {
    #if SUB_ON(0)
    case 0: { EpiInProj8 e{ws}; phase_gemm((const u16*)(ws + OFF_ABUF), 1024, (const u16*)(ws + OFF_WINT) + (size_t)layer * PROJW * 1024, 1024, NT, PROJW, 1024, e, lds); } break;

#endif
    #if SUB_ON(1)
    case 1:
        for (int it = blockIdx.x; it < 2048; it += gridDim.x) gdn_prep_item(P, layer, it, lds);
        phase_s5<false>(P, layer, lds);
        break;

#endif
    #if SUB_ON(2)
    case 2:
        if (blockIdx.x < 16) gdn_scan_chain(P, blockIdx.x, lds);
        else if (blockIdx.x < 24) {
            const int gt = (blockIdx.x - 16) * NTHR + threadIdx.x;
            if (gt < 4096) {
                const int bg = gt >> 6, n = gt & 63;
                const float2 a = ((const float2*)(ws + OFF_S5P + layer * S5P_LAYER + S5P_A64))[(bg & 15) * 64 + n];
                float2* st = (float2*)(ws + OFF_S5ST) + (size_t)bg * 128 * 64 + n;
                float xr = 0.f, xi = 0.f;
                for (int c = 0; c < 128; ++c) {
                    const float2 sv = st[c * 64];
                    st[c * 64] = make_float2(xr, xi);
                    const float nr = a.x * xr - a.y * xi + sv.x, ni = a.x * xi + a.y * xr + sv.y;
                    xr = nr; xi = ni;
                }
            }
        }
        __syncthreads();
        phase_attn(P, layer, lds);
        break;

#endif
    #if SUB_ON(3)
    case 3: phase_s5<true>(P, layer, lds); phase_gdn_norm(P, layer); break;

#endif
    #if SUB_ON(4)
    case 4: {
        EpiGlu8 e{(u16*)(ws + OFF_ABUF), P.in[16] + layer * 512};
        phase_gemm((const u16*)(ws + OFF_YS5), 256, (const u16*)(ws + OFF_GLUT) + (size_t)layer * 512 * 256, 256, NT, 512, 256, e, lds);
    } break;

#endif
    #if SUB_ON(5)
    case 5: { EpiResidual8 e{hin, P.out}; phase_gemm((const u16*)(ws + OFF_ABUF), 1024, (const u16*)(ws + OFF_WOUTT) + (size_t)layer * 1024 * 1024, 1024, NT, 1024, 1024, e, lds); } break;

#endif
    #if SUB_ON(6)
    case 6: phase_rms(P, P.out, P.in[23] + layer * DM, (u16*)(ws + OFF_ABUF), -1, true); break;

#endif
    #if SUB_ON(7)
    case 7: { pg8::EpiBf16<0> e{(u16*)(ws + OFF_PQ), 1024, nullptr, 0, 0}; phase_gemm((const u16*)(ws + OFF_ABUF), 1024, (const u16*)(ws + OFF_WQT) + (size_t)layer * 1024 * 1024, 1024, NT, 1024, 1024, e, lds); } break;

#endif
    #if SUB_ON(8)
    case 8: phase_topk(P, layer, lds); break;

#endif
    #if SUB_ON(9)
    case 9: phase_peer_u(P, layer, lds); break;
#endif
    #if SUB_ON(10)
    case 10: phase_peer_v(P, layer, P.out, P.out, layer == 1, lds); break;
#endif
    }
}

#ifndef USE_CG_SYNC
#define USE_CG_SYNC 0
#endif
#if USE_CG_SYNC
#define GRID_SYNC() cg::this_grid().sync()
#else
#define GRID_SYNC() xcd_barrier(xbar)
#endif
__global__ void __launch_bounds__(NTHR) mk_fwd(Params P, int ph_lo, int ph_hi) {
    extern __shared__ __attribute__((aligned(16))) char lds[];
#if !USE_CG_SYNC
    volatile LAS unsigned* xst = (volatile LAS unsigned*)(lds + LDS_BYTES - 16);
    if (threadIdx.x == 0) { xst[0] = 0u; xst[1] = 0u; }
    __syncthreads();
    XcdBarrier xbar = xcd_barrier_post((unsigned*)(P.ws + OFF_CTL), xst);
#endif
#ifndef DUP_SUB
#define DUP_SUB -1
#endif
#define PH(k) if (ph_lo <= (k) && (k) < ph_hi) { \
        if ((k) >= 2 && (((k) - 2) % PH_PER_LAYER == DUP_SUB || (DUP_SUB == 20 && ((k) - 2) % PH_PER_LAYER == 2))) { \
            if (DUP_SUB == 9) phase_peer_u(P, ((k) - 2) / PH_PER_LAYER, lds); \
            else if (DUP_SUB == 2) { if (blockIdx.x < 16) gdn_scan_chain(P, blockIdx.x, lds); } \
            else if (DUP_SUB == 20 && ((k) - 2) % PH_PER_LAYER == 2) { phase_attn(P, ((k) - 2) / PH_PER_LAYER, lds, 1); } \
            else if (DUP_SUB == 5) { if ((k) < 2 + PH_PER_LAYER) run_phase(P, (k), lds); } \
            else run_phase(P, (k), lds); } \
        if ((k) < 2 && DUP_SUB == 100 + (k)) run_phase(P, (k), lds); \
        run_phase(P, (k), lds); if (DUP_SUB == 99) GRID_SYNC(); if ((k) + 1 < ph_hi) GRID_SYNC(); }
    PH(0) PH(1) PH(2) PH(3) PH(4) PH(5) PH(6) PH(7) PH(8) PH(9) PH(10) PH(11)
    PH(12) PH(13) PH(14) PH(15) PH(16) PH(17) PH(18) PH(19) PH(20) PH(21) PH(22) PH(23)
#undef PH
}

extern "C" void kernel_launch(void* const* d_in, const int* in_sizes, int n_in, void* d_out, int out_size, void* d_ws, size_t ws_size, hipStream_t stream) {
    static int grid = 0;
    if (grid == 0) {
        int dev = 0, cus = 0, per_cu = 0;
        hipGetDevice(&dev);
        hipDeviceGetAttribute(&cus, hipDeviceAttributeMultiprocessorCount, dev);
        hipFuncSetAttribute((const void*)mk_fwd, hipFuncAttributeMaxDynamicSharedMemorySize, LDS_BYTES);
        hipOccupancyMaxActiveBlocksPerMultiprocessor(&per_cu, (const void*)mk_fwd, NTHR, LDS_BYTES);
        if (per_cu < 1) { fprintf(stderr, "occupancy query says %d blocks per CU\n", per_cu); per_cu = 1; }
        grid = cus;
        if (ws_size < OFF_END) { fprintf(stderr, "workspace too small: %zu < %zu\n", ws_size, (size_t)OFF_END); }
    }
    Params p{};
    for (int i = 0; i < 29; ++i) p.in[i] = (const float*)d_in[i];
    p.out = (float*)d_out; p.ws = (char*)d_ws;
#if MK_ONE_LAUNCH
    int lo = 0, hi = NPHASE;
    (void)hipMemsetAsync((char*)d_ws + OFF_CTL, 0, 65536, stream);
#if USE_CG_SYNC
    void* args[] = {&p, &lo, &hi};
    hipError_t e = hipLaunchCooperativeKernel((const void*)mk_fwd, dim3(grid), dim3(NTHR), args, LDS_BYTES, stream);
    if (e != hipSuccess) fprintf(stderr, "cooperative launch failed: %s\n", hipGetErrorString(e));
#else
    hipLaunchKernelGGL(mk_fwd, dim3(grid), dim3(NTHR), LDS_BYTES, stream, p, lo, hi);
#endif
#else
    for (int ph = 0; ph < NPHASE; ++ph) hipLaunchKernelGGL(mk_fwd, dim3(grid), dim3(NTHR), LDS_BYTES, stream, p, ph, ph + 1);
#endif
}
```

```cpp
#include <hip/hip_runtime.h>
#include <hip/hip_cooperative_groups.h>
#include <stdint.h>
#include <stdio.h>
namespace cg = cooperative_groups;

#ifndef MK_ONE_LAUNCH
#define MK_ONE_LAUNCH 1
#endif

#define DI __device__ __forceinline__
typedef unsigned short u16;
typedef __attribute__((ext_vector_type(8))) short bf16x8;
typedef __attribute__((ext_vector_type(4))) short bf16x4;
typedef __attribute__((ext_vector_type(16))) float f32x16;
typedef __attribute__((ext_vector_type(4))) float f32x4;
typedef __attribute__((ext_vector_type(2))) float f32x2;

constexpr int NT = 32768, DM = 1024, SEQ = 8192, NBATCH = 4;
constexpr int NTHR = 512;
constexpr int INW = 2824;
constexpr int PROJW = 2816;
constexpr float LOG2E = 1.4426950408889634f;

constexpr size_t OFF_CTL   = 0;
constexpr size_t OFF_WINT  = 65536;
constexpr size_t OFF_WOUTT = OFF_WINT  + (size_t)2 * PROJW * 1024 * 2;
constexpr size_t OFF_WQT   = OFF_WOUTT + (size_t)2 * 1024 * 1024 * 2;
constexpr size_t OFF_GLUT  = OFF_WQT   + (size_t)2 * 1024 * 1024 * 2;
constexpr size_t OFF_KEYS  = OFF_GLUT  + (size_t)2 * 512 * 256 * 2;
constexpr size_t OFF_WAB   = OFF_KEYS  + (size_t)2 * 8 * 2 * 128 * 64 * 2;
constexpr size_t OFF_S5P   = OFF_WAB   + (size_t)2 * 8 * 1024 * 4;
constexpr size_t S5P_LAYER = 262144;
constexpr size_t S5P_ABAR = 0, S5P_A64 = 8192, S5P_BRE = 16384, S5P_BIM = 16384 + 65536, S5P_CM = 16384 + 131072;
constexpr size_t OFF_SCAL  = OFF_S5P   + 2 * S5P_LAYER;
constexpr size_t OFF_UTAB  = OFF_SCAL  + 256;
constexpr size_t OFF_VTAB  = OFF_UTAB  + (size_t)2 * 16384 * 1024;
constexpr size_t OFF_USCALE = OFF_VTAB + (size_t)2 * 16384 * 1024;
constexpr size_t OFF_V4TAB = OFF_USCALE + (size_t)2 * 16384 * 4;
constexpr size_t OFF_V4SC  = OFF_V4TAB + (size_t)2 * 16384 * 512;
constexpr size_t OFF_V8SC  = OFF_V4SC + (size_t)2 * 16384 * 4;
constexpr size_t OFF_ABUF  = OFF_V8SC + (size_t)2 * 16384 * 8;
constexpr size_t OFF_GG    = OFF_ABUF  + (size_t)NT * 1024 * 2;
constexpr size_t OFF_BETA  = OFF_GG    + (size_t)NT * 4 * 4;
constexpr size_t OFF_PROJ  = OFF_BETA  + (size_t)NT * 4 * 4;
constexpr size_t OFF_QKV   = OFF_PROJ;
constexpr size_t OFF_Z     = OFF_QKV   + (size_t)NT * 768 * 2;
constexpr size_t OFF_US    = OFF_Z     + (size_t)NT * 256 * 2;
constexpr size_t OFF_QC    = OFF_US    + (size_t)NT * 256 * 2;
constexpr size_t OFF_KC    = OFF_QC    + (size_t)NT * 512 * 2;
constexpr size_t OFF_VT    = OFF_KC    + (size_t)NT * 512 * 2;
constexpr size_t OFF_GREC  = OFF_VT    + (size_t)NT * 512 * 2;
constexpr size_t GREC_BYTES = 40960;
constexpr size_t OFF_EGL   = OFF_GREC  + (size_t)2048 * GREC_BYTES;
constexpr size_t OFF_S5ST  = OFF_EGL   + 2048 * 4;
constexpr size_t OFF_YS5   = OFF_S5ST  + (size_t)8192 * 64 * 8;
constexpr size_t OFF_END   = OFF_YS5   + (size_t)NT * 256 * 2;
constexpr size_t OFF_GDNO  = OFF_QKV;
constexpr size_t OFF_PQ    = OFF_PROJ;
constexpr size_t OFF_PICKE = OFF_GREC;
constexpr size_t OFF_PICKG = OFF_GREC + (size_t)NT * 128 * 2;
constexpr size_t OFF_COEF  = OFF_PICKG + (size_t)NT * 128 * 4;
constexpr size_t OFF_OFFS  = OFF_COEF + (size_t)NT * 128 * 4;
constexpr size_t OFF_XQ    = OFF_OFFS + (size_t)NT * 16;
constexpr size_t OFF_PSV   = OFF_PROJ + (size_t)NT * 1024 * 2;
constexpr size_t OFF_PSU   = OFF_YS5;
constexpr size_t OFF_SX    = OFF_XQ + (size_t)NT * 1024;
static_assert(OFF_SX + (size_t)NT * 4 <= OFF_GREC + (size_t)2048 * GREC_BYTES, "peer scratch must fit in the dead GDN record region");
static_assert(OFF_END < (size_t)512 * 1024 * 1024, "workspace");

constexpr int LDS_BYTES = 148480 + 16;

struct Params {
    const float* in[29];
    float* out;
    char* ws;
};

DI u16 f2bf(float x) { unsigned u = __float_as_uint(x); u += 0x7fffu + ((u >> 16) & 1u); return (u16)(u >> 16); }
DI float bf2f(u16 v) { return __uint_as_float(((unsigned)v) << 16); }
DI unsigned pack2(float a, float b) { unsigned r; asm("v_cvt_pk_bf16_f32 %0, %1, %2" : "=v"(r) : "v"(a), "v"(b)); return r; }
DI float wave_sum(float v) { for (int o = 32; o > 0; o >>= 1) v += __shfl_xor(v, o); return v; }
DI float gelu_tanh(float x) { float u = 0.7978845608028654f * (x + 0.044715f * x * x * x); float e = __expf(2.f * u); float th = 1.f - 2.f / (e + 1.f); return 0.5f * x * (1.f + th); }
DI float sigmoidf_(float x) { return 1.f / (1.f + __expf(-x)); }
#define MFMA32(a, b, c) __builtin_amdgcn_mfma_f32_32x32x16_bf16((a), (b), (c), 0, 0, 0)
#define MFMA16(a, b, c) __builtin_amdgcn_mfma_f32_16x16x32_bf16((a), (b), (c), 0, 0, 0)
DI bf16x8 ld8(const void* p) { return *(const bf16x8*)p; }
DI bf16x8 cat4(bf16x4 lo, bf16x4 hi) { return __builtin_shufflevector(lo, hi, 0, 1, 2, 3, 4, 5, 6, 7); }
DI bf16x8 pack8(float a0, float a1, float a2, float a3, float a4, float a5, float a6, float a7) {
    uint4 u; u.x = pack2(a0, a1); u.y = pack2(a2, a3); u.z = pack2(a4, a5); u.w = pack2(a6, a7);
    return __builtin_bit_cast(bf16x8, u);
}

template <class CM>
DI void transpose_tile(const float* __restrict__ src, int src_ld, u16* __restrict__ dst, int K, int n0, int k0, CM colmap, float* tl) {
    const int tid = threadIdx.x;
    {
        const int nn = tid & 63;
        const int sc = colmap(n0 + nn);
#pragma unroll
        for (int i = 0; i < 8; ++i) { const int kk = (tid >> 6) + 8 * i; tl[kk * 65 + nn] = src[(size_t)(k0 + kk) * src_ld + sc]; }
    }
    __syncthreads();
    {
        const int kk = tid & 63;
#pragma unroll
        for (int i = 0; i < 8; ++i) { const int nn = (tid >> 6) + 8 * i; dst[(size_t)(n0 + nn) * K + k0 + kk] = f2bf(tl[kk * 65 + nn]); }
    }
    __syncthreads();
}

DI void phase_prep(const Params& P, char* lds) {
    float* tl = (float*)lds;
    char* ws = P.ws;
    const int bid = blockIdx.x, nb = gridDim.x, tid = threadIdx.x;
    for (int j = bid; j < 2496; j += nb) {
        if (j < 1408) {
            const int l = j / 704, r = j % 704, nt = r / 16, kt = r % 16;
            transpose_tile(P.in[2] + (size_t)l * 1024 * INW, INW, (u16*)(ws + OFF_WINT) + (size_t)l * PROJW * 1024, 1024, nt * 64, kt * 64,
                           [](int n) { return n < 1024 ? n : n + 8; }, tl);
        } else if (j < 1920) {
            const int q = j - 1408; const int l = q / 256, r = q % 256, nt = r / 16, kt = r % 16;
            transpose_tile(P.in[22] + (size_t)l * 1024 * 1024, 1024, (u16*)(ws + OFF_WOUTT) + (size_t)l * 1024 * 1024, 1024, nt * 64, kt * 64, [](int n) { return n; }, tl);
        } else if (j < 2432) {
            const int q = j - 1920; const int l = q / 256, r = q % 256, nt = r / 16, kt = r % 16;
            transpose_tile(P.in[24] + (size_t)l * 1024 * 1024, 1024, (u16*)(ws + OFF_WQT) + (size_t)l * 1024 * 1024, 1024, nt * 64, kt * 64, [](int n) { return n; }, tl);
        } else {
            const int q = j - 2432; const int l = q / 32, r = q % 32, nt = r / 4, kt = r % 4;
            transpose_tile(P.in[15] + (size_t)l * 256 * 512, 512, (u16*)(ws + OFF_GLUT) + (size_t)l * 512 * 256, 256, nt * 64, kt * 64,
                           [](int n) { const int tile = n >> 8, wi = n & 255; return wi < 128 ? 128 * tile + wi : 256 + 128 * tile + (wi - 128); }, tl);
        }
    }
    const size_t gtid = (size_t)bid * NTHR + tid, gsz = (size_t)nb * NTHR;
    for (size_t i = gtid; i < (size_t)2 * 8 * 2 * 128 * 64; i += gsz) ((u16*)(ws + OFF_KEYS))[i] = f2bf(P.in[25][i]);
    for (size_t i = gtid; i < (size_t)2 * 8 * 1024; i += gsz) {
        const int l = (int)(i / 8192), j = (int)((i / 1024) % 8), k = (int)(i % 1024);
        ((float*)(ws + OFF_WAB))[i] = P.in[2][(size_t)l * 1024 * INW + (size_t)k * INW + 1024 + j];
    }
    {
        const int wv = tid >> 6, lane = tid & 63;
        for (int row = bid * 8 + wv; row < 2 * 16384; row += nb * 8) {
            const float4* s = (const float4*)(P.in[26] + (size_t)row * 1024) + lane * 4;
            float4 v[4]; float am = 0.f;
#pragma unroll
            for (int q = 0; q < 4; ++q) { v[q] = s[q]; am = fmaxf(am, fmaxf(fmaxf(fabsf(v[q].x), fabsf(v[q].y)), fmaxf(fabsf(v[q].z), fabsf(v[q].w)))); }
            for (int o = 32; o > 0; o >>= 1) am = fmaxf(am, __shfl_xor(am, o));
            const float sc = am > 0.f ? 127.f / am : 0.f;
            uint4 o4; unsigned* op = (unsigned*)&o4;
#pragma unroll
            for (int q = 0; q < 4; ++q) {
                const int a = (int)rintf(v[q].x * sc), b = (int)rintf(v[q].y * sc), c = (int)rintf(v[q].z * sc), d = (int)rintf(v[q].w * sc);
                op[q] = (unsigned)(a & 0xff) | ((unsigned)(b & 0xff) << 8) | ((unsigned)(c & 0xff) << 16) | ((unsigned)(d & 0xff) << 24);
            }
            ((uint4*)(ws + OFF_UTAB))[(size_t)row * 64 + lane] = o4;
            if (lane == 0) ((float*)(ws + OFF_V8SC))[2 * row] = am * (1.f / 127.f);
        }
        for (int row = bid * 8 + wv; row < 2 * 16384; row += nb * 8) {
            const float4* s = (const float4*)(P.in[27] + (size_t)row * 1024) + lane * 4;
            float4 v[4]; float am = 0.f;
#pragma unroll
            for (int q = 0; q < 4; ++q) { v[q] = s[q]; am = fmaxf(am, fmaxf(fmaxf(fabsf(v[q].x), fabsf(v[q].y)), fmaxf(fabsf(v[q].z), fabsf(v[q].w)))); }
            for (int o = 32; o > 0; o >>= 1) am = fmaxf(am, __shfl_xor(am, o));
            const float sc8 = am > 0.f ? 127.f / am : 0.f;
            uint4 o8; unsigned* op = (unsigned*)&o8;
#pragma unroll
            for (int q = 0; q < 4; ++q) {
                const int a = (int)rintf(v[q].x * sc8), b = (int)rintf(v[q].y * sc8), c = (int)rintf(v[q].z * sc8), d = (int)rintf(v[q].w * sc8);
                op[q] = (unsigned)(a & 0xff) | ((unsigned)(b & 0xff) << 8) | ((unsigned)(c & 0xff) << 16) | ((unsigned)(d & 0xff) << 24);
            }
            ((uint4*)(ws + OFF_VTAB))[(size_t)row * 64 + lane] = o8;
            if (lane == 0) ((float*)(ws + OFF_V8SC))[2 * row + 1] = am * (1.f / 127.f);
            const float sc4 = am > 0.f ? 7.f / am : 0.f;
            unsigned d[2];
#pragma unroll
            for (int h2 = 0; h2 < 2; ++h2) {
                const float4 a = v[2 * h2], b = v[2 * h2 + 1];
                const unsigned n0 = (unsigned)((int)rintf(a.x * sc4) + 8), n1 = (unsigned)((int)rintf(a.y * sc4) + 8), n2 = (unsigned)((int)rintf(a.z * sc4) + 8), n3 = (unsigned)((int)rintf(a.w * sc4) + 8);
                const unsigned n4 = (unsigned)((int)rintf(b.x * sc4) + 8), n5 = (unsigned)((int)rintf(b.y * sc4) + 8), n6 = (unsigned)((int)rintf(b.z * sc4) + 8), n7 = (unsigned)((int)rintf(b.w * sc4) + 8);
                d[h2] = n0 | (n4 << 4) | (n1 << 8) | (n5 << 12) | (n2 << 16) | (n6 << 20) | (n3 << 24) | (n7 << 28);
            }
            ((uint2*)(ws + OFF_V4TAB))[(size_t)row * 64 + lane] = make_uint2(d[0], d[1]);
            if (lane == 0) ((float*)(ws + OFF_V4SC))[row] = am * (1.f / 7.f);
        }
    }
    for (size_t i = gtid; i < (size_t)2 * 16 * 64; i += gsz) {
        const int l = (int)(i / 1024), g = (int)((i / 64) % 16), n = (int)(i % 64);
        const float step = __expf(P.in[14][l * 16 + g]);
        const float lr = P.in[7][i], li = P.in[8][i];
        const float er = expf(lr * step); const float ar = er * cosf(li * step), ai = er * sinf(li * step);
        const float e64 = expf(64.f * lr * step); const float a64r = e64 * cosf(64.f * li * step), a64i = e64 * sinf(64.f * li * step);
        char* sp = ws + OFF_S5P + l * S5P_LAYER;
        ((float2*)(sp + S5P_ABAR))[g * 64 + n] = make_float2(ar, ai);
        ((float2*)(sp + S5P_A64))[g * 64 + n] = make_float2(a64r, a64i);
        const float xr = ar - 1.f, xi = ai; const float den = 1.f / (lr * lr + li * li);
        const float cr = (xr * lr + xi * li) * den, ci = (xi * lr - xr * li) * den;
        for (int c = 0; c < 16; ++c) {
            const float br = P.in[9][i * 16 + c], bi = P.in[10][i * 16 + c];
            ((float*)(sp + S5P_BRE))[(g * 64 + n) * 16 + c] = cr * br - ci * bi;
            ((float*)(sp + S5P_BIM))[(g * 64 + n) * 16 + c] = cr * bi + ci * br;
        }
    }
    for (size_t i = gtid; i < (size_t)2 * 16 * 16 * 128; i += gsz) {
        const int l = (int)(i / 32768), g = (int)((i / 2048) % 16), c = (int)((i / 128) % 16), k = (int)(i % 128);
        const size_t si = ((size_t)(l * 16 + g) * 16 + c) * 64 + (k & 63);
        const float v = k < 64 ? P.in[11][si] : -P.in[12][si];
        ((u16*)(ws + OFF_S5P + l * S5P_LAYER + S5P_CM))[(g * 16 + c) * 128 + k] = f2bf(v);
    }
    if (bid == 0 && tid < 2) {
        const int l = tid; float s1 = 0.f, s2 = 0.f;
        for (int d = 0; d < 64; ++d) { s1 += P.in[17][l * 64 + d] * P.in[18][l * 64 + d]; s2 += P.in[19][l * 64 + d] * P.in[20][l * 64 + d]; }
        const float lam_init = 0.8f - 0.6f * expf(-0.3f * (float)l);
        ((float*)(ws + OFF_SCAL))[l] = expf(s1) - expf(s2) + lam_init;
    }
}

DI void rms_token(const Params& P, int t, int lane, float4 (&v)[4], const float* gain, u16* dst, int ab_layer  , bool want_q = false) {
    float ss = 0.f;
#pragma unroll
    for (int i = 0; i < 4; ++i) ss += v[i].x * v[i].x + v[i].y * v[i].y + v[i].z * v[i].z + v[i].w * v[i].w;
    ss = wave_sum(ss);
    const float rstd = rsqrtf(ss * (1.f / DM) + 1e-6f);
    const float4* g4 = (const float4*)gain;
#pragma unroll
    for (int i = 0; i < 4; ++i) {
        const float4 g = g4[lane + 64 * i];
        v[i].x *= rstd * g.x; v[i].y *= rstd * g.y; v[i].z *= rstd * g.z; v[i].w *= rstd * g.w;
        uint2 o; o.x = pack2(v[i].x, v[i].y); o.y = pack2(v[i].z, v[i].w);
        *(uint2*)(dst + (size_t)t * DM + (lane + 64 * i) * 4) = o;
    }
    if (want_q) {
        float am = 0.f;
#pragma unroll
        for (int i = 0; i < 4; ++i) am = fmaxf(am, fmaxf(fmaxf(fabsf(v[i].x), fabsf(v[i].y)), fmaxf(fabsf(v[i].z), fabsf(v[i].w))));
        for (int o = 32; o > 0; o >>= 1) am = fmaxf(am, __shfl_xor(am, o));
        const float sc = am > 0.f ? 127.f / am : 0.f;
#pragma unroll
        for (int i = 0; i < 4; ++i) {
            const int a0 = (int)rintf(v[i].x * sc), a1 = (int)rintf(v[i].y * sc), a2 = (int)rintf(v[i].z * sc), a3 = (int)rintf(v[i].w * sc);
            ((unsigned*)(P.ws + OFF_XQ))[(size_t)t * 256 + lane + 64 * i] = (unsigned)(a0 & 0xff) | ((unsigned)(a1 & 0xff) << 8) | ((unsigned)(a2 & 0xff) << 16) | ((unsigned)(a3 & 0xff) << 24);
        }
        if (lane == 0) ((float*)(P.ws + OFF_SX))[t] = am * (1.f / 127.f);
    }
    if (ab_layer >= 0) {
        const float4* wab = (const float4*)(P.ws + OFF_WAB) + ab_layer * 8 * 256;
        float acc[8];
#pragma unroll
        for (int j = 0; j < 8; ++j) {
            float a = 0.f;
#pragma unroll
            for (int i = 0; i < 4; ++i) { const float4 w = wab[j * 256 + lane + 64 * i]; a += v[i].x * w.x + v[i].y * w.y + v[i].z * w.z + v[i].w * w.w; }
            acc[j] = wave_sum(a);
        }
        if (lane < 4) {
            const float a = lane == 0 ? acc[0] : lane == 1 ? acc[1] : lane == 2 ? acc[2] : acc[3];
            const float b = lane == 0 ? acc[4] : lane == 1 ? acc[5] : lane == 2 ? acc[6] : acc[7];
            const float xx = a + P.in[5][ab_layer * 4 + lane];
            const float sp = xx > 20.f ? xx : log1pf(__expf(xx));
            ((float*)(P.ws + OFF_GG))[t * 4 + lane] = -__expf(P.in[4][ab_layer * 4 + lane]) * sp;
            ((float*)(P.ws + OFF_BETA))[t * 4 + lane] = sigmoidf_(b);
        }
    }
}

DI void phase_rms(const Params& P, const float* src, const float* gain, u16* dst, int ab_layer, bool want_q = false) {
    const int w = threadIdx.x >> 6, lane = threadIdx.x & 63;
    for (int t = blockIdx.x * 8 + w; t < NT; t += gridDim.x * 8) {
        const float4* s4 = (const float4*)(src + (size_t)t * DM);
        float4 v[4];
#pragma unroll
        for (int i = 0; i < 4; ++i) v[i] = s4[lane + 64 * i];
        rms_token(P, t, lane, v, gain, dst, ab_layer, want_q);
    }
}

namespace pg8 {
#define PG8_LAS __attribute__((address_space(3)))
typedef unsigned short bf16_t;
typedef short bf16x8 __attribute__((ext_vector_type(8)));
typedef float f32x4 __attribute__((ext_vector_type(4)));
typedef unsigned u32x4 __attribute__((ext_vector_type(4)));
constexpr int BM = 256, BK = 64, HALF = 128, HTB = HALF * BK * 2  , STAGE_BYTES = 8 * HTB, NXCD = 8, WGM = 8;

__host__ __device__ __forceinline__ int lds_byte(int r, int c) { const int st = (r >> 4) * 2 + (c >> 5), rr = r & 15, cc = c & 31, ob = rr * 64 + cc * 2; return st * 1024 + (ob ^ (((ob >> 9) & 1) << 5)); }
__host__ __device__ __forceinline__ void stage_rc(int b, int& R, int& C) { const int st = b / 1024, sb = b % 1024, swz = sb ^ (((sb >> 9) & 1) << 5); R = (st >> 1) * 16 + swz / 64; C = (st & 1) * 32 + (swz % 64) / 2; }
__host__ __device__ __forceinline__ int perm32(int rho) { const int n = rho >> 4, i = rho & 15; return 8 * (i >> 2) + 4 * n + (i & 3); }

struct Unit { int pm, pn; };
struct Gemm { const bf16_t* A; const bf16_t* Bt; int M, N, K; };

struct StaticOrder {
    int nM, nN, nwg, G, c;
    __host__ __device__ void init(int M, int N, int G_, int c_) { nM = M / BM; nN = N / BM; nwg = nM * nN; G = G_; c = c_; }
    __host__ __device__ bool next(int i, Unit& u) const {
        const long L = (long)i * G + c; if (L >= nwg) return false;
        int wgid = (int)L; { const int q = nwg / NXCD, r = nwg % NXCD, xcd = wgid % NXCD, off = wgid / NXCD; wgid = (xcd < r ? xcd * (q + 1) : r * (q + 1) + (xcd - r) * q) + off; }
        const int nig = WGM * nN, gid = wgid / nig, fm = gid * WGM, gsz = (nM - fm) < WGM ? (nM - fm) : WGM;
        u.pm = fm + ((wgid % nig) % gsz); u.pn = (wgid % nig) / gsz; return true;
    }
    __device__ __forceinline__ void a_ready(const Unit&) const {}
    __device__ __forceinline__ void done(const Unit&) const {}
};
struct CountedOrder : StaticOrder {
    const unsigned* ready; unsigned need; unsigned* tmo;
    __device__ __forceinline__ void a_ready(const Unit& u) const {
        if (threadIdx.x < 64) {
            const unsigned long long t0 = __builtin_amdgcn_s_memrealtime(); unsigned polls = 0;
            while ((unsigned)__builtin_amdgcn_readfirstlane(__hip_atomic_load(ready + 64 * u.pm, __ATOMIC_RELAXED, __HIP_MEMORY_SCOPE_AGENT)) < need) {
                if ((++polls & 255u) == 0u && __builtin_amdgcn_readfirstlane(__hip_atomic_load(tmo, __ATOMIC_RELAXED, __HIP_MEMORY_SCOPE_AGENT)) != 0u) break;
                if (__builtin_amdgcn_s_memrealtime() - t0 > 2000000ull) {
                    if (threadIdx.x == 0) { unsigned expect = 0u; __hip_atomic_compare_exchange_strong(tmo + 1, &expect, 0x600u | (unsigned)(u.pm & 0xff), __ATOMIC_RELAXED, __ATOMIC_RELAXED, __HIP_MEMORY_SCOPE_AGENT); __hip_atomic_store(tmo, 1u, __ATOMIC_RELAXED, __HIP_MEMORY_SCOPE_AGENT); }
                    break; }
                __builtin_amdgcn_s_sleep(2); }
            __builtin_amdgcn_fence(__ATOMIC_ACQUIRE, "agent");
            asm volatile("s_waitcnt vmcnt(0)" ::: "memory");
        }
#if !defined(BROKEN_HOOK_NO_BARRIER)
        asm volatile("" ::: "memory"); __builtin_amdgcn_s_barrier(); asm volatile("" ::: "memory");
#endif
    }
};

__device__ __forceinline__ unsigned cvt_pk_bf16(float lo, float hi) { unsigned r; asm volatile("v_cvt_pk_bf16_f32 %0, %1, %2" : "=v"(r) : "v"(lo), "v"(hi)); return r; }
typedef float f32x2 __attribute__((ext_vector_type(2)));
__device__ __forceinline__ f32x2 gelu_pk(f32x2 v) {
    const f32x2 av = __builtin_elementwise_abs(v), d = av * 0.2316418882f + 1.0f;
    f32x2 t; t.x = __builtin_amdgcn_rcpf(d.x); t.y = __builtin_amdgcn_rcpf(d.y);
    f32x2 q = t * 0.5307027145f + (-0.7265760135f); q = q * t + 0.7107068705f; q = q * t + (-0.142248368f); q = q * t + 0.127414796f; q = q * t;
    const f32x2 s = (v * v) * (-0.72134752044f);
    f32x2 e; e.x = __builtin_amdgcn_exp2f(s.x); e.y = __builtin_amdgcn_exp2f(s.y);
    const f32x2 m = v * (q * e), r = v - m;
    f32x2 o; o.x = v.x < 0.f ? m.x : r.x; o.y = v.y < 0.f ? m.y : r.y; return o;
}

struct EpiF32 {
    static constexpr bool PERM = false, AFTER_DRAIN = false;
    float* C; int ldc; const float* bias;
    __device__ __forceinline__ void operator()(const f32x4 (&acc)[2][2][4][2], const Unit& u, int wr, int wc, int fr, int fq) const {
        const int row0 = u.pm * BM + wr * 64 + fr, col0 = u.pn * BM + wc * 32 + 4 * fq;
        f32x4 bv[2][2];
#pragma unroll
        for (int bj = 0; bj < 2; ++bj)
#pragma unroll
            for (int n = 0; n < 2; ++n) bv[bj][n] = bias ? *(const f32x4*)(bias + col0 + bj * HALF + n * 16) : (f32x4){0.f, 0.f, 0.f, 0.f};
#pragma unroll
        for (int ai = 0; ai < 2; ++ai)
#pragma unroll
            for (int m = 0; m < 4; ++m) { float* rowp = C + (size_t)(row0 + ai * HALF + m * 16) * ldc + col0;
#pragma unroll
                for (int bj = 0; bj < 2; ++bj)
#pragma unroll
                    for (int n = 0; n < 2; ++n) *(f32x4*)(rowp + bj * HALF + n * 16) = acc[ai][bj][m][n] + bv[bj][n]; }
    }
};
template <int ACT  > struct EpiBf16 {
    static constexpr bool PERM = true, AFTER_DRAIN = false;
    bf16_t* O; int ldc; const float* bias; int split_cols; size_t split_stride;
    __device__ __forceinline__ void operator()(const f32x4 (&acc)[2][2][4][2], const Unit& u, int wr, int wc, int fr, int fq) const {
        const int row0 = u.pm * BM + wr * 64 + fr; int colt = u.pn * BM; bf16_t* base = O;
        if (split_cols) { const int t = colt / split_cols; base += (size_t)t * split_stride; colt -= t * split_cols; }
        const int col0 = colt + wc * 32 + 8 * fq, bcol0 = u.pn * BM + wc * 32 + 8 * fq;
        f32x4 bv[2][2];
#pragma unroll
        for (int bj = 0; bj < 2; ++bj)
#pragma unroll
            for (int n = 0; n < 2; ++n) bv[bj][n] = bias ? *(const f32x4*)(bias + bcol0 + bj * HALF + 4 * n) : (f32x4){0.f, 0.f, 0.f, 0.f};
#pragma unroll
        for (int ai = 0; ai < 2; ++ai)
#pragma unroll
            for (int m = 0; m < 4; ++m) { bf16_t* rowp = base + (size_t)(row0 + ai * HALF + m * 16) * ldc + col0;
#pragma unroll
                for (int bj = 0; bj < 2; ++bj) { f32x4 v0 = acc[ai][bj][m][0] + bv[bj][0], v1 = acc[ai][bj][m][1] + bv[bj][1];
                    if (ACT == 1) { f32x2 a = gelu_pk((f32x2){v0[0], v0[1]}), b = gelu_pk((f32x2){v0[2], v0[3]}), c = gelu_pk((f32x2){v1[0], v1[1]}), d = gelu_pk((f32x2){v1[2], v1[3]});
                        v0 = (f32x4){a.x, a.y, b.x, b.y}; v1 = (f32x4){c.x, c.y, d.x, d.y}; }
                    if (ACT == 2) {
#pragma unroll
                        for (int j = 0; j < 4; ++j) { v0[j] = 0.5f * v0[j] * (1.0f + erff(v0[j] * 0.70710678f)); v1[j] = 0.5f * v1[j] * (1.0f + erff(v1[j] * 0.70710678f)); } }
                    u32x4 w; w.x = cvt_pk_bf16(v0[0], v0[1]); w.y = cvt_pk_bf16(v0[2], v0[3]); w.z = cvt_pk_bf16(v1[0], v1[1]); w.w = cvt_pk_bf16(v1[2], v1[3]);
                    *(u32x4*)(rowp + bj * HALF) = w; } }
    }
};


template <class Epi, class Sched, bool STAMP = false>
__device__ __forceinline__ void gemm_phase(PG8_LAS unsigned char* lds, const Gemm g, const Sched& S, const Epi& E, unsigned long long* stamps) {
    const int tid = threadIdx.x, wid = __builtin_amdgcn_readfirstlane(tid >> 6), lane = tid & 63, wr = wid >> 2, wc = wid & 3, fr = lane & 15, fq = lane >> 4;
    const int K = g.K, nt = K / BK;
    int ts_lo = 0, ts_hi = 0, nts = 0; const unsigned long long rt_entry = STAMP ? (unsigned long long)wall_clock64() : 0ull;
#define PG8_STAMP() do { if (STAMP && wid == 0 && nts < 64) { const unsigned long long _c = (unsigned long long)clock64(); \
        ts_lo = (lane == nts) ? (int)(unsigned)_c : ts_lo; ts_hi = (lane == nts) ? (int)(unsigned)(_c >> 32) : ts_hi; ++nts; } } while (0)
    PG8_STAMP();
    unsigned voffA[2], voffB[2];
#pragma unroll
    for (int i = 0; i < 2; ++i) { int R, C; stage_rc(tid * 16 + i * 8192, R, C); const int Rb = Epi::PERM ? ((R & ~31) + perm32(R & 31)) : R;
        voffA[i] = (unsigned)(R * K + C) * 2u; voffB[i] = (unsigned)(Rb * K + C) * 2u; }
    const size_t kstep = (size_t)(BK * 2);
    const size_t hstep = (size_t)HALF * K * 2;
    const size_t tstep = 2 * hstep;
    const unsigned ldsw = (unsigned)wid * 1024u;
    const int aoff = lds_byte(wr * 64 + fr, fq * 8), boff = lds_byte(wc * 32 + fr, fq * 8);
#define PG8_SA(b, h) (((b) * 2 + (h)) * HTB)
#define PG8_SB(b, h) ((4 + (b) * 2 + (h)) * HTB)
#define PG8_STAGE(bufoff, gbase, voff) do { _Pragma("unroll") for (int _i = 0; _i < 2; ++_i) \
        __builtin_amdgcn_global_load_lds((const unsigned*)((const char*)(gbase) + (voff)[_i]), (PG8_LAS unsigned*)(lds + (bufoff) + ldsw + _i * 8192), 16, 0, 0); } while (0)
#define PG8_LDA(dst, b, h) do { _Pragma("unroll") for (int m = 0; m < 4; ++m) _Pragma("unroll") for (int k = 0; k < 2; ++k) dst[m][k] = *(const PG8_LAS bf16x8*)(lds + PG8_SA(b, h) + aoff + m * 2048 + k * 1024); } while (0)
#define PG8_LDB(dst, b, h) do { _Pragma("unroll") for (int n = 0; n < 2; ++n) _Pragma("unroll") for (int k = 0; k < 2; ++k) dst[n][k] = *(const PG8_LAS bf16x8*)(lds + PG8_SB(b, h) + boff + n * 2048 + k * 1024); } while (0)
#define PG8_MMA(ai, bj, At, Bt) do { __builtin_amdgcn_s_setprio(1); _Pragma("unroll") for (int m = 0; m < 4; ++m) _Pragma("unroll") for (int n = 0; n < 2; ++n) _Pragma("unroll") for (int k = 0; k < 2; ++k) \
        acc[ai][bj][m][n] = __builtin_amdgcn_mfma_f32_16x16x32_bf16(Bt[n][k], At[m][k], acc[ai][bj][m][n], 0, 0, 0); __builtin_amdgcn_s_setprio(0); } while (0)
#define PG8_WAIT_V(n) asm volatile("s_waitcnt vmcnt(" #n ")" ::: "memory")
#define PG8_WAIT_L(n) asm volatile("s_waitcnt lgkmcnt(" #n ")" ::: "memory")
#define PG8_BAR __builtin_amdgcn_s_barrier()
#define PG8_SCHED __builtin_amdgcn_sched_barrier(0)
    Unit cur, nxt; int ui = 0;
    if (!S.next(0, cur)) return;
    f32x4 acc[2][2][4][2];
#pragma unroll
    for (int a = 0; a < 2; ++a)
#pragma unroll
        for (int b = 0; b < 2; ++b)
#pragma unroll
            for (int m = 0; m < 4; ++m)
#pragma unroll
                for (int n = 0; n < 2; ++n) acc[a][b][m][n] = (f32x4){0.f, 0.f, 0.f, 0.f};
    bf16x8 At[4][2], B0[2][2], B1[2][2];
    const char* cA = (const char*)g.A + (size_t)cur.pm * tstep; const char* cB = (const char*)g.Bt + (size_t)cur.pn * tstep;
    S.a_ready(cur);
    PG8_STAGE(PG8_SB(0, 0), cB, voffB); PG8_STAGE(PG8_SA(0, 0), cA, voffA); PG8_STAGE(PG8_SB(0, 1), cB + hstep, voffB); PG8_STAGE(PG8_SA(0, 1), cA + hstep, voffA);
    if (wr == 1) PG8_BAR;
    PG8_WAIT_V(4); PG8_BAR;
    PG8_STAGE(PG8_SB(1, 0), cB + kstep, voffB); PG8_STAGE(PG8_SA(1, 0), cA + kstep, voffA); PG8_STAGE(PG8_SB(1, 1), cB + hstep + kstep, voffB);
    PG8_WAIT_V(6); PG8_BAR;
    PG8_STAMP();
    for (;;) {
        const bool has_next = S.next(ui + 1, nxt);
        const char* nA = has_next ? (const char*)g.A + (size_t)nxt.pm * tstep : cA; const char* nB = has_next ? (const char*)g.Bt + (size_t)nxt.pn * tstep : cB;
        for (int t = 0; t < nt; t += 2) {
            const bool last = (t == nt - 2);
            const char* a1 = cA + (size_t)(t + 1) * kstep;
            const char* a2 = last ? nA : cA + (size_t)(t + 2) * kstep; const char* b2 = last ? nB : cB + (size_t)(t + 2) * kstep;
            const char* a3 = a2 + kstep; const char* b3 = b2 + kstep;
            if (last && has_next) S.a_ready(nxt);
            PG8_LDB(B0, 0, 0); PG8_SCHED; PG8_LDA(At, 0, 0); PG8_STAGE(PG8_SA(1, 1), a1 + hstep, voffA);
            PG8_WAIT_L(8); PG8_BAR; PG8_WAIT_L(0); PG8_MMA(0, 0, At, B0); PG8_BAR; PG8_SCHED;
            PG8_LDB(B1, 0, 1); PG8_STAGE(PG8_SB(0, 0), b2, voffB);
            PG8_BAR; PG8_WAIT_L(0); PG8_MMA(0, 1, At, B1); PG8_BAR;
            PG8_LDA(At, 0, 1); PG8_STAGE(PG8_SA(0, 0), a2, voffA);
            PG8_BAR; PG8_WAIT_L(0); PG8_MMA(1, 0, At, B0); PG8_BAR; PG8_SCHED;
            PG8_STAGE(PG8_SB(0, 1), b2 + hstep, voffB);
            PG8_WAIT_V(6); PG8_BAR; PG8_MMA(1, 1, At, B1); PG8_BAR;
            PG8_LDB(B0, 1, 0); PG8_SCHED; PG8_LDA(At, 1, 0); PG8_STAGE(PG8_SA(0, 1), a2 + hstep, voffA);
            PG8_WAIT_L(8); PG8_BAR; PG8_WAIT_L(0); PG8_MMA(0, 0, At, B0); PG8_BAR; PG8_SCHED;
            PG8_LDB(B1, 1, 1); PG8_STAGE(PG8_SB(1, 0), b3, voffB);
            PG8_BAR; PG8_WAIT_L(0); PG8_MMA(0, 1, At, B1); PG8_BAR;
            PG8_LDA(At, 1, 1); PG8_STAGE(PG8_SA(1, 0), a3, voffA);
            PG8_BAR; PG8_WAIT_L(0); PG8_MMA(1, 0, At, B0); PG8_BAR; PG8_SCHED;
            PG8_STAGE(PG8_SB(1, 1), b3 + hstep, voffB);
            PG8_WAIT_V(6); PG8_BAR; PG8_MMA(1, 1, At, B1); PG8_BAR;
        }
        PG8_STAMP();
        if constexpr (!Epi::AFTER_DRAIN) { E(acc, cur, wr, wc, fr, fq); S.done(cur); }
        PG8_STAMP();
        if (!has_next) break;
#pragma unroll
        for (int a = 0; a < 2; ++a)
#pragma unroll
            for (int b = 0; b < 2; ++b)
#pragma unroll
                for (int m = 0; m < 4; ++m)
#pragma unroll
                    for (int n = 0; n < 2; ++n) acc[a][b][m][n] = (f32x4){0.f, 0.f, 0.f, 0.f};
        cur = nxt; cA = nA; cB = nB; ++ui;
    }
    PG8_WAIT_V(0);
    if (wr == 0) PG8_BAR;
    PG8_BAR;
    if constexpr (Epi::AFTER_DRAIN) { E.fused(acc, cur, wr, wc, fr, fq, lds, wid, lane); S.done(cur); }
    PG8_STAMP();
    if (STAMP && wid == 0) { stamps[lane] = lane < nts ? (((unsigned long long)(unsigned)ts_hi << 32) | (unsigned)ts_lo) : 0ull;
        if (lane == 62) stamps[62] = rt_entry; if (lane == 63) stamps[63] = (unsigned long long)wall_clock64(); }
#undef PG8_STAMP
#undef PG8_SA
#undef PG8_SB
#undef PG8_STAGE
#undef PG8_LDA
#undef PG8_LDB
#undef PG8_MMA
#undef PG8_WAIT_V
#undef PG8_WAIT_L
#undef PG8_BAR
#undef PG8_SCHED
}
}

struct EpiInProj8 {
    static constexpr bool PERM = true, AFTER_DRAIN = false;
    char* ws;
    DI void operator()(const pg8::f32x4 (&acc)[2][2][4][2], const pg8::Unit& u, int wr, int wc, int fr, int fq) const {
        const int row0 = u.pm * 256 + wr * 64 + fr; const int pn = u.pn;
        if (pn >= 9) {
            u16* vt = (u16*)(ws + OFF_VT);
#pragma unroll
            for (int ai = 0; ai < 2; ++ai)
#pragma unroll
                for (int m = 0; m < 4; ++m) {
                    const int tok = row0 + ai * 128 + m * 16; const int b = tok >> 13;
                    const int l = ((tok & 8191) & ~15) | (fr < 4 ? fr : fr < 8 ? fr + 4 : fr < 12 ? fr - 4 : fr);
#pragma unroll
                    for (int bj = 0; bj < 2; ++bj)
#pragma unroll
                        for (int n = 0; n < 2; ++n)
#pragma unroll
                            for (int j = 0; j < 4; ++j) {
                                const int c = (pn - 9) * 256 + wc * 32 + 8 * fq + bj * 128 + 4 * n + j; const int head = c >> 7, dv = c & 127;
                                vt[((size_t)((b * 4 + head) * 128 + (l >> 6))) * 8192 + dv * 64 + (l & 63)] = f2bf(acc[ai][bj][m][n][j]);
                            }
                }
            return;
        }
        u16* base; int pitch, c0; float sc = 1.f;
        if (pn < 3) { base = (u16*)(ws + OFF_QKV); pitch = 768; c0 = pn * 256; }
        else if (pn == 3) { base = (u16*)(ws + OFF_Z); pitch = 256; c0 = 0; }
        else if (pn == 4) { base = (u16*)(ws + OFF_US); pitch = 256; c0 = 0; }
        else if (pn < 7) { base = (u16*)(ws + OFF_QC); pitch = 512; c0 = (pn - 5) * 256; sc = 0.125f * LOG2E; }
        else { base = (u16*)(ws + OFF_KC); pitch = 512; c0 = (pn - 7) * 256; }
        const int col0 = c0 + wc * 32 + 8 * fq;
#pragma unroll
        for (int ai = 0; ai < 2; ++ai)
#pragma unroll
            for (int m = 0; m < 4; ++m) {
                u16* rowp = base + (size_t)(row0 + ai * 128 + m * 16) * pitch + col0;
#pragma unroll
                for (int bj = 0; bj < 2; ++bj) {
                    const pg8::f32x4 v0 = acc[ai][bj][m][0] * sc, v1 = acc[ai][bj][m][1] * sc;
                    uint4 w; w.x = pack2(v0[0], v0[1]); w.y = pack2(v0[2], v0[3]); w.z = pack2(v1[0], v1[1]); w.w = pack2(v1[2], v1[3]);
                    *(uint4*)(rowp + bj * 128) = w;
                }
            }
    }
};
struct EpiResidual8 {
    static constexpr bool PERM = false, AFTER_DRAIN = false;
    const float* hin; float* hout;
    DI void operator()(const pg8::f32x4 (&acc)[2][2][4][2], const pg8::Unit& u, int wr, int wc, int fr, int fq) const {
        const int row0 = u.pm * 256 + wr * 64 + fr, col0 = u.pn * 256 + wc * 32 + 4 * fq;
#pragma unroll
        for (int ai = 0; ai < 2; ++ai)
#pragma unroll
            for (int m = 0; m < 4; ++m) {
                const size_t ro = (size_t)(row0 + ai * 128 + m * 16) * DM + col0;
#pragma unroll
                for (int bj = 0; bj < 2; ++bj)
#pragma unroll
                    for (int n = 0; n < 2; ++n) {
                        const pg8::f32x4 h = *(const pg8::f32x4*)(hin + ro + bj * 128 + n * 16);
                        *(pg8::f32x4*)(hout + ro + bj * 128 + n * 16) = h + acc[ai][bj][m][n];
                    }
            }
    }
};
struct EpiGlu8 {
    static constexpr bool PERM = true, AFTER_DRAIN = false;
    u16* mix; const float* bias;
    DI void operator()(const pg8::f32x4 (&acc)[2][2][4][2], const pg8::Unit& u, int wr, int wc, int fr, int fq) const {
        const int row0 = u.pm * 256 + wr * 64 + fr, col0 = u.pn * 128 + wc * 32 + 8 * fq;
#pragma unroll
        for (int n = 0; n < 2; ++n) {
            const pg8::f32x4 bv = *(const pg8::f32x4*)(bias + col0 + 4 * n), bg = *(const pg8::f32x4*)(bias + 256 + col0 + 4 * n);
#pragma unroll
            for (int ai = 0; ai < 2; ++ai)
#pragma unroll
                for (int m = 0; m < 4; ++m) {
                    const pg8::f32x4 val = acc[ai][0][m][n] + bv, gt = acc[ai][1][m][n] + bg;
                    uint2 w; w.x = pack2(val[0] * sigmoidf_(gt[0]), val[1] * sigmoidf_(gt[1])); w.y = pack2(val[2] * sigmoidf_(gt[2]), val[3] * sigmoidf_(gt[3]));
                    *(uint2*)(mix + (size_t)(row0 + ai * 128 + m * 16) * DM + 256 + col0 + 4 * n) = w;
                }
        }
    }
};
template <class Epi>
DI void phase_gemm(const u16* A, int lda, const u16* Bt, int ldb, int M, int N, int K, Epi epi, char* lds) {
    pg8::Gemm g{A, Bt, M, N, K};
    pg8::StaticOrder S; S.init(M, N, (int)gridDim.x, (int)blockIdx.x);
    pg8::gemm_phase<Epi, pg8::StaticOrder, false>((PG8_LAS unsigned char*)lds, g, S, epi, nullptr);
}

template <int CTRL> DI float dppf(float v) { return __int_as_float(__builtin_amdgcn_update_dpp(0, __float_as_int(v), CTRL, 0xF, 0xF, true)); }
DI void gdn_prep_item(const Params& P, int layer, int item, char* lds) {
    const int tid = threadIdx.x, lane = tid & 63, w = tid >> 6;
    const int b = item >> 9, head = (item >> 7) & 3, ch = item & 127;
    const int t0 = b * SEQ + ch * 64;
    u16* raw = (u16*)lds;
    float* qs = (float*)(lds + 25856);
    float* ks = qs + 64 * 68;
    float* vs = ks + 64 * 68;
    float* Lp = vs + 64 * 68;
    u16* qb = (u16*)(Lp + 64 * 68);
    u16* kb = qb + 64 * 72;
    float* Gs = (float*)(kb + 64 * 72);
    float* bs = Gs + 64;
    u16* Xs = raw;
    u16* QKs = raw + 8704;
    const u16* qkv = (const u16*)(P.ws + OFF_QKV);
    u16* rec = (u16*)(P.ws + OFF_GREC + (size_t)item * GREC_BYTES);
    for (int i = tid; i < 67 * 24; i += NTHR) {
        const int row = i / 24, c8 = i % 24; const int part = c8 >> 3, cc = (c8 & 7) * 8;
        const int l = ch * 64 + row - 3;
        uint4 v = make_uint4(0, 0, 0, 0);
        if (l >= 0) v = *(const uint4*)(qkv + (size_t)(b * SEQ + l) * 768 + part * 256 + head * 64 + cc);
        *(uint4*)(raw + row * 192 + part * 64 + cc) = v;
    }
    if (tid < 64) {
        bs[tid] = ((const float*)(P.ws + OFF_BETA))[(t0 + tid) * 4 + head];
        float g = ((const float*)(P.ws + OFF_GG))[(t0 + tid) * 4 + head];
#pragma unroll
        for (int o = 1; o < 64; o <<= 1) { const float tt = __shfl_up(g, o); if (lane >= o) g += tt; }
        Gs[tid] = g;
    }
    __syncthreads();
    {
        const float* cw = P.in[3] + (size_t)layer * 4 * 768;
#pragma unroll 1
        for (int it = 0; it < 3; ++it) {
            const int id = tid + NTHR * it; const int t = id / 24, c8 = id % 24; const int part = c8 >> 3, d0 = (c8 & 7) * 8;
            float a[8];
#pragma unroll
            for (int k = 0; k < 8; ++k) a[k] = 0.f;
#pragma unroll
            for (int j = 0; j < 4; ++j) {
                const uint4 rv = *(const uint4*)(raw + (t + j) * 192 + part * 64 + d0);
                const float4 w0 = *(const float4*)(cw + j * 768 + part * 256 + head * 64 + d0), w1 = *(const float4*)(cw + j * 768 + part * 256 + head * 64 + d0 + 4);
                a[0] += w0.x * bf2f((u16)(rv.x & 0xffff)); a[1] += w0.y * bf2f((u16)(rv.x >> 16));
                a[2] += w0.z * bf2f((u16)(rv.y & 0xffff)); a[3] += w0.w * bf2f((u16)(rv.y >> 16));
                a[4] += w1.x * bf2f((u16)(rv.z & 0xffff)); a[5] += w1.y * bf2f((u16)(rv.z >> 16));
                a[6] += w1.z * bf2f((u16)(rv.w & 0xffff)); a[7] += w1.w * bf2f((u16)(rv.w >> 16));
            }
            float ss = 0.f;
#pragma unroll
            for (int k = 0; k < 8; ++k) { a[k] = a[k] * sigmoidf_(a[k]); ss += a[k] * a[k]; }
            ss += dppf<0xB1>(ss); ss += dppf<0x4E>(ss); ss += dppf<0x141>(ss);
            const float sc = part == 2 ? 1.f : rsqrtf(ss + 1e-6f) * (part == 0 ? 0.125f : 1.f);
#pragma unroll
            for (int k = 0; k < 8; ++k) a[k] *= sc;
            float* dst = (part == 0 ? qs : part == 1 ? ks : vs) + t * 68 + d0;
            *(float4*)dst = make_float4(a[0], a[1], a[2], a[3]); *(float4*)(dst + 4) = make_float4(a[4], a[5], a[6], a[7]);
            if (part < 2) {
                uint4 pk; pk.x = pack2(a[0], a[1]); pk.y = pack2(a[2], a[3]); pk.z = pack2(a[4], a[5]); pk.w = pack2(a[6], a[7]);
                *(uint4*)((part == 0 ? qb : kb) + t * 72 + d0) = pk;
            }
        }
    }
    __syncthreads();
    {
        const int r = lane & 31, hh = lane >> 5; const int bi = (w >> 1) & 1, bj = w & 1; const bool isqk = w >= 4;
        const u16* Am = (isqk ? qb : kb) + (bi * 32 + r) * 72 + hh * 8;
        const u16* Bm = kb + (bj * 32 + r) * 72 + hh * 8;
        f32x16 acc;
#pragma unroll
        for (int e = 0; e < 16; ++e) acc[e] = 0.f;
#pragma unroll
        for (int s = 0; s < 4; ++s) acc = MFMA32(ld8(Am + s * 16), ld8(Bm + s * 16), acc);
        const int cidx = bj * 32 + r; const float Gc = Gs[cidx], bc = bs[cidx];
#pragma unroll
        for (int e = 0; e < 16; ++e) {
            const int ridx = bi * 32 + (e & 3) + 8 * (e >> 2) + 4 * hh;
            if (isqk) {
                QKs[ridx * 64 + cidx] = f2bf(cidx <= ridx ? acc[e] * __expf(Gs[ridx] - Gc) : 0.f);
            } else {
                Lp[ridx * 68 + (cidx & 3) * 16 + (cidx >> 2)] = (ridx < cidx) ? bc * acc[e] * __expf(Gc - Gs[ridx]) : 0.f;
            }
        }
    }
    __syncthreads();
    {
        const int c = tid >> 2, q = tid & 3; const bool isw = c >= 64; const int cc = c & 63;
        float rhs[16];
#pragma unroll
        for (int m = 0; m < 16; ++m) {
            const int i = 4 * m + q; const float bi_ = bs[i];
            rhs[m] = isw ? ks[i * 68 + cc] * bi_ * __expf(Gs[i]) : vs[i * 68 + cc] * bi_;
        }
        const float* Lq = Lp + q * 16;
#define SOLVE_STEP(j_, CTRL_) do { \
            const float xj = dppf<CTRL_>(rhs[(j_) >> 2]); \
            const float4* l4 = (const float4*)(Lq + (j_) * 68); \
            const float4 la = l4[0], lb = l4[1], lc = l4[2], ld = l4[3]; \
            rhs[0] -= la.x * xj; rhs[1] -= la.y * xj; rhs[2] -= la.z * xj; rhs[3] -= la.w * xj; \
            rhs[4] -= lb.x * xj; rhs[5] -= lb.y * xj; rhs[6] -= lb.z * xj; rhs[7] -= lb.w * xj; \
            rhs[8] -= lc.x * xj; rhs[9] -= lc.y * xj; rhs[10] -= lc.z * xj; rhs[11] -= lc.w * xj; \
            rhs[12] -= ld.x * xj; rhs[13] -= ld.y * xj; rhs[14] -= ld.z * xj; rhs[15] -= ld.w * xj; } while (0)
#pragma unroll
        for (int jj = 0; jj < 16; ++jj) {
            SOLVE_STEP(4 * jj + 0, 0x00); SOLVE_STEP(4 * jj + 1, 0x55); SOLVE_STEP(4 * jj + 2, 0xAA); SOLVE_STEP(4 * jj + 3, 0xFF);
        }
#undef SOLVE_STEP
        __syncthreads();
#pragma unroll
        for (int m = 0; m < 16; ++m) Xs[(4 * m + q) * 136 + c] = f2bf(rhs[m]);
    }
    __syncthreads();
    {
#pragma unroll
        for (int it = 0; it < 2; ++it) {
            const int id = tid + NTHR * it; const int i = id >> 4, c8 = (id & 15) * 8;
            *(uint4*)(rec + (c8 >> 6) * 4096 + i * 64 + (c8 & 63)) = *(const uint4*)(Xs + i * 136 + c8);
        }
        *(uint4*)(rec + 2 * 4096 + tid * 8) = *(const uint4*)(QKs + tid * 8);
        {
            const int t = tid >> 3, d0 = (tid & 7) * 8; const float eg = __expf(Gs[t]);
            const float4 x0 = *(const float4*)(qs + t * 68 + d0), x1 = *(const float4*)(qs + t * 68 + d0 + 4);
            uint4 pk; pk.x = pack2(x0.x * eg, x0.y * eg); pk.y = pack2(x0.z * eg, x0.w * eg); pk.z = pack2(x1.x * eg, x1.y * eg); pk.w = pack2(x1.z * eg, x1.w * eg);
            *(uint4*)(rec + 3 * 4096 + t * 64 + d0) = pk;
        }
        {
            const int d = tid & 63, tb = (tid >> 6) * 8; const float Gl = Gs[63];
            float kv[8];
#pragma unroll
            for (int k = 0; k < 8; ++k) kv[k] = ks[(tb + k) * 68 + d] * __expf(Gl - Gs[tb + k]);
            uint4 pk; pk.x = pack2(kv[0], kv[1]); pk.y = pack2(kv[2], kv[3]); pk.z = pack2(kv[4], kv[5]); pk.w = pack2(kv[6], kv[7]);
            *(uint4*)(rec + 4 * 4096 + d * 64 + tb) = pk;
            if (tid == 0) ((float*)(P.ws + OFF_EGL))[item] = __expf(Gl);
        }
    }
    __syncthreads();
}

constexpr int RP = 72;
DI void gdn_scan_chain(const Params& P, int chain, char* lds) {
    const int tid = threadIdx.x, lane = tid & 63, w = tid >> 6;
    const int b = chain >> 2, head = chain & 3;
    u16* buf0 = (u16*)lds;
    u16* buf1 = buf0 + 320 * RP;
    const char* recbase = P.ws + OFF_GREC + (size_t)(chain * 128) * GREC_BYTES;
    const float* egl = (const float*)(P.ws + OFF_EGL) + chain * 128;
    float* gout = (float*)(P.ws + OFF_GDNO);
    uint4 rg0, rg1, rg2, rg3, rg4;
#define SCAN_ISSUE(c_) do { const uint4* src_ = (const uint4*)(recbase + (size_t)(c_) * GREC_BYTES) + tid; \
        rg0 = src_[0]; rg1 = src_[NTHR]; rg2 = src_[2 * NTHR]; rg3 = src_[3 * NTHR]; rg4 = src_[4 * NTHR]; } while (0)
#define SCAN_PUT(buf_, i_, v_) do { const int id_ = tid + NTHR * (i_); *(uint4*)((buf_) + (id_ >> 3) * RP + (id_ & 7) * 8) = (v_); } while (0)
#define SCAN_COMMIT(buf_) do { SCAN_PUT(buf_, 0, rg0); SCAN_PUT(buf_, 1, rg1); SCAN_PUT(buf_, 2, rg2); SCAN_PUT(buf_, 3, rg3); SCAN_PUT(buf_, 4, rg4); } while (0)
    f32x4 S[4];
#pragma unroll
    for (int m = 0; m < 4; ++m) S[m] = (f32x4){0.f, 0.f, 0.f, 0.f};
    const int r16 = lane & 15, g = lane >> 4;
    SCAN_ISSUE(0); SCAN_COMMIT(buf0);
    __syncthreads();
    for (int c = 0; c < 128; ++c) {
        u16* cur = (c & 1) ? buf1 : buf0; u16* nxt = (c & 1) ? buf0 : buf1;
        if (c + 1 < 128) SCAN_ISSUE(c + 1);
        if (w < 4) {
            const float dec = egl[c];
            const u16* Ub = cur;
            const u16* Wb = cur + 64 * RP;
            const u16* QKb = cur + 128 * RP;
            const u16* QGb = cur + 192 * RP;
            const u16* KDb = cur + 256 * RP;
            bf16x8 Sb[2];
#pragma unroll
            for (int s = 0; s < 2; ++s) Sb[s] = pack8(S[2 * s][0], S[2 * s][1], S[2 * s][2], S[2 * s][3], S[2 * s + 1][0], S[2 * s + 1][1], S[2 * s + 1][2], S[2 * s + 1][3]);
            f32x4 vn[4], o[4];
#pragma unroll
            for (int mb = 0; mb < 4; ++mb) {
                f32x4 a = (f32x4){0.f, 0.f, 0.f, 0.f}, oo = (f32x4){0.f, 0.f, 0.f, 0.f};
#pragma unroll
                for (int s = 0; s < 2; ++s) {
                    const u16* pw = Wb + (16 * mb + r16) * RP + 32 * s + 4 * g;
                    const u16* pq = QGb + (16 * mb + r16) * RP + 32 * s + 4 * g;
                    a = MFMA16(cat4(*(const bf16x4*)pw, *(const bf16x4*)(pw + 16)), Sb[s], a);
                    oo = MFMA16(cat4(*(const bf16x4*)pq, *(const bf16x4*)(pq + 16)), Sb[s], oo);
                }
#pragma unroll
                for (int e = 0; e < 4; ++e) vn[mb][e] = bf2f(Ub[(16 * mb + 4 * g + e) * RP + 16 * w + r16]) - a[e];
                o[mb] = oo;
            }
            bf16x8 Vb[2];
#pragma unroll
            for (int s = 0; s < 2; ++s) Vb[s] = pack8(vn[2 * s][0], vn[2 * s][1], vn[2 * s][2], vn[2 * s][3], vn[2 * s + 1][0], vn[2 * s + 1][1], vn[2 * s + 1][2], vn[2 * s + 1][3]);
#pragma unroll
            for (int mb = 0; mb < 4; ++mb) {
                f32x4 oo = o[mb];
                f32x4 sn = S[mb] * dec;
#pragma unroll
                for (int s = 0; s < 2; ++s) {
                    const u16* pk = QKb + (16 * mb + r16) * RP + 32 * s + 4 * g;
                    const u16* pd = KDb + (16 * mb + r16) * RP + 32 * s + 4 * g;
                    oo = MFMA16(cat4(*(const bf16x4*)pk, *(const bf16x4*)(pk + 16)), Vb[s], oo);
                    sn = MFMA16(cat4(*(const bf16x4*)pd, *(const bf16x4*)(pd + 16)), Vb[s], sn);
                }
                S[mb] = sn;
#pragma unroll
                for (int e = 0; e < 4; ++e)
                    gout[(size_t)(b * SEQ + c * 64 + 16 * mb + 4 * g + e) * 256 + head * 64 + 16 * w + r16] = oo[e];
            }
        }
        if (c + 1 < 128) SCAN_COMMIT(nxt);
        __syncthreads();
    }
}

DI void phase_gdn_norm(const Params& P, int layer) {
    const int w = threadIdx.x >> 6, lane = threadIdx.x & 63;
    const float* gout = (const float*)(P.ws + OFF_GDNO);
    const u16* z = (const u16*)(P.ws + OFF_Z);
    u16* mix = (u16*)(P.ws + OFF_ABUF);
    const float4 ng = ((const float4*)(P.in[6] + layer * 64))[lane & 15];
    for (int t = blockIdx.x * 8 + w; t < NT; t += gridDim.x * 8) {
        const float4 o = ((const float4*)(gout + (size_t)t * 256))[lane];
        float ss = o.x * o.x + o.y * o.y + o.z * o.z + o.w * o.w;
        ss += __shfl_xor(ss, 1); ss += __shfl_xor(ss, 2); ss += __shfl_xor(ss, 4); ss += __shfl_xor(ss, 8);
        const float rstd = rsqrtf(ss * (1.f / 64.f) + 1e-6f);
        const uint2 zz = *(const uint2*)(z + (size_t)t * 256 + lane * 4);
        const float z0 = bf2f((u16)(zz.x & 0xffff)), z1 = bf2f((u16)(zz.x >> 16)), z2 = bf2f((u16)(zz.y & 0xffff)), z3 = bf2f((u16)(zz.y >> 16));
        uint2 r;
        r.x = pack2(o.x * rstd * ng.x * z0 * sigmoidf_(z0), o.y * rstd * ng.y * z1 * sigmoidf_(z1));
        r.y = pack2(o.z * rstd * ng.z * z2 * sigmoidf_(z2), o.w * rstd * ng.w * z3 * sigmoidf_(z3));
        *(uint2*)(mix + (size_t)t * DM + lane * 4) = r;
    }
}

template <bool FINAL>
DI void s5_item(const Params& P, int layer, int item, char* wlds, int lane) {
    const int b = item >> 11, g = (item >> 7) & 15, ch = item & 127;
    const int t0 = b * SEQ + ch * 64;
    const char* sp = P.ws + OFF_S5P + layer * S5P_LAYER;
    float* ut = (float*)wlds;
    u16* Xs = (u16*)(wlds + 4096);
    {
        const u16* src = (const u16*)(P.ws + OFF_US) + (size_t)(t0 + lane) * 256 + g * 16;
        const uint4 a = *(const uint4*)src, c = *(const uint4*)(src + 8);
        const unsigned uu[8] = {a.x, a.y, a.z, a.w, c.x, c.y, c.z, c.w};
#pragma unroll
        for (int i = 0; i < 8; ++i) { ut[lane * 16 + 2 * i] = bf2f((u16)(uu[i] & 0xffff)); ut[lane * 16 + 2 * i + 1] = bf2f((u16)(uu[i] >> 16)); }
    }
    float Br[16], Bi[16];
    {
        const float4* br = (const float4*)(sp + S5P_BRE) + (g * 64 + lane) * 4; const float4* bi = (const float4*)(sp + S5P_BIM) + (g * 64 + lane) * 4;
#pragma unroll
        for (int i = 0; i < 4; ++i) { const float4 x = br[i], y = bi[i]; Br[4 * i] = x.x; Br[4 * i + 1] = x.y; Br[4 * i + 2] = x.z; Br[4 * i + 3] = x.w; Bi[4 * i] = y.x; Bi[4 * i + 1] = y.y; Bi[4 * i + 2] = y.z; Bi[4 * i + 3] = y.w; }
    }
    const float2 ab = ((const float2*)(sp + S5P_ABAR))[g * 64 + lane];
    float2* st = (float2*)(P.ws + OFF_S5ST) + (size_t)item * 64 + lane;
    float xr = 0.f, xi = 0.f;
    if (FINAL) { const float2 c0 = *st; xr = c0.x; xi = c0.y; }
    bf16x8 cf[4];
    if (FINAL) {
        const u16* cm = (const u16*)(sp + S5P_CM) + (g * 16 + (lane & 15)) * 128 + 8 * (lane >> 4);
#pragma unroll
        for (int s = 0; s < 4; ++s) cf[s] = ld8(cm + 32 * s);
    }
    __builtin_amdgcn_wave_barrier();
    asm volatile("s_waitcnt lgkmcnt(0)" ::: "memory");
    for (int half = 0; half < 2; ++half) {
        for (int tt = 0; tt < 32; ++tt) {
            const int t = half * 32 + tt;
            const float4* u4 = (const float4*)(ut + t * 16);
            float br_ = 0.f, bi_ = 0.f;
#pragma unroll
            for (int q = 0; q < 4; ++q) {
                const float4 u = u4[q];
                br_ += Br[4 * q] * u.x + Br[4 * q + 1] * u.y + Br[4 * q + 2] * u.z + Br[4 * q + 3] * u.w;
                bi_ += Bi[4 * q] * u.x + Bi[4 * q + 1] * u.y + Bi[4 * q + 2] * u.z + Bi[4 * q + 3] * u.w;
            }
            const float nr = ab.x * xr - ab.y * xi + br_, ni = ab.x * xi + ab.y * xr + bi_;
            xr = nr; xi = ni;
            if (FINAL) { Xs[tt * 136 + lane] = f2bf(xr); Xs[tt * 136 + 64 + lane] = f2bf(xi); }
        }
        if (FINAL) {
            asm volatile("s_waitcnt lgkmcnt(0)" ::: "memory");
            __builtin_amdgcn_wave_barrier();
            const int r16 = lane & 15, gg = lane >> 4;
            const float dsv = P.in[13][layer * 256 + g * 16 + r16];
#pragma unroll
            for (int mb = 0; mb < 2; ++mb) {
                f32x4 acc = (f32x4){0.f, 0.f, 0.f, 0.f};
#pragma unroll
                for (int s = 0; s < 4; ++s) acc = MFMA16(ld8(Xs + (16 * mb + r16) * 136 + 32 * s + 8 * gg), cf[s], acc);
#pragma unroll
                for (int e = 0; e < 4; ++e) {
                    const int tk = half * 32 + 16 * mb + 4 * gg + e;
                    const float y = acc[e] + dsv * ut[tk * 16 + r16];
                    ((u16*)(P.ws + OFF_YS5))[(size_t)(t0 + tk) * 256 + g * 16 + r16] = f2bf(gelu_tanh(y));
                }
            }
            asm volatile("s_waitcnt lgkmcnt(0)" ::: "memory");
            __builtin_amdgcn_wave_barrier();
        }
    }
    if (!FINAL) *st = make_float2(xr, xi);
    asm volatile("s_waitcnt lgkmcnt(0)" ::: "memory");
    __builtin_amdgcn_wave_barrier();
}
template <bool FINAL>
DI void phase_s5(const Params& P, int layer, char* lds) {
    const int w = threadIdx.x >> 6, lane = threadIdx.x & 63;
    char* wl = lds + w * 12800;
    for (int it = blockIdx.x * 8 + w; it < 8192; it += gridDim.x * 8) s5_item<FINAL>(P, layer, it, wl, lane);
}
constexpr int ATT_STAGE_B = 32768;
DI void attn_item(const Params& P, int layer, int b, int head, int qb, char* lds) {
    const int tid = threadIdx.x, lane = tid & 63, w = __builtin_amdgcn_readfirstlane(tid >> 6);
    const int m = w >> 2, wq = w & 3, r = lane & 31, hh = lane >> 5;
    PG8_LAS unsigned char* L = (PG8_LAS unsigned char*)lds;
    const u16* QC = (const u16*)(P.ws + OFF_QC);
    const u16* KC = (const u16*)(P.ws + OFF_KC);
    const u16* VT = (const u16*)(P.ws + OFF_VT);
    const int qw0 = qb * 128 + 32 * wq;
    const int q = qw0 + r;
    bf16x8 qf[4];
    {
        const u16* qp = QC + (size_t)(b * SEQ + q) * 512 + head * 128 + m * 64 + hh * 8;
#pragma unroll
        for (int s = 0; s < 4; ++s) qf[s] = ld8(qp + 16 * s);
    }
    f32x16 o[4];
#pragma unroll
    for (int d = 0; d < 4; ++d)
#pragma unroll
        for (int e = 0; e < 16; ++e) o[d][e] = 0.f;
    float mrun = -INFINITY, lrun = 0.f;
    const int nkv = 2 * (qb + 1);
    unsigned ksrc0, ksrc1, vsrc0, vsrc1;
    {
        int key = 4 * (2 * w) + (lane >> 4);     ksrc0 = (unsigned)(key * 1024 + (((lane & 15) ^ (key & 15)) << 4));
        key = 4 * (2 * w + 1) + (lane >> 4);     ksrc1 = (unsigned)(key * 1024 + (((lane & 15) ^ (key & 15)) << 4));
        int dv = 8 * (2 * w) + (lane >> 3);      vsrc0 = (unsigned)(dv * 128 + (((lane & 7) ^ ((dv >> 1) & 7)) << 4));
        dv = 8 * (2 * w + 1) + (lane >> 3);      vsrc1 = (unsigned)(dv * 128 + (((lane & 7) ^ ((dv >> 1) & 7)) << 4));
    }
    const char* kbase = (const char*)(KC + (size_t)(b * SEQ) * 512 + head * 128);
    const char* vbase = (const char*)(VT + (size_t)((b * 4 + head) * 128) * SEQ);
#define ATT_DMA(t_, st_) do { \
        const char* kb_ = kbase + (size_t)(t_) * 65536; const char* vb_ = vbase + (size_t)(t_) * 16384; \
        PG8_LAS unsigned char* d_ = L + (st_) * ATT_STAGE_B + w * 2048; \
        __builtin_amdgcn_global_load_lds((const unsigned*)(kb_ + ksrc0), (PG8_LAS unsigned*)(d_), 16, 0, 0); \
        __builtin_amdgcn_global_load_lds((const unsigned*)(kb_ + ksrc1), (PG8_LAS unsigned*)(d_ + 1024), 16, 0, 0); \
        __builtin_amdgcn_global_load_lds((const unsigned*)(vb_ + vsrc0), (PG8_LAS unsigned*)(d_ + 16384), 16, 0, 0); \
        __builtin_amdgcn_global_load_lds((const unsigned*)(vb_ + vsrc1), (PG8_LAS unsigned*)(d_ + 16384 + 1024), 16, 0, 0); } while (0)
    int koff[4], voff[4];
#pragma unroll
    for (int s = 0; s < 4; ++s) {
        koff[s] = r * 256 + ((((m * 8 + hh + 2 * s) ^ (r & 15)) & 15) << 4);
        voff[s] = 16384 + r * 128 + ((((2 * s + hh) ^ ((r >> 1) & 7)) & 7) << 4);
    }
#define ATT_LD16(off_) (*(const PG8_LAS bf16x8*)(L + (off_)))
#define ATT_QK(stb_, init_) do { \
        const float in_ = (init_); \
        _Pragma("unroll") for (int e = 0; e < 16; ++e) { s0[e] = in_; s1[e] = in_; } \
        bf16x8 ka[4], kb[4]; \
        _Pragma("unroll") for (int s = 0; s < 4; ++s) { ka[s] = ATT_LD16((stb_) + koff[s]); kb[s] = ATT_LD16((stb_) + koff[s] + 8192); } \
        __builtin_amdgcn_sched_barrier(0); \
        _Pragma("unroll") for (int s = 0; s < 4; ++s) { \
            s0 = MFMA32(ka[s], qf[s], s0); \
            s1 = MFMA32(kb[s], qf[s], s1); } } while (0)
#define ATT_MASK(j_) do { \
        if (64 * (j_) + 63 > qw0) { \
            _Pragma("unroll") for (int e = 0; e < 16; ++e) { \
                const int key = 64 * (j_) + (e & 3) + 8 * (e >> 2) + 4 * hh; \
                if (key > q) s0[e] = -INFINITY; \
                if (key + 32 > q) s1[e] = -INFINITY; } } } while (0)
#define ATT_PACK() do { \
        pf[0] = pack8(s0[0], s0[1], s0[2], s0[3], s0[4], s0[5], s0[6], s0[7]); \
        pf[1] = pack8(s0[8], s0[9], s0[10], s0[11], s0[12], s0[13], s0[14], s0[15]); \
        pf[2] = pack8(s1[0], s1[1], s1[2], s1[3], s1[4], s1[5], s1[6], s1[7]); \
        pf[3] = pack8(s1[8], s1[9], s1[10], s1[11], s1[12], s1[13], s1[14], s1[15]); } while (0)
#define ATT_SM_HEAVY(j_) do { \
        ATT_MASK(j_); \
        float mx = s0[0]; \
        _Pragma("unroll") for (int e = 1; e < 16; ++e) mx = fmaxf(mx, s0[e]); \
        _Pragma("unroll") for (int e = 0; e < 16; ++e) mx = fmaxf(mx, s1[e]); \
        mx = fmaxf(mx, __shfl_xor(mx, 32)); \
        float mnew = mrun; \
        if (__builtin_amdgcn_ballot_w64(mx > mrun + 8.f) != 0ull) { \
            mnew = fmaxf(mrun, mx); \
            const float alpha = __builtin_amdgcn_exp2f(mrun - mnew); \
            mrun = mnew; lrun *= alpha; \
            _Pragma("unroll") for (int d = 0; d < 4; ++d) o[d] = o[d] * alpha; } \
        float psum = 0.f; \
        _Pragma("unroll") for (int e = 0; e < 16; ++e) { s0[e] = __builtin_amdgcn_exp2f(s0[e] - mnew); psum += s0[e]; } \
        _Pragma("unroll") for (int e = 0; e < 16; ++e) { s1[e] = __builtin_amdgcn_exp2f(s1[e] - mnew); psum += s1[e]; } \
        lrun += psum; \
        ATT_PACK(); } while (0)
#define ATT_SM_LIGHT(j_) do { \
        ATT_MASK(j_); \
        _Pragma("unroll") for (int e = 0; e < 16; ++e) { s0[e] = __builtin_amdgcn_exp2f(s0[e]); s1[e] = __builtin_amdgcn_exp2f(s1[e]); } \
        { float ps_ = 0.f; _Pragma("unroll") for (int e = 0; e < 16; ++e) ps_ += s0[e] + s1[e]; lrun += ps_; } \
        ATT_PACK(); } while (0)
#define ATT_LDV(dst_, stb_, d_) do { _Pragma("unroll") for (int kk = 0; kk < 4; ++kk) dst_[kk] = ATT_LD16((stb_) + voff[kk] + (d_) * 4096); } while (0)
#define ATT_MM4(d_, src_) do { __builtin_amdgcn_s_setprio(1); _Pragma("unroll") for (int kk = 0; kk < 4; ++kk) o[d_] = MFMA32(src_[kk], pf[kk], o[d_]); __builtin_amdgcn_s_setprio(0); } while (0)
#define ATT_PV(stb_) do { \
        bf16x8 va[4], vb[4]; \
        ATT_LDV(va, stb_, 0); __builtin_amdgcn_sched_barrier(0); \
        ATT_LDV(vb, stb_, 1); __builtin_amdgcn_sched_barrier(0); ATT_MM4(0, va); __builtin_amdgcn_sched_barrier(0); \
        ATT_LDV(va, stb_, 2); __builtin_amdgcn_sched_barrier(0); ATT_MM4(1, vb); __builtin_amdgcn_sched_barrier(0); \
        ATT_LDV(vb, stb_, 3); __builtin_amdgcn_sched_barrier(0); ATT_MM4(2, va); __builtin_amdgcn_sched_barrier(0); \
        ATT_MM4(3, vb); } while (0)
#define ATT_BAR(n_) do { asm volatile("s_waitcnt vmcnt(" #n_ ")" ::: "memory"); __builtin_amdgcn_s_barrier(); asm volatile("" ::: "memory"); __builtin_amdgcn_sched_barrier(0); } while (0)
    bf16x8 pf[4];
    bool pend = false;
    bool first_ = true;
    ATT_DMA(0, 0); ATT_DMA(1, 1);
    asm volatile("" :: "v"(qf[0]), "v"(qf[1]), "v"(qf[2]), "v"(qf[3]));
    ATT_BAR(4);
#pragma unroll 1
    for (int j = 0; j < nkv; ++j) {
        const int cur = (j & 3) * ATT_STAGE_B, prv = ((j + 3) & 3) * ATT_STAGE_B;
        const bool more = j + 2 < nkv;
        if (more) ATT_DMA(j + 2, (j + 2) & 3);
        const bool act = 64 * j <= qw0 + 31;
        const bool heavy = ((j & 15) == 0) || first_;
        f32x16 s0, s1;
        if (act) { if (heavy) { ATT_QK(cur, 0.f); } else { ATT_QK(cur, -mrun); } }
        if (pend) { ATT_PV(prv); pend = false; }
        if (act) { if (heavy) { ATT_SM_HEAVY(j); } else { ATT_SM_LIGHT(j); } first_ = false; pend = true; }
        if (more) { ATT_BAR(4); } else { ATT_BAR(0); }
    }
    if (pend) { ATT_PV(((nkv - 1) & 3) * ATT_STAGE_B); }
    __syncthreads();
    const float ltot = lrun + __shfl_xor(lrun, 32);
    const float inv = 1.f / ltot;
    float* ex = (float*)lds;
    if (m == 1) {
#pragma unroll
        for (int d = 0; d < 4; ++d)
#pragma unroll
            for (int e = 0; e < 16; ++e) ex[(wq * 64 + d * 16 + e) * 64 + lane] = o[d][e] * inv;
    }
    __syncthreads();
    if (m == 0) {
        const float lam = ((const float*)(P.ws + OFF_SCAL))[layer];
        const float lam_init = 0.8f - 0.6f * __expf(-0.3f * (float)layer);
        float ss = 0.f;
#pragma unroll
        for (int d = 0; d < 4; ++d)
#pragma unroll
            for (int e = 0; e < 16; ++e) { const float v = o[d][e] * inv - lam * ex[(wq * 64 + d * 16 + e) * 64 + lane]; o[d][e] = v; ss += v * v; }
        ss += __shfl_xor(ss, 32);
        const float scl = rsqrtf(ss * (1.f / 128.f) + 1e-6f) * (1.f - lam_init);
        const float* ng = P.in[21] + layer * 128;
        u16* mix = (u16*)(P.ws + OFF_ABUF) + (size_t)(b * SEQ + q) * DM + 512 + head * 128;
#pragma unroll
        for (int d = 0; d < 4; ++d)
#pragma unroll
            for (int qd = 0; qd < 4; ++qd) {
                const int dv0 = 32 * d + 8 * qd + 4 * hh;
                const float4 g4 = *(const float4*)(ng + dv0);
                uint2 pk; pk.x = pack2(o[d][4 * qd] * scl * g4.x, o[d][4 * qd + 1] * scl * g4.y); pk.y = pack2(o[d][4 * qd + 2] * scl * g4.z, o[d][4 * qd + 3] * scl * g4.w);
                *(uint2*)(mix + dv0) = pk;
            }
    }
    __syncthreads();
#undef ATT_DMA
#undef ATT_LD16
#undef ATT_BAR
#undef ATT_QK
#undef ATT_MASK
#undef ATT_PACK
#undef ATT_SM_HEAVY
#undef ATT_SM_LIGHT
#undef ATT_PV
#undef ATT_LDV
#undef ATT_MM4
}
DI void phase_attn(const Params& P, int layer, char* lds, int cidx = 0) {
    unsigned* ctr = (unsigned*)(P.ws + OFF_CTL + 16384 + (layer + 2 * cidx) * 256);
    volatile int* slot = (volatile int*)(lds + LDS_BYTES - 32);
    for (;;) {
        if (threadIdx.x == 0) *slot = (int)atomicAdd(ctr, 1u);
        __syncthreads();
        const int idx = *slot;
        __syncthreads();
        if (idx >= 1024) break;
        const int qb = 63 - (idx >> 4), bh = idx & 15;
        attn_item(P, layer, bh >> 2, bh & 3, qb, lds);
    }
}

DI void sort16_desc(float (&a)[16]) {
#pragma unroll
    for (int k = 2; k <= 16; k <<= 1)
#pragma unroll
        for (int j = k >> 1; j > 0; j >>= 1)
#pragma unroll
            for (int i = 0; i < 16; ++i) {
                const int l = i ^ j;
                if (l > i) {
                    const float hi = fmaxf(a[i], a[l]), lo = fminf(a[i], a[l]);
                    if ((i & k) == 0) { a[i] = hi; a[l] = lo; } else { a[i] = lo; a[l] = hi; }
                }
            }
}
DI void merge_top16(float (&a)[16], const float (&b)[16]) {
#pragma unroll
    for (int i = 0; i < 16; ++i) a[i] = fmaxf(a[i], b[15 - i]);
#pragma unroll
    for (int j = 8; j > 0; j >>= 1)
#pragma unroll
        for (int i = 0; i < 16; ++i) {
            const int l = i ^ j;
            if (l > i) { const float hi = fmaxf(a[i], a[l]), lo = fminf(a[i], a[l]); a[i] = hi; a[l] = lo; }
        }
}
DI void phase_topk(const Params& P, int layer, char* lds) {
    const int w = threadIdx.x >> 6, lane = threadIdx.x & 63, r = lane & 31, hh = lane >> 5;
    const u16* PQ = (const u16*)(P.ws + OFF_PQ);
    const u16* KEYS = (const u16*)(P.ws + OFF_KEYS) + (size_t)layer * 8 * 2 * 128 * 64;
    unsigned* pk32 = (unsigned*)(P.ws + OFF_PICKE);
    unsigned* Hs = (unsigned*)lds;
    unsigned char* mytab = (unsigned char*)(lds + 4096 + threadIdx.x * 32);
    for (int it0 = blockIdx.x * 8; it0 < 8192; it0 += gridDim.x * 8) {
        const int it = it0 + w;
        const int tile = it >> 3, h = it & 7; const int tok = tile * 32 + r;
        float sv[2][16];
#pragma unroll
        for (int p = 0; p < 2; ++p) {
            bf16x8 bq[4];
            const u16* qp = PQ + (size_t)tok * 1024 + h * 128 + p * 64 + hh * 8;
#pragma unroll
            for (int s = 0; s < 4; ++s) bq[s] = ld8(qp + 16 * s);
            float blk[4][16];
#pragma unroll
            for (int kb = 0; kb < 4; ++kb) {
                f32x16 acc;
#pragma unroll
                for (int e = 0; e < 16; ++e) acc[e] = 0.f;
                const u16* kp = KEYS + ((size_t)((h * 2 + p) * 128 + 32 * kb + r)) * 64 + hh * 8;
#pragma unroll
                for (int s = 0; s < 4; ++s) acc = MFMA32(ld8(kp + 16 * s), bq[s], acc);
#pragma unroll
                for (int e = 0; e < 16; ++e) {
                    const unsigned key = 32 * kb + (e & 3) + 8 * (e >> 2) + 4 * hh;
                    blk[kb][e] = __uint_as_float((__float_as_uint(acc[e]) & ~0x7Fu) | key);
                }
                sort16_desc(blk[kb]);
            }
            merge_top16(blk[0], blk[1]); merge_top16(blk[2], blk[3]); merge_top16(blk[0], blk[2]);
            float oth[16];
#pragma unroll
            for (int k = 0; k < 16; ++k) oth[k] = __shfl_xor(blk[0][k], 32);
            merge_top16(blk[0], oth);
#pragma unroll
            for (int k = 0; k < 16; ++k) sv[p][k] = blk[0][k];
        }
        {
            uint4 t0, t1; unsigned* a0 = (unsigned*)&t0; unsigned* a1 = (unsigned*)&t1;
#pragma unroll
            for (int q = 0; q < 4; ++q) {
                a0[q] = (__float_as_uint(sv[0][4 * q]) & 0x7Fu) | ((__float_as_uint(sv[0][4 * q + 1]) & 0x7Fu) << 8) | ((__float_as_uint(sv[0][4 * q + 2]) & 0x7Fu) << 16) | ((__float_as_uint(sv[0][4 * q + 3]) & 0x7Fu) << 24);
                a1[q] = (__float_as_uint(sv[1][4 * q]) & 0x7Fu) | ((__float_as_uint(sv[1][4 * q + 1]) & 0x7Fu) << 8) | ((__float_as_uint(sv[1][4 * q + 2]) & 0x7Fu) << 16) | ((__float_as_uint(sv[1][4 * q + 3]) & 0x7Fu) << 24);
            }
            *(uint4*)mytab = t0; *(uint4*)(mytab + 16) = t1;
        }
        float top[16], b1[16], b2[16], b3[16];
#pragma unroll
        for (int k = 0; k < 16; ++k) { b1[k] = -INFINITY; b2[k] = -INFINITY; b3[k] = -INFINITY; }
        {
            int cnt = 0;
#pragma unroll
            for (int i = 0; i < 16; ++i)
#pragma unroll
                for (int j = 0; j < 16; ++j)
                    if ((i + 1) * (j + 1) <= 16) {
                        const float sm = __uint_as_float(__float_as_uint(sv[0][i]) & ~0x7Fu) + __uint_as_float(__float_as_uint(sv[1][j]) & ~0x7Fu);
                        const float pk = __uint_as_float((__float_as_uint(sm) & ~0xFFu) | (unsigned)(i * 16 + j));
                        if (i == 0) top[j] = pk;
                        else { if (cnt < 16) b1[cnt] = pk; else if (cnt < 32) b2[cnt - 16] = pk; else b3[cnt - 32] = pk; ++cnt; }
                    }
        }
        sort16_desc(b1); sort16_desc(b2);
        { const float hi = fmaxf(b3[0], b3[1]), lo = fminf(b3[0], b3[1]); b3[0] = hi; b3[1] = lo; }
        merge_top16(top, b1); merge_top16(b2, b3); merge_top16(top, b2);
        float ev[16]; float den = 0.f;
        const float mx = __uint_as_float(__float_as_uint(top[0]) & ~0xFFu);
#pragma unroll
        for (int k = 0; k < 16; ++k) { ev[k] = __expf(__uint_as_float(__float_as_uint(top[k]) & ~0xFFu) - mx); den += ev[k]; }
        const float rden = 1.f / den;
        unsigned ex[16]; unsigned c_lo = 0, c_hi = 0;
#pragma unroll
        for (int k = 0; k < 16; ++k) {
            const unsigned code = __float_as_uint(top[k]) & 0xFFu;
            ex[k] = (unsigned)mytab[code >> 4] * 128u + (unsigned)mytab[16 + (code & 15u)];
        }
        unsigned rk[16];
#pragma unroll
        for (int k = 0; k < 16; ++k) {
            const unsigned pt = ex[k] >> 11; const unsigned sh = 8u * (pt & 3u); const bool islo = pt < 4u;
            rk[k] = ((islo ? c_lo : c_hi) >> sh) & 0xFFu;
            c_lo += islo ? (1u << sh) : 0u; c_hi += islo ? 0u : (1u << sh);
        }
        if (hh == 0) { Hs[(r * 8 + h) * 2] = c_lo; Hs[(r * 8 + h) * 2 + 1] = c_hi; }
        __syncthreads();
        unsigned tot_lo = 0, tot_hi = 0, bef_lo = 0, bef_hi = 0;
#pragma unroll
        for (int hq = 0; hq < 8; ++hq) {
            const unsigned a = Hs[(r * 8 + hq) * 2], b = Hs[(r * 8 + hq) * 2 + 1];
            tot_lo += a; tot_hi += b;
            if (hq < h) { bef_lo += a; bef_hi += b; }
        }
        unsigned offp[9]; offp[0] = 0;
#pragma unroll
        for (int pt = 0; pt < 8; ++pt) offp[pt + 1] = offp[pt] + (((pt < 4 ? tot_lo : tot_hi) >> (8 * (pt & 3))) & 0xFFu);
        if (h == 0 && hh == 0) {
            uint4 ob; ob.x = offp[0] | (offp[1] << 8) | (offp[2] << 16) | (offp[3] << 24); ob.y = offp[4] | (offp[5] << 8) | (offp[6] << 16) | (offp[7] << 24); ob.z = offp[8]; ob.w = 0;
            ((uint4*)(P.ws + OFF_OFFS))[tok] = ob;
        }
        const unsigned base_lo = (offp[0] | (offp[1] << 8) | (offp[2] << 16) | (offp[3] << 24)) + bef_lo;
        const unsigned base_hi = (offp[4] | (offp[5] << 8) | (offp[6] << 16) | (offp[7] << 24)) + bef_hi;
#pragma unroll
        for (int k = 0; k < 16; ++k) {
            if ((k >> 3) == hh) {
                const unsigned pt = ex[k] >> 11; const unsigned sh = 8u * (pt & 3u);
                const unsigned pos = (((pt < 4u ? base_lo : base_hi) >> sh) & 0xFFu) + rk[k];
                pk32[(size_t)tok * 128 + pos] = ((unsigned)f2bf(ev[k] * rden) << 16) | ex[k];
            }
        }
        __syncthreads();
    }
}

DI void fp8x16_to_f32(const uint4& u, float (&f)[16]) {
    const unsigned uu[4] = {u.x, u.y, u.z, u.w};
#pragma unroll
    for (int q = 0; q < 4; ++q) {
        const f32x2 lo = __builtin_amdgcn_cvt_pk_f32_fp8((int)uu[q], false), hi = __builtin_amdgcn_cvt_pk_f32_fp8((int)uu[q], true);
        f[4 * q] = lo[0]; f[4 * q + 1] = lo[1]; f[4 * q + 2] = hi[0]; f[4 * q + 3] = hi[1];
    }
}
template <int CTRL> DI int dpp_i(int v) { return __builtin_amdgcn_update_dpp(0, v, CTRL, 0xF, 0xF, true); }
template <int CTRL> DI float dpp_f(float v) { return __int_as_float(__builtin_amdgcn_update_dpp(0, __float_as_int(v), CTRL, 0xF, 0xF, true)); }
DI float wave_sum_fast(float v) {
    v += dpp_f<0xB1>(v); v += dpp_f<0x4E>(v); v += dpp_f<0x124>(v); v += dpp_f<0x128>(v);
    v += __shfl_xor(v, 16); v += __shfl_xor(v, 32); return v;
}
DI int rowreduce4(int p0, int p1, int p2, int p3, bool odd, bool bit1) {
    const int a01 = odd ? p1 : p0, b01 = odd ? p0 : p1;
    const int r01 = a01 + dpp_i<0xB1>(b01);
    const int a23 = odd ? p3 : p2, b23 = odd ? p2 : p3;
    const int r23 = a23 + dpp_i<0xB1>(b23);
    const int a = bit1 ? r23 : r01, b = bit1 ? r01 : r23;
    int r = a + dpp_i<0x4E>(b);
    r += dpp_i<0x124>(r);
    r += dpp_i<0x128>(r);
    return r;
}
DI int dot16_i8(const uint4& u, const int (&xq)[4]) {
    int p = __builtin_amdgcn_sdot4((int)u.x, xq[0], 0, false);
    p = __builtin_amdgcn_sdot4((int)u.y, xq[1], p, false);
    p = __builtin_amdgcn_sdot4((int)u.z, xq[2], p, false);
    p = __builtin_amdgcn_sdot4((int)u.w, xq[3], p, false);
    return p;
}
#define PEER_LOAD8(buf_, tab_, ev_, base_) do { _Pragma("unroll") for (int i_ = 0; i_ < 8; ++i_) { \
        const int e_ = __builtin_amdgcn_readlane((ev_), (base_) + i_); buf_[i_] = *(const uint4*)((tab_) + (size_t)e_ * 1024 + lane * 16); } } while (0)

#define RL(v_, i_) __builtin_amdgcn_readlane((int)(v_), (i_))
#define PEER_OFFS(p_, j_, BASE_, N_) do { \
        const unsigned ox_ = (unsigned)RL(myoff.x, j_), oy_ = (unsigned)RL(myoff.y, j_), oz_ = (unsigned)RL(myoff.z, j_); \
        const int p0_ = (p_), p1_ = (p_) + 1; \
        const unsigned lo_ = p0_ < 4 ? (ox_ >> (8 * p0_)) & 255u : (oy_ >> (8 * (p0_ - 4))) & 255u; \
        const unsigned hi_ = p1_ < 4 ? (ox_ >> (8 * p1_)) & 255u : p1_ < 8 ? (oy_ >> (8 * (p1_ - 4))) & 255u : (oz_ & 255u); \
        BASE_ = (int)lo_; N_ = (int)(hi_ - lo_); } while (0)
typedef __attribute__((ext_vector_type(4))) unsigned u32x4_t;
typedef __attribute__((ext_vector_type(2))) unsigned u32x2_t;
#define PEER_ROWS8B(buf_, rs_, ev_, b_) do { _Pragma("unroll") for (int k_ = 0; k_ < 8; ++k_) { \
        int li_ = 8 * (b_) + k_; li_ = li_ > 63 ? 63 : li_; const int eo_ = RL(ev_, li_); \
        buf_[k_] = __builtin_bit_cast(uint4, __builtin_amdgcn_raw_buffer_load_b128(rs_, lane * 16, eo_, 0)); } } while (0)
#define PEER_ROWS8(buf_, tab_, ev_, b_) do { _Pragma("unroll") for (int k_ = 0; k_ < 8; ++k_) { \
        int li_ = 8 * (b_) + k_; li_ = li_ > 63 ? 63 : li_; const int e_ = RL(ev_, li_); buf_[k_] = *(const uint4*)((tab_) + (size_t)e_ * 1024 + lane * 16); } } while (0)

struct PeerMeta { int e; float g, su, sx, sv; int slot; int idx; int valid; };
DI void phase_peer_u(const Params& P, int layer, char* lds) {
    const int w = threadIdx.x >> 6, lane = threadIdx.x & 63;
    const uint8_t* UT = (const uint8_t*)(P.ws + OFF_UTAB) + (size_t)layer * 16384 * 1024;
    const __amdgpu_buffer_rsrc_t urs = __builtin_amdgcn_make_buffer_rsrc((void*)UT, 0, 16384 * 1024, 0x00020000);
    const unsigned* pk32 = (const unsigned*)(P.ws + OFF_PICKE);
    const float2* sc2 = (const float2*)(P.ws + OFF_V8SC) + layer * 16384;
    float* coefb = (float*)(P.ws + OFF_COEF);
    const uint4* XQ4 = (const uint4*)(P.ws + OFF_XQ); const float* SXp = (const float*)(P.ws + OFF_SX);
    const int stride = gridDim.x * 8, t_first = blockIdx.x * 8 + w;
    const int ntok = t_first < NT ? (NT - t_first + stride - 1) / stride : 0;
    uint4* xql = (uint4*)(lds + w * 16384);
#pragma unroll 1
    for (int jg = 0; jg < ntok; jg += 16) {
        const int ng = (ntok - jg) < 16 ? (ntok - jg) : 16;
        for (int j = 0; j < ng; ++j) xql[j * 64 + lane] = XQ4[(size_t)(t_first + (jg + j) * stride) * 64 + lane];
        uint4 myoff = make_uint4(0, 0, 0, 0); float sxv = 0.f;
        if (lane < ng) { const int t = t_first + (jg + lane) * stride; myoff = ((const uint4*)(P.ws + OFF_OFFS))[t]; sxv = SXp[t]; }
#pragma unroll 1
        for (int p = 0; p < 8; ++p) {
            int nj, basej;
            {
                const unsigned lo = p < 4 ? (myoff.x >> (8 * p)) & 255u : (myoff.y >> (8 * (p - 4))) & 255u;
                const int p1 = p + 1;
                const unsigned hi = p1 < 4 ? (myoff.x >> (8 * p1)) & 255u : p1 < 8 ? (myoff.y >> (8 * (p1 - 4))) & 255u : (myoff.z & 255u);
                basej = (int)lo; nj = lane < ng ? (int)(hi - lo) : 0;
            }
            int pend = nj;
#pragma unroll
            for (int o = 1; o < 16; o <<= 1) { const int tt = __shfl_up(pend, o); if (lane >= o) pend += tt; }
            const int pref = pend - nj;
            const int L = RL(pend, 15);
            if (L == 0) continue;
            const int nsb = (L + 63) >> 6;
#define U_META(sb_, M_) do { \
                const int f_ = 64 * (sb_) + 4 * (lane & 15) + (lane >> 4);        \
                M_.valid = f_ < L; const int fc_ = M_.valid ? f_ : L - 1; \
                int j_ = 0; \
                _Pragma("unroll") for (int jj_ = 0; jj_ < 15; ++jj_) j_ += (jj_ < ng - 1 && fc_ >= RL(pend, jj_)) ? 1 : 0; \
                const int pj_ = __shfl(pref, j_), bj_ = __shfl(basej, j_); \
                M_.slot = j_; M_.idx = (t_first + (jg + j_) * stride) * 128 + bj_ + (fc_ - pj_); \
                const unsigned pw_ = pk32[M_.idx]; const int ee_ = (int)(pw_ & 0xFFFFu); M_.e = (int)(((unsigned)ee_ << 10) | ((unsigned)j_ << 28)); M_.g = __uint_as_float(pw_ & 0xFFFF0000u); { const float2 s2_ = sc2[ee_]; M_.su = s2_.x; M_.sv = s2_.y; } M_.sx = __shfl(sxv, j_); } while (0)
#define U_LOADB(buf_, M_, b_) do { _Pragma("unroll") for (int h_ = 0; h_ < 2; ++h_) { \
                const int pk_ = __builtin_amdgcn_ds_bpermute(((lane & 48) + 2 * (b_) + h_) << 2, M_.e); \
                const int vo_ = (pk_ & 0x0FFFFFFF) + (lane & 15) * 16; \
                _Pragma("unroll") for (int c_ = 0; c_ < 4; ++c_) buf_[4 * h_ + c_] = __builtin_bit_cast(uint4, __builtin_amdgcn_raw_buffer_load_b128(urs, vo_ + 256 * c_, 0, 0)); } } while (0)
            PeerMeta cur, nxt;
            U_META(0, cur);
            uint4 bufA[8], bufB[8], bufC[8], bufD[8];
            U_LOADB(bufA, cur, 0); U_LOADB(bufB, cur, 1); U_LOADB(bufC, cur, 2);
            int xslot = -1; uint4 xc0 = make_uint4(0, 0, 0, 0), xc1 = xc0, xc2 = xc0, xc3 = xc0;
#pragma unroll 1
            for (int sb = 0; sb < nsb; ++sb) {
                const bool has_next = sb + 1 < nsb;
                if (has_next) U_META(sb + 1, nxt); else nxt = cur;
                int md = 0;
#define U_DOT4(acc_, r_, x_) do { acc_ = __builtin_amdgcn_sdot4((int)(r_).x, (int)(x_).x, acc_, false); acc_ = __builtin_amdgcn_sdot4((int)(r_).y, (int)(x_).y, acc_, false); \
                    acc_ = __builtin_amdgcn_sdot4((int)(r_).z, (int)(x_).z, acc_, false); acc_ = __builtin_amdgcn_sdot4((int)(r_).w, (int)(x_).w, acc_, false); } while (0)
#define U_STEP(k_, cur_, pf_) do { \
                    if ((k_) + 3 < 8) { U_LOADB(pf_, cur, (k_) + 3); } else if (has_next) { U_LOADB(pf_, nxt, (k_) + 3 - 8); } \
                    asm volatile("" ::: "memory"); __builtin_amdgcn_sched_barrier(0); \
                    _Pragma("unroll") for (int h_ = 0; h_ < 2; ++h_) { \
                        const int q_ = 2 * (k_) + h_; \
                        const int pk_ = __builtin_amdgcn_ds_bpermute(((lane & 48) + q_) << 2, cur.e); \
                        const int sl_ = (int)((unsigned)pk_ >> 28); \
                        if (__builtin_amdgcn_ballot_w64(sl_ != xslot) != 0ull) {        \
                            const uint4* xp_ = xql + sl_ * 64 + (lane & 15); \
                            xc0 = xp_[0]; xc1 = xp_[16]; xc2 = xp_[32]; xc3 = xp_[48]; xslot = sl_; } \
                        int a0_ = 0, a1_ = 0; \
                        U_DOT4(a0_, cur_[4 * h_ + 0], xc0); U_DOT4(a1_, cur_[4 * h_ + 1], xc1); U_DOT4(a0_, cur_[4 * h_ + 2], xc2); U_DOT4(a1_, cur_[4 * h_ + 3], xc3); \
                        int r_ = a0_ + a1_; \
                        r_ += dpp_i<0xB1>(r_); r_ += dpp_i<0x4E>(r_); r_ += dpp_i<0x124>(r_); r_ += dpp_i<0x128>(r_); \
                        md = ((lane & 15) == q_) ? r_ : md; } \
                    asm volatile("" ::: "memory"); __builtin_amdgcn_sched_barrier(0); } while (0)
                U_STEP(0, bufA, bufD); U_STEP(1, bufB, bufA); U_STEP(2, bufC, bufB); U_STEP(3, bufD, bufC);
                U_STEP(4, bufA, bufD); U_STEP(5, bufB, bufA); U_STEP(6, bufC, bufB); U_STEP(7, bufD, bufC);
#undef U_STEP
#undef U_DOT4
                const float dot = (float)md * cur.su * cur.sx;
                const float coef = cur.g * gelu_tanh(dot) * cur.sv;
                if (cur.valid) coefb[cur.idx] = coef;
                cur = nxt;
            }
#undef U_LOADB
#undef U_META
        }
    }
}

DI void peer_token_epilogue(const Params& P, int layer, int t, int lane, const f32x2 (&y2)[8], const float* hin, float* hout, bool last, const float* wab_lds) {
    u16* abuf = (u16*)(P.ws + OFF_ABUF);
    float4 v[4];
    const float4* h4 = (const float4*)(hin + (size_t)t * DM + lane * 16);
#pragma unroll
    for (int i = 0; i < 4; ++i) { v[i] = h4[i]; v[i].x += y2[2 * i][0]; v[i].y += y2[2 * i][1]; v[i].z += y2[2 * i + 1][0]; v[i].w += y2[2 * i + 1][1]; }
    float ss = 0.f;
#pragma unroll
    for (int i = 0; i < 4; ++i) ss += v[i].x * v[i].x + v[i].y * v[i].y + v[i].z * v[i].z + v[i].w * v[i].w;
    ss = wave_sum_fast(ss);
    const float rstd = rsqrtf(ss * (1.f / DM) + 1e-6f);
    if (last) {
        const float4* g4 = (const float4*)(P.in[28]) + lane * 4;
        float4* o4 = (float4*)(hout + (size_t)t * DM + lane * 16);
#pragma unroll
        for (int i = 0; i < 4; ++i) { const float4 g = g4[i]; o4[i] = make_float4(v[i].x * rstd * g.x, v[i].y * rstd * g.y, v[i].z * rstd * g.z, v[i].w * rstd * g.w); }
    } else {
        float4* o4 = (float4*)(hout + (size_t)t * DM + lane * 16);
#pragma unroll
        for (int i = 0; i < 4; ++i) o4[i] = v[i];
        const float4* g4 = (const float4*)(P.in[1] + (layer + 1) * DM) + lane * 4;
        float vn[16];
#pragma unroll
        for (int i = 0; i < 4; ++i) { const float4 g = g4[i]; vn[4 * i] = v[i].x * rstd * g.x; vn[4 * i + 1] = v[i].y * rstd * g.y; vn[4 * i + 2] = v[i].z * rstd * g.z; vn[4 * i + 3] = v[i].w * rstd * g.w; }
        uint4 o0, o1;
        o0.x = pack2(vn[0], vn[1]); o0.y = pack2(vn[2], vn[3]); o0.z = pack2(vn[4], vn[5]); o0.w = pack2(vn[6], vn[7]);
        o1.x = pack2(vn[8], vn[9]); o1.y = pack2(vn[10], vn[11]); o1.z = pack2(vn[12], vn[13]); o1.w = pack2(vn[14], vn[15]);
        *(uint4*)(abuf + (size_t)t * DM + lane * 16) = o0; *(uint4*)(abuf + (size_t)t * DM + lane * 16 + 8) = o1;
        const float4* wab = (const float4*)wab_lds;
        float myacc = 0.f;
#pragma unroll 1
        for (int j = 0; j < 8; ++j) {
            float a = 0.f;
#pragma unroll
            for (int i = 0; i < 4; ++i) { const float4 ww = wab[j * 256 + lane * 4 + i]; a += vn[4 * i] * ww.x + vn[4 * i + 1] * ww.y + vn[4 * i + 2] * ww.z + vn[4 * i + 3] * ww.w; }
            a = wave_sum_fast(a);
            myacc = (lane == j) ? a : myacc;
        }
        const float bb = __shfl(myacc, (lane + 4) & 63);
        if (lane < 4) {
            const int L1 = layer + 1;
            const float a = myacc;
            const float xx = a + P.in[5][L1 * 4 + lane];
            const float sp = xx > 20.f ? xx : log1pf(__expf(xx));
            ((float*)(P.ws + OFF_GG))[t * 4 + lane] = -__expf(P.in[4][L1 * 4 + lane]) * sp;
            ((float*)(P.ws + OFF_BETA))[t * 4 + lane] = sigmoidf_(bb);
        }
    }
}

#ifndef V4_THR
#define V4_THR 0.25f
#endif
DI int peer_v_compact(int& e, float& c, bool small, int lane) {
    unsigned long long m = __builtin_amdgcn_ballot_w64(small);
    const unsigned long long lt = (1ull << lane) - 1ull;
    const int n8 = 64 - __popcll(m), n8r = (n8 + 7) & ~7;
    const int rank4 = __popcll(m & lt);
    if (small && rank4 < n8r - n8) small = false;
    m = __builtin_amdgcn_ballot_w64(small);
    const int pos = small ? n8r + __popcll(m & lt) : __popcll(~m & lt);
    e = __builtin_amdgcn_ds_permute(pos * 4, e);
    c = __int_as_float(__builtin_amdgcn_ds_permute(pos * 4, __float_as_int(c)));
    return n8r;
}
DI float wave_max(float v) {
    v = fmaxf(v, dpp_f<0xB1>(v)); v = fmaxf(v, dpp_f<0x4E>(v)); v = fmaxf(v, dpp_f<0x124>(v)); v = fmaxf(v, dpp_f<0x128>(v));
    v = fmaxf(v, __shfl_xor(v, 16)); v = fmaxf(v, __shfl_xor(v, 32)); return v;
}
#define VDOT_PAIR1(Y_, j_, a_, b_, sl_, sh_) do { \
        const int p01_ = (int)__builtin_amdgcn_perm((unsigned)(b_), (unsigned)(a_), 0x05010400u), p23_ = (int)__builtin_amdgcn_perm((unsigned)(b_), (unsigned)(a_), 0x07030602u); \
        Y_[4 * (j_)] = __builtin_amdgcn_sdot4(p01_, sl_, Y_[4 * (j_)], false); Y_[4 * (j_) + 1] = __builtin_amdgcn_sdot4(p01_, sh_, Y_[4 * (j_) + 1], false); \
        Y_[4 * (j_) + 2] = __builtin_amdgcn_sdot4(p23_, sl_, Y_[4 * (j_) + 2], false); Y_[4 * (j_) + 3] = __builtin_amdgcn_sdot4(p23_, sh_, Y_[4 * (j_) + 3], false); } while (0)
#define VDOT_PAIR(Y_, a0_, a1_, a2_, a3_, b0_, b1_, b2_, b3_, sl_, sh_) do { \
        VDOT_PAIR1(Y_, 0, a0_, b0_, sl_, sh_); VDOT_PAIR1(Y_, 1, a1_, b1_, sl_, sh_); VDOT_PAIR1(Y_, 2, a2_, b2_, sl_, sh_); VDOT_PAIR1(Y_, 3, a3_, b3_, sl_, sh_); } while (0)
struct VMeta { int e0, e1, cq0, cq1, nb0, nb1, zs; float f8, f4; };
DI VMeta peer_v_meta(int e0, int e1, float c0, float c1, int lane) {
    VMeta M;
    const float am = wave_max(fmaxf(fabsf(c0), fabsf(c1)));
    M.nb0 = peer_v_compact(e0, c0, fabsf(c0) < V4_THR * am, lane);
    M.nb1 = peer_v_compact(e1, c1, fabsf(c1) < V4_THR * am, lane);
    const bool q0 = lane >= M.nb0, q1 = lane >= M.nb1;
    if (q0) c0 *= (127.f / 7.f);
    if (q1) c1 *= (127.f / 7.f);
    const float m8 = wave_max(fmaxf(q0 ? 0.f : fabsf(c0), q1 ? 0.f : fabsf(c1)));
    const float m4 = wave_max(fmaxf(q0 ? fabsf(c0) : 0.f, q1 ? fabsf(c1) : 0.f));
    const float r8 = m8 > 0.f ? 127.f / m8 : 0.f, r4 = m4 > 0.f ? 127.f / m4 : 0.f;
    M.cq0 = (int)rintf(c0 * (q0 ? r4 : r8)); M.cq1 = (int)rintf(c1 * (q1 ? r4 : r8));
    int zs = (q0 ? M.cq0 : 0) + (q1 ? M.cq1 : 0);
    for (int o = 32; o > 0; o >>= 1) zs += __shfl_xor(zs, o);
    M.zs = zs; M.e0 = e0; M.e1 = e1; M.f8 = m8 * (1.f / 127.f); M.f4 = m4 * (1.f / 127.f);
    return M;
}
DI void phase_peer_v(const Params& P, int layer, const float* hin, float* hout, bool last, char* lds) {
    const int w = threadIdx.x >> 6, lane = threadIdx.x & 63;
    if (!last) { const float4* src = (const float4*)(P.ws + OFF_WAB) + (layer + 1) * 8 * 256; for (int i = threadIdx.x; i < 2048; i += NTHR) ((float4*)lds)[i] = src[i]; }
    __syncthreads();
    const uint8_t* VTb = (const uint8_t*)(P.ws + OFF_VTAB) + (size_t)layer * 16384 * 1024;
    const uint8_t* V4b = (const uint8_t*)(P.ws + OFF_V4TAB) + (size_t)layer * 16384 * 512;
    const __amdgpu_buffer_rsrc_t v8rs = __builtin_amdgcn_make_buffer_rsrc((void*)VTb, 0, 16384 * 1024, 0x00020000);
    const __amdgpu_buffer_rsrc_t v4rs = __builtin_amdgcn_make_buffer_rsrc((void*)V4b, 0, 16384 * 512, 0x00020000);
    const unsigned* pk32 = (const unsigned*)(P.ws + OFF_PICKE); const float* coefb = (const float*)(P.ws + OFF_COEF);
    const int stride = gridDim.x * 8;
    int t = blockIdx.x * 8 + w;
    if (t >= NT) return;
    uint4 bufA[8], bufB[8], bufC[8], bufD[8];
#define V_IS4(M_, k_) (8 * ((k_) & 7) >= (((k_) >> 3) ? M_.nb1 : M_.nb0))
#define V_LOAD(buf_, M_, k_) do { \
        if (V_IS4(M_, k_)) { _Pragma("unroll") for (int i_ = 0; i_ < 8; ++i_) { const int e_ = RL(((k_) >> 3) ? M_.e1 : M_.e0, 8 * ((k_) & 7) + i_); \
                const uint2 t_ = *(const uint2*)(V4b + (size_t)e_ * 512 + lane * 8); buf_[i_].x = t_.x; buf_[i_].y = t_.y; } } \
        else { _Pragma("unroll") for (int i_ = 0; i_ < 8; ++i_) { const int e_ = RL(((k_) >> 3) ? M_.e1 : M_.e0, 8 * ((k_) & 7) + i_); \
                buf_[i_] = *(const uint4*)(VTb + (size_t)e_ * 1024 + lane * 16); } } } while (0)
    VMeta cur = peer_v_meta((int)(pk32[(size_t)t * 128 + lane] & 0xFFFFu), (int)(pk32[(size_t)t * 128 + 64 + lane] & 0xFFFFu), coefb[(size_t)t * 128 + lane], coefb[(size_t)t * 128 + 64 + lane], lane);
    V_LOAD(bufA, cur, 0); V_LOAD(bufB, cur, 1); V_LOAD(bufC, cur, 2);
#pragma unroll 1
    for (; t < NT; t += stride) {
        const int tn = t + stride; const bool has_next = tn < NT;
        int ne0 = 0, ne1 = 0; float nc0 = 0.f, nc1 = 0.f;
        if (has_next) { ne0 = (int)(pk32[(size_t)tn * 128 + lane] & 0xFFFFu); ne1 = (int)(pk32[(size_t)tn * 128 + 64 + lane] & 0xFFFFu); nc0 = coefb[(size_t)tn * 128 + lane]; nc1 = coefb[(size_t)tn * 128 + 64 + lane]; }
        int y8[16], y4[16];
#pragma unroll
        for (int i = 0; i < 16; ++i) { y8[i] = 0; y4[i] = 0; }
#define V_STEP(k_, cur_, pf_) do { \
            if ((k_) + 3 < 16) { V_LOAD(pf_, cur, (k_) + 3); } \
            asm volatile("" ::: "memory"); __builtin_amdgcn_sched_barrier(0); \
            if (V_IS4(cur, k_)) { \
                _Pragma("unroll") for (int i = 0; i < 8; i += 2) { \
                    const int ca_ = RL(((k_) >> 3) ? cur.cq1 : cur.cq0, 8 * ((k_) & 7) + i) & 0xFF, cb_ = RL(((k_) >> 3) ? cur.cq1 : cur.cq0, 8 * ((k_) & 7) + i + 1) & 0xFF; \
                    const int sl_ = ca_ | (cb_ << 8), sh_ = sl_ << 16; \
                    const unsigned xa0 = cur_[i].x, xa1 = cur_[i].y, xb0 = cur_[i + 1].x, xb1 = cur_[i + 1].y; \
                    VDOT_PAIR(y4, xa0 & 0x0F0F0F0Fu, (xa0 >> 4) & 0x0F0F0F0Fu, xa1 & 0x0F0F0F0Fu, (xa1 >> 4) & 0x0F0F0F0Fu, \
                              xb0 & 0x0F0F0F0Fu, (xb0 >> 4) & 0x0F0F0F0Fu, xb1 & 0x0F0F0F0Fu, (xb1 >> 4) & 0x0F0F0F0Fu, sl_, sh_); } \
            } else { \
                _Pragma("unroll") for (int i = 0; i < 8; i += 2) { \
                    const int ca_ = RL(((k_) >> 3) ? cur.cq1 : cur.cq0, 8 * ((k_) & 7) + i) & 0xFF, cb_ = RL(((k_) >> 3) ? cur.cq1 : cur.cq0, 8 * ((k_) & 7) + i + 1) & 0xFF; \
                    const int sl_ = ca_ | (cb_ << 8), sh_ = sl_ << 16; \
                    VDOT_PAIR(y8, cur_[i].x, cur_[i].y, cur_[i].z, cur_[i].w, cur_[i + 1].x, cur_[i + 1].y, cur_[i + 1].z, cur_[i + 1].w, sl_, sh_); } } \
            asm volatile("" ::: "memory"); __builtin_amdgcn_sched_barrier(0); } while (0)
        V_STEP(0, bufA, bufD); V_STEP(1, bufB, bufA); V_STEP(2, bufC, bufB); V_STEP(3, bufD, bufC);
        V_STEP(4, bufA, bufD); V_STEP(5, bufB, bufA); V_STEP(6, bufC, bufB); V_STEP(7, bufD, bufC);
        V_STEP(8, bufA, bufD); V_STEP(9, bufB, bufA); V_STEP(10, bufC, bufB); V_STEP(11, bufD, bufC);
        V_STEP(12, bufA, bufD); V_STEP(13, bufB, bufA); V_STEP(14, bufC, bufB); V_STEP(15, bufD, bufC);
#undef V_STEP
        f32x2 y2[8];
#pragma unroll
        for (int i = 0; i < 8; ++i) y2[i] = (f32x2){(float)y8[2 * i] * cur.f8 + (float)(y4[2 * i] - 8 * cur.zs) * cur.f4, (float)y8[2 * i + 1] * cur.f8 + (float)(y4[2 * i + 1] - 8 * cur.zs) * cur.f4};
        if (has_next) {
            cur = peer_v_meta(ne0, ne1, nc0, nc1, lane);
            V_LOAD(bufA, cur, 0); V_LOAD(bufB, cur, 1); V_LOAD(bufC, cur, 2);
        }
        asm volatile("" ::: "memory"); __builtin_amdgcn_sched_barrier(0);
        peer_token_epilogue(P, layer, t, lane, y2, hin, hout, last, (const float*)lds);
    }
#undef V_LOAD
#undef V_IS4
}

#define XB_TMO      128
#define XB_XCNT(j)  (256  + 64 * (j))
#define XB_XSUB(j)  (1280 + 64 * (j))
#define XB_XGEN(j)  (2304 + 64 * (j))
#define XB_TOP      3328
#define XB_TOPGEN   3392
#define XCD_BAR_WORDS 3456
#define XB_SPIN_CAP (1u << 22)
#define LAS __attribute__((address_space(3)))
DI unsigned xb_ld(unsigned* p)              { return __hip_atomic_load(p, __ATOMIC_RELAXED, __HIP_MEMORY_SCOPE_AGENT); }
DI unsigned xb_add(unsigned* p, unsigned v) { return __hip_atomic_fetch_add(p, v, __ATOMIC_RELAXED, __HIP_MEMORY_SCOPE_AGENT); }
DI unsigned xb_xcc_id() { return (unsigned)__builtin_amdgcn_s_getreg((3 << 11) | 20) & 0xFu; }
#define XB_SPIN(cond, bar) do { unsigned _sp = 0; while (cond) { __builtin_amdgcn_s_sleep(1); \
    if ((++_sp & 255u) == 0u) { if (xb_ld(&(bar)[XB_TMO])) break; if (_sp > XB_SPIN_CAP) { atomicAdd(&(bar)[XB_TMO], 1u); break; } } } } while (0)
struct XcdBarrier { unsigned* bar; unsigned x; volatile LAS unsigned* st; };
DI XcdBarrier xcd_barrier_post(unsigned* bar, volatile LAS unsigned* st) {
    XcdBarrier b; b.bar = bar; b.x = xb_xcc_id(); b.st = st;
    if (threadIdx.x == 0) (void)xb_add(&bar[XB_XCNT(b.x)], 1u);
    return b;
}
DI void xcd_barrier_complete(unsigned* bar, unsigned x, unsigned& nloc, unsigned& nx) {
    const unsigned G = gridDim.x * gridDim.y * gridDim.z;
    unsigned sum, cnt, mine, sp = 0u;
    for (;;) {
        sum = 0u; cnt = 0u; mine = 0u;
#pragma unroll
        for (unsigned j = 0; j < 16; ++j) { const unsigned c = xb_ld(&bar[XB_XCNT(j)]); sum += c; cnt += (c > 0u) ? 1u : 0u; mine = (j == x) ? c : mine; }
        if (sum == G) break;
        __builtin_amdgcn_s_sleep(1);
        if ((++sp & 255u) == 0u) { if (xb_ld(&bar[XB_TMO])) break; if (sp > XB_SPIN_CAP) { atomicAdd(&bar[XB_TMO], 1u); break; } }
    }
    nloc = mine > 0u ? mine : 1u; nx = cnt > 0u ? cnt : 1u;
}
DI void xcd_barrier(const XcdBarrier& b) {
    asm volatile("s_waitcnt vmcnt(0)" ::: "memory");
    __syncthreads();
    if (threadIdx.x == 0) {
        unsigned* bar = b.bar;
        __builtin_amdgcn_s_waitcnt(0);
        unsigned nloc = b.st[0], nx = b.st[1];
        if (nloc == 0u) { xcd_barrier_complete(bar, b.x, nloc, nx); b.st[0] = nloc; b.st[1] = nx; }
        const unsigned old = xb_add(&bar[XB_XSUB(b.x)], 1u);
        const unsigned gen = old / nloc;
        if (old + 1u == (gen + 1u) * nloc) {
            __builtin_amdgcn_fence(__ATOMIC_RELEASE, "agent");
            asm volatile("s_waitcnt vmcnt(0)" ::: "memory");
            const unsigned og = xb_add(&bar[XB_TOP], 1u);
            const unsigned tg = og / nx;
            if (og + 1u == (tg + 1u) * nx) xb_add(&bar[XB_TOPGEN], 1u);
            else XB_SPIN(xb_ld(&bar[XB_TOPGEN]) == tg, bar);
            __builtin_amdgcn_fence(__ATOMIC_ACQUIRE, "agent");
            xb_add(&bar[XB_XGEN(b.x)], 1u);
            asm volatile("s_waitcnt vmcnt(0)" ::: "memory");
        } else {
            XB_SPIN(xb_ld(&bar[XB_XGEN(b.x)]) == gen, bar);
            __builtin_amdgcn_fence(__ATOMIC_ACQUIRE, "agent");
            asm volatile("s_waitcnt vmcnt(0)" ::: "memory");
        }
    }
    __syncthreads();
}

constexpr int PH_PER_LAYER = 11;
constexpr int NPHASE = 2 + 2 * PH_PER_LAYER;

#ifdef ONLY_SUB
#define SUB_ON(k) (ONLY_SUB == (k))
#else
#define SUB_ON(k) 1
#endif
DI void run_phase(const Params& P, int ph, char* lds) {
    char* ws = P.ws;
#if SUB_ON(100)
    if (ph == 0) { phase_prep(P, lds); return; }
#endif
#if SUB_ON(101)
    if (ph == 1) { phase_rms(P, P.in[0], P.in[1], (u16*)(ws + OFF_ABUF), 0); return; }
#endif
    if (ph < 2) return;
    const int layer = (ph - 2) / PH_PER_LAYER, sub = (ph - 2) % PH_PER_LAYER;
    const float* hin = layer == 0 ? P.in[0] : P.out;
    switch (sub) {
    #if SUB_ON(0)
    case 0: { EpiInProj8 e{ws}; phase_gemm((const u16*)(ws + OFF_ABUF), 1024, (const u16*)(ws + OFF_WINT) + (size_t)layer * PROJW * 1024, 1024, NT, PROJW, 1024, e, lds); } break;

#endif
    #if SUB_ON(1)
    case 1:
        for (int it = blockIdx.x; it < 2048; it += gridDim.x) gdn_prep_item(P, layer, it, lds);
        phase_s5<false>(P, layer, lds);
        break;

#endif
    #if SUB_ON(2)
    case 2:
        if (blockIdx.x < 16) gdn_scan_chain(P, blockIdx.x, lds);
        else if (blockIdx.x < 24) {
            const int gt = (blockIdx.x - 16) * NTHR + threadIdx.x;
            if (gt < 4096) {
                const int bg = gt >> 6, n = gt & 63;
                const float2 a = ((const float2*)(ws + OFF_S5P + layer * S5P_LAYER + S5P_A64))[(bg & 15) * 64 + n];
                float2* st = (float2*)(ws + OFF_S5ST) + (size_t)bg * 128 * 64 + n;
                float xr = 0.f, xi = 0.f;
                for (int c = 0; c < 128; ++c) {
                    const float2 sv = st[c * 64];
                    st[c * 64] = make_float2(xr, xi);
                    const float nr = a.x * xr - a.y * xi + sv.x, ni = a.x * xi + a.y * xr + sv.y;
                    xr = nr; xi = ni;
                }
            }
        }
        __syncthreads();
        phase_attn(P, layer, lds);
        break;

#endif
    #if SUB_ON(3)
    case 3: phase_s5<true>(P, layer, lds); phase_gdn_norm(P, layer); break;

#endif
    #if SUB_ON(4)
    case 4: {
        EpiGlu8 e{(u16*)(ws + OFF_ABUF), P.in[16] + layer * 512};
        phase_gemm((const u16*)(ws + OFF_YS5), 256, (const u16*)(ws + OFF_GLUT) + (size_t)layer * 512 * 256, 256, NT, 512, 256, e, lds);
    } break;

#endif
    #if SUB_ON(5)
    case 5: { EpiResidual8 e{hin, P.out}; phase_gemm((const u16*)(ws + OFF_ABUF), 1024, (const u16*)(ws + OFF_WOUTT) + (size_t)layer * 1024 * 1024, 1024, NT, 1024, 1024, e, lds); } break;

#endif
    #if SUB_ON(6)
    case 6: phase_rms(P, P.out, P.in[23] + layer * DM, (u16*)(ws + OFF_ABUF), -1, true); break;

#endif
    #if SUB_ON(7)
    case 7: { pg8::EpiBf16<0> e{(u16*)(ws + OFF_PQ), 1024, nullptr, 0, 0}; phase_gemm((const u16*)(ws + OFF_ABUF), 1024, (const u16*)(ws + OFF_WQT) + (size_t)layer * 1024 * 1024, 1024, NT, 1024, 1024, e, lds); } break;

#endif
    #if SUB_ON(8)
    case 8: phase_topk(P, layer, lds); break;

#endif
    #if SUB_ON(9)
    case 9: phase_peer_u(P, layer, lds); break;
#endif
    #if SUB_ON(10)
    case 10: phase_peer_v(P, layer, P.out, P.out, layer == 1, lds); break;
#endif
    }
}

#ifndef USE_CG_SYNC
#define USE_CG_SYNC 0
#endif
#if USE_CG_SYNC
#define GRID_SYNC() cg::this_grid().sync()
#else
#define GRID_SYNC() xcd_barrier(xbar)
#endif
__global__ void __launch_bounds__(NTHR) mk_fwd(Params P, int ph_lo, int ph_hi) {
    extern __shared__ __attribute__((aligned(16))) char lds[];
#if !USE_CG_SYNC
    volatile LAS unsigned* xst = (volatile LAS unsigned*)(lds + LDS_BYTES - 16);
    if (threadIdx.x == 0) { xst[0] = 0u; xst[1] = 0u; }
    __syncthreads();
    XcdBarrier xbar = xcd_barrier_post((unsigned*)(P.ws + OFF_CTL), xst);
#endif
#ifndef DUP_SUB
#define DUP_SUB -1
#endif
#define PH(k) if (ph_lo <= (k) && (k) < ph_hi) { \
        if ((k) >= 2 && (((k) - 2) % PH_PER_LAYER == DUP_SUB || (DUP_SUB == 20 && ((k) - 2) % PH_PER_LAYER == 2))) { \
            if (DUP_SUB == 9) phase_peer_u(P, ((k) - 2) / PH_PER_LAYER, lds); \
            else if (DUP_SUB == 2) { if (blockIdx.x < 16) gdn_scan_chain(P, blockIdx.x, lds); } \
            else if (DUP_SUB == 20 && ((k) - 2) % PH_PER_LAYER == 2) { phase_attn(P, ((k) - 2) / PH_PER_LAYER, lds, 1); } \
            else if (DUP_SUB == 5) { if ((k) < 2 + PH_PER_LAYER) run_phase(P, (k), lds); } \
            else run_phase(P, (k), lds); } \
        if ((k) < 2 && DUP_SUB == 100 + (k)) run_phase(P, (k), lds); \
        run_phase(P, (k), lds); if (DUP_SUB == 99) GRID_SYNC(); if ((k) + 1 < ph_hi) GRID_SYNC(); }
    PH(0) PH(1) PH(2) PH(3) PH(4) PH(5) PH(6) PH(7) PH(8) PH(9) PH(10) PH(11)
    PH(12) PH(13) PH(14) PH(15) PH(16) PH(17) PH(18) PH(19) PH(20) PH(21) PH(22) PH(23)
#undef PH
}

extern "C" void kernel_launch(void* const* d_in, const int* in_sizes, int n_in, void* d_out, int out_size, void* d_ws, size_t ws_size, hipStream_t stream) {
    static int grid = 0;
    if (grid == 0) {
        int dev = 0, cus = 0, per_cu = 0;
        hipGetDevice(&dev);
        hipDeviceGetAttribute(&cus, hipDeviceAttributeMultiprocessorCount, dev);
        hipFuncSetAttribute((const void*)mk_fwd, hipFuncAttributeMaxDynamicSharedMemorySize, LDS_BYTES);
        hipOccupancyMaxActiveBlocksPerMultiprocessor(&per_cu, (const void*)mk_fwd, NTHR, LDS_BYTES);
        if (per_cu < 1) { fprintf(stderr, "occupancy query says %d blocks per CU\n", per_cu); per_cu = 1; }
        grid = cus;
        if (ws_size < OFF_END) { fprintf(stderr, "workspace too small: %zu < %zu\n", ws_size, (size_t)OFF_END); }
    }
    Params p{};
    for (int i = 0; i < 29; ++i) p.in[i] = (const float*)d_in[i];
    p.out = (float*)d_out; p.ws = (char*)d_ws;
#if MK_ONE_LAUNCH
    int lo = 0, hi = NPHASE;
    (void)hipMemsetAsync((char*)d_ws + OFF_CTL, 0, 65536, stream);
#if USE_CG_SYNC
    void* args[] = {&p, &lo, &hi};
    hipError_t e = hipLaunchCooperativeKernel((const void*)mk_fwd, dim3(grid), dim3(NTHR), args, LDS_BYTES, stream);
    if (e != hipSuccess) fprintf(stderr, "cooperative launch failed: %s\n", hipGetErrorString(e));
#else
    hipLaunchKernelGGL(mk_fwd, dim3(grid), dim3(NTHR), LDS_BYTES, stream, p, lo, hi);
#endif
#else
    for (int ph = 0; ph < NPHASE; ++ph) hipLaunchKernelGGL(mk_fwd, dim3(grid), dim3(NTHR), LDS_BYTES, stream, p, ph, ph + 1);
#endif
}
```

```cpp
#include <hip/hip_runtime.h>
#include <hip/hip_cooperative_groups.h>
#include <stdint.h>
#include <stdio.h>
namespace cg = cooperative_groups;

#ifndef MK_ONE_LAUNCH
#define MK_ONE_LAUNCH 1
#endif

#define DI __device__ __forceinline__
typedef unsigned short u16;
typedef __attribute__((ext_vector_type(8))) short bf16x8;
typedef __attribute__((ext_vector_type(4))) short bf16x4;
typedef __attribute__((ext_vector_type(16))) float f32x16;
typedef __attribute__((ext_vector_type(4))) float f32x4;
typedef __attribute__((ext_vector_type(2))) float f32x2;

constexpr int NT = 32768, DM = 1024, SEQ = 8192, NBATCH = 4;
constexpr int NTHR = 512;
constexpr int INW = 2824;
constexpr int PROJW = 2816;
constexpr float LOG2E = 1.4426950408889634f;

constexpr size_t OFF_CTL   = 0;
constexpr size_t OFF_WINT  = 65536;
constexpr size_t OFF_WOUTT = OFF_WINT  + (size_t)2 * PROJW * 1024 * 2;
constexpr size_t OFF_WQT   = OFF_WOUTT + (size_t)2 * 1024 * 1024 * 2;
constexpr size_t OFF_GLUT  = OFF_WQT   + (size_t)2 * 1024 * 1024 * 2;
constexpr size_t OFF_KEYS  = OFF_GLUT  + (size_t)2 * 512 * 256 * 2;
constexpr size_t OFF_WAB   = OFF_KEYS  + (size_t)2 * 8 * 2 * 128 * 64 * 2;
constexpr size_t OFF_S5P   = OFF_WAB   + (size_t)2 * 8 * 1024 * 4;
constexpr size_t S5P_LAYER = 262144;
constexpr size_t S5P_ABAR = 0, S5P_A64 = 8192, S5P_BRE = 16384, S5P_BIM = 16384 + 65536, S5P_CM = 16384 + 131072;
constexpr size_t OFF_SCAL  = OFF_S5P   + 2 * S5P_LAYER;
constexpr size_t OFF_UTAB  = OFF_SCAL  + 256;
constexpr size_t OFF_VTAB  = OFF_UTAB  + (size_t)2 * 16384 * 1024;
constexpr size_t OFF_USCALE = OFF_VTAB + (size_t)2 * 16384 * 1024;
constexpr size_t OFF_V4TAB = OFF_USCALE + (size_t)2 * 16384 * 4;
constexpr size_t OFF_V4SC  = OFF_V4TAB + (size_t)2 * 16384 * 512;
constexpr size_t OFF_V8SC  = OFF_V4SC + (size_t)2 * 16384 * 4;
constexpr size_t OFF_ABUF  = OFF_V8SC + (size_t)2 * 16384 * 8;
constexpr size_t OFF_GG    = OFF_ABUF  + (size_t)NT * 1024 * 2;
constexpr size_t OFF_BETA  = OFF_GG    + (size_t)NT * 4 * 4;
constexpr size_t OFF_PROJ  = OFF_BETA  + (size_t)NT * 4 * 4;
constexpr size_t OFF_QKV   = OFF_PROJ;
constexpr size_t OFF_Z     = OFF_QKV   + (size_t)NT * 768 * 2;
constexpr size_t OFF_US    = OFF_Z     + (size_t)NT * 256 * 2;
constexpr size_t OFF_QC    = OFF_US    + (size_t)NT * 256 * 2;
constexpr size_t OFF_KC    = OFF_QC    + (size_t)NT * 512 * 2;
constexpr size_t OFF_VT    = OFF_KC    + (size_t)NT * 512 * 2;
constexpr size_t OFF_GREC  = OFF_VT    + (size_t)NT * 512 * 2;
constexpr size_t GREC_BYTES = 40960;
constexpr size_t OFF_EGL   = OFF_GREC  + (size_t)2048 * GREC_BYTES;
constexpr size_t OFF_S5ST  = OFF_EGL   + 2048 * 4;
constexpr size_t OFF_YS5   = OFF_S5ST  + (size_t)8192 * 64 * 8;
constexpr size_t OFF_END   = OFF_YS5   + (size_t)NT * 256 * 2;
constexpr size_t OFF_GDNO  = OFF_QKV;
constexpr size_t OFF_PQ    = OFF_PROJ;
constexpr size_t OFF_PICKE = OFF_GREC;
constexpr size_t OFF_PICKG = OFF_GREC + (size_t)NT * 128 * 2;
constexpr size_t OFF_COEF  = OFF_PICKG + (size_t)NT * 128 * 4;
constexpr size_t OFF_OFFS  = OFF_COEF + (size_t)NT * 128 * 4;
constexpr size_t OFF_XQ    = OFF_OFFS + (size_t)NT * 16;
constexpr size_t OFF_PSV   = OFF_PROJ + (size_t)NT * 1024 * 2;
constexpr size_t OFF_PSU   = OFF_YS5;
constexpr size_t OFF_SX    = OFF_XQ + (size_t)NT * 1024;
static_assert(OFF_SX + (size_t)NT * 4 <= OFF_GREC + (size_t)2048 * GREC_BYTES, "peer scratch must fit in the dead GDN record region");
static_assert(OFF_END < (size_t)512 * 1024 * 1024, "workspace");

constexpr int LDS_BYTES = 148480 + 16;

struct Params {
    const float* in[29];
    float* out;
    char* ws;
};

DI u16 f2bf(float x) { unsigned u = __float_as_uint(x); u += 0x7fffu + ((u >> 16) & 1u); return (u16)(u >> 16); }
DI float bf2f(u16 v) { return __uint_as_float(((unsigned)v) << 16); }
DI unsigned pack2(float a, float b) { unsigned r; asm("v_cvt_pk_bf16_f32 %0, %1, %2" : "=v"(r) : "v"(a), "v"(b)); return r; }
DI float wave_sum(float v) { for (int o = 32; o > 0; o >>= 1) v += __shfl_xor(v, o); return v; }
DI float gelu_tanh(float x) { float u = 0.7978845608028654f * (x + 0.044715f * x * x * x); float e = __expf(2.f * u); float th = 1.f - 2.f / (e + 1.f); return 0.5f * x * (1.f + th); }
DI float sigmoidf_(float x) { return 1.f / (1.f + __expf(-x)); }
#define MFMA32(a, b, c) __builtin_amdgcn_mfma_f32_32x32x16_bf16((a), (b), (c), 0, 0, 0)
#define MFMA16(a, b, c) __builtin_amdgcn_mfma_f32_16x16x32_bf16((a), (b), (c), 0, 0, 0)
DI bf16x8 ld8(const void* p) { return *(const bf16x8*)p; }
DI bf16x8 cat4(bf16x4 lo, bf16x4 hi) { return __builtin_shufflevector(lo, hi, 0, 1, 2, 3, 4, 5, 6, 7); }
DI bf16x8 pack8(float a0, float a1, float a2, float a3, float a4, float a5, float a6, float a7) {
    uint4 u; u.x = pack2(a0, a1); u.y = pack2(a2, a3); u.z = pack2(a4, a5); u.w = pack2(a6, a7);
    return __builtin_bit_cast(bf16x8, u);
}

template <class CM>
DI void transpose_tile(const float* __restrict__ src, int src_ld, u16* __restrict__ dst, int K, int n0, int k0, CM colmap, float* tl) {
    const int tid = threadIdx.x;
    {
        const int nn = tid & 63;
        const int sc = colmap(n0 + nn);
#pragma unroll
        for (int i = 0; i < 8; ++i) { const int kk = (tid >> 6) + 8 * i; tl[kk * 65 + nn] = src[(size_t)(k0 + kk) * src_ld + sc]; }
    }
    __syncthreads();
    {
        const int kk = tid & 63;
#pragma unroll
        for (int i = 0; i < 8; ++i) { const int nn = (tid >> 6) + 8 * i; dst[(size_t)(n0 + nn) * K + k0 + kk] = f2bf(tl[kk * 65 + nn]); }
    }
    __syncthreads();
}

DI void phase_prep(const Params& P, char* lds) {
    float* tl = (float*)lds;
    char* ws = P.ws;
    const int bid = blockIdx.x, nb = gridDim.x, tid = threadIdx.x;
    for (int j = bid; j < 2496; j += nb) {
        if (j < 1408) {
            const int l = j / 704, r = j % 704, nt = r / 16, kt = r % 16;
            transpose_tile(P.in[2] + (size_t)l * 1024 * INW, INW, (u16*)(ws + OFF_WINT) + (size_t)l * PROJW * 1024, 1024, nt * 64, kt * 64,
                           [](int n) { return n < 1024 ? n : n + 8; }, tl);
        } else if (j < 1920) {
            const int q = j - 1408; const int l = q / 256, r = q % 256, nt = r / 16, kt = r % 16;
            transpose_tile(P.in[22] + (size_t)l * 1024 * 1024, 1024, (u16*)(ws + OFF_WOUTT) + (size_t)l * 1024 * 1024, 1024, nt * 64, kt * 64, [](int n) { return n; }, tl);
        } else if (j < 2432) {
            const int q = j - 1920; const int l = q / 256, r = q % 256, nt = r / 16, kt = r % 16;
            transpose_tile(P.in[24] + (size_t)l * 1024 * 1024, 1024, (u16*)(ws + OFF_WQT) + (size_t)l * 1024 * 1024, 1024, nt * 64, kt * 64, [](int n) { return n; }, tl);
        } else {
            const int q = j - 2432; const int l = q / 32, r = q % 32, nt = r / 4, kt = r % 4;
            transpose_tile(P.in[15] + (size_t)l * 256 * 512, 512, (u16*)(ws + OFF_GLUT) + (size_t)l * 512 * 256, 256, nt * 64, kt * 64,
                           [](int n) { const int tile = n >> 8, wi = n & 255; return wi < 128 ? 128 * tile + wi : 256 + 128 * tile + (wi - 128); }, tl);
        }
    }
    const size_t gtid = (size_t)bid * NTHR + tid, gsz = (size_t)nb * NTHR;
    for (size_t i = gtid; i < (size_t)2 * 8 * 2 * 128 * 64; i += gsz) ((u16*)(ws + OFF_KEYS))[i] = f2bf(P.in[25][i]);
    for (size_t i = gtid; i < (size_t)2 * 8 * 1024; i += gsz) {
        const int l = (int)(i / 8192), j = (int)((i / 1024) % 8), k = (int)(i % 1024);
        ((float*)(ws + OFF_WAB))[i] = P.in[2][(size_t)l * 1024 * INW + (size_t)k * INW + 1024 + j];
    }
    {
        const int wv = tid >> 6, lane = tid & 63;
        for (int row = bid * 8 + wv; row < 2 * 16384; row += nb * 8) {
            const float4* s = (const float4*)(P.in[26] + (size_t)row * 1024) + lane * 4;
            float4 v[4]; float am = 0.f;
#pragma unroll
            for (int q = 0; q < 4; ++q) { v[q] = s[q]; am = fmaxf(am, fmaxf(fmaxf(fabsf(v[q].x), fabsf(v[q].y)), fmaxf(fabsf(v[q].z), fabsf(v[q].w)))); }
            for (int o = 32; o > 0; o >>= 1) am = fmaxf(am, __shfl_xor(am, o));
            const float sc = am > 0.f ? 127.f / am : 0.f;
            uint4 o4; unsigned* op = (unsigned*)&o4;
#pragma unroll
            for (int q = 0; q < 4; ++q) {
                const int a = (int)rintf(v[q].x * sc), b = (int)rintf(v[q].y * sc), c = (int)rintf(v[q].z * sc), d = (int)rintf(v[q].w * sc);
                op[q] = (unsigned)(a & 0xff) | ((unsigned)(b & 0xff) << 8) | ((unsigned)(c & 0xff) << 16) | ((unsigned)(d & 0xff) << 24);
            }
            ((uint4*)(ws + OFF_UTAB))[(size_t)row * 64 + lane] = o4;
            if (lane == 0) ((float*)(ws + OFF_V8SC))[2 * row] = am * (1.f / 127.f);
        }
        for (int row = bid * 8 + wv; row < 2 * 16384; row += nb * 8) {
            const float4* s = (const float4*)(P.in[27] + (size_t)row * 1024) + lane * 4;
            float4 v[4]; float am = 0.f;
#pragma unroll
            for (int q = 0; q < 4; ++q) { v[q] = s[q]; am = fmaxf(am, fmaxf(fmaxf(fabsf(v[q].x), fabsf(v[q].y)), fmaxf(fabsf(v[q].z), fabsf(v[q].w)))); }
            for (int o = 32; o > 0; o >>= 1) am = fmaxf(am, __shfl_xor(am, o));
            const float sc8 = am > 0.f ? 127.f / am : 0.f;
            uint4 o8; unsigned* op = (unsigned*)&o8;
#pragma unroll
            for (int q = 0; q < 4; ++q) {
                const int a = (int)rintf(v[q].x * sc8), b = (int)rintf(v[q].y * sc8), c = (int)rintf(v[q].z * sc8), d = (int)rintf(v[q].w * sc8);
                op[q] = (unsigned)(a & 0xff) | ((unsigned)(b & 0xff) << 8) | ((unsigned)(c & 0xff) << 16) | ((unsigned)(d & 0xff) << 24);
            }
            ((uint4*)(ws + OFF_VTAB))[(size_t)row * 64 + lane] = o8;
            if (lane == 0) ((float*)(ws + OFF_V8SC))[2 * row + 1] = am * (1.f / 127.f);
            const float sc4 = am > 0.f ? 7.f / am : 0.f;
            unsigned d[2];
#pragma unroll
            for (int h2 = 0; h2 < 2; ++h2) {
                const float4 a = v[2 * h2], b = v[2 * h2 + 1];
                const unsigned n0 = (unsigned)((int)rintf(a.x * sc4) + 8), n1 = (unsigned)((int)rintf(a.y * sc4) + 8), n2 = (unsigned)((int)rintf(a.z * sc4) + 8), n3 = (unsigned)((int)rintf(a.w * sc4) + 8);
                const unsigned n4 = (unsigned)((int)rintf(b.x * sc4) + 8), n5 = (unsigned)((int)rintf(b.y * sc4) + 8), n6 = (unsigned)((int)rintf(b.z * sc4) + 8), n7 = (unsigned)((int)rintf(b.w * sc4) + 8);
                d[h2] = n0 | (n4 << 4) | (n1 << 8) | (n5 << 12) | (n2 << 16) | (n6 << 20) | (n3 << 24) | (n7 << 28);
            }
            ((uint2*)(ws + OFF_V4TAB))[(size_t)row * 64 + lane] = make_uint2(d[0], d[1]);
            if (lane == 0) ((float*)(ws + OFF_V4SC))[row] = am * (1.f / 7.f);
        }
    }
    for (size_t i = gtid; i < (size_t)2 * 16 * 64; i += gsz) {
        const int l = (int)(i / 1024), g = (int)((i / 64) % 16), n = (int)(i % 64);
        const float step = __expf(P.in[14][l * 16 + g]);
        const float lr = P.in[7][i], li = P.in[8][i];
        const float er = expf(lr * step); const float ar = er * cosf(li * step), ai = er * sinf(li * step);
        const float e64 = expf(64.f * lr * step); const float a64r = e64 * cosf(64.f * li * step), a64i = e64 * sinf(64.f * li * step);
        char* sp = ws + OFF_S5P + l * S5P_LAYER;
        ((float2*)(sp + S5P_ABAR))[g * 64 + n] = make_float2(ar, ai);
        ((float2*)(sp + S5P_A64))[g * 64 + n] = make_float2(a64r, a64i);
        const float xr = ar - 1.f, xi = ai; const float den = 1.f / (lr * lr + li * li);
        const float cr = (xr * lr + xi * li) * den, ci = (xi * lr - xr * li) * den;
        for (int c = 0; c < 16; ++c) {
            const float br = P.in[9][i * 16 + c], bi = P.in[10][i * 16 + c];
            ((float*)(sp + S5P_BRE))[(g * 64 + n) * 16 + c] = cr * br - ci * bi;
            ((float*)(sp + S5P_BIM))[(g * 64 + n) * 16 + c] = cr * bi + ci * br;
        }
    }
    for (size_t i = gtid; i < (size_t)2 * 16 * 16 * 128; i += gsz) {
        const int l = (int)(i / 32768), g = (int)((i / 2048) % 16), c = (int)((i / 128) % 16), k = (int)(i % 128);
        const size_t si = ((size_t)(l * 16 + g) * 16 + c) * 64 + (k & 63);
        const float v = k < 64 ? P.in[11][si] : -P.in[12][si];
        ((u16*)(ws + OFF_S5P + l * S5P_LAYER + S5P_CM))[(g * 16 + c) * 128 + k] = f2bf(v);
    }
    if (bid == 0 && tid < 2) {
        const int l = tid; float s1 = 0.f, s2 = 0.f;
        for (int d = 0; d < 64; ++d) { s1 += P.in[17][l * 64 + d] * P.in[18][l * 64 + d]; s2 += P.in[19][l * 64 + d] * P.in[20][l * 64 + d]; }
        const float lam_init = 0.8f - 0.6f * expf(-0.3f * (float)l);
        ((float*)(ws + OFF_SCAL))[l] = expf(s1) - expf(s2) + lam_init;
    }
}

DI void rms_token(const Params& P, int t, int lane, float4 (&v)[4], const float* gain, u16* dst, int ab_layer  , bool want_q = false) {
    float ss = 0.f;
#pragma unroll
    for (int i = 0; i < 4; ++i) ss += v[i].x * v[i].x + v[i].y * v[i].y + v[i].z * v[i].z + v[i].w * v[i].w;
    ss = wave_sum(ss);
    const float rstd = rsqrtf(ss * (1.f / DM) + 1e-6f);
    const float4* g4 = (const float4*)gain;
#pragma unroll
    for (int i = 0; i < 4; ++i) {
        const float4 g = g4[lane + 64 * i];
        v[i].x *= rstd * g.x; v[i].y *= rstd * g.y; v[i].z *= rstd * g.z; v[i].w *= rstd * g.w;
        uint2 o; o.x = pack2(v[i].x, v[i].y); o.y = pack2(v[i].z, v[i].w);
        *(uint2*)(dst + (size_t)t * DM + (lane + 64 * i) * 4) = o;
    }
    if (want_q) {
        float am = 0.f;
#pragma unroll
        for (int i = 0; i < 4; ++i) am = fmaxf(am, fmaxf(fmaxf(fabsf(v[i].x), fabsf(v[i].y)), fmaxf(fabsf(v[i].z), fabsf(v[i].w))));
        for (int o = 32; o > 0; o >>= 1) am = fmaxf(am, __shfl_xor(am, o));
        const float sc = am > 0.f ? 127.f / am : 0.f;
#pragma unroll
        for (int i = 0; i < 4; ++i) {
            const int a0 = (int)rintf(v[i].x * sc), a1 = (int)rintf(v[i].y * sc), a2 = (int)rintf(v[i].z * sc), a3 = (int)rintf(v[i].w * sc);
            ((unsigned*)(P.ws + OFF_XQ))[(size_t)t * 256 + lane + 64 * i] = (unsigned)(a0 & 0xff) | ((unsigned)(a1 & 0xff) << 8) | ((unsigned)(a2 & 0xff) << 16) | ((unsigned)(a3 & 0xff) << 24);
        }
        if (lane == 0) ((float*)(P.ws + OFF_SX))[t] = am * (1.f / 127.f);
    }
    if (ab_layer >= 0) {
        const float4* wab = (const float4*)(P.ws + OFF_WAB) + ab_layer * 8 * 256;
        float acc[8];
#pragma unroll
        for (int j = 0; j < 8; ++j) {
            float a = 0.f;
#pragma unroll
            for (int i = 0; i < 4; ++i) { const float4 w = wab[j * 256 + lane + 64 * i]; a += v[i].x * w.x + v[i].y * w.y + v[i].z * w.z + v[i].w * w.w; }
            acc[j] = wave_sum(a);
        }
        if (lane < 4) {
            const float a = lane == 0 ? acc[0] : lane == 1 ? acc[1] : lane == 2 ? acc[2] : acc[3];
            const float b = lane == 0 ? acc[4] : lane == 1 ? acc[5] : lane == 2 ? acc[6] : acc[7];
            const float xx = a + P.in[5][ab_layer * 4 + lane];
            const float sp = xx > 20.f ? xx : log1pf(__expf(xx));
            ((float*)(P.ws + OFF_GG))[t * 4 + lane] = -__expf(P.in[4][ab_layer * 4 + lane]) * sp;
            ((float*)(P.ws + OFF_BETA))[t * 4 + lane] = sigmoidf_(b);
        }
    }
}

DI void phase_rms(const Params& P, const float* src, const float* gain, u16* dst, int ab_layer, bool want_q = false) {
    const int w = threadIdx.x >> 6, lane = threadIdx.x & 63;
    for (int t = blockIdx.x * 8 + w; t < NT; t += gridDim.x * 8) {
        const float4* s4 = (const float4*)(src + (size_t)t * DM);
        float4 v[4];
#pragma unroll
        for (int i = 0; i < 4; ++i) v[i] = s4[lane + 64 * i];
        rms_token(P, t, lane, v, gain, dst, ab_layer, want_q);
    }
}

namespace pg8 {
#define PG8_LAS __attribute__((address_space(3)))
typedef unsigned short bf16_t;
typedef short bf16x8 __attribute__((ext_vector_type(8)));
typedef float f32x4 __attribute__((ext_vector_type(4)));
typedef unsigned u32x4 __attribute__((ext_vector_type(4)));
constexpr int BM = 256, BK = 64, HALF = 128, HTB = HALF * BK * 2  , STAGE_BYTES = 8 * HTB, NXCD = 8, WGM = 8;

__host__ __device__ __forceinline__ int lds_byte(int r, int c) { const int st = (r >> 4) * 2 + (c >> 5), rr = r & 15, cc = c & 31, ob = rr * 64 + cc * 2; return st * 1024 + (ob ^ (((ob >> 9) & 1) << 5)); }
__host__ __device__ __forceinline__ void stage_rc(int b, int& R, int& C) { const int st = b / 1024, sb = b % 1024, swz = sb ^ (((sb >> 9) & 1) << 5); R = (st >> 1) * 16 + swz / 64; C = (st & 1) * 32 + (swz % 64) / 2; }
__host__ __device__ __forceinline__ int perm32(int rho) { const int n = rho >> 4, i = rho & 15; return 8 * (i >> 2) + 4 * n + (i & 3); }

struct Unit { int pm, pn; };
struct Gemm { const bf16_t* A; const bf16_t* Bt; int M, N, K; };

struct StaticOrder {
    int nM, nN, nwg, G, c;
    __host__ __device__ void init(int M, int N, int G_, int c_) { nM = M / BM; nN = N / BM; nwg = nM * nN; G = G_; c = c_; }
    __host__ __device__ bool next(int i, Unit& u) const {
        const long L = (long)i * G + c; if (L >= nwg) return false;
        int wgid = (int)L; { const int q = nwg / NXCD, r = nwg % NXCD, xcd = wgid % NXCD, off = wgid / NXCD; wgid = (xcd < r ? xcd * (q + 1) : r * (q + 1) + (xcd - r) * q) + off; }
        const int nig = WGM * nN, gid = wgid / nig, fm = gid * WGM, gsz = (nM - fm) < WGM ? (nM - fm) : WGM;
        u.pm = fm + ((wgid % nig) % gsz); u.pn = (wgid % nig) / gsz; return true;
    }
    __device__ __forceinline__ void a_ready(const Unit&) const {}
    __device__ __forceinline__ void done(const Unit&) const {}
};
struct CountedOrder : StaticOrder {
    const unsigned* ready; unsigned need; unsigned* tmo;
    __device__ __forceinline__ void a_ready(const Unit& u) const {
        if (threadIdx.x < 64) {
            const unsigned long long t0 = __builtin_amdgcn_s_memrealtime(); unsigned polls = 0;
            while ((unsigned)__builtin_amdgcn_readfirstlane(__hip_atomic_load(ready + 64 * u.pm, __ATOMIC_RELAXED, __HIP_MEMORY_SCOPE_AGENT)) < need) {
                if ((++polls & 255u) == 0u && __builtin_amdgcn_readfirstlane(__hip_atomic_load(tmo, __ATOMIC_RELAXED, __HIP_MEMORY_SCOPE_AGENT)) != 0u) break;
                if (__builtin_amdgcn_s_memrealtime() - t0 > 2000000ull) {
                    if (threadIdx.x == 0) { unsigned expect = 0u; __hip_atomic_compare_exchange_strong(tmo + 1, &expect, 0x600u | (unsigned)(u.pm & 0xff), __ATOMIC_RELAXED, __ATOMIC_RELAXED, __HIP_MEMORY_SCOPE_AGENT); __hip_atomic_store(tmo, 1u, __ATOMIC_RELAXED, __HIP_MEMORY_SCOPE_AGENT); }
                    break; }
                __builtin_amdgcn_s_sleep(2); }
            __builtin_amdgcn_fence(__ATOMIC_ACQUIRE, "agent");
            asm volatile("s_waitcnt vmcnt(0)" ::: "memory");
        }
#if !defined(BROKEN_HOOK_NO_BARRIER)
        asm volatile("" ::: "memory"); __builtin_amdgcn_s_barrier(); asm volatile("" ::: "memory");
#endif
    }
};

__device__ __forceinline__ unsigned cvt_pk_bf16(float lo, float hi) { unsigned r; asm volatile("v_cvt_pk_bf16_f32 %0, %1, %2" : "=v"(r) : "v"(lo), "v"(hi)); return r; }
typedef float f32x2 __attribute__((ext_vector_type(2)));
__device__ __forceinline__ f32x2 gelu_pk(f32x2 v) {
    const f32x2 av = __builtin_elementwise_abs(v), d = av * 0.2316418882f + 1.0f;
    f32x2 t; t.x = __builtin_amdgcn_rcpf(d.x); t.y = __builtin_amdgcn_rcpf(d.y);
    f32x2 q = t * 0.5307027145f + (-0.7265760135f); q = q * t + 0.7107068705f; q = q * t + (-0.142248368f); q = q * t + 0.127414796f; q = q * t;
    const f32x2 s = (v * v) * (-0.72134752044f);
    f32x2 e; e.x = __builtin_amdgcn_exp2f(s.x); e.y = __builtin_amdgcn_exp2f(s.y);
    const f32x2 m = v * (q * e), r = v - m;
    f32x2 o; o.x = v.x < 0.f ? m.x : r.x; o.y = v.y < 0.f ? m.y : r.y; return o;
}

struct EpiF32 {
    static constexpr bool PERM = false, AFTER_DRAIN = false;
    float* C; int ldc; const float* bias;
    __device__ __forceinline__ void operator()(const f32x4 (&acc)[2][2][4][2], const Unit& u, int wr, int wc, int fr, int fq) const {
        const int row0 = u.pm * BM + wr * 64 + fr, col0 = u.pn * BM + wc * 32 + 4 * fq;
        f32x4 bv[2][2];
#pragma unroll
        for (int bj = 0; bj < 2; ++bj)
#pragma unroll
            for (int n = 0; n < 2; ++n) bv[bj][n] = bias ? *(const f32x4*)(bias + col0 + bj * HALF + n * 16) : (f32x4){0.f, 0.f, 0.f, 0.f};
#pragma unroll
        for (int ai = 0; ai < 2; ++ai)
#pragma unroll
            for (int m = 0; m < 4; ++m) { float* rowp = C + (size_t)(row0 + ai * HALF + m * 16) * ldc + col0;
#pragma unroll
                for (int bj = 0; bj < 2; ++bj)
#pragma unroll
                    for (int n = 0; n < 2; ++n) *(f32x4*)(rowp + bj * HALF + n * 16) = acc[ai][bj][m][n] + bv[bj][n]; }
    }
};
template <int ACT  > struct EpiBf16 {
    static constexpr bool PERM = true, AFTER_DRAIN = false;
    bf16_t* O; int ldc; const float* bias; int split_cols; size_t split_stride;
    __device__ __forceinline__ void operator()(const f32x4 (&acc)[2][2][4][2], const Unit& u, int wr, int wc, int fr, int fq) const {
        const int row0 = u.pm * BM + wr * 64 + fr; int colt = u.pn * BM; bf16_t* base = O;
        if (split_cols) { const int t = colt / split_cols; base += (size_t)t * split_stride; colt -= t * split_cols; }
        const int col0 = colt + wc * 32 + 8 * fq, bcol0 = u.pn * BM + wc * 32 + 8 * fq;
        f32x4 bv[2][2];
#pragma unroll
        for (int bj = 0; bj < 2; ++bj)
#pragma unroll
            for (int n = 0; n < 2; ++n) bv[bj][n] = bias ? *(const f32x4*)(bias + bcol0 + bj * HALF + 4 * n) : (f32x4){0.f, 0.f, 0.f, 0.f};
#pragma unroll
        for (int ai = 0; ai < 2; ++ai)
#pragma unroll
            for (int m = 0; m < 4; ++m) { bf16_t* rowp = base + (size_t)(row0 + ai * HALF + m * 16) * ldc + col0;
#pragma unroll
                for (int bj = 0; bj < 2; ++bj) { f32x4 v0 = acc[ai][bj][m][0] + bv[bj][0], v1 = acc[ai][bj][m][1] + bv[bj][1];
                    if (ACT == 1) { f32x2 a = gelu_pk((f32x2){v0[0], v0[1]}), b = gelu_pk((f32x2){v0[2], v0[3]}), c = gelu_pk((f32x2){v1[0], v1[1]}), d = gelu_pk((f32x2){v1[2], v1[3]});
                        v0 = (f32x4){a.x, a.y, b.x, b.y}; v1 = (f32x4){c.x, c.y, d.x, d.y}; }
                    if (ACT == 2) {
#pragma unroll
                        for (int j = 0; j < 4; ++j) { v0[j] = 0.5f * v0[j] * (1.0f + erff(v0[j] * 0.70710678f)); v1[j] = 0.5f * v1[j] * (1.0f + erff(v1[j] * 0.70710678f)); } }
                    u32x4 w; w.x = cvt_pk_bf16(v0[0], v0[1]); w.y = cvt_pk_bf16(v0[2], v0[3]); w.z = cvt_pk_bf16(v1[0], v1[1]); w.w = cvt_pk_bf16(v1[2], v1[3]);
                    *(u32x4*)(rowp + bj * HALF) = w; } }
    }
};


template <class Epi, class Sched, bool STAMP = false>
__device__ __forceinline__ void gemm_phase(PG8_LAS unsigned char* lds, const Gemm g, const Sched& S, const Epi& E, unsigned long long* stamps) {
    const int tid = threadIdx.x, wid = __builtin_amdgcn_readfirstlane(tid >> 6), lane = tid & 63, wr = wid >> 2, wc = wid & 3, fr = lane & 15, fq = lane >> 4;
    const int K = g.K, nt = K / BK;
    int ts_lo = 0, ts_hi = 0, nts = 0; const unsigned long long rt_entry = STAMP ? (unsigned long long)wall_clock64() : 0ull;
#define PG8_STAMP() do { if (STAMP && wid == 0 && nts < 64) { const unsigned long long _c = (unsigned long long)clock64(); \
        ts_lo = (lane == nts) ? (int)(unsigned)_c : ts_lo; ts_hi = (lane == nts) ? (int)(unsigned)(_c >> 32) : ts_hi; ++nts; } } while (0)
    PG8_STAMP();
    unsigned voffA[2], voffB[2];
#pragma unroll
    for (int i = 0; i < 2; ++i) { int R, C; stage_rc(tid * 16 + i * 8192, R, C); const int Rb = Epi::PERM ? ((R & ~31) + perm32(R & 31)) : R;
        voffA[i] = (unsigned)(R * K + C) * 2u; voffB[i] = (unsigned)(Rb * K + C) * 2u; }
    const size_t kstep = (size_t)(BK * 2);
    const size_t hstep = (size_t)HALF * K * 2;
    const size_t tstep = 2 * hstep;
    const unsigned ldsw = (unsigned)wid * 1024u;
    const int aoff = lds_byte(wr * 64 + fr, fq * 8), boff = lds_byte(wc * 32 + fr, fq * 8);
#define PG8_SA(b, h) (((b) * 2 + (h)) * HTB)
#define PG8_SB(b, h) ((4 + (b) * 2 + (h)) * HTB)
#define PG8_STAGE(bufoff, gbase, voff) do { _Pragma("unroll") for (int _i = 0; _i < 2; ++_i) \
        __builtin_amdgcn_global_load_lds((const unsigned*)((const char*)(gbase) + (voff)[_i]), (PG8_LAS unsigned*)(lds + (bufoff) + ldsw + _i * 8192), 16, 0, 0); } while (0)
#define PG8_LDA(dst, b, h) do { _Pragma("unroll") for (int m = 0; m < 4; ++m) _Pragma("unroll") for (int k = 0; k < 2; ++k) dst[m][k] = *(const PG8_LAS bf16x8*)(lds + PG8_SA(b, h) + aoff + m * 2048 + k * 1024); } while (0)
#define PG8_LDB(dst, b, h) do { _Pragma("unroll") for (int n = 0; n < 2; ++n) _Pragma("unroll") for (int k = 0; k < 2; ++k) dst[n][k] = *(const PG8_LAS bf16x8*)(lds + PG8_SB(b, h) + boff + n * 2048 + k * 1024); } while (0)
#define PG8_MMA(ai, bj, At, Bt) do { __builtin_amdgcn_s_setprio(1); _Pragma("unroll") for (int m = 0; m < 4; ++m) _Pragma("unroll") for (int n = 0; n < 2; ++n) _Pragma("unroll") for (int k = 0; k < 2; ++k) \
        acc[ai][bj][m][n] = __builtin_amdgcn_mfma_f32_16x16x32_bf16(Bt[n][k], At[m][k], acc[ai][bj][m][n], 0, 0, 0); __builtin_amdgcn_s_setprio(0); } while (0)
#define PG8_WAIT_V(n) asm volatile("s_waitcnt vmcnt(" #n ")" ::: "memory")
#define PG8_WAIT_L(n) asm volatile("s_waitcnt lgkmcnt(" #n ")" ::: "memory")
#define PG8_BAR __builtin_amdgcn_s_barrier()
#define PG8_SCHED __builtin_amdgcn_sched_barrier(0)
    Unit cur, nxt; int ui = 0;
    if (!S.next(0, cur)) return;
    f32x4 acc[2][2][4][2];
#pragma unroll
    for (int a = 0; a < 2; ++a)
#pragma unroll
        for (int b = 0; b < 2; ++b)
#pragma unroll
            for (int m = 0; m < 4; ++m)
#pragma unroll
                for (int n = 0; n < 2; ++n) acc[a][b][m][n] = (f32x4){0.f, 0.f, 0.f, 0.f};
    bf16x8 At[4][2], B0[2][2], B1[2][2];
    const char* cA = (const char*)g.A + (size_t)cur.pm * tstep; const char* cB = (const char*)g.Bt + (size_t)cur.pn * tstep;
    S.a_ready(cur);
    PG8_STAGE(PG8_SB(0, 0), cB, voffB); PG8_STAGE(PG8_SA(0, 0), cA, voffA); PG8_STAGE(PG8_SB(0, 1), cB + hstep, voffB); PG8_STAGE(PG8_SA(0, 1), cA + hstep, voffA);
    if (wr == 1) PG8_BAR;
    PG8_WAIT_V(4); PG8_BAR;
    PG8_STAGE(PG8_SB(1, 0), cB + kstep, voffB); PG8_STAGE(PG8_SA(1, 0), cA + kstep, voffA); PG8_STAGE(PG8_SB(1, 1), cB + hstep + kstep, voffB);
    PG8_WAIT_V(6); PG8_BAR;
    PG8_STAMP();
    for (;;) {
        const bool has_next = S.next(ui + 1, nxt);
        const char* nA = has_next ? (const char*)g.A + (size_t)nxt.pm * tstep : cA; const char* nB = has_next ? (const char*)g.Bt + (size_t)nxt.pn * tstep : cB;
        for (int t = 0; t < nt; t += 2) {
            const bool last = (t == nt - 2);
            const char* a1 = cA + (size_t)(t + 1) * kstep;
            const char* a2 = last ? nA : cA + (size_t)(t + 2) * kstep; const char* b2 = last ? nB : cB + (size_t)(t + 2) * kstep;
            const char* a3 = a2 + kstep; const char* b3 = b2 + kstep;
            if (last && has_next) S.a_ready(nxt);
            PG8_LDB(B0, 0, 0); PG8_SCHED; PG8_LDA(At, 0, 0); PG8_STAGE(PG8_SA(1, 1), a1 + hstep, voffA);
            PG8_WAIT_L(8); PG8_BAR; PG8_WAIT_L(0); PG8_MMA(0, 0, At, B0); PG8_BAR; PG8_SCHED;
            PG8_LDB(B1, 0, 1); PG8_STAGE(PG8_SB(0, 0), b2, voffB);
            PG8_BAR; PG8_WAIT_L(0); PG8_MMA(0, 1, At, B1); PG8_BAR;
            PG8_LDA(At, 0, 1); PG8_STAGE(PG8_SA(0, 0), a2, voffA);
            PG8_BAR; PG8_WAIT_L(0); PG8_MMA(1, 0, At, B0); PG8_BAR; PG8_SCHED;
            PG8_STAGE(PG8_SB(0, 1), b2 + hstep, voffB);
            PG8_WAIT_V(6); PG8_BAR; PG8_MMA(1, 1, At, B1); PG8_BAR;
            PG8_LDB(B0, 1, 0); PG8_SCHED; PG8_LDA(At, 1, 0); PG8_STAGE(PG8_SA(0, 1), a2 + hstep, voffA);
            PG8_WAIT_L(8); PG8_BAR; PG8_WAIT_L(0); PG8_MMA(0, 0, At, B0); PG8_BAR; PG8_SCHED;
            PG8_LDB(B1, 1, 1); PG8_STAGE(PG8_SB(1, 0), b3, voffB);
            PG8_BAR; PG8_WAIT_L(0); PG8_MMA(0, 1, At, B1); PG8_BAR;
            PG8_LDA(At, 1, 1); PG8_STAGE(PG8_SA(1, 0), a3, voffA);
            PG8_BAR; PG8_WAIT_L(0); PG8_MMA(1, 0, At, B0); PG8_BAR; PG8_SCHED;
            PG8_STAGE(PG8_SB(1, 1), b3 + hstep, voffB);
            PG8_WAIT_V(6); PG8_BAR; PG8_MMA(1, 1, At, B1); PG8_BAR;
        }
        PG8_STAMP();
        if constexpr (!Epi::AFTER_DRAIN) { E(acc, cur, wr, wc, fr, fq); S.done(cur); }
        PG8_STAMP();
        if (!has_next) break;
#pragma unroll
        for (int a = 0; a < 2; ++a)
#pragma unroll
            for (int b = 0; b < 2; ++b)
#pragma unroll
                for (int m = 0; m < 4; ++m)
#pragma unroll
                    for (int n = 0; n < 2; ++n) acc[a][b][m][n] = (f32x4){0.f, 0.f, 0.f, 0.f};
        cur = nxt; cA = nA; cB = nB; ++ui;
    }
    PG8_WAIT_V(0);
    if (wr == 0) PG8_BAR;
    PG8_BAR;
    if constexpr (Epi::AFTER_DRAIN) { E.fused(acc, cur, wr, wc, fr, fq, lds, wid, lane); S.done(cur); }
    PG8_STAMP();
    if (STAMP && wid == 0) { stamps[lane] = lane < nts ? (((unsigned long long)(unsigned)ts_hi << 32) | (unsigned)ts_lo) : 0ull;
        if (lane == 62) stamps[62] = rt_entry; if (lane == 63) stamps[63] = (unsigned long long)wall_clock64(); }
#undef PG8_STAMP
#undef PG8_SA
#undef PG8_SB
#undef PG8_STAGE
#undef PG8_LDA
#undef PG8_LDB
#undef PG8_MMA
#undef PG8_WAIT_V
#undef PG8_WAIT_L
#undef PG8_BAR
#undef PG8_SCHED
}
}

struct EpiInProj8 {
    static constexpr bool PERM = true, AFTER_DRAIN = false;
    char* ws;
    DI void operator()(const pg8::f32x4 (&acc)[2][2][4][2], const pg8::Unit& u, int wr, int wc, int fr, int fq) const {
        const int row0 = u.pm * 256 + wr * 64 + fr; const int pn = u.pn;
        if (pn >= 9) {
            u16* vt = (u16*)(ws + OFF_VT);
#pragma unroll
            for (int ai = 0; ai < 2; ++ai)
#pragma unroll
                for (int m = 0; m < 4; ++m) {
                    const int tok = row0 + ai * 128 + m * 16; const int b = tok >> 13;
                    const int l = ((tok & 8191) & ~15) | (fr < 4 ? fr : fr < 8 ? fr + 4 : fr < 12 ? fr - 4 : fr);
#pragma unroll
                    for (int bj = 0; bj < 2; ++bj)
#pragma unroll
                        for (int n = 0; n < 2; ++n)
#pragma unroll
                            for (int j = 0; j < 4; ++j) {
                                const int c = (pn - 9) * 256 + wc * 32 + 8 * fq + bj * 128 + 4 * n + j; const int head = c >> 7, dv = c & 127;
                                vt[((size_t)((b * 4 + head) * 128 + (l >> 6))) * 8192 + dv * 64 + (l & 63)] = f2bf(acc[ai][bj][m][n][j]);
                            }
                }
            return;
        }
        u16* base; int pitch, c0; float sc = 1.f;
        if (pn < 3) { base = (u16*)(ws + OFF_QKV); pitch = 768; c0 = pn * 256; }
        else if (pn == 3) { base = (u16*)(ws + OFF_Z); pitch = 256; c0 = 0; }
        else if (pn == 4) { base = (u16*)(ws + OFF_US); pitch = 256; c0 = 0; }
        else if (pn < 7) { base = (u16*)(ws + OFF_QC); pitch = 512; c0 = (pn - 5) * 256; sc = 0.125f * LOG2E; }
        else { base = (u16*)(ws + OFF_KC); pitch = 512; c0 = (pn - 7) * 256; }
        const int col0 = c0 + wc * 32 + 8 * fq;
#pragma unroll
        for (int ai = 0; ai < 2; ++ai)
#pragma unroll
            for (int m = 0; m < 4; ++m) {
                u16* rowp = base + (size_t)(row0 + ai * 128 + m * 16) * pitch + col0;
#pragma unroll
                for (int bj = 0; bj < 2; ++bj) {
                    const pg8::f32x4 v0 = acc[ai][bj][m][0] * sc, v1 = acc[ai][bj][m][1] * sc;
                    uint4 w; w.x = pack2(v0[0], v0[1]); w.y = pack2(v0[2], v0[3]); w.z = pack2(v1[0], v1[1]); w.w = pack2(v1[2], v1[3]);
                    *(uint4*)(rowp + bj * 128) = w;
                }
            }
    }
};
struct EpiResidual8 {
    static constexpr bool PERM = false, AFTER_DRAIN = false;
    const float* hin; float* hout;
    DI void operator()(const pg8::f32x4 (&acc)[2][2][4][2], const pg8::Unit& u, int wr, int wc, int fr, int fq) const {
        const int row0 = u.pm * 256 + wr * 64 + fr, col0 = u.pn * 256 + wc * 32 + 4 * fq;
#pragma unroll
        for (int ai = 0; ai < 2; ++ai)
#pragma unroll
            for (int m = 0; m < 4; ++m) {
                const size_t ro = (size_t)(row0 + ai * 128 + m * 16) * DM + col0;
#pragma unroll
                for (int bj = 0; bj < 2; ++bj)
#pragma unroll
                    for (int n = 0; n < 2; ++n) {
                        const pg8::f32x4 h = *(const pg8::f32x4*)(hin + ro + bj * 128 + n * 16);
                        *(pg8::f32x4*)(hout + ro + bj * 128 + n * 16) = h + acc[ai][bj][m][n];
                    }
            }
    }
};
struct EpiGlu8 {
    static constexpr bool PERM = true, AFTER_DRAIN = false;
    u16* mix; const float* bias;
    DI void operator()(const pg8::f32x4 (&acc)[2][2][4][2], const pg8::Unit& u, int wr, int wc, int fr, int fq) const {
        const int row0 = u.pm * 256 + wr * 64 + fr, col0 = u.pn * 128 + wc * 32 + 8 * fq;
#pragma unroll
        for (int n = 0; n < 2; ++n) {
            const pg8::f32x4 bv = *(const pg8::f32x4*)(bias + col0 + 4 * n), bg = *(const pg8::f32x4*)(bias + 256 + col0 + 4 * n);
#pragma unroll
            for (int ai = 0; ai < 2; ++ai)
#pragma unroll
                for (int m = 0; m < 4; ++m) {
                    const pg8::f32x4 val = acc[ai][0][m][n] + bv, gt = acc[ai][1][m][n] + bg;
                    uint2 w; w.x = pack2(val[0] * sigmoidf_(gt[0]), val[1] * sigmoidf_(gt[1])); w.y = pack2(val[2] * sigmoidf_(gt[2]), val[3] * sigmoidf_(gt[3]));
                    *(uint2*)(mix + (size_t)(row0 + ai * 128 + m * 16) * DM + 256 + col0 + 4 * n) = w;
                }
        }
    }
};
template <class Epi>
DI void phase_gemm(const u16* A, int lda, const u16* Bt, int ldb, int M, int N, int K, Epi epi, char* lds) {
    pg8::Gemm g{A, Bt, M, N, K};
    pg8::StaticOrder S; S.init(M, N, (int)gridDim.x, (int)blockIdx.x);
    pg8::gemm_phase<Epi, pg8::StaticOrder, false>((PG8_LAS unsigned char*)lds, g, S, epi, nullptr);
}

template <int CTRL> DI float dppf(float v) { return __int_as_float(__builtin_amdgcn_update_dpp(0, __float_as_int(v), CTRL, 0xF, 0xF, true)); }
DI void gdn_prep_item(const Params& P, int layer, int item, char* lds) {
    const int tid = threadIdx.x, lane = tid & 63, w = tid >> 6;
    const int b = item >> 9, head = (item >> 7) & 3, ch = item & 127;
    const int t0 = b * SEQ + ch * 64;
    u16* raw = (u16*)lds;
    float* qs = (float*)(lds + 25856);
    float* ks = qs + 64 * 68;
    float* vs = ks + 64 * 68;
    float* Lp = vs + 64 * 68;
    u16* qb = (u16*)(Lp + 64 * 68);
    u16* kb = qb + 64 * 72;
    float* Gs = (float*)(kb + 64 * 72);
    float* bs = Gs + 64;
    u16* Xs = raw;
    u16* QKs = raw + 8704;
    const u16* qkv = (const u16*)(P.ws + OFF_QKV);
    u16* rec = (u16*)(P.ws + OFF_GREC + (size_t)item * GREC_BYTES);
    for (int i = tid; i < 67 * 24; i += NTHR) {
        const int row = i / 24, c8 = i % 24; const int part = c8 >> 3, cc = (c8 & 7) * 8;
        const int l = ch * 64 + row - 3;
        uint4 v = make_uint4(0, 0, 0, 0);
        if (l >= 0) v = *(const uint4*)(qkv + (size_t)(b * SEQ + l) * 768 + part * 256 + head * 64 + cc);
        *(uint4*)(raw + row * 192 + part * 64 + cc) = v;
    }
    if (tid < 64) {
        bs[tid] = ((const float*)(P.ws + OFF_BETA))[(t0 + tid) * 4 + head];
        float g = ((const float*)(P.ws + OFF_GG))[(t0 + tid) * 4 + head];
#pragma unroll
        for (int o = 1; o < 64; o <<= 1) { const float tt = __shfl_up(g, o); if (lane >= o) g += tt; }
        Gs[tid] = g;
    }
    __syncthreads();
    {
        const float* cw = P.in[3] + (size_t)layer * 4 * 768;
#pragma unroll 1
        for (int it = 0; it < 3; ++it) {
            const int id = tid + NTHR * it; const int t = id / 24, c8 = id % 24; const int part = c8 >> 3, d0 = (c8 & 7) * 8;
            float a[8];
#pragma unroll
            for (int k = 0; k < 8; ++k) a[k] = 0.f;
#pragma unroll
            for (int j = 0; j < 4; ++j) {
                const uint4 rv = *(const uint4*)(raw + (t + j) * 192 + part * 64 + d0);
                const float4 w0 = *(const float4*)(cw + j * 768 + part * 256 + head * 64 + d0), w1 = *(const float4*)(cw + j * 768 + part * 256 + head * 64 + d0 + 4);
                a[0] += w0.x * bf2f((u16)(rv.x & 0xffff)); a[1] += w0.y * bf2f((u16)(rv.x >> 16));
                a[2] += w0.z * bf2f((u16)(rv.y & 0xffff)); a[3] += w0.w * bf2f((u16)(rv.y >> 16));
                a[4] += w1.x * bf2f((u16)(rv.z & 0xffff)); a[5] += w1.y * bf2f((u16)(rv.z >> 16));
                a[6] += w1.z * bf2f((u16)(rv.w & 0xffff)); a[7] += w1.w * bf2f((u16)(rv.w >> 16));
            }
            float ss = 0.f;
#pragma unroll
            for (int k = 0; k < 8; ++k) { a[k] = a[k] * sigmoidf_(a[k]); ss += a[k] * a[k]; }
            ss += dppf<0xB1>(ss); ss += dppf<0x4E>(ss); ss += dppf<0x141>(ss);
            const float sc = part == 2 ? 1.f : rsqrtf(ss + 1e-6f) * (part == 0 ? 0.125f : 1.f);
#pragma unroll
            for (int k = 0; k < 8; ++k) a[k] *= sc;
            float* dst = (part == 0 ? qs : part == 1 ? ks : vs) + t * 68 + d0;
            *(float4*)dst = make_float4(a[0], a[1], a[2], a[3]); *(float4*)(dst + 4) = make_float4(a[4], a[5], a[6], a[7]);
            if (part < 2) {
                uint4 pk; pk.x = pack2(a[0], a[1]); pk.y = pack2(a[2], a[3]); pk.z = pack2(a[4], a[5]); pk.w = pack2(a[6], a[7]);
                *(uint4*)((part == 0 ? qb : kb) + t * 72 + d0) = pk;
            }
        }
    }
    __syncthreads();
    {
        const int r = lane & 31, hh = lane >> 5; const int bi = (w >> 1) & 1, bj = w & 1; const bool isqk = w >= 4;
        const u16* Am = (isqk ? qb : kb) + (bi * 32 + r) * 72 + hh * 8;
        const u16* Bm = kb + (bj * 32 + r) * 72 + hh * 8;
        f32x16 acc;
#pragma unroll
        for (int e = 0; e < 16; ++e) acc[e] = 0.f;
#pragma unroll
        for (int s = 0; s < 4; ++s) acc = MFMA32(ld8(Am + s * 16), ld8(Bm + s * 16), acc);
        const int cidx = bj * 32 + r; const float Gc = Gs[cidx], bc = bs[cidx];
#pragma unroll
        for (int e = 0; e < 16; ++e) {
            const int ridx = bi * 32 + (e & 3) + 8 * (e >> 2) + 4 * hh;
            if (isqk) {
                QKs[ridx * 64 + cidx] = f2bf(cidx <= ridx ? acc[e] * __expf(Gs[ridx] - Gc) : 0.f);
            } else {
                Lp[ridx * 68 + (cidx & 3) * 16 + (cidx >> 2)] = (ridx < cidx) ? bc * acc[e] * __expf(Gc - Gs[ridx]) : 0.f;
            }
        }
    }
    __syncthreads();
    {
        const int c = tid >> 2, q = tid & 3; const bool isw = c >= 64; const int cc = c & 63;
        float rhs[16];
#pragma unroll
        for (int m = 0; m < 16; ++m) {
            const int i = 4 * m + q; const float bi_ = bs[i];
            rhs[m] = isw ? ks[i * 68 + cc] * bi_ * __expf(Gs[i]) : vs[i * 68 + cc] * bi_;
        }
        const float* Lq = Lp + q * 16;
#define SOLVE_STEP(j_, CTRL_) do { \
            const float xj = dppf<CTRL_>(rhs[(j_) >> 2]); \
            const float4* l4 = (const float4*)(Lq + (j_) * 68); \
            const float4 la = l4[0], lb = l4[1], lc = l4[2], ld = l4[3]; \
            rhs[0] -= la.x * xj; rhs[1] -= la.y * xj; rhs[2] -= la.z * xj; rhs[3] -= la.w * xj; \
            rhs[4] -= lb.x * xj; rhs[5] -= lb.y * xj; rhs[6] -= lb.z * xj; rhs[7] -= lb.w * xj; \
            rhs[8] -= lc.x * xj; rhs[9] -= lc.y * xj; rhs[10] -= lc.z * xj; rhs[11] -= lc.w * xj; \
            rhs[12] -= ld.x * xj; rhs[13] -= ld.y * xj; rhs[14] -= ld.z * xj; rhs[15] -= ld.w * xj; } while (0)
#pragma unroll
        for (int jj = 0; jj < 16; ++jj) {
            SOLVE_STEP(4 * jj + 0, 0x00); SOLVE_STEP(4 * jj + 1, 0x55); SOLVE_STEP(4 * jj + 2, 0xAA); SOLVE_STEP(4 * jj + 3, 0xFF);
        }
#undef SOLVE_STEP
        __syncthreads();
#pragma unroll
        for (int m = 0; m < 16; ++m) Xs[(4 * m + q) * 136 + c] = f2bf(rhs[m]);
    }
    __syncthreads();
    {
#pragma unroll
        for (int it = 0; it < 2; ++it) {
            const int id = tid + NTHR * it; const int i = id >> 4, c8 = (id & 15) * 8;
            *(uint4*)(rec + (c8 >> 6) * 4096 + i * 64 + (c8 & 63)) = *(const uint4*)(Xs + i * 136 + c8);
        }
        *(uint4*)(rec + 2 * 4096 + tid * 8) = *(const uint4*)(QKs + tid * 8);
        {
            const int t = tid >> 3, d0 = (tid & 7) * 8; const float eg = __expf(Gs[t]);
            const float4 x0 = *(const float4*)(qs + t * 68 + d0), x1 = *(const float4*)(qs + t * 68 + d0 + 4);
            uint4 pk; pk.x = pack2(x0.x * eg, x0.y * eg); pk.y = pack2(x0.z * eg, x0.w * eg); pk.z = pack2(x1.x * eg, x1.y * eg); pk.w = pack2(x1.z * eg, x1.w * eg);
            *(uint4*)(rec + 3 * 4096 + t * 64 + d0) = pk;
        }
        {
            const int d = tid & 63, tb = (tid >> 6) * 8; const float Gl = Gs[63];
            float kv[8];
#pragma unroll
            for (int k = 0; k < 8; ++k) kv[k] = ks[(tb + k) * 68 + d] * __expf(Gl - Gs[tb + k]);
            uint4 pk; pk.x = pack2(kv[0], kv[1]); pk.y = pack2(kv[2], kv[3]); pk.z = pack2(kv[4], kv[5]); pk.w = pack2(kv[6], kv[7]);
            *(uint4*)(rec + 4 * 4096 + d * 64 + tb) = pk;
            if (tid == 0) ((float*)(P.ws + OFF_EGL))[item] = __expf(Gl);
        }
    }
    __syncthreads();
}

constexpr int RP = 72;
DI void gdn_scan_chain(const Params& P, int chain, char* lds) {
    const int tid = threadIdx.x, lane = tid & 63, w = tid >> 6;
    const int b = chain >> 2, head = chain & 3;
    u16* buf0 = (u16*)lds;
    u16* buf1 = buf0 + 320 * RP;
    const char* recbase = P.ws + OFF_GREC + (size_t)(chain * 128) * GREC_BYTES;
    const float* egl = (const float*)(P.ws + OFF_EGL) + chain * 128;
    float* gout = (float*)(P.ws + OFF_GDNO);
    uint4 rg0, rg1, rg2, rg3, rg4;
#define SCAN_ISSUE(c_) do { const uint4* src_ = (const uint4*)(recbase + (size_t)(c_) * GREC_BYTES) + tid; \
        rg0 = src_[0]; rg1 = src_[NTHR]; rg2 = src_[2 * NTHR]; rg3 = src_[3 * NTHR]; rg4 = src_[4 * NTHR]; } while (0)
#define SCAN_PUT(buf_, i_, v_) do { const int id_ = tid + NTHR * (i_); *(uint4*)((buf_) + (id_ >> 3) * RP + (id_ & 7) * 8) = (v_); } while (0)
#define SCAN_COMMIT(buf_) do { SCAN_PUT(buf_, 0, rg0); SCAN_PUT(buf_, 1, rg1); SCAN_PUT(buf_, 2, rg2); SCAN_PUT(buf_, 3, rg3); SCAN_PUT(buf_, 4, rg4); } while (0)
    f32x4 S[4];
#pragma unroll
    for (int m = 0; m < 4; ++m) S[m] = (f32x4){0.f, 0.f, 0.f, 0.f};
    const int r16 = lane & 15, g = lane >> 4;
    SCAN_ISSUE(0); SCAN_COMMIT(buf0);
    __syncthreads();
    for (int c = 0; c < 128; ++c) {
        u16* cur = (c & 1) ? buf1 : buf0; u16* nxt = (c & 1) ? buf0 : buf1;
        if (c + 1 < 128) SCAN_ISSUE(c + 1);
        if (w < 4) {
            const float dec = egl[c];
            const u16* Ub = cur;
            const u16* Wb = cur + 64 * RP;
            const u16* QKb = cur + 128 * RP;
            const u16* QGb = cur + 192 * RP;
            const u16* KDb = cur + 256 * RP;
            bf16x8 Sb[2];
#pragma unroll
            for (int s = 0; s < 2; ++s) Sb[s] = pack8(S[2 * s][0], S[2 * s][1], S[2 * s][2], S[2 * s][3], S[2 * s + 1][0], S[2 * s + 1][1], S[2 * s + 1][2], S[2 * s + 1][3]);
            f32x4 vn[4], o[4];
#pragma unroll
            for (int mb = 0; mb < 4; ++mb) {
                f32x4 a = (f32x4){0.f, 0.f, 0.f, 0.f}, oo = (f32x4){0.f, 0.f, 0.f, 0.f};
#pragma unroll
                for (int s = 0; s < 2; ++s) {
                    const u16* pw = Wb + (16 * mb + r16) * RP + 32 * s + 4 * g;
                    const u16* pq = QGb + (16 * mb + r16) * RP + 32 * s + 4 * g;
                    a = MFMA16(cat4(*(const bf16x4*)pw, *(const bf16x4*)(pw + 16)), Sb[s], a);
                    oo = MFMA16(cat4(*(const bf16x4*)pq, *(const bf16x4*)(pq + 16)), Sb[s], oo);
                }
#pragma unroll
                for (int e = 0; e < 4; ++e) vn[mb][e] = bf2f(Ub[(16 * mb + 4 * g + e) * RP + 16 * w + r16]) - a[e];
                o[mb] = oo;
            }
            bf16x8 Vb[2];
#pragma unroll
            for (int s = 0; s < 2; ++s) Vb[s] = pack8(vn[2 * s][0], vn[2 * s][1], vn[2 * s][2], vn[2 * s][3], vn[2 * s + 1][0], vn[2 * s + 1][1], vn[2 * s + 1][2], vn[2 * s + 1][3]);
#pragma unroll
            for (int mb = 0; mb < 4; ++mb) {
                f32x4 oo = o[mb];
                f32x4 sn = S[mb] * dec;
#pragma unroll
                for (int s = 0; s < 2; ++s) {
                    const u16* pk = QKb + (16 * mb + r16) * RP + 32 * s + 4 * g;
                    const u16* pd = KDb + (16 * mb + r16) * RP + 32 * s + 4 * g;
                    oo = MFMA16(cat4(*(const bf16x4*)pk, *(const bf16x4*)(pk + 16)), Vb[s], oo);
                    sn = MFMA16(cat4(*(const bf16x4*)pd, *(const bf16x4*)(pd + 16)), Vb[s], sn);
                }
                S[mb] = sn;
#pragma unroll
                for (int e = 0; e < 4; ++e)
                    gout[(size_t)(b * SEQ + c * 64 + 16 * mb + 4 * g + e) * 256 + head * 64 + 16 * w + r16] = oo[e];
            }
        }
        if (c + 1 < 128) SCAN_COMMIT(nxt);
        __syncthreads();
    }
}

DI void phase_gdn_norm(const Params& P, int layer) {
    const int w = threadIdx.x >> 6, lane = threadIdx.x & 63;
    const float* gout = (const float*)(P.ws + OFF_GDNO);
    const u16* z = (const u16*)(P.ws + OFF_Z);
    u16* mix = (u16*)(P.ws + OFF_ABUF);
    const float4 ng = ((const float4*)(P.in[6] + layer * 64))[lane & 15];
    for (int t = blockIdx.x * 8 + w; t < NT; t += gridDim.x * 8) {
        const float4 o = ((const float4*)(gout + (size_t)t * 256))[lane];
        float ss = o.x * o.x + o.y * o.y + o.z * o.z + o.w * o.w;
        ss += __shfl_xor(ss, 1); ss += __shfl_xor(ss, 2); ss += __shfl_xor(ss, 4); ss += __shfl_xor(ss, 8);
        const float rstd = rsqrtf(ss * (1.f / 64.f) + 1e-6f);
        const uint2 zz = *(const uint2*)(z + (size_t)t * 256 + lane * 4);
        const float z0 = bf2f((u16)(zz.x & 0xffff)), z1 = bf2f((u16)(zz.x >> 16)), z2 = bf2f((u16)(zz.y & 0xffff)), z3 = bf2f((u16)(zz.y >> 16));
        uint2 r;
        r.x = pack2(o.x * rstd * ng.x * z0 * sigmoidf_(z0), o.y * rstd * ng.y * z1 * sigmoidf_(z1));
        r.y = pack2(o.z * rstd * ng.z * z2 * sigmoidf_(z2), o.w * rstd * ng.w * z3 * sigmoidf_(z3));
        *(uint2*)(mix + (size_t)t * DM + lane * 4) = r;
    }
}

template <bool FINAL>
DI void s5_item(const Params& P, int layer, int item, char* wlds, int lane) {
    const int b = item >> 11, g = (item >> 7) & 15, ch = item & 127;
    const int t0 = b * SEQ + ch * 64;
    const char* sp = P.ws + OFF_S5P + layer * S5P_LAYER;
    float* ut = (float*)wlds;
    u16* Xs = (u16*)(wlds + 4096);
    {
        const u16* src = (const u16*)(P.ws + OFF_US) + (size_t)(t0 + lane) * 256 + g * 16;
        const uint4 a = *(const uint4*)src, c = *(const uint4*)(src + 8);
        const unsigned uu[8] = {a.x, a.y, a.z, a.w, c.x, c.y, c.z, c.w};
#pragma unroll
        for (int i = 0; i < 8; ++i) { ut[lane * 16 + 2 * i] = bf2f((u16)(uu[i] & 0xffff)); ut[lane * 16 + 2 * i + 1] = bf2f((u16)(uu[i] >> 16)); }
    }
    float Br[16], Bi[16];
    {
        const float4* br = (const float4*)(sp + S5P_BRE) + (g * 64 + lane) * 4; const float4* bi = (const float4*)(sp + S5P_BIM) + (g * 64 + lane) * 4;
#pragma unroll
        for (int i = 0; i < 4; ++i) { const float4 x = br[i], y = bi[i]; Br[4 * i] = x.x; Br[4 * i + 1] = x.y; Br[4 * i + 2] = x.z; Br[4 * i + 3] = x.w; Bi[4 * i] = y.x; Bi[4 * i + 1] = y.y; Bi[4 * i + 2] = y.z; Bi[4 * i + 3] = y.w; }
    }
    const float2 ab = ((const float2*)(sp + S5P_ABAR))[g * 64 + lane];
    float2* st = (float2*)(P.ws + OFF_S5ST) + (size_t)item * 64 + lane;
    float xr = 0.f, xi = 0.f;
    if (FINAL) { const float2 c0 = *st; xr = c0.x; xi = c0.y; }
    bf16x8 cf[4];
    if (FINAL) {
        const u16* cm = (const u16*)(sp + S5P_CM) + (g * 16 + (lane & 15)) * 128 + 8 * (lane >> 4);
#pragma unroll
        for (int s = 0; s < 4; ++s) cf[s] = ld8(cm + 32 * s);
    }
    __builtin_amdgcn_wave_barrier();
    asm volatile("s_waitcnt lgkmcnt(0)" ::: "memory");
    for (int half = 0; half < 2; ++half) {
        for (int tt = 0; tt < 32; ++tt) {
            const int t = half * 32 + tt;
            const float4* u4 = (const float4*)(ut + t * 16);
            float br_ = 0.f, bi_ = 0.f;
#pragma unroll
            for (int q = 0; q < 4; ++q) {
                const float4 u = u4[q];
                br_ += Br[4 * q] * u.x + Br[4 * q + 1] * u.y + Br[4 * q + 2] * u.z + Br[4 * q + 3] * u.w;
                bi_ += Bi[4 * q] * u.x + Bi[4 * q + 1] * u.y + Bi[4 * q + 2] * u.z + Bi[4 * q + 3] * u.w;
            }
            const float nr = ab.x * xr - ab.y * xi + br_, ni = ab.x * xi + ab.y * xr + bi_;
            xr = nr; xi = ni;
            if (FINAL) { Xs[tt * 136 + lane] = f2bf(xr); Xs[tt * 136 + 64 + lane] = f2bf(xi); }
        }
        if (FINAL) {
            asm volatile("s_waitcnt lgkmcnt(0)" ::: "memory");
            __builtin_amdgcn_wave_barrier();
            const int r16 = lane & 15, gg = lane >> 4;
            const float dsv = P.in[13][layer * 256 + g * 16 + r16];
#pragma unroll
            for (int mb = 0; mb < 2; ++mb) {
                f32x4 acc = (f32x4){0.f, 0.f, 0.f, 0.f};
#pragma unroll
                for (int s = 0; s < 4; ++s) acc = MFMA16(ld8(Xs + (16 * mb + r16) * 136 + 32 * s + 8 * gg), cf[s], acc);
#pragma unroll
                for (int e = 0; e < 4; ++e) {
                    const int tk = half * 32 + 16 * mb + 4 * gg + e;
                    const float y = acc[e] + dsv * ut[tk * 16 + r16];
                    ((u16*)(P.ws + OFF_YS5))[(size_t)(t0 + tk) * 256 + g * 16 + r16] = f2bf(gelu_tanh(y));
                }
            }
            asm volatile("s_waitcnt lgkmcnt(0)" ::: "memory");
            __builtin_amdgcn_wave_barrier();
        }
    }
    if (!FINAL) *st = make_float2(xr, xi);
    asm volatile("s_waitcnt lgkmcnt(0)" ::: "memory");
    __builtin_amdgcn_wave_barrier();
}
template <bool FINAL>
DI void phase_s5(const Params& P, int layer, char* lds) {
    const int w = threadIdx.x >> 6, lane = threadIdx.x & 63;
    char* wl = lds + w * 12800;
    for (int it = blockIdx.x * 8 + w; it < 8192; it += gridDim.x * 8) s5_item<FINAL>(P, layer, it, wl, lane);
}
constexpr int ATT_STAGE_B = 32768;
DI void attn_item(const Params& P, int layer, int b, int head, int qb, char* lds) {
    const int tid = threadIdx.x, lane = tid & 63, w = __builtin_amdgcn_readfirstlane(tid >> 6);
    const int m = w >> 2, wq = w & 3, r = lane & 31, hh = lane >> 5;
    PG8_LAS unsigned char* L = (PG8_LAS unsigned char*)lds;
    const u16* QC = (const u16*)(P.ws + OFF_QC);
    const u16* KC = (const u16*)(P.ws + OFF_KC);
    const u16* VT = (const u16*)(P.ws + OFF_VT);
    const int qw0 = qb * 128 + 32 * wq;
    const int q = qw0 + r;
    bf16x8 qf[4];
    {
        const u16* qp = QC + (size_t)(b * SEQ + q) * 512 + head * 128 + m * 64 + hh * 8;
#pragma unroll
        for (int s = 0; s < 4; ++s) qf[s] = ld8(qp + 16 * s);
    }
    f32x16 o[4];
#pragma unroll
    for (int d = 0; d < 4; ++d)
#pragma unroll
        for (int e = 0; e < 16; ++e) o[d][e] = 0.f;
    float mrun = -INFINITY, lrun = 0.f;
    const int nkv = 2 * (qb + 1);
    unsigned ksrc0, ksrc1, vsrc0, vsrc1;
    {
        int key = 4 * (2 * w) + (lane >> 4);     ksrc0 = (unsigned)(key * 1024 + (((lane & 15) ^ (key & 15)) << 4));
        key = 4 * (2 * w + 1) + (lane >> 4);     ksrc1 = (unsigned)(key * 1024 + (((lane & 15) ^ (key & 15)) << 4));
        int dv = 8 * (2 * w) + (lane >> 3);      vsrc0 = (unsigned)(dv * 128 + (((lane & 7) ^ ((dv >> 1) & 7)) << 4));
        dv = 8 * (2 * w + 1) + (lane >> 3);      vsrc1 = (unsigned)(dv * 128 + (((lane & 7) ^ ((dv >> 1) & 7)) << 4));
    }
    const char* kbase = (const char*)(KC + (size_t)(b * SEQ) * 512 + head * 128);
    const char* vbase = (const char*)(VT + (size_t)((b * 4 + head) * 128) * SEQ);
#define ATT_DMA(t_, st_) do { \
        const char* kb_ = kbase + (size_t)(t_) * 65536; const char* vb_ = vbase + (size_t)(t_) * 16384; \
        PG8_LAS unsigned char* d_ = L + (st_) * ATT_STAGE_B + w * 2048; \
        __builtin_amdgcn_global_load_lds((const unsigned*)(kb_ + ksrc0), (PG8_LAS unsigned*)(d_), 16, 0, 0); \
        __builtin_amdgcn_global_load_lds((const unsigned*)(kb_ + ksrc1), (PG8_LAS unsigned*)(d_ + 1024), 16, 0, 0); \
        __builtin_amdgcn_global_load_lds((const unsigned*)(vb_ + vsrc0), (PG8_LAS unsigned*)(d_ + 16384), 16, 0, 0); \
        __builtin_amdgcn_global_load_lds((const unsigned*)(vb_ + vsrc1), (PG8_LAS unsigned*)(d_ + 16384 + 1024), 16, 0, 0); } while (0)
    int koff[4], voff[4];
#pragma unroll
    for (int s = 0; s < 4; ++s) {
        koff[s] = r * 256 + ((((m * 8 + hh + 2 * s) ^ (r & 15)) & 15) << 4);
        voff[s] = 16384 + r * 128 + ((((2 * s + hh) ^ ((r >> 1) & 7)) & 7) << 4);
    }
#define ATT_LD16(off_) (*(const PG8_LAS bf16x8*)(L + (off_)))
#define ATT_QK(stb_, init_) do { \
        const float in_ = (init_); \
        _Pragma("unroll") for (int e = 0; e < 16; ++e) { s0[e] = in_; s1[e] = in_; } \
        bf16x8 ka[4], kb[4]; \
        _Pragma("unroll") for (int s = 0; s < 4; ++s) { ka[s] = ATT_LD16((stb_) + koff[s]); kb[s] = ATT_LD16((stb_) + koff[s] + 8192); } \
        __builtin_amdgcn_sched_barrier(0); \
        _Pragma("unroll") for (int s = 0; s < 4; ++s) { \
            s0 = MFMA32(ka[s], qf[s], s0); \
            s1 = MFMA32(kb[s], qf[s], s1); } } while (0)
#define ATT_MASK(j_) do { \
        if (64 * (j_) + 63 > qw0) { \
            _Pragma("unroll") for (int e = 0; e < 16; ++e) { \
                const int key = 64 * (j_) + (e & 3) + 8 * (e >> 2) + 4 * hh; \
                if (key > q) s0[e] = -INFINITY; \
                if (key + 32 > q) s1[e] = -INFINITY; } } } while (0)
#define ATT_PACK() do { \
        pf[0] = pack8(s0[0], s0[1], s0[2], s0[3], s0[4], s0[5], s0[6], s0[7]); \
        pf[1] = pack8(s0[8], s0[9], s0[10], s0[11], s0[12], s0[13], s0[14], s0[15]); \
        pf[2] = pack8(s1[0], s1[1], s1[2], s1[3], s1[4], s1[5], s1[6], s1[7]); \
        pf[3] = pack8(s1[8], s1[9], s1[10], s1[11], s1[12], s1[13], s1[14], s1[15]); } while (0)
#define ATT_SM_HEAVY(j_) do { \
        ATT_MASK(j_); \
        float mx = s0[0]; \
        _Pragma("unroll") for (int e = 1; e < 16; ++e) mx = fmaxf(mx, s0[e]); \
        _Pragma("unroll") for (int e = 0; e < 16; ++e) mx = fmaxf(mx, s1[e]); \
        mx = fmaxf(mx, __shfl_xor(mx, 32)); \
        float mnew = mrun; \
        if (__builtin_amdgcn_ballot_w64(mx > mrun + 8.f) != 0ull) { \
            mnew = fmaxf(mrun, mx); \
            const float alpha = __builtin_amdgcn_exp2f(mrun - mnew); \
            mrun = mnew; lrun *= alpha; \
            _Pragma("unroll") for (int d = 0; d < 4; ++d) o[d] = o[d] * alpha; } \
        float psum = 0.f; \
        _Pragma("unroll") for (int e = 0; e < 16; ++e) { s0[e] = __builtin_amdgcn_exp2f(s0[e] - mnew); psum += s0[e]; } \
        _Pragma("unroll") for (int e = 0; e < 16; ++e) { s1[e] = __builtin_amdgcn_exp2f(s1[e] - mnew); psum += s1[e]; } \
        lrun += psum; \
        ATT_PACK(); } while (0)
#define ATT_SM_LIGHT(j_) do { \
        ATT_MASK(j_); \
        _Pragma("unroll") for (int e = 0; e < 16; ++e) { s0[e] = __builtin_amdgcn_exp2f(s0[e]); s1[e] = __builtin_amdgcn_exp2f(s1[e]); } \
        { float ps_ = 0.f; _Pragma("unroll") for (int e = 0; e < 16; ++e) ps_ += s0[e] + s1[e]; lrun += ps_; } \
        ATT_PACK(); } while (0)
#define ATT_LDV(dst_, stb_, d_) do { _Pragma("unroll") for (int kk = 0; kk < 4; ++kk) dst_[kk] = ATT_LD16((stb_) + voff[kk] + (d_) * 4096); } while (0)
#define ATT_MM4(d_, src_) do { __builtin_amdgcn_s_setprio(1); _Pragma("unroll") for (int kk = 0; kk < 4; ++kk) o[d_] = MFMA32(src_[kk], pf[kk], o[d_]); __builtin_amdgcn_s_setprio(0); } while (0)
#define ATT_PV(stb_) do { \
        bf16x8 va[4], vb[4]; \
        ATT_LDV(va, stb_, 0); __builtin_amdgcn_sched_barrier(0); \
        ATT_LDV(vb, stb_, 1); __builtin_amdgcn_sched_barrier(0); ATT_MM4(0, va); __builtin_amdgcn_sched_barrier(0); \
        ATT_LDV(va, stb_, 2); __builtin_amdgcn_sched_barrier(0); ATT_MM4(1, vb); __builtin_amdgcn_sched_barrier(0); \
        ATT_LDV(vb, stb_, 3); __builtin_amdgcn_sched_barrier(0); ATT_MM4(2, va); __builtin_amdgcn_sched_barrier(0); \
        ATT_MM4(3, vb); } while (0)
#define ATT_BAR(n_) do { asm volatile("s_waitcnt vmcnt(" #n_ ")" ::: "memory"); __builtin_amdgcn_s_barrier(); asm volatile("" ::: "memory"); __builtin_amdgcn_sched_barrier(0); } while (0)
    bf16x8 pf[4];
    bool pend = false;
    bool first_ = true;
    ATT_DMA(0, 0); ATT_DMA(1, 1);
    asm volatile("" :: "v"(qf[0]), "v"(qf[1]), "v"(qf[2]), "v"(qf[3]));
    ATT_BAR(4);
#pragma unroll 1
    for (int j = 0; j < nkv; ++j) {
        const int cur = (j & 3) * ATT_STAGE_B, prv = ((j + 3) & 3) * ATT_STAGE_B;
        const bool more = j + 2 < nkv;
        if (more) ATT_DMA(j + 2, (j + 2) & 3);
        const bool act = 64 * j <= qw0 + 31;
        const bool heavy = ((j & 15) == 0) || first_;
        f32x16 s0, s1;
        if (act) { if (heavy) { ATT_QK(cur, 0.f); } else { ATT_QK(cur, -mrun); } }
        if (pend) { ATT_PV(prv); pend = false; }
        if (act) { if (heavy) { ATT_SM_HEAVY(j); } else { ATT_SM_LIGHT(j); } first_ = false; pend = true; }
        if (more) { ATT_BAR(4); } else { ATT_BAR(0); }
    }
    if (pend) { ATT_PV(((nkv - 1) & 3) * ATT_STAGE_B); }
    __syncthreads();
    const float ltot = lrun + __shfl_xor(lrun, 32);
    const float inv = 1.f / ltot;
    float* ex = (float*)lds;
    if (m == 1) {
#pragma unroll
        for (int d = 0; d < 4; ++d)
#pragma unroll
            for (int e = 0; e < 16; ++e) ex[(wq * 64 + d * 16 + e) * 64 + lane] = o[d][e] * inv;
    }
    __syncthreads();
    if (m == 0) {
        const float lam = ((const float*)(P.ws + OFF_SCAL))[layer];
        const float lam_init = 0.8f - 0.6f * __expf(-0.3f * (float)layer);
        float ss = 0.f;
#pragma unroll
        for (int d = 0; d < 4; ++d)
#pragma unroll
            for (int e = 0; e < 16; ++e) { const float v = o[d][e] * inv - lam * ex[(wq * 64 + d * 16 + e) * 64 + lane]; o[d][e] = v; ss += v * v; }
        ss += __shfl_xor(ss, 32);
        const float scl = rsqrtf(ss * (1.f / 128.f) + 1e-6f) * (1.f - lam_init);
        const float* ng = P.in[21] + layer * 128;
        u16* mix = (u16*)(P.ws + OFF_ABUF) + (size_t)(b * SEQ + q) * DM + 512 + head * 128;
#pragma unroll
        for (int d = 0; d < 4; ++d)
#pragma unroll
            for (int qd = 0; qd < 4; ++qd) {
                const int dv0 = 32 * d + 8 * qd + 4 * hh;
                const float4 g4 = *(const float4*)(ng + dv0);
                uint2 pk; pk.x = pack2(o[d][4 * qd] * scl * g4.x, o[d][4 * qd + 1] * scl * g4.y); pk.y = pack2(o[d][4 * qd + 2] * scl * g4.z, o[d][4 * qd + 3] * scl * g4.w);
                *(uint2*)(mix + dv0) = pk;
            }
    }
    __syncthreads();
#undef ATT_DMA
#undef ATT_LD16
#undef ATT_BAR
#undef ATT_QK
#undef ATT_MASK
#undef ATT_PACK
#undef ATT_SM_HEAVY
#undef ATT_SM_LIGHT
#undef ATT_PV
#undef ATT_LDV
#undef ATT_MM4
}
DI void phase_attn(const Params& P, int layer, char* lds, int cidx = 0) {
    unsigned* ctr = (unsigned*)(P.ws + OFF_CTL + 16384 + (layer + 2 * cidx) * 256);
    volatile int* slot = (volatile int*)(lds + LDS_BYTES - 32);
    for (;;) {
        if (threadIdx.x == 0) *slot = (int)atomicAdd(ctr, 1u);
        __syncthreads();
        const int idx = *slot;
        __syncthreads();
        if (idx >= 1024) break;
        const int qb = 63 - (idx >> 4), bh = idx & 15;
        attn_item(P, layer, bh >> 2, bh & 3, qb, lds);
    }
}

DI void sort16_desc(float (&a)[16]) {
#pragma unroll
    for (int k = 2; k <= 16; k <<= 1)
#pragma unroll
        for (int j = k >> 1; j > 0; j >>= 1)
#pragma unroll
            for (int i = 0; i < 16; ++i) {
                const int l = i ^ j;
                if (l > i) {
                    const float hi = fmaxf(a[i], a[l]), lo = fminf(a[i], a[l]);
                    if ((i & k) == 0) { a[i] = hi; a[l] = lo; } else { a[i] = lo; a[l] = hi; }
                }
            }
}
DI void merge_top16(float (&a)[16], const float (&b)[16]) {
#pragma unroll
    for (int i = 0; i < 16; ++i) a[i] = fmaxf(a[i], b[15 - i]);
#pragma unroll
    for (int j = 8; j > 0; j >>= 1)
#pragma unroll
        for (int i = 0; i < 16; ++i) {
            const int l = i ^ j;
            if (l > i) { const float hi = fmaxf(a[i], a[l]), lo = fminf(a[i], a[l]); a[i] = hi; a[l] = lo; }
        }
}
DI void phase_topk(const Params& P, int layer, char* lds) {
    const int w = threadIdx.x >> 6, lane = threadIdx.x & 63, r = lane & 31, hh = lane >> 5;
    const u16* PQ = (const u16*)(P.ws + OFF_PQ);
    const u16* KEYS = (const u16*)(P.ws + OFF_KEYS) + (size_t)layer * 8 * 2 * 128 * 64;
    unsigned* pk32 = (unsigned*)(P.ws + OFF_PICKE);
    unsigned* Hs = (unsigned*)lds;
    unsigned char* mytab = (unsigned char*)(lds + 4096 + threadIdx.x * 32);
    for (int it0 = blockIdx.x * 8; it0 < 8192; it0 += gridDim.x * 8) {
        const int it = it0 + w;
        const int tile = it >> 3, h = it & 7; const int tok = tile * 32 + r;
        float sv[2][16];
#pragma unroll
        for (int p = 0; p < 2; ++p) {
            bf16x8 bq[4];
            const u16* qp = PQ + (size_t)tok * 1024 + h * 128 + p * 64 + hh * 8;
#pragma unroll
            for (int s = 0; s < 4; ++s) bq[s] = ld8(qp + 16 * s);
            float blk[4][16];
#pragma unroll
            for (int kb = 0; kb < 4; ++kb) {
                f32x16 acc;
#pragma unroll
                for (int e = 0; e < 16; ++e) acc[e] = 0.f;
                const u16* kp = KEYS + ((size_t)((h * 2 + p) * 128 + 32 * kb + r)) * 64 + hh * 8;
#pragma unroll
                for (int s = 0; s < 4; ++s) acc = MFMA32(ld8(kp + 16 * s), bq[s], acc);
#pragma unroll
                for (int e = 0; e < 16; ++e) {
                    const unsigned key = 32 * kb + (e & 3) + 8 * (e >> 2) + 4 * hh;
                    blk[kb][e] = __uint_as_float((__float_as_uint(acc[e]) & ~0x7Fu) | key);
                }
                sort16_desc(blk[kb]);
            }
            merge_top16(blk[0], blk[1]); merge_top16(blk[2], blk[3]); merge_top16(blk[0], blk[2]);
            float oth[16];
#pragma unroll
            for (int k = 0; k < 16; ++k) oth[k] = __shfl_xor(blk[0][k], 32);
            merge_top16(blk[0], oth);
#pragma unroll
            for (int k = 0; k < 16; ++k) sv[p][k] = blk[0][k];
        }
        {
            uint4 t0, t1; unsigned* a0 = (unsigned*)&t0; unsigned* a1 = (unsigned*)&t1;
#pragma unroll
            for (int q = 0; q < 4; ++q) {
                a0[q] = (__float_as_uint(sv[0][4 * q]) & 0x7Fu) | ((__float_as_uint(sv[0][4 * q + 1]) & 0x7Fu) << 8) | ((__float_as_uint(sv[0][4 * q + 2]) & 0x7Fu) << 16) | ((__float_as_uint(sv[0][4 * q + 3]) & 0x7Fu) << 24);
                a1[q] = (__float_as_uint(sv[1][4 * q]) & 0x7Fu) | ((__float_as_uint(sv[1][4 * q + 1]) & 0x7Fu) << 8) | ((__float_as_uint(sv[1][4 * q + 2]) & 0x7Fu) << 16) | ((__float_as_uint(sv[1][4 * q + 3]) & 0x7Fu) << 24);
            }
            *(uint4*)mytab = t0; *(uint4*)(mytab + 16) = t1;
        }
        float top[16], b1[16], b2[16], b3[16];
#pragma unroll
        for (int k = 0; k < 16; ++k) { b1[k] = -INFINITY; b2[k] = -INFINITY; b3[k] = -INFINITY; }
        {
            int cnt = 0;
#pragma unroll
            for (int i = 0; i < 16; ++i)
#pragma unroll
                for (int j = 0; j < 16; ++j)
                    if ((i + 1) * (j + 1) <= 16) {
                        const float sm = __uint_as_float(__float_as_uint(sv[0][i]) & ~0x7Fu) + __uint_as_float(__float_as_uint(sv[1][j]) & ~0x7Fu);
                        const float pk = __uint_as_float((__float_as_uint(sm) & ~0xFFu) | (unsigned)(i * 16 + j));
                        if (i == 0) top[j] = pk;
                        else { if (cnt < 16) b1[cnt] = pk; else if (cnt < 32) b2[cnt - 16] = pk; else b3[cnt - 32] = pk; ++cnt; }
                    }
        }
        sort16_desc(b1); sort16_desc(b2);
        { const float hi = fmaxf(b3[0], b3[1]), lo = fminf(b3[0], b3[1]); b3[0] = hi; b3[1] = lo; }
        merge_top16(top, b1); merge_top16(b2, b3); merge_top16(top, b2);
        float ev[16]; float den = 0.f;
        const float mx = __uint_as_float(__float_as_uint(top[0]) & ~0xFFu);
#pragma unroll
        for (int k = 0; k < 16; ++k) { ev[k] = __expf(__uint_as_float(__float_as_uint(top[k]) & ~0xFFu) - mx); den += ev[k]; }
        const float rden = 1.f / den;
        unsigned ex[16]; unsigned c_lo = 0, c_hi = 0;
#pragma unroll
        for (int k = 0; k < 16; ++k) {
            const unsigned code = __float_as_uint(top[k]) & 0xFFu;
            ex[k] = (unsigned)mytab[code >> 4] * 128u + (unsigned)mytab[16 + (code & 15u)];
        }
        unsigned rk[16];
#pragma unroll
        for (int k = 0; k < 16; ++k) {
            const unsigned pt = ex[k] >> 11; const unsigned sh = 8u * (pt & 3u); const bool islo = pt < 4u;
            rk[k] = ((islo ? c_lo : c_hi) >> sh) & 0xFFu;
            c_lo += islo ? (1u << sh) : 0u; c_hi += islo ? 0u : (1u << sh);
        }
        if (hh == 0) { Hs[(r * 8 + h) * 2] = c_lo; Hs[(r * 8 + h) * 2 + 1] = c_hi; }
        __syncthreads();
        unsigned tot_lo = 0, tot_hi = 0, bef_lo = 0, bef_hi = 0;
#pragma unroll
        for (int hq = 0; hq < 8; ++hq) {
            const unsigned a = Hs[(r * 8 + hq) * 2], b = Hs[(r * 8 + hq) * 2 + 1];
            tot_lo += a; tot_hi += b;
            if (hq < h) { bef_lo += a; bef_hi += b; }
        }
        unsigned offp[9]; offp[0] = 0;
#pragma unroll
        for (int pt = 0; pt < 8; ++pt) offp[pt + 1] = offp[pt] + (((pt < 4 ? tot_lo : tot_hi) >> (8 * (pt & 3))) & 0xFFu);
        if (h == 0 && hh == 0) {
            uint4 ob; ob.x = offp[0] | (offp[1] << 8) | (offp[2] << 16) | (offp[3] << 24); ob.y = offp[4] | (offp[5] << 8) | (offp[6] << 16) | (offp[7] << 24); ob.z = offp[8]; ob.w = 0;
            ((uint4*)(P.ws + OFF_OFFS))[tok] = ob;
        }
        const unsigned base_lo = (offp[0] | (offp[1] << 8) | (offp[2] << 16) | (offp[3] << 24)) + bef_lo;
        const unsigned base_hi = (offp[4] | (offp[5] << 8) | (offp[6] << 16) | (offp[7] << 24)) + bef_hi;
#pragma unroll
        for (int k = 0; k < 16; ++k) {
            if ((k >> 3) == hh) {
                const unsigned pt = ex[k] >> 11; const unsigned sh = 8u * (pt & 3u);
                const unsigned pos = (((pt < 4u ? base_lo : base_hi) >> sh) & 0xFFu) + rk[k];
                pk32[(size_t)tok * 128 + pos] = ((unsigned)f2bf(ev[k] * rden) << 16) | ex[k];
            }
        }
        __syncthreads();
    }
}

DI void fp8x16_to_f32(const uint4& u, float (&f)[16]) {
    const unsigned uu[4] = {u.x, u.y, u.z, u.w};
#pragma unroll
    for (int q = 0; q < 4; ++q) {
        const f32x2 lo = __builtin_amdgcn_cvt_pk_f32_fp8((int)uu[q], false), hi = __builtin_amdgcn_cvt_pk_f32_fp8((int)uu[q], true);
        f[4 * q] = lo[0]; f[4 * q + 1] = lo[1]; f[4 * q + 2] = hi[0]; f[4 * q + 3] = hi[1];
    }
}
template <int CTRL> DI int dpp_i(int v) { return __builtin_amdgcn_update_dpp(0, v, CTRL, 0xF, 0xF, true); }
template <int CTRL> DI float dpp_f(float v) { return __int_as_float(__builtin_amdgcn_update_dpp(0, __float_as_int(v), CTRL, 0xF, 0xF, true)); }
DI float wave_sum_fast(float v) {
    v += dpp_f<0xB1>(v); v += dpp_f<0x4E>(v); v += dpp_f<0x124>(v); v += dpp_f<0x128>(v);
    v += __shfl_xor(v, 16); v += __shfl_xor(v, 32); return v;
}
DI int rowreduce4(int p0, int p1, int p2, int p3, bool odd, bool bit1) {
    const int a01 = odd ? p1 : p0, b01 = odd ? p0 : p1;
    const int r01 = a01 + dpp_i<0xB1>(b01);
    const int a23 = odd ? p3 : p2, b23 = odd ? p2 : p3;
    const int r23 = a23 + dpp_i<0xB1>(b23);
    const int a = bit1 ? r23 : r01, b = bit1 ? r01 : r23;
    int r = a + dpp_i<0x4E>(b);
    r += dpp_i<0x124>(r);
    r += dpp_i<0x128>(r);
    return r;
}
DI int dot16_i8(const uint4& u, const int (&xq)[4]) {
    int p = __builtin_amdgcn_sdot4((int)u.x, xq[0], 0, false);
    p = __builtin_amdgcn_sdot4((int)u.y, xq[1], p, false);
    p = __builtin_amdgcn_sdot4((int)u.z, xq[2], p, false);
    p = __builtin_amdgcn_sdot4((int)u.w, xq[3], p, false);
    return p;
}
#define PEER_LOAD8(buf_, tab_, ev_, base_) do { _Pragma("unroll") for (int i_ = 0; i_ < 8; ++i_) { \
        const int e_ = __builtin_amdgcn_readlane((ev_), (base_) + i_); buf_[i_] = *(const uint4*)((tab_) + (size_t)e_ * 1024 + lane * 16); } } while (0)

#define RL(v_, i_) __builtin_amdgcn_readlane((int)(v_), (i_))
#define PEER_OFFS(p_, j_, BASE_, N_) do { \
        const unsigned ox_ = (unsigned)RL(myoff.x, j_), oy_ = (unsigned)RL(myoff.y, j_), oz_ = (unsigned)RL(myoff.z, j_); \
        const int p0_ = (p_), p1_ = (p_) + 1; \
        const unsigned lo_ = p0_ < 4 ? (ox_ >> (8 * p0_)) & 255u : (oy_ >> (8 * (p0_ - 4))) & 255u; \
        const unsigned hi_ = p1_ < 4 ? (ox_ >> (8 * p1_)) & 255u : p1_ < 8 ? (oy_ >> (8 * (p1_ - 4))) & 255u : (oz_ & 255u); \
        BASE_ = (int)lo_; N_ = (int)(hi_ - lo_); } while (0)
typedef __attribute__((ext_vector_type(4))) unsigned u32x4_t;
typedef __attribute__((ext_vector_type(2))) unsigned u32x2_t;
#define PEER_ROWS8B(buf_, rs_, ev_, b_) do { _Pragma("unroll") for (int k_ = 0; k_ < 8; ++k_) { \
        int li_ = 8 * (b_) + k_; li_ = li_ > 63 ? 63 : li_; const int eo_ = RL(ev_, li_); \
        buf_[k_] = __builtin_bit_cast(uint4, __builtin_amdgcn_raw_buffer_load_b128(rs_, lane * 16, eo_, 0)); } } while (0)
#define PEER_ROWS8(buf_, tab_, ev_, b_) do { _Pragma("unroll") for (int k_ = 0; k_ < 8; ++k_) { \
        int li_ = 8 * (b_) + k_; li_ = li_ > 63 ? 63 : li_; const int e_ = RL(ev_, li_); buf_[k_] = *(const uint4*)((tab_) + (size_t)e_ * 1024 + lane * 16); } } while (0)

struct PeerMeta { int e; float g, su, sx, sv; int slot; int idx; int valid; };
DI void phase_peer_u(const Params& P, int layer, char* lds) {
    const int w = threadIdx.x >> 6, lane = threadIdx.x & 63;
    const uint8_t* UT = (const uint8_t*)(P.ws + OFF_UTAB) + (size_t)layer * 16384 * 1024;
    const __amdgpu_buffer_rsrc_t urs = __builtin_amdgcn_make_buffer_rsrc((void*)UT, 0, 16384 * 1024, 0x00020000);
    const unsigned* pk32 = (const unsigned*)(P.ws + OFF_PICKE);
    const float2* sc2 = (const float2*)(P.ws + OFF_V8SC) + layer * 16384;
    float* coefb = (float*)(P.ws + OFF_COEF);
    const uint4* XQ4 = (const uint4*)(P.ws + OFF_XQ); const float* SXp = (const float*)(P.ws + OFF_SX);
    const int stride = gridDim.x * 8, t_first = blockIdx.x * 8 + w;
    const int ntok = t_first < NT ? (NT - t_first + stride - 1) / stride : 0;
    uint4* xql = (uint4*)(lds + w * 16384);
#pragma unroll 1
    for (int jg = 0; jg < ntok; jg += 16) {
        const int ng = (ntok - jg) < 16 ? (ntok - jg) : 16;
        for (int j = 0; j < ng; ++j) xql[j * 64 + lane] = XQ4[(size_t)(t_first + (jg + j) * stride) * 64 + lane];
        uint4 myoff = make_uint4(0, 0, 0, 0); float sxv = 0.f;
        if (lane < ng) { const int t = t_first + (jg + lane) * stride; myoff = ((const uint4*)(P.ws + OFF_OFFS))[t]; sxv = SXp[t]; }
#pragma unroll 1
        for (int p = 0; p < 8; ++p) {
            int nj, basej;
            {
                const unsigned lo = p < 4 ? (myoff.x >> (8 * p)) & 255u : (myoff.y >> (8 * (p - 4))) & 255u;
                const int p1 = p + 1;
                const unsigned hi = p1 < 4 ? (myoff.x >> (8 * p1)) & 255u : p1 < 8 ? (myoff.y >> (8 * (p1 - 4))) & 255u : (myoff.z & 255u);
                basej = (int)lo; nj = lane < ng ? (int)(hi - lo) : 0;
            }
            int pend = nj;
#pragma unroll
            for (int o = 1; o < 16; o <<= 1) { const int tt = __shfl_up(pend, o); if (lane >= o) pend += tt; }
            const int pref = pend - nj;
            const int L = RL(pend, 15);
            if (L == 0) continue;
            const int nsb = (L + 63) >> 6;
#define U_META(sb_, M_) do { \
                const int f_ = 64 * (sb_) + 4 * (lane & 15) + (lane >> 4);        \
                M_.valid = f_ < L; const int fc_ = M_.valid ? f_ : L - 1; \
                int j_ = 0; \
                _Pragma("unroll") for (int jj_ = 0; jj_ < 15; ++jj_) j_ += (jj_ < ng - 1 && fc_ >= RL(pend, jj_)) ? 1 : 0; \
                const int pj_ = __shfl(pref, j_), bj_ = __shfl(basej, j_); \
                M_.slot = j_; M_.idx = (t_first + (jg + j_) * stride) * 128 + bj_ + (fc_ - pj_); \
                const unsigned pw_ = pk32[M_.idx]; const int ee_ = (int)(pw_ & 0xFFFFu); M_.e = (int)(((unsigned)ee_ << 10) | ((unsigned)j_ << 28)); M_.g = __uint_as_float(pw_ & 0xFFFF0000u); { const float2 s2_ = sc2[ee_]; M_.su = s2_.x; M_.sv = s2_.y; } M_.sx = __shfl(sxv, j_); } while (0)
#define U_LOADB(buf_, M_, b_) do { _Pragma("unroll") for (int h_ = 0; h_ < 2; ++h_) { \
                const int pk_ = __builtin_amdgcn_ds_bpermute(((lane & 48) + 2 * (b_) + h_) << 2, M_.e); \
                const int vo_ = (pk_ & 0x0FFFFFFF) + (lane & 15) * 16; \
                _Pragma("unroll") for (int c_ = 0; c_ < 4; ++c_) buf_[4 * h_ + c_] = __builtin_bit_cast(uint4, __builtin_amdgcn_raw_buffer_load_b128(urs, vo_ + 256 * c_, 0, 0)); } } while (0)
            PeerMeta cur, nxt;
            U_META(0, cur);
            uint4 bufA[8], bufB[8], bufC[8], bufD[8];
            U_LOADB(bufA, cur, 0); U_LOADB(bufB, cur, 1); U_LOADB(bufC, cur, 2);
            int xslot = -1; uint4 xc0 = make_uint4(0, 0, 0, 0), xc1 = xc0, xc2 = xc0, xc3 = xc0;
#pragma unroll 1
            for (int sb = 0; sb < nsb; ++sb) {
                const bool has_next = sb + 1 < nsb;
                if (has_next) U_META(sb + 1, nxt); else nxt = cur;
                int md = 0;
#define U_DOT4(acc_, r_, x_) do { acc_ = __builtin_amdgcn_sdot4((int)(r_).x, (int)(x_).x, acc_, false); acc_ = __builtin_amdgcn_sdot4((int)(r_).y, (int)(x_).y, acc_, false); \
                    acc_ = __builtin_amdgcn_sdot4((int)(r_).z, (int)(x_).z, acc_, false); acc_ = __builtin_amdgcn_sdot4((int)(r_).w, (int)(x_).w, acc_, false); } while (0)
#define U_STEP(k_, cur_, pf_) do { \
                    if ((k_) + 3 < 8) { U_LOADB(pf_, cur, (k_) + 3); } else if (has_next) { U_LOADB(pf_, nxt, (k_) + 3 - 8); } \
                    asm volatile("" ::: "memory"); __builtin_amdgcn_sched_barrier(0); \
                    _Pragma("unroll") for (int h_ = 0; h_ < 2; ++h_) { \
                        const int q_ = 2 * (k_) + h_; \
                        const int pk_ = __builtin_amdgcn_ds_bpermute(((lane & 48) + q_) << 2, cur.e); \
                        const int sl_ = (int)((unsigned)pk_ >> 28); \
                        if (__builtin_amdgcn_ballot_w64(sl_ != xslot) != 0ull) {        \
                            const uint4* xp_ = xql + sl_ * 64 + (lane & 15); \
                            xc0 = xp_[0]; xc1 = xp_[16]; xc2 = xp_[32]; xc3 = xp_[48]; xslot = sl_; } \
                        int a0_ = 0, a1_ = 0; \
                        U_DOT4(a0_, cur_[4 * h_ + 0], xc0); U_DOT4(a1_, cur_[4 * h_ + 1], xc1); U_DOT4(a0_, cur_[4 * h_ + 2], xc2); U_DOT4(a1_, cur_[4 * h_ + 3], xc3); \
                        int r_ = a0_ + a1_; \
                        r_ += dpp_i<0xB1>(r_); r_ += dpp_i<0x4E>(r_); r_ += dpp_i<0x124>(r_); r_ += dpp_i<0x128>(r_); \
                        md = ((lane & 15) == q_) ? r_ : md; } \
                    asm volatile("" ::: "memory"); __builtin_amdgcn_sched_barrier(0); } while (0)
                U_STEP(0, bufA, bufD); U_STEP(1, bufB, bufA); U_STEP(2, bufC, bufB); U_STEP(3, bufD, bufC);
                U_STEP(4, bufA, bufD); U_STEP(5, bufB, bufA); U_STEP(6, bufC, bufB); U_STEP(7, bufD, bufC);
#undef U_STEP
#undef U_DOT4
                const float dot = (float)md * cur.su * cur.sx;
                const float coef = cur.g * gelu_tanh(dot) * cur.sv;
                if (cur.valid) coefb[cur.idx] = coef;
                cur = nxt;
            }
#undef U_LOADB
#undef U_META
        }
    }
}

DI void peer_token_epilogue(const Params& P, int layer, int t, int lane, float4 (&v)[4], float* hout, bool last, const float* wab_lds) {
    u16* abuf = (u16*)(P.ws + OFF_ABUF);
    float ss = 0.f;
#pragma unroll
    for (int i = 0; i < 4; ++i) ss += v[i].x * v[i].x + v[i].y * v[i].y + v[i].z * v[i].z + v[i].w * v[i].w;
    ss = wave_sum_fast(ss);
    const float rstd = rsqrtf(ss * (1.f / DM) + 1e-6f);
    if (last) {
        const float4* g4 = (const float4*)(P.in[28]) + lane * 4;
        float4* o4 = (float4*)(hout + (size_t)t * DM + lane * 16);
#pragma unroll
        for (int i = 0; i < 4; ++i) { const float4 g = g4[i]; o4[i] = make_float4(v[i].x * rstd * g.x, v[i].y * rstd * g.y, v[i].z * rstd * g.z, v[i].w * rstd * g.w); }
    } else {
        float4* o4 = (float4*)(hout + (size_t)t * DM + lane * 16);
#pragma unroll
        for (int i = 0; i < 4; ++i) o4[i] = v[i];
        const float4* g4 = (const float4*)(P.in[1] + (layer + 1) * DM) + lane * 4;
        float vn[16];
#pragma unroll
        for (int i = 0; i < 4; ++i) { const float4 g = g4[i]; vn[4 * i] = v[i].x * rstd * g.x; vn[4 * i + 1] = v[i].y * rstd * g.y; vn[4 * i + 2] = v[i].z * rstd * g.z; vn[4 * i + 3] = v[i].w * rstd * g.w; }
        uint4 o0, o1;
        o0.x = pack2(vn[0], vn[1]); o0.y = pack2(vn[2], vn[3]); o0.z = pack2(vn[4], vn[5]); o0.w = pack2(vn[6], vn[7]);
        o1.x = pack2(vn[8], vn[9]); o1.y = pack2(vn[10], vn[11]); o1.z = pack2(vn[12], vn[13]); o1.w = pack2(vn[14], vn[15]);
        *(uint4*)(abuf + (size_t)t * DM + lane * 16) = o0; *(uint4*)(abuf + (size_t)t * DM + lane * 16 + 8) = o1;
        const float4* wab = (const float4*)wab_lds;
        float myacc = 0.f;
#pragma unroll 1
        for (int j = 0; j < 8; ++j) {
            float a = 0.f;
#pragma unroll
            for (int i = 0; i < 4; ++i) { const float4 ww = wab[j * 256 + lane * 4 + i]; a += vn[4 * i] * ww.x + vn[4 * i + 1] * ww.y + vn[4 * i + 2] * ww.z + vn[4 * i + 3] * ww.w; }
            a = wave_sum_fast(a);
            myacc = (lane == j) ? a : myacc;
        }
        const float bb = __shfl(myacc, (lane + 4) & 63);
        if (lane < 4) {
            const int L1 = layer + 1;
            const float a = myacc;
            const float xx = a + P.in[5][L1 * 4 + lane];
            const float sp = xx > 20.f ? xx : log1pf(__expf(xx));
            ((float*)(P.ws + OFF_GG))[t * 4 + lane] = -__expf(P.in[4][L1 * 4 + lane]) * sp;
            ((float*)(P.ws + OFF_BETA))[t * 4 + lane] = sigmoidf_(bb);
        }
    }
}

#ifndef V4_THR
#define V4_THR 0.25f
#endif
DI int peer_v_compact(int& e, float& c, bool small, int lane) {
    unsigned long long m = __builtin_amdgcn_ballot_w64(small);
    const unsigned long long lt = (1ull << lane) - 1ull;
    const int n8 = 64 - __popcll(m), n8r = (n8 + 7) & ~7;
    const int rank4 = __popcll(m & lt);
    if (small && rank4 < n8r - n8) small = false;
    m = __builtin_amdgcn_ballot_w64(small);
    const int pos = small ? n8r + __popcll(m & lt) : __popcll(~m & lt);
    e = __builtin_amdgcn_ds_permute(pos * 4, e);
    c = __int_as_float(__builtin_amdgcn_ds_permute(pos * 4, __float_as_int(c)));
    return n8r;
}
DI float wave_max(float v) {
    v = fmaxf(v, dpp_f<0xB1>(v)); v = fmaxf(v, dpp_f<0x4E>(v)); v = fmaxf(v, dpp_f<0x124>(v)); v = fmaxf(v, dpp_f<0x128>(v));
    const float a = __int_as_float(__builtin_amdgcn_readlane(__float_as_int(v), 0)), b = __int_as_float(__builtin_amdgcn_readlane(__float_as_int(v), 16));
    const float c = __int_as_float(__builtin_amdgcn_readlane(__float_as_int(v), 32)), d = __int_as_float(__builtin_amdgcn_readlane(__float_as_int(v), 48));
    return fmaxf(fmaxf(a, b), fmaxf(c, d));
}
#define VPERM_LO(a_, b_) ((int)__builtin_amdgcn_perm((unsigned)(b_), (unsigned)(a_), 0x05010400u))
#define VPERM_HI(a_, b_) ((int)__builtin_amdgcn_perm((unsigned)(b_), (unsigned)(a_), 0x07030602u))
#define VDOT_PAIR(Y_, a0_, a1_, a2_, a3_, b0_, b1_, b2_, b3_, sl_, sh_) do { \
        const unsigned ua0_ = (a0_), ua1_ = (a1_), ua2_ = (a2_), ua3_ = (a3_), ub0_ = (b0_), ub1_ = (b1_), ub2_ = (b2_), ub3_ = (b3_); \
        __builtin_amdgcn_sched_barrier(0); \
        const int p0_ = VPERM_LO(ua0_, ub0_), q0_ = VPERM_HI(ua0_, ub0_), p1_ = VPERM_LO(ua1_, ub1_), q1_ = VPERM_HI(ua1_, ub1_); \
        const int p2_ = VPERM_LO(ua2_, ub2_), q2_ = VPERM_HI(ua2_, ub2_), p3_ = VPERM_LO(ua3_, ub3_), q3_ = VPERM_HI(ua3_, ub3_); \
        __builtin_amdgcn_sched_barrier(0); \
        Y_[0] = __builtin_amdgcn_sdot4(p0_, sl_, Y_[0], false); Y_[1] = __builtin_amdgcn_sdot4(p0_, sh_, Y_[1], false); \
        Y_[2] = __builtin_amdgcn_sdot4(q0_, sl_, Y_[2], false); Y_[3] = __builtin_amdgcn_sdot4(q0_, sh_, Y_[3], false); \
        Y_[4] = __builtin_amdgcn_sdot4(p1_, sl_, Y_[4], false); Y_[5] = __builtin_amdgcn_sdot4(p1_, sh_, Y_[5], false); \
        Y_[6] = __builtin_amdgcn_sdot4(q1_, sl_, Y_[6], false); Y_[7] = __builtin_amdgcn_sdot4(q1_, sh_, Y_[7], false); \
        Y_[8] = __builtin_amdgcn_sdot4(p2_, sl_, Y_[8], false); Y_[9] = __builtin_amdgcn_sdot4(p2_, sh_, Y_[9], false); \
        Y_[10] = __builtin_amdgcn_sdot4(q2_, sl_, Y_[10], false); Y_[11] = __builtin_amdgcn_sdot4(q2_, sh_, Y_[11], false); \
        Y_[12] = __builtin_amdgcn_sdot4(p3_, sl_, Y_[12], false); Y_[13] = __builtin_amdgcn_sdot4(p3_, sh_, Y_[13], false); \
        Y_[14] = __builtin_amdgcn_sdot4(q3_, sl_, Y_[14], false); Y_[15] = __builtin_amdgcn_sdot4(q3_, sh_, Y_[15], false); \
        __builtin_amdgcn_sched_barrier(0); } while (0)
struct VMeta { int e0, e1, cq0, cq1, nb0, nb1, zs; float f8, f4; };
DI VMeta peer_v_meta(int e0, int e1, float c0, float c1, int lane) {
    VMeta M;
    const float am = wave_max(fmaxf(fabsf(c0), fabsf(c1)));
    M.nb0 = peer_v_compact(e0, c0, fabsf(c0) < V4_THR * am, lane);
    M.nb1 = peer_v_compact(e1, c1, fabsf(c1) < V4_THR * am, lane);
    const bool q0 = lane >= M.nb0, q1 = lane >= M.nb1;
    if (q0) c0 *= (127.f / 7.f);
    if (q1) c1 *= (127.f / 7.f);
    const float m8 = wave_max(fmaxf(q0 ? 0.f : fabsf(c0), q1 ? 0.f : fabsf(c1)));
    const float m4 = wave_max(fmaxf(q0 ? fabsf(c0) : 0.f, q1 ? fabsf(c1) : 0.f));
    const float r8 = m8 > 0.f ? 127.f / m8 : 0.f, r4 = m4 > 0.f ? 127.f / m4 : 0.f;
    M.cq0 = (int)rintf(c0 * (q0 ? r4 : r8)); M.cq1 = (int)rintf(c1 * (q1 ? r4 : r8));
    int zs = (q0 ? M.cq0 : 0) + (q1 ? M.cq1 : 0);
    zs += dpp_i<0xB1>(zs); zs += dpp_i<0x4E>(zs); zs += dpp_i<0x124>(zs); zs += dpp_i<0x128>(zs);
    zs = __builtin_amdgcn_readlane(zs, 0) + __builtin_amdgcn_readlane(zs, 16) + __builtin_amdgcn_readlane(zs, 32) + __builtin_amdgcn_readlane(zs, 48);
    M.zs = zs; M.e0 = e0; M.e1 = e1; M.f8 = m8 * (1.f / 127.f); M.f4 = m4 * (1.f / 127.f);
    return M;
}
DI void phase_peer_v(const Params& P, int layer, const float* hin, float* hout, bool last, char* lds) {
    const int w = threadIdx.x >> 6, lane = threadIdx.x & 63;
    if (!last) { const float4* src = (const float4*)(P.ws + OFF_WAB) + (layer + 1) * 8 * 256; for (int i = threadIdx.x; i < 2048; i += NTHR) ((float4*)lds)[i] = src[i]; }
    __syncthreads();
    const uint8_t* VTb = (const uint8_t*)(P.ws + OFF_VTAB) + (size_t)layer * 16384 * 1024;
    const uint8_t* V4b = (const uint8_t*)(P.ws + OFF_V4TAB) + (size_t)layer * 16384 * 512;
    const __amdgpu_buffer_rsrc_t v8rs = __builtin_amdgcn_make_buffer_rsrc((void*)VTb, 0, 16384 * 1024, 0x00020000);
    const __amdgpu_buffer_rsrc_t v4rs = __builtin_amdgcn_make_buffer_rsrc((void*)V4b, 0, 16384 * 512, 0x00020000);
    const unsigned* pk32 = (const unsigned*)(P.ws + OFF_PICKE); const float* coefb = (const float*)(P.ws + OFF_COEF);
    const int stride = gridDim.x * 8;
    int t = blockIdx.x * 8 + w;
    if (t >= NT) return;
    uint4 bufA[8], bufB[8], bufC[8], bufD[8];
#define V_IS4(M_, k_) (8 * ((k_) & 7) >= (((k_) >> 3) ? M_.nb1 : M_.nb0))
#define V_LOAD(buf_, M_, k_) do { \
        if (V_IS4(M_, k_)) { _Pragma("unroll") for (int i_ = 0; i_ < 8; ++i_) { const int e_ = RL(((k_) >> 3) ? M_.e1 : M_.e0, 8 * ((k_) & 7) + i_); \
                const uint2 t_ = *(const uint2*)(V4b + (size_t)e_ * 512 + lane * 8); buf_[i_].x = t_.x; buf_[i_].y = t_.y; } } \
        else { _Pragma("unroll") for (int i_ = 0; i_ < 8; ++i_) { const int e_ = RL(((k_) >> 3) ? M_.e1 : M_.e0, 8 * ((k_) & 7) + i_); \
                buf_[i_] = *(const uint4*)(VTb + (size_t)e_ * 1024 + lane * 16); } } } while (0)
    VMeta cur = peer_v_meta((int)(pk32[(size_t)t * 128 + lane] & 0xFFFFu), (int)(pk32[(size_t)t * 128 + 64 + lane] & 0xFFFFu), coefb[(size_t)t * 128 + lane], coefb[(size_t)t * 128 + 64 + lane], lane);
    V_LOAD(bufA, cur, 0); V_LOAD(bufB, cur, 1); V_LOAD(bufC, cur, 2);
#pragma unroll 1
    for (; t < NT; t += stride) {
        const int tn = t + stride; const bool has_next = tn < NT;
        int ne0 = 0, ne1 = 0; float nc0 = 0.f, nc1 = 0.f;
        if (has_next) { ne0 = (int)(pk32[(size_t)tn * 128 + lane] & 0xFFFFu); ne1 = (int)(pk32[(size_t)tn * 128 + 64 + lane] & 0xFFFFu); nc0 = coefb[(size_t)tn * 128 + lane]; nc1 = coefb[(size_t)tn * 128 + 64 + lane]; }
        int y8[16], y4[16];
#pragma unroll
        for (int i = 0; i < 16; ++i) { y8[i] = 0; y4[i] = 0; }
#define V_STEP(k_, cur_, pf_) do { \
            if ((k_) + 3 < 16) { V_LOAD(pf_, cur, (k_) + 3); } \
            asm volatile("" ::: "memory"); __builtin_amdgcn_sched_barrier(0); \
            if (V_IS4(cur, k_)) { \
                _Pragma("unroll") for (int i = 0; i < 8; i += 2) { \
                    const int ca_ = RL(((k_) >> 3) ? cur.cq1 : cur.cq0, 8 * ((k_) & 7) + i) & 0xFF, cb_ = RL(((k_) >> 3) ? cur.cq1 : cur.cq0, 8 * ((k_) & 7) + i + 1) & 0xFF; \
                    const int sl_ = ca_ | (cb_ << 8), sh_ = sl_ << 16; \
                    const unsigned xa0 = cur_[i].x, xa1 = cur_[i].y, xb0 = cur_[i + 1].x, xb1 = cur_[i + 1].y; \
                    VDOT_PAIR(y4, xa0 & 0x0F0F0F0Fu, (xa0 >> 4) & 0x0F0F0F0Fu, xa1 & 0x0F0F0F0Fu, (xa1 >> 4) & 0x0F0F0F0Fu, \
                              xb0 & 0x0F0F0F0Fu, (xb0 >> 4) & 0x0F0F0F0Fu, xb1 & 0x0F0F0F0Fu, (xb1 >> 4) & 0x0F0F0F0Fu, sl_, sh_); } \
            } else { \
                _Pragma("unroll") for (int i = 0; i < 8; i += 2) { \
                    const int ca_ = RL(((k_) >> 3) ? cur.cq1 : cur.cq0, 8 * ((k_) & 7) + i) & 0xFF, cb_ = RL(((k_) >> 3) ? cur.cq1 : cur.cq0, 8 * ((k_) & 7) + i + 1) & 0xFF; \
                    const int sl_ = ca_ | (cb_ << 8), sh_ = sl_ << 16; \
                    VDOT_PAIR(y8, cur_[i].x, cur_[i].y, cur_[i].z, cur_[i].w, cur_[i + 1].x, cur_[i + 1].y, cur_[i + 1].z, cur_[i + 1].w, sl_, sh_); } } \
            asm volatile("" ::: "memory"); __builtin_amdgcn_sched_barrier(0); } while (0)
        V_STEP(0, bufA, bufD); V_STEP(1, bufB, bufA); V_STEP(2, bufC, bufB); V_STEP(3, bufD, bufC);
        V_STEP(4, bufA, bufD); V_STEP(5, bufB, bufA); V_STEP(6, bufC, bufB); V_STEP(7, bufD, bufC);
        V_STEP(8, bufA, bufD); V_STEP(9, bufB, bufA); V_STEP(10, bufC, bufB); V_STEP(11, bufD, bufC);
        V_STEP(12, bufA, bufD);
        float4 hv[4];
        { const float4* h4 = (const float4*)(hin + (size_t)t * DM + lane * 16);
#pragma unroll
          for (int i = 0; i < 4; ++i) hv[i] = h4[i]; }
        V_STEP(13, bufB, bufA);
        V_STEP(14, bufC, bufB); V_STEP(15, bufD, bufC);
#undef V_STEP
        float4 hy[4];
#pragma unroll
        for (int i = 0; i < 4; ++i) {
            hy[i].x = hv[i].x + (float)y8[4 * i] * cur.f8 + (float)(y4[4 * i] - 8 * cur.zs) * cur.f4;
            hy[i].y = hv[i].y + (float)y8[4 * i + 1] * cur.f8 + (float)(y4[4 * i + 1] - 8 * cur.zs) * cur.f4;
            hy[i].z = hv[i].z + (float)y8[4 * i + 2] * cur.f8 + (float)(y4[4 * i + 2] - 8 * cur.zs) * cur.f4;
            hy[i].w = hv[i].w + (float)y8[4 * i + 3] * cur.f8 + (float)(y4[4 * i + 3] - 8 * cur.zs) * cur.f4;
        }
        if (has_next) {
            cur = peer_v_meta(ne0, ne1, nc0, nc1, lane);
            V_LOAD(bufA, cur, 0); V_LOAD(bufB, cur, 1); V_LOAD(bufC, cur, 2);
        }
        asm volatile("" ::: "memory"); __builtin_amdgcn_sched_barrier(0);
        peer_token_epilogue(P, layer, t, lane, hy, hout, last, (const float*)lds);
    }
#undef V_LOAD
#undef V_IS4
}

#define XB_TMO      128
#define XB_XCNT(j)  (256  + 64 * (j))
#define XB_XSUB(j)  (1280 + 64 * (j))
#define XB_XGEN(j)  (2304 + 64 * (j))
#define XB_TOP      3328
#define XB_TOPGEN   3392
#define XCD_BAR_WORDS 3456
#define XB_SPIN_CAP (1u << 22)
#define LAS __attribute__((address_space(3)))
DI unsigned xb_ld(unsigned* p)              { return __hip_atomic_load(p, __ATOMIC_RELAXED, __HIP_MEMORY_SCOPE_AGENT); }
DI unsigned xb_add(unsigned* p, unsigned v) { return __hip_atomic_fetch_add(p, v, __ATOMIC_RELAXED, __HIP_MEMORY_SCOPE_AGENT); }
DI unsigned xb_xcc_id() { return (unsigned)__builtin_amdgcn_s_getreg((3 << 11) | 20) & 0xFu; }
#define XB_SPIN(cond, bar) do { unsigned _sp = 0; while (cond) { __builtin_amdgcn_s_sleep(1); \
    if ((++_sp & 255u) == 0u) { if (xb_ld(&(bar)[XB_TMO])) break; if (_sp > XB_SPIN_CAP) { atomicAdd(&(bar)[XB_TMO], 1u); break; } } } } while (0)
struct XcdBarrier { unsigned* bar; unsigned x; volatile LAS unsigned* st; };
DI XcdBarrier xcd_barrier_post(unsigned* bar, volatile LAS unsigned* st) {
    XcdBarrier b; b.bar = bar; b.x = xb_xcc_id(); b.st = st;
    if (threadIdx.x == 0) (void)xb_add(&bar[XB_XCNT(b.x)], 1u);
    return b;
}
DI void xcd_barrier_complete(unsigned* bar, unsigned x, unsigned& nloc, unsigned& nx) {
    const unsigned G = gridDim.x * gridDim.y * gridDim.z;
    unsigned sum, cnt, mine, sp = 0u;
    for (;;) {
        sum = 0u; cnt = 0u; mine = 0u;
#pragma unroll
        for (unsigned j = 0; j < 16; ++j) { const unsigned c = xb_ld(&bar[XB_XCNT(j)]); sum += c; cnt += (c > 0u) ? 1u : 0u; mine = (j == x) ? c : mine; }
        if (sum == G) break;
        __builtin_amdgcn_s_sleep(1);
        if ((++sp & 255u) == 0u) { if (xb_ld(&bar[XB_TMO])) break; if (sp > XB_SPIN_CAP) { atomicAdd(&bar[XB_TMO], 1u); break; } }
    }
    nloc = mine > 0u ? mine : 1u; nx = cnt > 0u ? cnt : 1u;
}
DI void xcd_barrier(const XcdBarrier& b) {
    asm volatile("s_waitcnt vmcnt(0)" ::: "memory");
    __syncthreads();
    if (threadIdx.x == 0) {
        unsigned* bar = b.bar;
        __builtin_amdgcn_s_waitcnt(0);
        unsigned nloc = b.st[0], nx = b.st[1];
        if (nloc == 0u) { xcd_barrier_complete(bar, b.x, nloc, nx); b.st[0] = nloc; b.st[1] = nx; }
        const unsigned old = xb_add(&bar[XB_XSUB(b.x)], 1u);
        const unsigned gen = old / nloc;
        if (old + 1u == (gen + 1u) * nloc) {
            __builtin_amdgcn_fence(__ATOMIC_RELEASE, "agent");
            asm volatile("s_waitcnt vmcnt(0)" ::: "memory");
            const unsigned og = xb_add(&bar[XB_TOP], 1u);
            const unsigned tg = og / nx;
            if (og + 1u == (tg + 1u) * nx) xb_add(&bar[XB_TOPGEN], 1u);
            else XB_SPIN(xb_ld(&bar[XB_TOPGEN]) == tg, bar);
            __builtin_amdgcn_fence(__ATOMIC_ACQUIRE, "agent");
            xb_add(&bar[XB_XGEN(b.x)], 1u);
            asm volatile("s_waitcnt vmcnt(0)" ::: "memory");
        } else {
            XB_SPIN(xb_ld(&bar[XB_XGEN(b.x)]) == gen, bar);
            __builtin_amdgcn_fence(__ATOMIC_ACQUIRE, "agent");
            asm volatile("s_waitcnt vmcnt(0)" ::: "memory");
        }
    }
    __syncthreads();
}

constexpr int PH_PER_LAYER = 11;
constexpr int NPHASE = 2 + 2 * PH_PER_LAYER;

#ifdef ONLY_SUB
#define SUB_ON(k) (ONLY_SUB == (k))
#else
#define SUB_ON(k) 1
#endif
DI void run_phase(const Params& P, int ph, char* lds) {
    char* ws = P.ws;
#if SUB_ON(100)
    if (ph == 0) { phase_prep(P, lds); return; }
#endif
#if SUB_ON(101)
    if (ph == 1) { phase_rms(P, P.in[0], P.in[1], (u16*)(ws + OFF_ABUF), 0); return; }
#endif
    if (ph < 2) return;
    const int layer = (ph - 2) / PH_PER_LAYER, sub = (ph - 2) % PH_PER_LAYER;
    const float* hin = layer == 0 ? P.in[0] : P.out;
    switch (sub) {
    #if SUB_ON(0)
    case 0: { EpiInProj8 e{ws}; phase_gemm((const u16*)(ws + OFF_ABUF), 1024, (const u16*)(ws + OFF_WINT) + (size_t)layer * PROJW * 1024, 1024, NT, PROJW, 1024, e, lds); } break;

#endif
    #if SUB_ON(1)
    case 1:
        for (int it = blockIdx.x; it < 2048; it += gridDim.x) gdn_prep_item(P, layer, it, lds);
        phase_s5<false>(P, layer, lds);
        break;

#endif
    #if SUB_ON(2)
    case 2:
        if (blockIdx.x < 16) gdn_scan_chain(P, blockIdx.x, lds);
        else if (blockIdx.x < 24) {
            const int gt = (blockIdx.x - 16) * NTHR + threadIdx.x;
            if (gt < 4096) {
                const int bg = gt >> 6, n = gt & 63;
                const float2 a = ((const float2*)(ws + OFF_S5P + layer * S5P_LAYER + S5P_A64))[(bg & 15) * 64 + n];
                float2* st = (float2*)(ws + OFF_S5ST) + (size_t)bg * 128 * 64 + n;
                float xr = 0.f, xi = 0.f;
                for (int c = 0; c < 128; ++c) {
                    const float2 sv = st[c * 64];
                    st[c * 64] = make_float2(xr, xi);
                    const float nr = a.x * xr - a.y * xi + sv.x, ni = a.x * xi + a.y * xr + sv.y;
                    xr = nr; xi = ni;
                }
            }
        }
        __syncthreads();
        phase_attn(P, layer, lds);
        break;

#endif
    #if SUB_ON(3)
    case 3: phase_s5<true>(P, layer, lds); phase_gdn_norm(P, layer); break;

#endif
    #if SUB_ON(4)
    case 4: {
        EpiGlu8 e{(u16*)(ws + OFF_ABUF), P.in[16] + layer * 512};
        phase_gemm((const u16*)(ws + OFF_YS5), 256, (const u16*)(ws + OFF_GLUT) + (size_t)layer * 512 * 256, 256, NT, 512, 256, e, lds);
    } break;

#endif
    #if SUB_ON(5)
    case 5: { EpiResidual8 e{hin, P.out}; phase_gemm((const u16*)(ws + OFF_ABUF), 1024, (const u16*)(ws + OFF_WOUTT) + (size_t)layer * 1024 * 1024, 1024, NT, 1024, 1024, e, lds); } break;

#endif
    #if SUB_ON(6)
    case 6: phase_rms(P, P.out, P.in[23] + layer * DM, (u16*)(ws + OFF_ABUF), -1, true); break;

#endif
    #if SUB_ON(7)
    case 7: { pg8::EpiBf16<0> e{(u16*)(ws + OFF_PQ), 1024, nullptr, 0, 0}; phase_gemm((const u16*)(ws + OFF_ABUF), 1024, (const u16*)(ws + OFF_WQT) + (size_t)layer * 1024 * 1024, 1024, NT, 1024, 1024, e, lds); } break;

#endif
    #if SUB_ON(8)
    case 8: phase_topk(P, layer, lds); break;

#endif
    #if SUB_ON(9)
    case 9: phase_peer_u(P, layer, lds); break;
#endif
    #if SUB_ON(10)
    case 10: phase_peer_v(P, layer, P.out, P.out, layer == 1, lds); break;
#endif
    }
}

#ifndef USE_CG_SYNC
#define USE_CG_SYNC 0
#endif
#if USE_CG_SYNC
#define GRID_SYNC() cg::this_grid().sync()
#else
#define GRID_SYNC() xcd_barrier(xbar)
#endif
__global__ void __launch_bounds__(NTHR) mk_fwd(Params P, int ph_lo, int ph_hi) {
    extern __shared__ __attribute__((aligned(16))) char lds[];
#if !USE_CG_SYNC
    volatile LAS unsigned* xst = (volatile LAS unsigned*)(lds + LDS_BYTES - 16);
    if (threadIdx.x == 0) { xst[0] = 0u; xst[1] = 0u; }
    __syncthreads();
    XcdBarrier xbar = xcd_barrier_post((unsigned*)(P.ws + OFF_CTL), xst);
#endif
#ifndef DUP_SUB
#define DUP_SUB -1
#endif
#define PH(k) if (ph_lo <= (k) && (k) < ph_hi) { \
        if ((k) >= 2 && (((k) - 2) % PH_PER_LAYER == DUP_SUB || (DUP_SUB == 20 && ((k) - 2) % PH_PER_LAYER == 2))) { \
            if (DUP_SUB == 9) phase_peer_u(P, ((k) - 2) / PH_PER_LAYER, lds); \
            else if (DUP_SUB == 2) { if (blockIdx.x < 16) gdn_scan_chain(P, blockIdx.x, lds); } \
            else if (DUP_SUB == 20 && ((k) - 2) % PH_PER_LAYER == 2) { phase_attn(P, ((k) - 2) / PH_PER_LAYER, lds, 1); } \
            else if (DUP_SUB == 5) { if ((k) < 2 + PH_PER_LAYER) run_phase(P, (k), lds); } \
            else run_phase(P, (k), lds); } \
        if ((k) < 2 && DUP_SUB == 100 + (k)) run_phase(P, (k), lds); \
        run_phase(P, (k), lds); if (DUP_SUB == 99) GRID_SYNC(); if ((k) + 1 < ph_hi) GRID_SYNC(); }
    PH(0) PH(1) PH(2) PH(3) PH(4) PH(5) PH(6) PH(7) PH(8) PH(9) PH(10) PH(11)
    PH(12) PH(13) PH(14) PH(15) PH(16) PH(17) PH(18) PH(19) PH(20) PH(21) PH(22) PH(23)
#undef PH
}

extern "C" void kernel_launch(void* const* d_in, const int* in_sizes, int n_in, void* d_out, int out_size, void* d_ws, size_t ws_size, hipStream_t stream) {
    static int grid = 0;
    if (grid == 0) {
        int dev = 0, cus = 0, per_cu = 0;
        hipGetDevice(&dev);
        hipDeviceGetAttribute(&cus, hipDeviceAttributeMultiprocessorCount, dev);
        hipFuncSetAttribute((const void*)mk_fwd, hipFuncAttributeMaxDynamicSharedMemorySize, LDS_BYTES);
        hipOccupancyMaxActiveBlocksPerMultiprocessor(&per_cu, (const void*)mk_fwd, NTHR, LDS_BYTES);
        if (per_cu < 1) { fprintf(stderr, "occupancy query says %d blocks per CU\n", per_cu); per_cu = 1; }
        grid = cus;
        if (ws_size < OFF_END) { fprintf(stderr, "workspace too small: %zu < %zu\n", ws_size, (size_t)OFF_END); }
    }
    Params p{};
    for (int i = 0; i < 29; ++i) p.in[i] = (const float*)d_in[i];
    p.out = (float*)d_out; p.ws = (char*)d_ws;
#if MK_ONE_LAUNCH
    int lo = 0, hi = NPHASE;
    (void)hipMemsetAsync((char*)d_ws + OFF_CTL, 0, 65536, stream);
#if USE_CG_SYNC
    void* args[] = {&p, &lo, &hi};
    hipError_t e = hipLaunchCooperativeKernel((const void*)mk_fwd, dim3(grid), dim3(NTHR), args, LDS_BYTES, stream);
    if (e != hipSuccess) fprintf(stderr, "cooperative launch failed: %s\n", hipGetErrorString(e));
#else
    hipLaunchKernelGGL(mk_fwd, dim3(grid), dim3(NTHR), LDS_BYTES, stream, p, lo, hi);
#endif
#else
    for (int ph = 0; ph < NPHASE; ++ph) hipLaunchKernelGGL(mk_fwd, dim3(grid), dim3(NTHR), LDS_BYTES, stream, p, ph, ph + 1);
#endif
}
```

```cpp
#include <hip/hip_runtime.h>
#include <hip/hip_cooperative_groups.h>
#include <stdint.h>
#include <stdio.h>
namespace cg = cooperative_groups;

#ifndef MK_ONE_LAUNCH
#define MK_ONE_LAUNCH 1
#endif

#define DI __device__ __forceinline__
typedef unsigned short u16;
typedef __attribute__((ext_vector_type(8))) short bf16x8;
typedef __attribute__((ext_vector_type(4))) short bf16x4;
typedef __attribute__((ext_vector_type(16))) float f32x16;
typedef __attribute__((ext_vector_type(4))) float f32x4;
typedef __attribute__((ext_vector_type(2))) float f32x2;

constexpr int NT = 32768, DM = 1024, SEQ = 8192, NBATCH = 4;
constexpr int NTHR = 512;
constexpr int INW = 2824;
constexpr int PROJW = 2816;
constexpr float LOG2E = 1.4426950408889634f;

constexpr size_t OFF_CTL   = 0;
constexpr size_t OFF_WINT  = 65536;
constexpr size_t OFF_WOUTT = OFF_WINT  + (size_t)2 * PROJW * 1024 * 2;
constexpr size_t OFF_WQT   = OFF_WOUTT + (size_t)2 * 1024 * 1024 * 2;
constexpr size_t OFF_GLUT  = OFF_WQT   + (size_t)2 * 1024 * 1024 * 2;
constexpr size_t OFF_KEYS  = OFF_GLUT  + (size_t)2 * 512 * 256 * 2;
constexpr size_t OFF_WAB   = OFF_KEYS  + (size_t)2 * 8 * 2 * 128 * 64 * 2;
constexpr size_t OFF_S5P   = OFF_WAB   + (size_t)2 * 8 * 1024 * 4;
constexpr size_t S5P_LAYER = 262144;
constexpr size_t S5P_ABAR = 0, S5P_A64 = 8192, S5P_BRE = 16384, S5P_BIM = 16384 + 65536, S5P_CM = 16384 + 131072;
constexpr size_t OFF_SCAL  = OFF_S5P   + 2 * S5P_LAYER;
constexpr size_t OFF_UTAB  = OFF_SCAL  + 256;
constexpr size_t OFF_VTAB  = OFF_UTAB  + (size_t)2 * 16384 * 1024;
constexpr size_t OFF_USCALE = OFF_VTAB + (size_t)2 * 16384 * 1024;
constexpr size_t OFF_V4TAB = OFF_USCALE + (size_t)2 * 16384 * 4;
constexpr size_t OFF_V4SC  = OFF_V4TAB + (size_t)2 * 16384 * 512;
constexpr size_t OFF_V8SC  = OFF_V4SC + (size_t)2 * 16384 * 4;
constexpr size_t OFF_ABUF  = OFF_V8SC + (size_t)2 * 16384 * 8;
constexpr size_t OFF_GG    = OFF_ABUF  + (size_t)NT * 1024 * 2;
constexpr size_t OFF_BETA  = OFF_GG    + (size_t)NT * 4 * 4;
constexpr size_t OFF_PROJ  = OFF_BETA  + (size_t)NT * 4 * 4;
constexpr size_t OFF_QKV   = OFF_PROJ;
constexpr size_t OFF_Z     = OFF_QKV   + (size_t)NT * 768 * 2;
constexpr size_t OFF_US    = OFF_Z     + (size_t)NT * 256 * 2;
constexpr size_t OFF_QC    = OFF_US    + (size_t)NT * 256 * 2;
constexpr size_t OFF_KC    = OFF_QC    + (size_t)NT * 512 * 2;
constexpr size_t OFF_VT    = OFF_KC    + (size_t)NT * 512 * 2;
constexpr size_t OFF_GREC  = OFF_VT    + (size_t)NT * 512 * 2;
constexpr size_t GREC_BYTES = 40960;
constexpr size_t OFF_EGL   = OFF_GREC  + (size_t)2048 * GREC_BYTES;
constexpr size_t OFF_S5ST  = OFF_EGL   + 2048 * 4;
constexpr size_t OFF_YS5   = OFF_S5ST  + (size_t)8192 * 64 * 8;
constexpr size_t OFF_END   = OFF_YS5   + (size_t)NT * 256 * 2;
constexpr size_t OFF_HMID  = OFF_END;
constexpr size_t OFF_END2  = OFF_HMID + (size_t)NT * 1024 * 2;
constexpr size_t OFF_GDNO  = OFF_QKV;
constexpr size_t OFF_PQ    = OFF_PROJ;
constexpr size_t OFF_PICKE = OFF_GREC;
constexpr size_t OFF_PICKG = OFF_GREC + (size_t)NT * 128 * 2;
constexpr size_t OFF_COEF  = OFF_PICKG + (size_t)NT * 128 * 4;
constexpr size_t OFF_OFFS  = OFF_COEF + (size_t)NT * 128 * 4;
constexpr size_t OFF_XQ    = OFF_OFFS + (size_t)NT * 16;
constexpr size_t OFF_PSV   = OFF_PROJ + (size_t)NT * 1024 * 2;
constexpr size_t OFF_PSU   = OFF_YS5;
constexpr size_t OFF_SX    = OFF_XQ + (size_t)NT * 1024;
static_assert(OFF_SX + (size_t)NT * 4 <= OFF_GREC + (size_t)2048 * GREC_BYTES, "peer scratch must fit in the dead GDN record region");
static_assert(OFF_END < (size_t)512 * 1024 * 1024, "workspace");

constexpr int LDS_BYTES = 148480 + 16;

struct Params {
    const float* in[29];
    float* out;
    char* ws;
};

typedef __bf16 nbf16x2 __attribute__((ext_vector_type(2)));
DI unsigned pack2(float a, float b) { const f32x2 v = {a, b}; return __builtin_bit_cast(unsigned, __builtin_convertvector(v, nbf16x2)); }
DI u16 f2bf(float x) { return (u16)(pack2(x, x) & 0xffffu); }
DI float bf2f(u16 v) { return __uint_as_float(((unsigned)v) << 16); }
DI float wave_sum(float v) { for (int o = 32; o > 0; o >>= 1) v += __shfl_xor(v, o); return v; }
template <int CTRL> DI float dpp_q(float v) { return __int_as_float(__builtin_amdgcn_update_dpp(0, __float_as_int(v), CTRL, 0xF, 0xF, true)); }
DI float rl_f(float v, int l) { return __int_as_float(__builtin_amdgcn_readlane(__float_as_int(v), l)); }
DI float wave_sum_u(float v) {
    v += dpp_q<0xB1>(v); v += dpp_q<0x4E>(v); v += dpp_q<0x124>(v); v += dpp_q<0x128>(v);
    return (rl_f(v, 0) + rl_f(v, 16)) + (rl_f(v, 32) + rl_f(v, 48));
}
DI float wave_max_u(float v) {
    v = fmaxf(v, dpp_q<0xB1>(v)); v = fmaxf(v, dpp_q<0x4E>(v)); v = fmaxf(v, dpp_q<0x124>(v)); v = fmaxf(v, dpp_q<0x128>(v));
    return fmaxf(fmaxf(rl_f(v, 0), rl_f(v, 16)), fmaxf(rl_f(v, 32), rl_f(v, 48)));
}
DI float frcp(float x) { return __builtin_amdgcn_rcpf(x); }
DI float gelu_tanh(float x) { float u = 0.7978845608028654f * (x + 0.044715f * x * x * x); float e = __expf(2.f * u); float th = 1.f - 2.f * frcp(e + 1.f); return 0.5f * x * (1.f + th); }
DI float sigmoidf_(float x) { return frcp(1.f + __expf(-x)); }
DI float softplus_f(float x) { return fmaxf(x, 0.f) + __logf(1.f + __expf(-fabsf(x))); }
#define MFMA32(a, b, c) __builtin_amdgcn_mfma_f32_32x32x16_bf16((a), (b), (c), 0, 0, 0)
#define MFMA16(a, b, c) __builtin_amdgcn_mfma_f32_16x16x32_bf16((a), (b), (c), 0, 0, 0)
DI bf16x8 ld8(const void* p) { return *(const bf16x8*)p; }
DI bf16x8 cat4(bf16x4 lo, bf16x4 hi) { return __builtin_shufflevector(lo, hi, 0, 1, 2, 3, 4, 5, 6, 7); }
DI bf16x8 pack8(float a0, float a1, float a2, float a3, float a4, float a5, float a6, float a7) {
    uint4 u; u.x = pack2(a0, a1); u.y = pack2(a2, a3); u.z = pack2(a4, a5); u.w = pack2(a6, a7);
    return __builtin_bit_cast(bf16x8, u);
}

template <class CM>
DI void transpose_tile(const float* __restrict__ src, int src_ld, u16* __restrict__ dst, int K, int n0, int k0, CM colmap, float* tl) {
    const int tid = threadIdx.x;
    {
        const int nn = tid & 63;
        const int sc = colmap(n0 + nn);
#pragma unroll
        for (int i = 0; i < 8; ++i) { const int kk = (tid >> 6) + 8 * i; tl[kk * 65 + nn] = src[(size_t)(k0 + kk) * src_ld + sc]; }
    }
    __syncthreads();
    {
        const int kk = tid & 63;
#pragma unroll
        for (int i = 0; i < 8; ++i) { const int nn = (tid >> 6) + 8 * i; dst[(size_t)(n0 + nn) * K + k0 + kk] = f2bf(tl[kk * 65 + nn]); }
    }
    __syncthreads();
}

DI void phase_prep(const Params& P, char* lds) {
    float* tl = (float*)lds;
    char* ws = P.ws;
    const int bid = blockIdx.x, nb = gridDim.x, tid = threadIdx.x;
    for (int j = bid; j < 2496; j += nb) {
        if (j < 1408) {
            const int l = j / 704, r = j % 704, nt = r / 16, kt = r % 16;
            transpose_tile(P.in[2] + (size_t)l * 1024 * INW, INW, (u16*)(ws + OFF_WINT) + (size_t)l * PROJW * 1024, 1024, nt * 64, kt * 64,
                           [](int n) { return n < 1024 ? n : n + 8; }, tl);
        } else if (j < 1920) {
            const int q = j - 1408; const int l = q / 256, r = q % 256, nt = r / 16, kt = r % 16;
            transpose_tile(P.in[22] + (size_t)l * 1024 * 1024, 1024, (u16*)(ws + OFF_WOUTT) + (size_t)l * 1024 * 1024, 1024, nt * 64, kt * 64, [](int n) { return n; }, tl);
        } else if (j < 2432) {
            const int q = j - 1920; const int l = q / 256, r = q % 256, nt = r / 16, kt = r % 16;
            transpose_tile(P.in[24] + (size_t)l * 1024 * 1024, 1024, (u16*)(ws + OFF_WQT) + (size_t)l * 1024 * 1024, 1024, nt * 64, kt * 64, [](int n) { return n; }, tl);
        } else {
            const int q = j - 2432; const int l = q / 32, r = q % 32, nt = r / 4, kt = r % 4;
            transpose_tile(P.in[15] + (size_t)l * 256 * 512, 512, (u16*)(ws + OFF_GLUT) + (size_t)l * 512 * 256, 256, nt * 64, kt * 64,
                           [](int n) { const int tile = n >> 8, wi = n & 255; return wi < 128 ? 128 * tile + wi : 256 + 128 * tile + (wi - 128); }, tl);
        }
    }
    const size_t gtid = (size_t)bid * NTHR + tid, gsz = (size_t)nb * NTHR;
    for (size_t i = gtid; i < (size_t)2 * 8 * 2 * 128 * 64; i += gsz) ((u16*)(ws + OFF_KEYS))[i] = f2bf(P.in[25][i]);
    for (size_t i = gtid; i < (size_t)2 * 8 * 1024; i += gsz) {
        const int l = (int)(i / 8192), j = (int)((i / 1024) % 8), k = (int)(i % 1024);
        ((float*)(ws + OFF_WAB))[i] = P.in[2][(size_t)l * 1024 * INW + (size_t)k * INW + 1024 + j];
    }
    {
        const int wv = tid >> 6, lane = tid & 63;
        for (int row = bid * 8 + wv; row < 2 * 16384; row += nb * 8) {
            const float4* s = (const float4*)(P.in[26] + (size_t)row * 1024) + lane * 4;
            float4 v[4]; float am = 0.f;
#pragma unroll
            for (int q = 0; q < 4; ++q) { v[q] = s[q]; am = fmaxf(am, fmaxf(fmaxf(fabsf(v[q].x), fabsf(v[q].y)), fmaxf(fabsf(v[q].z), fabsf(v[q].w)))); }
            for (int o = 32; o > 0; o >>= 1) am = fmaxf(am, __shfl_xor(am, o));
            const float sc = am > 0.f ? 127.f / am : 0.f;
            uint4 o4; unsigned* op = (unsigned*)&o4;
#pragma unroll
            for (int q = 0; q < 4; ++q) {
                const int a = (int)rintf(v[q].x * sc), b = (int)rintf(v[q].y * sc), c = (int)rintf(v[q].z * sc), d = (int)rintf(v[q].w * sc);
                op[q] = (unsigned)(a & 0xff) | ((unsigned)(b & 0xff) << 8) | ((unsigned)(c & 0xff) << 16) | ((unsigned)(d & 0xff) << 24);
            }
            ((uint4*)(ws + OFF_UTAB))[(size_t)row * 64 + lane] = o4;
            if (lane == 0) ((float*)(ws + OFF_V8SC))[2 * row] = am * (1.f / 127.f);
        }
        for (int row = bid * 8 + wv; row < 2 * 16384; row += nb * 8) {
            const float4* s = (const float4*)(P.in[27] + (size_t)row * 1024) + lane * 4;
            float4 v[4]; float am = 0.f;
#pragma unroll
            for (int q = 0; q < 4; ++q) { v[q] = s[q]; am = fmaxf(am, fmaxf(fmaxf(fabsf(v[q].x), fabsf(v[q].y)), fmaxf(fabsf(v[q].z), fabsf(v[q].w)))); }
            for (int o = 32; o > 0; o >>= 1) am = fmaxf(am, __shfl_xor(am, o));
            const float sc8 = am > 0.f ? 127.f / am : 0.f;
            uint4 o8; unsigned* op = (unsigned*)&o8;
#pragma unroll
            for (int q = 0; q < 4; ++q) {
                const int a = (int)rintf(v[q].x * sc8), b = (int)rintf(v[q].y * sc8), c = (int)rintf(v[q].z * sc8), d = (int)rintf(v[q].w * sc8);
                op[q] = (unsigned)(a & 0xff) | ((unsigned)(b & 0xff) << 8) | ((unsigned)(c & 0xff) << 16) | ((unsigned)(d & 0xff) << 24);
            }
            ((uint4*)(ws + OFF_VTAB))[(size_t)row * 64 + lane] = o8;
            if (lane == 0) ((float*)(ws + OFF_V8SC))[2 * row + 1] = am * (1.f / 127.f);
            const float sc4 = am > 0.f ? 7.f / am : 0.f;
            unsigned d[2];
#pragma unroll
            for (int h2 = 0; h2 < 2; ++h2) {
                const float4 a = v[2 * h2], b = v[2 * h2 + 1];
                const unsigned n0 = (unsigned)((int)rintf(a.x * sc4) + 8), n1 = (unsigned)((int)rintf(a.y * sc4) + 8), n2 = (unsigned)((int)rintf(a.z * sc4) + 8), n3 = (unsigned)((int)rintf(a.w * sc4) + 8);
                const unsigned n4 = (unsigned)((int)rintf(b.x * sc4)) & 15u, n5 = (unsigned)((int)rintf(b.y * sc4)) & 15u, n6 = (unsigned)((int)rintf(b.z * sc4)) & 15u, n7 = (unsigned)((int)rintf(b.w * sc4)) & 15u;
                d[h2] = n0 | (n4 << 4) | (n1 << 8) | (n5 << 12) | (n2 << 16) | (n6 << 20) | (n3 << 24) | (n7 << 28);
            }
            ((uint2*)(ws + OFF_V4TAB))[(size_t)row * 64 + lane] = make_uint2(d[0], d[1]);
            if (lane == 0) ((float*)(ws + OFF_V4SC))[row] = am * (1.f / 7.f);
        }
    }
    for (size_t i = gtid; i < (size_t)2 * 16 * 64; i += gsz) {
        const int l = (int)(i / 1024), g = (int)((i / 64) % 16), n = (int)(i % 64);
        const float step = __expf(P.in[14][l * 16 + g]);
        const float lr = P.in[7][i], li = P.in[8][i];
        const float er = expf(lr * step); const float ar = er * cosf(li * step), ai = er * sinf(li * step);
        const float e64 = expf(64.f * lr * step); const float a64r = e64 * cosf(64.f * li * step), a64i = e64 * sinf(64.f * li * step);
        char* sp = ws + OFF_S5P + l * S5P_LAYER;
        ((float2*)(sp + S5P_ABAR))[g * 64 + n] = make_float2(ar, ai);
        ((float2*)(sp + S5P_A64))[g * 64 + n] = make_float2(a64r, a64i);
        const float xr = ar - 1.f, xi = ai; const float den = 1.f / (lr * lr + li * li);
        const float cr = (xr * lr + xi * li) * den, ci = (xi * lr - xr * li) * den;
        for (int c = 0; c < 16; ++c) {
            const float br = P.in[9][i * 16 + c], bi = P.in[10][i * 16 + c];
            ((float*)(sp + S5P_BRE))[(g * 64 + n) * 16 + c] = cr * br - ci * bi;
            ((float*)(sp + S5P_BIM))[(g * 64 + n) * 16 + c] = cr * bi + ci * br;
        }
    }
    for (size_t i = gtid; i < (size_t)2 * 16 * 16 * 128; i += gsz) {
        const int l = (int)(i / 32768), g = (int)((i / 2048) % 16), c = (int)((i / 128) % 16), k = (int)(i % 128);
        const size_t si = ((size_t)(l * 16 + g) * 16 + c) * 64 + (k & 63);
        const float v = k < 64 ? P.in[11][si] : -P.in[12][si];
        ((u16*)(ws + OFF_S5P + l * S5P_LAYER + S5P_CM))[(g * 16 + c) * 128 + k] = f2bf(v);
    }
    if (bid == 0 && tid < 2) {
        const int l = tid; float s1 = 0.f, s2 = 0.f;
        for (int d = 0; d < 64; ++d) { s1 += P.in[17][l * 64 + d] * P.in[18][l * 64 + d]; s2 += P.in[19][l * 64 + d] * P.in[20][l * 64 + d]; }
        const float lam_init = 0.8f - 0.6f * expf(-0.3f * (float)l);
        ((float*)(ws + OFF_SCAL))[l] = expf(s1) - expf(s2) + lam_init;
    }
}

DI void rms_token(const Params& P, int t, int lane, float4 (&v)[4], const float4 (&gn)[4], u16* dst, int ab_layer  , bool want_q = false) {
    float ss = 0.f;
#pragma unroll
    for (int i = 0; i < 4; ++i) ss += v[i].x * v[i].x + v[i].y * v[i].y + v[i].z * v[i].z + v[i].w * v[i].w;
    ss = wave_sum_u(ss);
    const float rstd = rsqrtf(ss * (1.f / DM) + 1e-6f);
#pragma unroll
    for (int i = 0; i < 4; ++i) {
        const float4 g = gn[i];
        v[i].x *= rstd * g.x; v[i].y *= rstd * g.y; v[i].z *= rstd * g.z; v[i].w *= rstd * g.w;
        uint2 o; o.x = pack2(v[i].x, v[i].y); o.y = pack2(v[i].z, v[i].w);
        *(uint2*)(dst + (size_t)t * DM + (lane + 64 * i) * 4) = o;
    }
    if (want_q) {
        float am = 0.f;
#pragma unroll
        for (int i = 0; i < 4; ++i) am = fmaxf(am, fmaxf(fmaxf(fabsf(v[i].x), fabsf(v[i].y)), fmaxf(fabsf(v[i].z), fabsf(v[i].w))));
        am = wave_max_u(am);
        const float sc = am > 0.f ? 127.f / am : 0.f;
#pragma unroll
        for (int i = 0; i < 4; ++i) {
            const int a0 = (int)rintf(v[i].x * sc), a1 = (int)rintf(v[i].y * sc), a2 = (int)rintf(v[i].z * sc), a3 = (int)rintf(v[i].w * sc);
            ((unsigned*)(P.ws + OFF_XQ))[(size_t)t * 256 + lane + 64 * i] = (unsigned)(a0 & 0xff) | ((unsigned)(a1 & 0xff) << 8) | ((unsigned)(a2 & 0xff) << 16) | ((unsigned)(a3 & 0xff) << 24);
        }
        if (lane == 0) ((float*)(P.ws + OFF_SX))[t] = am * (1.f / 127.f);
    }
    if (ab_layer >= 0) {
        const float4* wab = (const float4*)(P.ws + OFF_WAB) + ab_layer * 8 * 256;
        float acc[8];
#pragma unroll
        for (int j = 0; j < 8; ++j) {
            float a = 0.f;
#pragma unroll
            for (int i = 0; i < 4; ++i) { const float4 w = wab[j * 256 + lane + 64 * i]; a += v[i].x * w.x + v[i].y * w.y + v[i].z * w.z + v[i].w * w.w; }
            acc[j] = wave_sum_u(a);
        }
        if (lane < 4) {
            const float a = lane == 0 ? acc[0] : lane == 1 ? acc[1] : lane == 2 ? acc[2] : acc[3];
            const float b = lane == 0 ? acc[4] : lane == 1 ? acc[5] : lane == 2 ? acc[6] : acc[7];
            const float xx = a + P.in[5][ab_layer * 4 + lane];
            const float sp = softplus_f(xx);
            ((float*)(P.ws + OFF_GG))[t * 4 + lane] = -__expf(P.in[4][ab_layer * 4 + lane]) * sp;
            ((float*)(P.ws + OFF_BETA))[t * 4 + lane] = sigmoidf_(b);
        }
    }
}

DI void phase_rms16(const Params& P, const u16* src16, const float* gain, u16* dst, bool want_q) {
    const int w = threadIdx.x >> 6, lane = threadIdx.x & 63;
    const int stride = gridDim.x * 8;
    int t = blockIdx.x * 8 + w;
    if (t >= NT) return;
    float4 gn[4];
#pragma unroll
    for (int i = 0; i < 4; ++i) gn[i] = ((const float4*)gain)[lane + 64 * i];
    uint2 nr[4];
    { const uint2* s2 = (const uint2*)(src16 + (size_t)t * DM);
#pragma unroll
      for (int i = 0; i < 4; ++i) nr[i] = s2[lane + 64 * i]; }
#pragma unroll 1
    for (; t < NT; t += stride) {
        float4 v[4];
#pragma unroll
        for (int i = 0; i < 4; ++i) v[i] = make_float4(bf2f((u16)(nr[i].x & 0xffff)), bf2f((u16)(nr[i].x >> 16)), bf2f((u16)(nr[i].y & 0xffff)), bf2f((u16)(nr[i].y >> 16)));
        if (t + stride < NT) {
            const uint2* s2 = (const uint2*)(src16 + (size_t)(t + stride) * DM);
#pragma unroll
            for (int i = 0; i < 4; ++i) nr[i] = s2[lane + 64 * i];
        }
        rms_token(P, t, lane, v, gn, dst, -1, want_q);
    }
}
DI void phase_rms(const Params& P, const float* src, const float* gain, u16* dst, int ab_layer, bool want_q = false) {
    const int w = threadIdx.x >> 6, lane = threadIdx.x & 63;
    const int stride = gridDim.x * 8;
    int t = blockIdx.x * 8 + w;
    if (t >= NT) return;
    float4 gn[4];
#pragma unroll
    for (int i = 0; i < 4; ++i) gn[i] = ((const float4*)gain)[lane + 64 * i];
    float4 nv[4];
    { const float4* s4 = (const float4*)(src + (size_t)t * DM);
#pragma unroll
      for (int i = 0; i < 4; ++i) nv[i] = s4[lane + 64 * i]; }
#pragma unroll 1
    for (; t < NT; t += stride) {
        float4 v[4];
#pragma unroll
        for (int i = 0; i < 4; ++i) v[i] = nv[i];
        if (t + stride < NT) {
            const float4* s4 = (const float4*)(src + (size_t)(t + stride) * DM);
#pragma unroll
            for (int i = 0; i < 4; ++i) nv[i] = s4[lane + 64 * i];
        }
        rms_token(P, t, lane, v, gn, dst, ab_layer, want_q);
    }
}

namespace pg8 {
#define PG8_LAS __attribute__((address_space(3)))
typedef unsigned short bf16_t;
typedef short bf16x8 __attribute__((ext_vector_type(8)));
typedef float f32x4 __attribute__((ext_vector_type(4)));
typedef unsigned u32x4 __attribute__((ext_vector_type(4)));
constexpr int BM = 256, BK = 64, HALF = 128, HTB = HALF * BK * 2  , STAGE_BYTES = 8 * HTB, NXCD = 8, WGM = 8;

__host__ __device__ __forceinline__ int lds_byte(int r, int c) { const int st = (r >> 4) * 2 + (c >> 5), rr = r & 15, cc = c & 31, ob = rr * 64 + cc * 2; return st * 1024 + (ob ^ (((ob >> 9) & 1) << 5)); }
__host__ __device__ __forceinline__ void stage_rc(int b, int& R, int& C) { const int st = b / 1024, sb = b % 1024, swz = sb ^ (((sb >> 9) & 1) << 5); R = (st >> 1) * 16 + swz / 64; C = (st & 1) * 32 + (swz % 64) / 2; }
__host__ __device__ __forceinline__ int perm32(int rho) { const int n = rho >> 4, i = rho & 15; return 8 * (i >> 2) + 4 * n + (i & 3); }

struct Unit { int pm, pn; };
struct Gemm { const bf16_t* A; const bf16_t* Bt; int M, N, K; };

struct StaticOrder {
    int nM, nN, nwg, G, c;
    __host__ __device__ void init(int M, int N, int G_, int c_) { nM = M / BM; nN = N / BM; nwg = nM * nN; G = G_; c = c_; }
    __host__ __device__ bool next(int i, Unit& u) const {
        const long L = (long)i * G + c; if (L >= nwg) return false;
        int wgid = (int)L; { const int q = nwg / NXCD, r = nwg % NXCD, xcd = wgid % NXCD, off = wgid / NXCD; wgid = (xcd < r ? xcd * (q + 1) : r * (q + 1) + (xcd - r) * q) + off; }
        const int nig = WGM * nN, gid = wgid / nig, fm = gid * WGM, gsz = (nM - fm) < WGM ? (nM - fm) : WGM;
        u.pm = fm + ((wgid % nig) % gsz); u.pn = (wgid % nig) / gsz; return true;
    }
    __device__ __forceinline__ void a_ready(const Unit&) const {}
    __device__ __forceinline__ void done(const Unit&) const {}
};
struct CountedOrder : StaticOrder {
    const unsigned* ready; unsigned need; unsigned* tmo;
    __device__ __forceinline__ void a_ready(const Unit& u) const {
        if (threadIdx.x < 64) {
            const unsigned long long t0 = __builtin_amdgcn_s_memrealtime(); unsigned polls = 0;
            while ((unsigned)__builtin_amdgcn_readfirstlane(__hip_atomic_load(ready + 64 * u.pm, __ATOMIC_RELAXED, __HIP_MEMORY_SCOPE_AGENT)) < need) {
                if ((++polls & 255u) == 0u && __builtin_amdgcn_readfirstlane(__hip_atomic_load(tmo, __ATOMIC_RELAXED, __HIP_MEMORY_SCOPE_AGENT)) != 0u) break;
                if (__builtin_amdgcn_s_memrealtime() - t0 > 2000000ull) {
                    if (threadIdx.x == 0) { unsigned expect = 0u; __hip_atomic_compare_exchange_strong(tmo + 1, &expect, 0x600u | (unsigned)(u.pm & 0xff), __ATOMIC_RELAXED, __ATOMIC_RELAXED, __HIP_MEMORY_SCOPE_AGENT); __hip_atomic_store(tmo, 1u, __ATOMIC_RELAXED, __HIP_MEMORY_SCOPE_AGENT); }
                    break; }
                __builtin_amdgcn_s_sleep(2); }
            __builtin_amdgcn_fence(__ATOMIC_ACQUIRE, "agent");
            asm volatile("s_waitcnt vmcnt(0)" ::: "memory");
        }
#if !defined(BROKEN_HOOK_NO_BARRIER)
        asm volatile("" ::: "memory"); __builtin_amdgcn_s_barrier(); asm volatile("" ::: "memory");
#endif
    }
};

__device__ __forceinline__ unsigned cvt_pk_bf16(float lo, float hi) { unsigned r; asm volatile("v_cvt_pk_bf16_f32 %0, %1, %2" : "=v"(r) : "v"(lo), "v"(hi)); return r; }
typedef float f32x2 __attribute__((ext_vector_type(2)));
__device__ __forceinline__ f32x2 gelu_pk(f32x2 v) {
    const f32x2 av = __builtin_elementwise_abs(v), d = av * 0.2316418882f + 1.0f;
    f32x2 t; t.x = __builtin_amdgcn_rcpf(d.x); t.y = __builtin_amdgcn_rcpf(d.y);
    f32x2 q = t * 0.5307027145f + (-0.7265760135f); q = q * t + 0.7107068705f; q = q * t + (-0.142248368f); q = q * t + 0.127414796f; q = q * t;
    const f32x2 s = (v * v) * (-0.72134752044f);
    f32x2 e; e.x = __builtin_amdgcn_exp2f(s.x); e.y = __builtin_amdgcn_exp2f(s.y);
    const f32x2 m = v * (q * e), r = v - m;
    f32x2 o; o.x = v.x < 0.f ? m.x : r.x; o.y = v.y < 0.f ? m.y : r.y; return o;
}

struct EpiF32 {
    static constexpr bool PERM = false, AFTER_DRAIN = false;
    float* C; int ldc; const float* bias;
    __device__ __forceinline__ void operator()(const f32x4 (&acc)[2][2][4][2], const Unit& u, int wr, int wc, int fr, int fq) const {
        const int row0 = u.pm * BM + wr * 64 + fr, col0 = u.pn * BM + wc * 32 + 4 * fq;
        f32x4 bv[2][2];
#pragma unroll
        for (int bj = 0; bj < 2; ++bj)
#pragma unroll
            for (int n = 0; n < 2; ++n) bv[bj][n] = bias ? *(const f32x4*)(bias + col0 + bj * HALF + n * 16) : (f32x4){0.f, 0.f, 0.f, 0.f};
#pragma unroll
        for (int ai = 0; ai < 2; ++ai)
#pragma unroll
            for (int m = 0; m < 4; ++m) { float* rowp = C + (size_t)(row0 + ai * HALF + m * 16) * ldc + col0;
#pragma unroll
                for (int bj = 0; bj < 2; ++bj)
#pragma unroll
                    for (int n = 0; n < 2; ++n) *(f32x4*)(rowp + bj * HALF + n * 16) = acc[ai][bj][m][n] + bv[bj][n]; }
    }
};
template <int ACT  > struct EpiBf16 {
    static constexpr bool PERM = true, AFTER_DRAIN = false;
    bf16_t* O; int ldc; const float* bias; int split_cols; size_t split_stride;
    __device__ __forceinline__ void operator()(const f32x4 (&acc)[2][2][4][2], const Unit& u, int wr, int wc, int fr, int fq) const {
        const int row0 = u.pm * BM + wr * 64 + fr; int colt = u.pn * BM; bf16_t* base = O;
        if (split_cols) { const int t = colt / split_cols; base += (size_t)t * split_stride; colt -= t * split_cols; }
        const int col0 = colt + wc * 32 + 8 * fq, bcol0 = u.pn * BM + wc * 32 + 8 * fq;
        f32x4 bv[2][2];
#pragma unroll
        for (int bj = 0; bj < 2; ++bj)
#pragma unroll
            for (int n = 0; n < 2; ++n) bv[bj][n] = bias ? *(const f32x4*)(bias + bcol0 + bj * HALF + 4 * n) : (f32x4){0.f, 0.f, 0.f, 0.f};
#pragma unroll
        for (int ai = 0; ai < 2; ++ai)
#pragma unroll
            for (int m = 0; m < 4; ++m) { bf16_t* rowp = base + (size_t)(row0 + ai * HALF + m * 16) * ldc + col0;
#pragma unroll
                for (int bj = 0; bj < 2; ++bj) { f32x4 v0 = acc[ai][bj][m][0] + bv[bj][0], v1 = acc[ai][bj][m][1] + bv[bj][1];
                    if (ACT == 1) { f32x2 a = gelu_pk((f32x2){v0[0], v0[1]}), b = gelu_pk((f32x2){v0[2], v0[3]}), c = gelu_pk((f32x2){v1[0], v1[1]}), d = gelu_pk((f32x2){v1[2], v1[3]});
                        v0 = (f32x4){a.x, a.y, b.x, b.y}; v1 = (f32x4){c.x, c.y, d.x, d.y}; }
                    if (ACT == 2) {
#pragma unroll
                        for (int j = 0; j < 4; ++j) { v0[j] = 0.5f * v0[j] * (1.0f + erff(v0[j] * 0.70710678f)); v1[j] = 0.5f * v1[j] * (1.0f + erff(v1[j] * 0.70710678f)); } }
                    u32x4 w; w.x = cvt_pk_bf16(v0[0], v0[1]); w.y = cvt_pk_bf16(v0[2], v0[3]); w.z = cvt_pk_bf16(v1[0], v1[1]); w.w = cvt_pk_bf16(v1[2], v1[3]);
                    *(u32x4*)(rowp + bj * HALF) = w; } }
    }
};


template <class Epi, class Sched, bool STAMP = false>
__device__ __forceinline__ void gemm_phase(PG8_LAS unsigned char* lds, const Gemm g, const Sched& S, const Epi& E, unsigned long long* stamps) {
    const int tid = threadIdx.x, wid = __builtin_amdgcn_readfirstlane(tid >> 6), lane = tid & 63, wr = wid >> 2, wc = wid & 3, fr = lane & 15, fq = lane >> 4;
    const int K = g.K, nt = K / BK;
    int ts_lo = 0, ts_hi = 0, nts = 0; const unsigned long long rt_entry = STAMP ? (unsigned long long)wall_clock64() : 0ull;
#define PG8_STAMP() do { if (STAMP && wid == 0 && nts < 64) { const unsigned long long _c = (unsigned long long)clock64(); \
        ts_lo = (lane == nts) ? (int)(unsigned)_c : ts_lo; ts_hi = (lane == nts) ? (int)(unsigned)(_c >> 32) : ts_hi; ++nts; } } while (0)
    PG8_STAMP();
    unsigned voffA[2], voffB[2];
#pragma unroll
    for (int i = 0; i < 2; ++i) { int R, C; stage_rc(tid * 16 + i * 8192, R, C); const int Rb = Epi::PERM ? ((R & ~31) + perm32(R & 31)) : R;
        voffA[i] = (unsigned)(R * K + C) * 2u; voffB[i] = (unsigned)(Rb * K + C) * 2u; }
    const size_t kstep = (size_t)(BK * 2);
    const size_t hstep = (size_t)HALF * K * 2;
    const size_t tstep = 2 * hstep;
    const unsigned ldsw = (unsigned)wid * 1024u;
    const int aoff = lds_byte(wr * 64 + fr, fq * 8), boff = lds_byte(wc * 32 + fr, fq * 8);
#define PG8_SA(b, h) (((b) * 2 + (h)) * HTB)
#define PG8_SB(b, h) ((4 + (b) * 2 + (h)) * HTB)
#define PG8_STAGE(bufoff, gbase, voff) do { _Pragma("unroll") for (int _i = 0; _i < 2; ++_i) \
        __builtin_amdgcn_global_load_lds((const unsigned*)((const char*)(gbase) + (voff)[_i]), (PG8_LAS unsigned*)(lds + (bufoff) + ldsw + _i * 8192), 16, 0, 0); } while (0)
#define PG8_LDA(dst, b, h) do { _Pragma("unroll") for (int m = 0; m < 4; ++m) _Pragma("unroll") for (int k = 0; k < 2; ++k) dst[m][k] = *(const PG8_LAS bf16x8*)(lds + PG8_SA(b, h) + aoff + m * 2048 + k * 1024); } while (0)
#define PG8_LDB(dst, b, h) do { _Pragma("unroll") for (int n = 0; n < 2; ++n) _Pragma("unroll") for (int k = 0; k < 2; ++k) dst[n][k] = *(const PG8_LAS bf16x8*)(lds + PG8_SB(b, h) + boff + n * 2048 + k * 1024); } while (0)
#define PG8_MMA(ai, bj, At, Bt) do { __builtin_amdgcn_s_setprio(1); _Pragma("unroll") for (int m = 0; m < 4; ++m) _Pragma("unroll") for (int n = 0; n < 2; ++n) _Pragma("unroll") for (int k = 0; k < 2; ++k) \
        acc[ai][bj][m][n] = __builtin_amdgcn_mfma_f32_16x16x32_bf16(Bt[n][k], At[m][k], acc[ai][bj][m][n], 0, 0, 0); __builtin_amdgcn_s_setprio(0); } while (0)
#define PG8_WAIT_V(n) asm volatile("s_waitcnt vmcnt(" #n ")" ::: "memory")
#define PG8_WAIT_L(n) asm volatile("s_waitcnt lgkmcnt(" #n ")" ::: "memory")
#define PG8_BAR __builtin_amdgcn_s_barrier()
#define PG8_SCHED __builtin_amdgcn_sched_barrier(0)
    Unit cur, nxt; int ui = 0;
    if (!S.next(0, cur)) return;
    f32x4 acc[2][2][4][2];
#pragma unroll
    for (int a = 0; a < 2; ++a)
#pragma unroll
        for (int b = 0; b < 2; ++b)
#pragma unroll
            for (int m = 0; m < 4; ++m)
#pragma unroll
                for (int n = 0; n < 2; ++n) acc[a][b][m][n] = (f32x4){0.f, 0.f, 0.f, 0.f};
    bf16x8 At[4][2], B0[2][2], B1[2][2];
    const char* cA = (const char*)g.A + (size_t)cur.pm * tstep; const char* cB = (const char*)g.Bt + (size_t)cur.pn * tstep;
    S.a_ready(cur);
    PG8_STAGE(PG8_SB(0, 0), cB, voffB); PG8_STAGE(PG8_SA(0, 0), cA, voffA); PG8_STAGE(PG8_SB(0, 1), cB + hstep, voffB); PG8_STAGE(PG8_SA(0, 1), cA + hstep, voffA);
    if (wr == 1) PG8_BAR;
    PG8_WAIT_V(4); PG8_BAR;
    PG8_STAGE(PG8_SB(1, 0), cB + kstep, voffB); PG8_STAGE(PG8_SA(1, 0), cA + kstep, voffA); PG8_STAGE(PG8_SB(1, 1), cB + hstep + kstep, voffB);
    PG8_WAIT_V(6); PG8_BAR;
    PG8_STAMP();
    for (;;) {
        const bool has_next = S.next(ui + 1, nxt);
        const char* nA = has_next ? (const char*)g.A + (size_t)nxt.pm * tstep : cA; const char* nB = has_next ? (const char*)g.Bt + (size_t)nxt.pn * tstep : cB;
        for (int t = 0; t < nt; t += 2) {
            const bool last = (t == nt - 2);
            const char* a1 = cA + (size_t)(t + 1) * kstep;
            const char* a2 = last ? nA : cA + (size_t)(t + 2) * kstep; const char* b2 = last ? nB : cB + (size_t)(t + 2) * kstep;
            const char* a3 = a2 + kstep; const char* b3 = b2 + kstep;
            if (last && has_next) S.a_ready(nxt);
            PG8_LDB(B0, 0, 0); PG8_SCHED; PG8_LDA(At, 0, 0); PG8_STAGE(PG8_SA(1, 1), a1 + hstep, voffA);
            PG8_WAIT_L(8); PG8_BAR; PG8_WAIT_L(0); PG8_MMA(0, 0, At, B0); PG8_BAR; PG8_SCHED;
            PG8_LDB(B1, 0, 1); PG8_STAGE(PG8_SB(0, 0), b2, voffB);
            PG8_BAR; PG8_WAIT_L(0); PG8_MMA(0, 1, At, B1); PG8_BAR;
            PG8_LDA(At, 0, 1); PG8_STAGE(PG8_SA(0, 0), a2, voffA);
            PG8_BAR; PG8_WAIT_L(0); PG8_MMA(1, 0, At, B0); PG8_BAR; PG8_SCHED;
            PG8_STAGE(PG8_SB(0, 1), b2 + hstep, voffB);
            PG8_WAIT_V(6); PG8_BAR; PG8_MMA(1, 1, At, B1); PG8_BAR;
            PG8_LDB(B0, 1, 0); PG8_SCHED; PG8_LDA(At, 1, 0); PG8_STAGE(PG8_SA(0, 1), a2 + hstep, voffA);
            PG8_WAIT_L(8); PG8_BAR; PG8_WAIT_L(0); PG8_MMA(0, 0, At, B0); PG8_BAR; PG8_SCHED;
            PG8_LDB(B1, 1, 1); PG8_STAGE(PG8_SB(1, 0), b3, voffB);
            PG8_BAR; PG8_WAIT_L(0); PG8_MMA(0, 1, At, B1); PG8_BAR;
            PG8_LDA(At, 1, 1); PG8_STAGE(PG8_SA(1, 0), a3, voffA);
            PG8_BAR; PG8_WAIT_L(0); PG8_MMA(1, 0, At, B0); PG8_BAR; PG8_SCHED;
            PG8_STAGE(PG8_SB(1, 1), b3 + hstep, voffB);
            PG8_WAIT_V(6); PG8_BAR; PG8_MMA(1, 1, At, B1); PG8_BAR;
        }
        PG8_STAMP();
        if constexpr (!Epi::AFTER_DRAIN) { E(acc, cur, wr, wc, fr, fq); S.done(cur); }
        PG8_STAMP();
        if (!has_next) break;
#pragma unroll
        for (int a = 0; a < 2; ++a)
#pragma unroll
            for (int b = 0; b < 2; ++b)
#pragma unroll
                for (int m = 0; m < 4; ++m)
#pragma unroll
                    for (int n = 0; n < 2; ++n) acc[a][b][m][n] = (f32x4){0.f, 0.f, 0.f, 0.f};
        cur = nxt; cA = nA; cB = nB; ++ui;
    }
    PG8_WAIT_V(0);
    if (wr == 0) PG8_BAR;
    PG8_BAR;
    if constexpr (Epi::AFTER_DRAIN) { E.fused(acc, cur, wr, wc, fr, fq, lds, wid, lane); S.done(cur); }
    PG8_STAMP();
    if (STAMP && wid == 0) { stamps[lane] = lane < nts ? (((unsigned long long)(unsigned)ts_hi << 32) | (unsigned)ts_lo) : 0ull;
        if (lane == 62) stamps[62] = rt_entry; if (lane == 63) stamps[63] = (unsigned long long)wall_clock64(); }
#undef PG8_STAMP
#undef PG8_SA
#undef PG8_SB
#undef PG8_STAGE
#undef PG8_LDA
#undef PG8_LDB
#undef PG8_MMA
#undef PG8_WAIT_V
#undef PG8_WAIT_L
#undef PG8_BAR
#undef PG8_SCHED
}
}

struct EpiInProj8 {
    static constexpr bool PERM = true, AFTER_DRAIN = false;
    char* ws;
    DI void operator()(const pg8::f32x4 (&acc)[2][2][4][2], const pg8::Unit& u, int wr, int wc, int fr, int fq) const {
        const int row0 = u.pm * 256 + wr * 64 + fr; const int pn = u.pn;
        if (pn >= 9) {
            u16* vt = (u16*)(ws + OFF_VT);
#pragma unroll
            for (int ai = 0; ai < 2; ++ai)
#pragma unroll
                for (int m = 0; m < 4; ++m) {
                    const int tok = row0 + ai * 128 + m * 16; const int b = tok >> 13;
                    const int l = ((tok & 8191) & ~15) | (fr < 4 ? fr : fr < 8 ? fr + 4 : fr < 12 ? fr - 4 : fr);
#pragma unroll
                    for (int bj = 0; bj < 2; ++bj)
#pragma unroll
                        for (int n = 0; n < 2; ++n)
#pragma unroll
                            for (int j = 0; j < 4; ++j) {
                                const int c = (pn - 9) * 256 + wc * 32 + 8 * fq + bj * 128 + 4 * n + j; const int head = c >> 7, dv = c & 127;
                                vt[((size_t)((b * 4 + head) * 128 + (l >> 6))) * 8192 + dv * 64 + (l & 63)] = f2bf(acc[ai][bj][m][n][j]);
                            }
                }
            return;
        }
        u16* base; int pitch, c0; float sc = 1.f;
        if (pn < 3) { base = (u16*)(ws + OFF_QKV); pitch = 768; c0 = pn * 256; }
        else if (pn == 3) { base = (u16*)(ws + OFF_Z); pitch = 256; c0 = 0; }
        else if (pn == 4) { base = (u16*)(ws + OFF_US); pitch = 256; c0 = 0; }
        else if (pn < 7) { base = (u16*)(ws + OFF_QC); pitch = 512; c0 = (pn - 5) * 256; sc = 0.125f * LOG2E; }
        else { base = (u16*)(ws + OFF_KC); pitch = 512; c0 = (pn - 7) * 256; }
        const int col0 = c0 + wc * 32 + 8 * fq;
#pragma unroll
        for (int ai = 0; ai < 2; ++ai)
#pragma unroll
            for (int m = 0; m < 4; ++m) {
                u16* rowp = base + (size_t)(row0 + ai * 128 + m * 16) * pitch + col0;
#pragma unroll
                for (int bj = 0; bj < 2; ++bj) {
                    const pg8::f32x4 v0 = acc[ai][bj][m][0] * sc, v1 = acc[ai][bj][m][1] * sc;
                    uint4 w; w.x = pack2(v0[0], v0[1]); w.y = pack2(v0[2], v0[3]); w.z = pack2(v1[0], v1[1]); w.w = pack2(v1[2], v1[3]);
                    *(uint4*)(rowp + bj * 128) = w;
                }
            }
    }
};
struct EpiResidual8 {
    static constexpr bool PERM = false, AFTER_DRAIN = false;
    const float* hin; u16* hout; const u16* hin16;
    DI void operator()(const pg8::f32x4 (&acc)[2][2][4][2], const pg8::Unit& u, int wr, int wc, int fr, int fq) const {
        const int row0 = u.pm * 256 + wr * 64 + fr, col0 = u.pn * 256 + wc * 32 + 4 * fq;
#pragma unroll
        for (int ai = 0; ai < 2; ++ai)
#pragma unroll
            for (int m = 0; m < 4; ++m) {
                const size_t ro = (size_t)(row0 + ai * 128 + m * 16) * DM + col0;
#pragma unroll
                for (int bj = 0; bj < 2; ++bj)
#pragma unroll
                    for (int n = 0; n < 2; ++n) {
                        pg8::f32x4 h;
                        if (hin16) { const uint2 p = *(const uint2*)(hin16 + ro + bj * 128 + n * 16); h[0] = bf2f((u16)(p.x & 0xffff)); h[1] = bf2f((u16)(p.x >> 16)); h[2] = bf2f((u16)(p.y & 0xffff)); h[3] = bf2f((u16)(p.y >> 16)); }
                        else h = *(const pg8::f32x4*)(hin + ro + bj * 128 + n * 16);
                        const pg8::f32x4 v = h + acc[ai][bj][m][n];
                        uint2 pk; pk.x = pack2(v[0], v[1]); pk.y = pack2(v[2], v[3]);
                        *(uint2*)(hout + ro + bj * 128 + n * 16) = pk;
                    }
            }
    }
};
struct EpiGlu8 {
    static constexpr bool PERM = true, AFTER_DRAIN = false;
    u16* mix; const float* bias;
    DI void operator()(const pg8::f32x4 (&acc)[2][2][4][2], const pg8::Unit& u, int wr, int wc, int fr, int fq) const {
        const int row0 = u.pm * 256 + wr * 64 + fr, col0 = u.pn * 128 + wc * 32 + 8 * fq;
#pragma unroll
        for (int n = 0; n < 2; ++n) {
            const pg8::f32x4 bv = *(const pg8::f32x4*)(bias + col0 + 4 * n), bg = *(const pg8::f32x4*)(bias + 256 + col0 + 4 * n);
#pragma unroll
            for (int ai = 0; ai < 2; ++ai)
#pragma unroll
                for (int m = 0; m < 4; ++m) {
                    const pg8::f32x4 val = acc[ai][0][m][n] + bv, gt = acc[ai][1][m][n] + bg;
                    uint2 w; w.x = pack2(val[0] * sigmoidf_(gt[0]), val[1] * sigmoidf_(gt[1])); w.y = pack2(val[2] * sigmoidf_(gt[2]), val[3] * sigmoidf_(gt[3]));
                    *(uint2*)(mix + (size_t)(row0 + ai * 128 + m * 16) * DM + 256 + col0 + 4 * n) = w;
                }
        }
    }
};
template <class Epi>
DI void phase_gemm(const u16* A, int lda, const u16* Bt, int ldb, int M, int N, int K, Epi epi, char* lds) {
    pg8::Gemm g{A, Bt, M, N, K};
    pg8::StaticOrder S; S.init(M, N, (int)gridDim.x, (int)blockIdx.x);
    pg8::gemm_phase<Epi, pg8::StaticOrder, false>((PG8_LAS unsigned char*)lds, g, S, epi, nullptr);
}

template <int CTRL> DI float dppf(float v) { return __int_as_float(__builtin_amdgcn_update_dpp(0, __float_as_int(v), CTRL, 0xF, 0xF, true)); }
DI void gdn_prep_load(const Params& P, int layer, int item, uint4 (&pre)[4], float4& pcw, float2& pgb) {
    const int tid = threadIdx.x;
    const int b = item >> 9, head = (item >> 7) & 3, ch = item & 127;
    const u16* qkv = (const u16*)(P.ws + OFF_QKV);
    pgb = make_float2(0.f, 0.f); pcw = make_float4(0.f, 0.f, 0.f, 0.f);
    if (tid < 64) { const int t = b * SEQ + ch * 64 + tid; pgb.x = ((const float*)(P.ws + OFF_GG))[t * 4 + head]; pgb.y = ((const float*)(P.ws + OFF_BETA))[t * 4 + head]; }
    if (tid < 192) {
        const int j = tid / 48, rem = tid % 48; const int part = rem >> 4, d4 = rem & 15;
        pcw = *(const float4*)(P.in[3] + (size_t)layer * 4 * 768 + j * 768 + part * 256 + head * 64 + d4 * 4);
    }
#pragma unroll
    for (int k = 0; k < 4; ++k) {
        const int i = tid + NTHR * k;
        pre[k] = make_uint4(0, 0, 0, 0);
        if (i < 67 * 24) {
            const int row = i / 24, c8 = i % 24; const int part = c8 >> 3, cc = (c8 & 7) * 8;
            const int l = ch * 64 + row - 3;
            if (l >= 0) pre[k] = *(const uint4*)(qkv + (size_t)(b * SEQ + l) * 768 + part * 256 + head * 64 + cc);
        }
    }
}
#define GDN_LDS_BAR() do { __builtin_amdgcn_sched_barrier(0); asm volatile("s_waitcnt lgkmcnt(0)" ::: "memory"); __builtin_amdgcn_s_barrier(); asm volatile("" ::: "memory"); __builtin_amdgcn_sched_barrier(0); } while (0)
DI void gdn_prep_item(const Params& P, int layer, int item, char* lds, uint4 (&pre)[4], float4& pcw, float2& pgb, int next_item) {
    const int tid = threadIdx.x, lane = tid & 63, w = tid >> 6;
    const int b = item >> 9, head = (item >> 7) & 3, ch = item & 127;
    const int t0 = b * SEQ + ch * 64;
    u16* raw = (u16*)lds;
    float* qs = (float*)(lds + 25856);
    float* ks = qs + 64 * 68;
    float* vs = ks + 64 * 68;
    float* Lp = vs + 64 * 68;
    u16* qb = (u16*)(Lp + 64 * 68);
    u16* kb = qb + 64 * 72;
    float* Gs = (float*)(kb + 64 * 72);
    float* bs = Gs + 64;
    u16* Xs = raw;
    u16* QKs = raw + 8704;
    u16* L21s = raw;
    u16* X1s = raw + 1280;
    float* Ds = (float*)qb;
    float* cws = bs + 64;
    const u16* qkv = (const u16*)(P.ws + OFF_QKV);
    u16* rec = (u16*)(P.ws + OFF_GREC + (size_t)item * GREC_BYTES);
#pragma unroll
    for (int k = 0; k < 4; ++k) {
        const int i = tid + NTHR * k;
        if (i < 67 * 24) { const int row = i / 24, c8 = i % 24; const int part = c8 >> 3, cc = (c8 & 7) * 8; *(uint4*)(raw + row * 192 + part * 64 + cc) = pre[k]; }
    }
    if (tid < 192) *(float4*)(cws + tid * 4) = pcw;
    if (tid < 64) {
        bs[tid] = pgb.y;
        float g = pgb.x;
#pragma unroll
        for (int o = 1; o < 64; o <<= 1) { const float tt = __shfl_up(g, o); if (lane >= o) g += tt; }
        Gs[tid] = g;
    }
    __syncthreads();
    {
#pragma unroll 1
        for (int it = 0; it < 3; ++it) {
            const int id = tid + NTHR * it; const int t = id / 24, c8 = id % 24; const int part = c8 >> 3, d0 = (c8 & 7) * 8;
            float a[8];
#pragma unroll
            for (int k = 0; k < 8; ++k) a[k] = 0.f;
#pragma unroll
            for (int j = 0; j < 4; ++j) {
                const uint4 rv = *(const uint4*)(raw + (t + j) * 192 + part * 64 + d0);
                const float4 w0 = *(const float4*)(cws + (j * 3 + part) * 64 + d0), w1 = *(const float4*)(cws + (j * 3 + part) * 64 + d0 + 4);
                a[0] += w0.x * bf2f((u16)(rv.x & 0xffff)); a[1] += w0.y * bf2f((u16)(rv.x >> 16));
                a[2] += w0.z * bf2f((u16)(rv.y & 0xffff)); a[3] += w0.w * bf2f((u16)(rv.y >> 16));
                a[4] += w1.x * bf2f((u16)(rv.z & 0xffff)); a[5] += w1.y * bf2f((u16)(rv.z >> 16));
                a[6] += w1.z * bf2f((u16)(rv.w & 0xffff)); a[7] += w1.w * bf2f((u16)(rv.w >> 16));
            }
            float ss = 0.f;
#pragma unroll
            for (int k = 0; k < 8; ++k) { a[k] = a[k] * sigmoidf_(a[k]); ss += a[k] * a[k]; }
            ss += dppf<0xB1>(ss); ss += dppf<0x4E>(ss); ss += dppf<0x141>(ss);
            const float sc = part == 2 ? 1.f : rsqrtf(ss + 1e-6f) * (part == 0 ? 0.125f : 1.f);
#pragma unroll
            for (int k = 0; k < 8; ++k) a[k] *= sc;
            float* dst = (part == 0 ? qs : part == 1 ? ks : vs) + t * 68 + d0;
            *(float4*)dst = make_float4(a[0], a[1], a[2], a[3]); *(float4*)(dst + 4) = make_float4(a[4], a[5], a[6], a[7]);
            if (part < 2) {
                uint4 pk; pk.x = pack2(a[0], a[1]); pk.y = pack2(a[2], a[3]); pk.z = pack2(a[4], a[5]); pk.w = pack2(a[6], a[7]);
                *(uint4*)((part == 0 ? qb : kb) + t * 72 + d0) = pk;
            }
        }
    }
    __syncthreads();
    {
        const int r = lane & 31, hh = lane >> 5; const int bi = (w >> 1) & 1, bj = w & 1; const bool isqk = w >= 4;
        const u16* Am = (isqk ? qb : kb) + (bi * 32 + r) * 72 + hh * 8;
        const u16* Bm = kb + (bj * 32 + r) * 72 + hh * 8;
        f32x16 acc;
#pragma unroll
        for (int e = 0; e < 16; ++e) acc[e] = 0.f;
#pragma unroll
        for (int s = 0; s < 4; ++s) acc = MFMA32(ld8(Am + s * 16), ld8(Bm + s * 16), acc);
        const int cidx = bj * 32 + r; const float Gc = Gs[cidx], bc = bs[cidx];
#pragma unroll
        for (int e = 0; e < 16; ++e) {
            const int ridx = bi * 32 + (e & 3) + 8 * (e >> 2) + 4 * hh;
            if (isqk) {
                QKs[ridx * 64 + cidx] = f2bf(cidx <= ridx ? acc[e] * __expf(Gs[ridx] - Gc) : 0.f);
            } else {
                const float lv = (ridx < cidx) ? bc * acc[e] * __expf(Gc - Gs[ridx]) : 0.f;
                Lp[ridx * 68 + (cidx & 3) * 16 + (cidx >> 2)] = lv;
                if (bi == 0 && bj == 1) L21s[r * 40 + ridx] = f2bf(lv);
            }
        }
    }
    __syncthreads();
    if (next_item < 2048) gdn_prep_load(P, layer, next_item, pre, pcw, pgb);
    {
        const int c = tid >> 2, q = tid & 3; const bool isw = c >= 64; const int cc = c & 63;
        float rhs[16];
#pragma unroll
        for (int m = 0; m < 16; ++m) {
            const int i = 4 * m + q; const float bi_ = bs[i];
            rhs[m] = isw ? ks[i * 68 + cc] * bi_ * __expf(Gs[i]) : vs[i * 68 + cc] * bi_;
        }
        const float* Lq = Lp + q * 16;
#define SOLVE_A(j_, CTRL_) do { \
            const float xj = dppf<CTRL_>(rhs[(j_) >> 2]); \
            const float4* l4 = (const float4*)(Lq + (j_) * 68); \
            const float4 la = l4[0], lb = l4[1]; \
            rhs[0] -= la.x * xj; rhs[1] -= la.y * xj; rhs[2] -= la.z * xj; rhs[3] -= la.w * xj; \
            rhs[4] -= lb.x * xj; rhs[5] -= lb.y * xj; rhs[6] -= lb.z * xj; rhs[7] -= lb.w * xj; } while (0)
#define SOLVE_B(j_, CTRL_) do { \
            const float xj = dppf<CTRL_>(rhs[(j_) >> 2]); \
            const float4* l4 = (const float4*)(Lq + (j_) * 68); \
            const float4 lc = l4[2], ld = l4[3]; \
            rhs[8] -= lc.x * xj; rhs[9] -= lc.y * xj; rhs[10] -= lc.z * xj; rhs[11] -= lc.w * xj; \
            rhs[12] -= ld.x * xj; rhs[13] -= ld.y * xj; rhs[14] -= ld.z * xj; rhs[15] -= ld.w * xj; } while (0)
#pragma unroll
        for (int jj = 0; jj < 8; ++jj) {
            SOLVE_A(4 * jj + 0, 0x00); SOLVE_A(4 * jj + 1, 0x55); SOLVE_A(4 * jj + 2, 0xAA); SOLVE_A(4 * jj + 3, 0xFF);
        }
#pragma unroll
        for (int m = 0; m < 8; ++m) X1s[c * 40 + 4 * m + q] = f2bf(rhs[m]);
        GDN_LDS_BAR();
        if (w < 4) {
            const int r = lane & 31, hh = lane >> 5;
            f32x16 acc;
#pragma unroll
            for (int e = 0; e < 16; ++e) acc[e] = 0.f;
#pragma unroll
            for (int s2 = 0; s2 < 2; ++s2) acc = MFMA32(ld8(L21s + r * 40 + 16 * s2 + 8 * hh), ld8(X1s + (w * 32 + r) * 40 + 16 * s2 + 8 * hh), acc);
#pragma unroll
            for (int e = 0; e < 16; ++e) Ds[(w * 32 + r) * 33 + (e & 3) + 8 * (e >> 2) + 4 * hh] = acc[e];
        }
        GDN_LDS_BAR();
#pragma unroll
        for (int m = 0; m < 8; ++m) rhs[8 + m] -= Ds[c * 33 + 4 * m + q];
#pragma unroll
        for (int jj = 8; jj < 16; ++jj) {
            SOLVE_B(4 * jj + 0, 0x00); SOLVE_B(4 * jj + 1, 0x55); SOLVE_B(4 * jj + 2, 0xAA); SOLVE_B(4 * jj + 3, 0xFF);
        }
#undef SOLVE_A
#undef SOLVE_B
        GDN_LDS_BAR();
#pragma unroll
        for (int m = 0; m < 16; ++m) Xs[(4 * m + q) * 136 + c] = f2bf(rhs[m]);
    }
    GDN_LDS_BAR();
    {
#pragma unroll
        for (int it = 0; it < 2; ++it) {
            const int id = tid + NTHR * it; const int i = id >> 4, c8 = (id & 15) * 8;
            *(uint4*)(rec + (c8 >> 6) * 4096 + i * 64 + (c8 & 63)) = *(const uint4*)(Xs + i * 136 + c8);
        }
        *(uint4*)(rec + 2 * 4096 + tid * 8) = *(const uint4*)(QKs + tid * 8);
        {
            const int t = tid >> 3, d0 = (tid & 7) * 8; const float eg = __expf(Gs[t]);
            const float4 x0 = *(const float4*)(qs + t * 68 + d0), x1 = *(const float4*)(qs + t * 68 + d0 + 4);
            uint4 pk; pk.x = pack2(x0.x * eg, x0.y * eg); pk.y = pack2(x0.z * eg, x0.w * eg); pk.z = pack2(x1.x * eg, x1.y * eg); pk.w = pack2(x1.z * eg, x1.w * eg);
            *(uint4*)(rec + 3 * 4096 + t * 64 + d0) = pk;
        }
        {
            const int d = tid & 63, tb = (tid >> 6) * 8; const float Gl = Gs[63];
            float kv[8];
#pragma unroll
            for (int k = 0; k < 8; ++k) kv[k] = ks[(tb + k) * 68 + d] * __expf(Gl - Gs[tb + k]);
            uint4 pk; pk.x = pack2(kv[0], kv[1]); pk.y = pack2(kv[2], kv[3]); pk.z = pack2(kv[4], kv[5]); pk.w = pack2(kv[6], kv[7]);
            *(uint4*)(rec + 4 * 4096 + d * 64 + tb) = pk;
            if (tid == 0) ((float*)(P.ws + OFF_EGL))[item] = __expf(Gl);
        }
    }
    GDN_LDS_BAR();
}

constexpr int RP = 72;
DI void gdn_scan_chain(const Params& P, int chain, char* lds) {
    const int tid = threadIdx.x, lane = tid & 63, w = tid >> 6;
    const int b = chain >> 2, head = chain & 3;
    u16* buf0 = (u16*)lds;
    u16* buf1 = buf0 + 320 * RP;
    const char* recbase = P.ws + OFF_GREC + (size_t)(chain * 128) * GREC_BYTES;
    const float* egl = (const float*)(P.ws + OFF_EGL) + chain * 128;
    float* gout = (float*)(P.ws + OFF_GDNO);
    uint4 rg0, rg1, rg2, rg3, rg4;
#define SCAN_ISSUE(c_) do { const uint4* src_ = (const uint4*)(recbase + (size_t)(c_) * GREC_BYTES) + tid; \
        rg0 = src_[0]; rg1 = src_[NTHR]; rg2 = src_[2 * NTHR]; rg3 = src_[3 * NTHR]; rg4 = src_[4 * NTHR]; } while (0)
#define SCAN_PUT(buf_, i_, v_) do { const int id_ = tid + NTHR * (i_); *(uint4*)((buf_) + (id_ >> 3) * RP + (id_ & 7) * 8) = (v_); } while (0)
#define SCAN_COMMIT(buf_) do { SCAN_PUT(buf_, 0, rg0); SCAN_PUT(buf_, 1, rg1); SCAN_PUT(buf_, 2, rg2); SCAN_PUT(buf_, 3, rg3); SCAN_PUT(buf_, 4, rg4); } while (0)
    f32x4 S[4];
#pragma unroll
    for (int m = 0; m < 4; ++m) S[m] = (f32x4){0.f, 0.f, 0.f, 0.f};
    const int r16 = lane & 15, g = lane >> 4;
    SCAN_ISSUE(0); SCAN_COMMIT(buf0);
    __syncthreads();
    for (int c = 0; c < 128; ++c) {
        u16* cur = (c & 1) ? buf1 : buf0; u16* nxt = (c & 1) ? buf0 : buf1;
        if (c + 1 < 128) SCAN_ISSUE(c + 1);
        if (w < 4) {
            const float dec = egl[c];
            const u16* Ub = cur;
            const u16* Wb = cur + 64 * RP;
            const u16* QKb = cur + 128 * RP;
            const u16* QGb = cur + 192 * RP;
            const u16* KDb = cur + 256 * RP;
            bf16x8 Sb[2];
#pragma unroll
            for (int s = 0; s < 2; ++s) Sb[s] = pack8(S[2 * s][0], S[2 * s][1], S[2 * s][2], S[2 * s][3], S[2 * s + 1][0], S[2 * s + 1][1], S[2 * s + 1][2], S[2 * s + 1][3]);
            f32x4 vn[4], o[4];
#pragma unroll
            for (int mb = 0; mb < 4; ++mb) {
                f32x4 a = (f32x4){0.f, 0.f, 0.f, 0.f}, oo = (f32x4){0.f, 0.f, 0.f, 0.f};
#pragma unroll
                for (int s = 0; s < 2; ++s) {
                    const u16* pw = Wb + (16 * mb + r16) * RP + 32 * s + 4 * g;
                    const u16* pq = QGb + (16 * mb + r16) * RP + 32 * s + 4 * g;
                    a = MFMA16(cat4(*(const bf16x4*)pw, *(const bf16x4*)(pw + 16)), Sb[s], a);
                    oo = MFMA16(cat4(*(const bf16x4*)pq, *(const bf16x4*)(pq + 16)), Sb[s], oo);
                }
#pragma unroll
                for (int e = 0; e < 4; ++e) vn[mb][e] = bf2f(Ub[(16 * mb + 4 * g + e) * RP + 16 * w + r16]) - a[e];
                o[mb] = oo;
            }
            bf16x8 Vb[2];
#pragma unroll
            for (int s = 0; s < 2; ++s) Vb[s] = pack8(vn[2 * s][0], vn[2 * s][1], vn[2 * s][2], vn[2 * s][3], vn[2 * s + 1][0], vn[2 * s + 1][1], vn[2 * s + 1][2], vn[2 * s + 1][3]);
#pragma unroll
            for (int mb = 0; mb < 4; ++mb) {
                f32x4 oo = o[mb];
                f32x4 sn = S[mb] * dec;
#pragma unroll
                for (int s = 0; s < 2; ++s) {
                    const u16* pk = QKb + (16 * mb + r16) * RP + 32 * s + 4 * g;
                    const u16* pd = KDb + (16 * mb + r16) * RP + 32 * s + 4 * g;
                    oo = MFMA16(cat4(*(const bf16x4*)pk, *(const bf16x4*)(pk + 16)), Vb[s], oo);
                    sn = MFMA16(cat4(*(const bf16x4*)pd, *(const bf16x4*)(pd + 16)), Vb[s], sn);
                }
                S[mb] = sn;
#pragma unroll
                for (int e = 0; e < 4; ++e)
                    gout[(size_t)(b * SEQ + c * 64 + 16 * mb + 4 * g + e) * 256 + head * 64 + 16 * w + r16] = oo[e];
            }
        }
        if (c + 1 < 128) SCAN_COMMIT(nxt);
        __syncthreads();
    }
}

DI void phase_gdn_norm(const Params& P, int layer) {
    const int w = threadIdx.x >> 6, lane = threadIdx.x & 63;
    const float* gout = (const float*)(P.ws + OFF_GDNO);
    const u16* z = (const u16*)(P.ws + OFF_Z);
    u16* mix = (u16*)(P.ws + OFF_ABUF);
    const float4 ng = ((const float4*)(P.in[6] + layer * 64))[lane & 15];
    for (int t = blockIdx.x * 8 + w; t < NT; t += gridDim.x * 8) {
        const float4 o = ((const float4*)(gout + (size_t)t * 256))[lane];
        float ss = o.x * o.x + o.y * o.y + o.z * o.z + o.w * o.w;
        ss += __shfl_xor(ss, 1); ss += __shfl_xor(ss, 2); ss += __shfl_xor(ss, 4); ss += __shfl_xor(ss, 8);
        const float rstd = rsqrtf(ss * (1.f / 64.f) + 1e-6f);
        const uint2 zz = *(const uint2*)(z + (size_t)t * 256 + lane * 4);
        const float z0 = bf2f((u16)(zz.x & 0xffff)), z1 = bf2f((u16)(zz.x >> 16)), z2 = bf2f((u16)(zz.y & 0xffff)), z3 = bf2f((u16)(zz.y >> 16));
        uint2 r;
        r.x = pack2(o.x * rstd * ng.x * z0 * sigmoidf_(z0), o.y * rstd * ng.y * z1 * sigmoidf_(z1));
        r.y = pack2(o.z * rstd * ng.z * z2 * sigmoidf_(z2), o.w * rstd * ng.w * z3 * sigmoidf_(z3));
        *(uint2*)(mix + (size_t)t * DM + lane * 4) = r;
    }
}

struct S5Consts { bf16x8 bre[2], bim[2], cf[4]; float2 ab; };
template <bool FINAL>
DI void s5_consts(const Params& P, int layer, int g, int lane, S5Consts& K) {
    const char* sp = P.ws + OFF_S5P + layer * S5P_LAYER;
    const int r = lane & 31, hh = lane >> 5;
#pragma unroll
    for (int nb = 0; nb < 2; ++nb) {
        const float* pr = (const float*)(sp + S5P_BRE) + ((g * 64 + nb * 32 + r) * 16 + 8 * hh); const float* pi = (const float*)(sp + S5P_BIM) + ((g * 64 + nb * 32 + r) * 16 + 8 * hh);
        const float4 x0 = *(const float4*)pr, x1 = *(const float4*)(pr + 4), y0 = *(const float4*)pi, y1 = *(const float4*)(pi + 4);
        K.bre[nb] = pack8(x0.x, x0.y, x0.z, x0.w, x1.x, x1.y, x1.z, x1.w); K.bim[nb] = pack8(y0.x, y0.y, y0.z, y0.w, y1.x, y1.y, y1.z, y1.w);
    }
    K.ab = ((const float2*)(sp + S5P_ABAR))[g * 64 + lane];
    if (FINAL) {
        const u16* cm = (const u16*)(sp + S5P_CM) + (g * 16 + (lane & 15)) * 128 + 8 * (lane >> 4);
#pragma unroll
        for (int s = 0; s < 4; ++s) K.cf[s] = ld8(cm + 32 * s);
    }
}
template <bool FINAL>
DI void s5_item(const Params& P, int layer, int item, char* wlds, int lane, const S5Consts& K) {
    const int b = item >> 11, g = (item >> 7) & 15, ch = item & 127;
    const int t0 = b * SEQ + ch * 64;
    const char* sp = P.ws + OFF_S5P + layer * S5P_LAYER;
    float* ut = (float*)wlds;
    u16* Xs = (u16*)(wlds + 4096);
    if (FINAL) {
        const u16* src = (const u16*)(P.ws + OFF_US) + (size_t)(t0 + lane) * 256 + g * 16;
        const uint4 a = *(const uint4*)src, c = *(const uint4*)(src + 8);
        const unsigned uu[8] = {a.x, a.y, a.z, a.w, c.x, c.y, c.z, c.w};
#pragma unroll
        for (int i = 0; i < 8; ++i) { ut[lane * 16 + 2 * i] = bf2f((u16)(uu[i] & 0xffff)); ut[lane * 16 + 2 * i + 1] = bf2f((u16)(uu[i] >> 16)); }
    }
    const int r = lane & 31, hh = lane >> 5;
    const bf16x8 (&bre)[2] = K.bre; const bf16x8 (&bim)[2] = K.bim; const bf16x8 (&cf)[4] = K.cf;
    const float2 ab = K.ab;
    const float nab_y = -ab.y;
    float2* st = (float2*)(P.ws + OFF_S5ST) + (size_t)item * 64 + lane;
    float xr = 0.f, xi = 0.f;
    if (FINAL) { const float2 c0 = *st; xr = c0.x; xi = c0.y; }
    __builtin_amdgcn_wave_barrier();
    asm volatile("s_waitcnt lgkmcnt(0)" ::: "memory");
#pragma unroll 1
    for (int half = 0; half < 2; ++half) {
        const bf16x8 ua = ld8((const u16*)(P.ws + OFF_US) + (size_t)(t0 + 32 * half + r) * 256 + g * 16 + 8 * hh);
        f32x16 z16;
#pragma unroll
        for (int e = 0; e < 16; ++e) z16[e] = 0.f;
        const f32x16 dre0 = MFMA32(ua, bre[0], z16), dre1 = MFMA32(ua, bre[1], z16), dim0 = MFMA32(ua, bim[0], z16), dim1 = MFMA32(ua, bim[1], z16);
#pragma unroll
        for (int q = 0; q < 4; ++q) {
            float lr[4], li[4], hr[4], hi[4];
#pragma unroll
            for (int i = 0; i < 4; ++i) {
                const int e = 4 * q + i;
                const auto pr = __builtin_amdgcn_permlane32_swap(__float_as_uint(dre0[e]), __float_as_uint(dre1[e]), false, false);
                const auto pi = __builtin_amdgcn_permlane32_swap(__float_as_uint(dim0[e]), __float_as_uint(dim1[e]), false, false);
                lr[i] = __uint_as_float(pr[0]); hr[i] = __uint_as_float(pr[1]); li[i] = __uint_as_float(pi[0]); hi[i] = __uint_as_float(pi[1]);
            }
            __builtin_amdgcn_sched_barrier(0);
#pragma unroll
            for (int s2 = 0; s2 < 2; ++s2)
#pragma unroll
                for (int i = 0; i < 4; ++i) {
                    const int tt = 8 * q + 4 * s2 + i;
                    const float br_ = s2 ? hr[i] : lr[i], bi_ = s2 ? hi[i] : li[i];
                    float t0_, t1_, nr, ni;
                    asm volatile("v_fma_f32 %0, %1, %2, %3" : "=v"(t0_) : "v"(nab_y), "v"(xi), "v"(br_));
                    asm volatile("v_fma_f32 %0, %1, %2, %3" : "=v"(t1_) : "v"(ab.y), "v"(xr), "v"(bi_));
                    asm volatile("v_fma_f32 %0, %1, %2, %3" : "=v"(nr) : "v"(ab.x), "v"(xr), "v"(t0_));
                    asm volatile("v_fma_f32 %0, %1, %2, %3" : "=v"(ni) : "v"(ab.x), "v"(xi), "v"(t1_));
                    xr = nr; xi = ni;
                    if (FINAL) { Xs[tt * 136 + lane] = f2bf(xr); Xs[tt * 136 + 64 + lane] = f2bf(xi); }
                }
        }
        if (FINAL) {
            asm volatile("s_waitcnt lgkmcnt(0)" ::: "memory");
            __builtin_amdgcn_wave_barrier();
            const int r16 = lane & 15, gg = lane >> 4;
            const float dsv = P.in[13][layer * 256 + g * 16 + r16];
#pragma unroll
            for (int mb = 0; mb < 2; ++mb) {
                f32x4 acc = (f32x4){0.f, 0.f, 0.f, 0.f};
#pragma unroll
                for (int s = 0; s < 4; ++s) acc = MFMA16(ld8(Xs + (16 * mb + r16) * 136 + 32 * s + 8 * gg), cf[s], acc);
#pragma unroll
                for (int e = 0; e < 4; ++e) {
                    const int tk = half * 32 + 16 * mb + 4 * gg + e;
                    const float y = acc[e] + dsv * ut[tk * 16 + r16];
                    ((u16*)(P.ws + OFF_YS5))[(size_t)(t0 + tk) * 256 + g * 16 + r16] = f2bf(gelu_tanh(y));
                }
            }
            asm volatile("s_waitcnt lgkmcnt(0)" ::: "memory");
            __builtin_amdgcn_wave_barrier();
        }
    }
    if (!FINAL) *st = make_float2(xr, xi);
    asm volatile("s_waitcnt lgkmcnt(0)" ::: "memory");
    __builtin_amdgcn_wave_barrier();
}
template <bool FINAL>
DI void phase_s5(const Params& P, int layer, char* lds) {
    const int w = threadIdx.x >> 6, lane = threadIdx.x & 63;
    char* wl = lds + w * 12800;
    const int it0 = blockIdx.x * 8 + w;
    if (it0 >= 8192) return;
    S5Consts K; s5_consts<FINAL>(P, layer, (it0 >> 7) & 15, lane, K);
    const bool same_g = ((gridDim.x * 8) & 2047) == 0;
    for (int it = it0; it < 8192; it += gridDim.x * 8) { if (!same_g && it != it0) s5_consts<FINAL>(P, layer, (it >> 7) & 15, lane, K); s5_item<FINAL>(P, layer, it, wl, lane, K); }
}
constexpr int ATT_STAGE_B = 32768;
DI void attn_item(const Params& P, int layer, int b, int head, int qb, char* lds) {
    const int tid = threadIdx.x, lane = tid & 63, w = __builtin_amdgcn_readfirstlane(tid >> 6);
    const int m = w >> 2, wq = w & 3, r = lane & 31, hh = lane >> 5;
    PG8_LAS unsigned char* L = (PG8_LAS unsigned char*)lds;
    const u16* QC = (const u16*)(P.ws + OFF_QC);
    const u16* KC = (const u16*)(P.ws + OFF_KC);
    const u16* VT = (const u16*)(P.ws + OFF_VT);
    const int qw0 = qb * 128 + 32 * wq;
    const int q = qw0 + r;
    bf16x8 qf[4];
    {
        const u16* qp = QC + (size_t)(b * SEQ + q) * 512 + head * 128 + m * 64 + hh * 8;
#pragma unroll
        for (int s = 0; s < 4; ++s) qf[s] = ld8(qp + 16 * s);
    }
    f32x16 o[4];
#pragma unroll
    for (int d = 0; d < 4; ++d)
#pragma unroll
        for (int e = 0; e < 16; ++e) o[d][e] = 0.f;
    float mrun = -INFINITY, lrun = 0.f;
    const int nkv = 2 * (qb + 1);
    unsigned ksrc0, ksrc1, vsrc0, vsrc1;
    {
        int key = 4 * (2 * w) + (lane >> 4);     ksrc0 = (unsigned)(key * 1024 + (((lane & 15) ^ (key & 15)) << 4));
        key = 4 * (2 * w + 1) + (lane >> 4);     ksrc1 = (unsigned)(key * 1024 + (((lane & 15) ^ (key & 15)) << 4));
        int dv = 8 * (2 * w) + (lane >> 3);      vsrc0 = (unsigned)(dv * 128 + (((lane & 7) ^ ((dv >> 1) & 7)) << 4));
        dv = 8 * (2 * w + 1) + (lane >> 3);      vsrc1 = (unsigned)(dv * 128 + (((lane & 7) ^ ((dv >> 1) & 7)) << 4));
    }
    const char* kbase = (const char*)(KC + (size_t)(b * SEQ) * 512 + head * 128);
    const char* vbase = (const char*)(VT + (size_t)((b * 4 + head) * 128) * SEQ);
#define ATT_DMA(t_, st_) do { \
        const char* kb_ = kbase + (size_t)(t_) * 65536; const char* vb_ = vbase + (size_t)(t_) * 16384; \
        PG8_LAS unsigned char* d_ = L + (st_) * ATT_STAGE_B + w * 2048; \
        __builtin_amdgcn_global_load_lds((const unsigned*)(kb_ + ksrc0), (PG8_LAS unsigned*)(d_), 16, 0, 0); \
        __builtin_amdgcn_global_load_lds((const unsigned*)(kb_ + ksrc1), (PG8_LAS unsigned*)(d_ + 1024), 16, 0, 0); \
        __builtin_amdgcn_global_load_lds((const unsigned*)(vb_ + vsrc0), (PG8_LAS unsigned*)(d_ + 16384), 16, 0, 0); \
        __builtin_amdgcn_global_load_lds((const unsigned*)(vb_ + vsrc1), (PG8_LAS unsigned*)(d_ + 16384 + 1024), 16, 0, 0); } while (0)
    int koff[4], voff[4];
#pragma unroll
    for (int s = 0; s < 4; ++s) {
        koff[s] = r * 256 + ((((m * 8 + hh + 2 * s) ^ (r & 15)) & 15) << 4);
        voff[s] = 16384 + r * 128 + ((((2 * s + hh) ^ ((r >> 1) & 7)) & 7) << 4);
    }
#define ATT_LD16(off_) (*(const PG8_LAS bf16x8*)(L + (off_)))
#define ATT_QK(stb_, init_) do { \
        const float in_ = (init_); \
        _Pragma("unroll") for (int e = 0; e < 16; ++e) { s0[e] = in_; s1[e] = in_; } \
        bf16x8 ka[4], kb[4]; \
        _Pragma("unroll") for (int s = 0; s < 4; ++s) { ka[s] = ATT_LD16((stb_) + koff[s]); kb[s] = ATT_LD16((stb_) + koff[s] + 8192); } \
        __builtin_amdgcn_sched_barrier(0); \
        _Pragma("unroll") for (int s = 0; s < 4; ++s) { \
            s0 = MFMA32(ka[s], qf[s], s0); \
            s1 = MFMA32(kb[s], qf[s], s1); } } while (0)
#define ATT_MASK(j_) do { \
        if (64 * (j_) + 63 > qw0) { \
            _Pragma("unroll") for (int e = 0; e < 16; ++e) { \
                const int key = 64 * (j_) + (e & 3) + 8 * (e >> 2) + 4 * hh; \
                if (key > q) s0[e] = -INFINITY; \
                if (key + 32 > q) s1[e] = -INFINITY; } } } while (0)
#define ATT_FADD(acc_, x_) asm volatile("v_add_f32 %0, %0, %1" : "+v"(acc_) : "v"(x_))
#define ATT_PACK() do { \
        pf[0] = pack8(s0[0], s0[1], s0[2], s0[3], s0[4], s0[5], s0[6], s0[7]); \
        pf[1] = pack8(s0[8], s0[9], s0[10], s0[11], s0[12], s0[13], s0[14], s0[15]); \
        pf[2] = pack8(s1[0], s1[1], s1[2], s1[3], s1[4], s1[5], s1[6], s1[7]); \
        pf[3] = pack8(s1[8], s1[9], s1[10], s1[11], s1[12], s1[13], s1[14], s1[15]); } while (0)
#define ATT_SM_HEAVY(j_) do { \
        ATT_MASK(j_); \
        float mx = s0[0]; \
        _Pragma("unroll") for (int e = 1; e < 16; ++e) mx = fmaxf(mx, s0[e]); \
        _Pragma("unroll") for (int e = 0; e < 16; ++e) mx = fmaxf(mx, s1[e]); \
        mx = fmaxf(mx, __shfl_xor(mx, 32)); \
        float mnew = mrun; \
        if (__builtin_amdgcn_ballot_w64(mx > mrun + 8.f) != 0ull) { \
            mnew = fmaxf(mrun, mx); \
            const float alpha = __builtin_amdgcn_exp2f(mrun - mnew); \
            mrun = mnew; lrun *= alpha; \
            _Pragma("unroll") for (int d = 0; d < 4; ++d) o[d] = o[d] * alpha; } \
        float psum = 0.f; \
        _Pragma("unroll") for (int e = 0; e < 16; ++e) { s0[e] = __builtin_amdgcn_exp2f(s0[e] - mnew); psum += s0[e]; } \
        _Pragma("unroll") for (int e = 0; e < 16; ++e) { s1[e] = __builtin_amdgcn_exp2f(s1[e] - mnew); psum += s1[e]; } \
        lrun += psum; \
        ATT_PACK(); } while (0)
#define ATT_SM_LIGHT(j_) do { \
        ATT_MASK(j_); \
        _Pragma("unroll") for (int e = 0; e < 16; ++e) { s0[e] = __builtin_amdgcn_exp2f(s0[e]); s1[e] = __builtin_amdgcn_exp2f(s1[e]); } \
        __builtin_amdgcn_sched_barrier(0); asm volatile("s_nop 0");        \
        { float p0_ = 0.f, p1_ = 0.f, p2_ = 0.f, p3_ = 0.f; \
          _Pragma("unroll") for (int e = 0; e < 16; e += 2) { ATT_FADD(p0_, s0[e]); ATT_FADD(p1_, s1[e]); ATT_FADD(p2_, s0[e + 1]); ATT_FADD(p3_, s1[e + 1]); } \
          lrun += (p0_ + p1_) + (p2_ + p3_); } \
        ATT_PACK(); } while (0)
#define ATT_LDV(dst_, stb_, d_) do { _Pragma("unroll") for (int kk = 0; kk < 4; ++kk) dst_[kk] = ATT_LD16((stb_) + voff[kk] + (d_) * 4096); } while (0)
#define ATT_MM4(d_, src_) do { __builtin_amdgcn_s_setprio(1); _Pragma("unroll") for (int kk = 0; kk < 4; ++kk) o[d_] = MFMA32(src_[kk], pf[kk], o[d_]); __builtin_amdgcn_s_setprio(0); } while (0)
#define ATT_PV(stb_) do { \
        bf16x8 va[4], vb[4]; \
        ATT_LDV(va, stb_, 0); __builtin_amdgcn_sched_barrier(0); \
        ATT_LDV(vb, stb_, 1); __builtin_amdgcn_sched_barrier(0); ATT_MM4(0, va); __builtin_amdgcn_sched_barrier(0); \
        ATT_LDV(va, stb_, 2); __builtin_amdgcn_sched_barrier(0); ATT_MM4(1, vb); __builtin_amdgcn_sched_barrier(0); \
        ATT_LDV(vb, stb_, 3); __builtin_amdgcn_sched_barrier(0); ATT_MM4(2, va); __builtin_amdgcn_sched_barrier(0); \
        ATT_MM4(3, vb); } while (0)
#define ATT_BAR(n_) do { asm volatile("s_waitcnt vmcnt(" #n_ ")" ::: "memory"); __builtin_amdgcn_s_barrier(); asm volatile("" ::: "memory"); __builtin_amdgcn_sched_barrier(0); } while (0)
    bf16x8 pf[4];
    bool pend = false;
    bool first_ = true;
    ATT_DMA(0, 0); ATT_DMA(1, 1);
    asm volatile("" :: "v"(qf[0]), "v"(qf[1]), "v"(qf[2]), "v"(qf[3]));
    ATT_BAR(4);
#pragma unroll 1
    for (int j = 0; j < nkv; ++j) {
        const int cur = (j & 3) * ATT_STAGE_B, prv = ((j + 3) & 3) * ATT_STAGE_B;
        const bool more = j + 2 < nkv;
        if (more) ATT_DMA(j + 2, (j + 2) & 3);
        const bool act = 64 * j <= qw0 + 31;
        const bool heavy = ((j & 63) == 0) || first_;
        f32x16 s0, s1;
        if (act) { if (heavy) { ATT_QK(cur, 0.f); } else { ATT_QK(cur, -mrun); } }
        if (pend) { ATT_PV(prv); pend = false; }
        if (act) { if (heavy) { ATT_SM_HEAVY(j); } else { ATT_SM_LIGHT(j); } first_ = false; pend = true; }
        if (more) { ATT_BAR(4); } else { ATT_BAR(0); }
    }
    if (pend) { ATT_PV(((nkv - 1) & 3) * ATT_STAGE_B); }
    __syncthreads();
    const float ltot = lrun + __shfl_xor(lrun, 32);
    const float inv = 1.f / ltot;
    float* ex = (float*)lds;
    if (m == 1) {
#pragma unroll
        for (int d = 0; d < 4; ++d)
#pragma unroll
            for (int e = 0; e < 16; ++e) ex[(wq * 64 + d * 16 + e) * 64 + lane] = o[d][e] * inv;
    }
    __syncthreads();
    if (m == 0) {
        const float lam = ((const float*)(P.ws + OFF_SCAL))[layer];
        const float lam_init = 0.8f - 0.6f * __expf(-0.3f * (float)layer);
        float ss = 0.f;
#pragma unroll
        for (int d = 0; d < 4; ++d)
#pragma unroll
            for (int e = 0; e < 16; ++e) { const float v = o[d][e] * inv - lam * ex[(wq * 64 + d * 16 + e) * 64 + lane]; o[d][e] = v; ss += v * v; }
        ss += __shfl_xor(ss, 32);
        const float scl = rsqrtf(ss * (1.f / 128.f) + 1e-6f) * (1.f - lam_init);
        const float* ng = P.in[21] + layer * 128;
        u16* mix = (u16*)(P.ws + OFF_ABUF) + (size_t)(b * SEQ + q) * DM + 512 + head * 128;
#pragma unroll
        for (int d = 0; d < 4; ++d)
#pragma unroll
            for (int qd = 0; qd < 4; ++qd) {
                const int dv0 = 32 * d + 8 * qd + 4 * hh;
                const float4 g4 = *(const float4*)(ng + dv0);
                uint2 pk; pk.x = pack2(o[d][4 * qd] * scl * g4.x, o[d][4 * qd + 1] * scl * g4.y); pk.y = pack2(o[d][4 * qd + 2] * scl * g4.z, o[d][4 * qd + 3] * scl * g4.w);
                *(uint2*)(mix + dv0) = pk;
            }
    }
    __syncthreads();
#undef ATT_DMA
#undef ATT_LD16
#undef ATT_BAR
#undef ATT_QK
#undef ATT_MASK
#undef ATT_PACK
#undef ATT_FADD
#undef ATT_SM_HEAVY
#undef ATT_SM_LIGHT
#undef ATT_PV
#undef ATT_LDV
#undef ATT_MM4
}
DI void phase_attn(const Params& P, int layer, char* lds, int cidx = 0) {
    unsigned* ctr = (unsigned*)(P.ws + OFF_CTL + 16384 + (layer + 2 * cidx) * 256);
    volatile int* slot = (volatile int*)(lds + LDS_BYTES - 32);
    for (;;) {
        if (threadIdx.x == 0) *slot = (int)atomicAdd(ctr, 1u);
        __syncthreads();
        const int idx = *slot;
        __syncthreads();
        if (idx >= 1024) break;
        const int qb = 63 - (idx >> 4), bh = idx & 15;
        attn_item(P, layer, bh >> 2, bh & 3, qb, lds);
    }
}

DI void sort16_desc(float (&a)[16]) {
#define CE(i, j) do { const float hi_ = fmaxf(a[i], a[j]), lo_ = fminf(a[i], a[j]); a[i] = hi_; a[j] = lo_; } while (0)
    CE(0,1); CE(2,3); CE(0,2); CE(1,3); CE(1,2); CE(4,5); CE(6,7); CE(4,6); CE(5,7); CE(5,6); CE(0,4); CE(2,6); CE(2,4); CE(1,5); CE(3,7); CE(3,5); CE(1,2); CE(3,4); CE(5,6); CE(8,9); CE(10,11); CE(8,10); CE(9,11); CE(9,10); CE(12,13); CE(14,15); CE(12,14); CE(13,15); CE(13,14); CE(8,12); CE(10,14); CE(10,12); CE(9,13); CE(11,15); CE(11,13); CE(9,10); CE(11,12); CE(13,14); CE(0,8); CE(4,12); CE(4,8); CE(2,10); CE(6,14); CE(6,10); CE(2,4); CE(6,8); CE(10,12); CE(1,9); CE(5,13); CE(5,9); CE(3,11); CE(7,15); CE(7,11); CE(3,5); CE(7,9); CE(11,13); CE(1,2); CE(3,4); CE(5,6); CE(7,8); CE(9,10); CE(11,12); CE(13,14);
#undef CE
}
DI void merge_top16(float (&a)[16], const float (&b)[16]) {
#pragma unroll
    for (int i = 0; i < 16; ++i) a[i] = fmaxf(a[i], b[15 - i]);
#pragma unroll
    for (int j = 8; j > 0; j >>= 1)
#pragma unroll
        for (int i = 0; i < 16; ++i) {
            const int l = i ^ j;
            if (l > i) { const float hi = fmaxf(a[i], a[l]), lo = fminf(a[i], a[l]); a[i] = hi; a[l] = lo; }
        }
}
DI void phase_topk(const Params& P, int layer, char* lds) {
    const int w = threadIdx.x >> 6, lane = threadIdx.x & 63, r = lane & 31, hh = lane >> 5;
    const u16* PQ = (const u16*)(P.ws + OFF_PQ);
    const u16* KEYS = (const u16*)(P.ws + OFF_KEYS) + (size_t)layer * 8 * 2 * 128 * 64;
    unsigned* pk32 = (unsigned*)(P.ws + OFF_PICKE);
    unsigned* Hs = (unsigned*)lds;
    unsigned char* mytab = (unsigned char*)(lds + 4096 + threadIdx.x * 32);
    for (int it0 = blockIdx.x * 8; it0 < 8192; it0 += gridDim.x * 8) {
        const int it = it0 + w;
        const int tile = it >> 3, h = it & 7; const int tok = tile * 32 + r;
        float sv[2][16];
#pragma unroll
        for (int p = 0; p < 2; ++p) {
            bf16x8 bq[4];
            const u16* qp = PQ + (size_t)tok * 1024 + h * 128 + p * 64 + hh * 8;
#pragma unroll
            for (int s = 0; s < 4; ++s) bq[s] = ld8(qp + 16 * s);
            float blk[4][16];
#pragma unroll
            for (int kb = 0; kb < 4; ++kb) {
                f32x16 acc;
#pragma unroll
                for (int e = 0; e < 16; ++e) acc[e] = 0.f;
                const u16* kp = KEYS + ((size_t)((h * 2 + p) * 128 + 32 * kb + r)) * 64 + hh * 8;
#pragma unroll
                for (int s = 0; s < 4; ++s) acc = MFMA32(ld8(kp + 16 * s), bq[s], acc);
#pragma unroll
                for (int e = 0; e < 16; ++e) {
                    const unsigned key = 32 * kb + (e & 3) + 8 * (e >> 2) + 4 * hh;
                    blk[kb][e] = __uint_as_float((__float_as_uint(acc[e]) & ~0x7Fu) | key);
                }
                sort16_desc(blk[kb]);
            }
            merge_top16(blk[0], blk[1]); merge_top16(blk[2], blk[3]); merge_top16(blk[0], blk[2]);
            float oth[16];
#pragma unroll
            for (int k = 0; k < 16; ++k) oth[k] = __shfl_xor(blk[0][k], 32);
            merge_top16(blk[0], oth);
#pragma unroll
            for (int k = 0; k < 16; ++k) sv[p][k] = blk[0][k];
        }
        {
            uint4 t0, t1; unsigned* a0 = (unsigned*)&t0; unsigned* a1 = (unsigned*)&t1;
#pragma unroll
            for (int q = 0; q < 4; ++q) {
                a0[q] = (__float_as_uint(sv[0][4 * q]) & 0x7Fu) | ((__float_as_uint(sv[0][4 * q + 1]) & 0x7Fu) << 8) | ((__float_as_uint(sv[0][4 * q + 2]) & 0x7Fu) << 16) | ((__float_as_uint(sv[0][4 * q + 3]) & 0x7Fu) << 24);
                a1[q] = (__float_as_uint(sv[1][4 * q]) & 0x7Fu) | ((__float_as_uint(sv[1][4 * q + 1]) & 0x7Fu) << 8) | ((__float_as_uint(sv[1][4 * q + 2]) & 0x7Fu) << 16) | ((__float_as_uint(sv[1][4 * q + 3]) & 0x7Fu) << 24);
            }
            *(uint4*)mytab = t0; *(uint4*)(mytab + 16) = t1;
        }
        float top[16], b1[16], b2[16], b3[16];
#pragma unroll
        for (int k = 0; k < 16; ++k) { b1[k] = -INFINITY; b2[k] = -INFINITY; b3[k] = -INFINITY; }
        {
            int cnt = 0;
#pragma unroll
            for (int i = 0; i < 16; ++i)
#pragma unroll
                for (int j = 0; j < 16; ++j)
                    if ((i + 1) * (j + 1) <= 16) {
                        const float sm = __uint_as_float(__float_as_uint(sv[0][i]) & ~0x7Fu) + __uint_as_float(__float_as_uint(sv[1][j]) & ~0x7Fu);
                        const float pk = __uint_as_float((__float_as_uint(sm) & ~0xFFu) | (unsigned)(i * 16 + j));
                        if (i == 0) top[j] = pk;
                        else { if (cnt < 16) b1[cnt] = pk; else if (cnt < 32) b2[cnt - 16] = pk; else b3[cnt - 32] = pk; ++cnt; }
                    }
        }
        sort16_desc(b1); sort16_desc(b2);
        { const float hi = fmaxf(b3[0], b3[1]), lo = fminf(b3[0], b3[1]); b3[0] = hi; b3[1] = lo; }
        merge_top16(top, b1); merge_top16(b2, b3); merge_top16(top, b2);
        float ev[16]; float den = 0.f;
        const float mx = __uint_as_float(__float_as_uint(top[0]) & ~0xFFu);
#pragma unroll
        for (int k = 0; k < 16; ++k) { ev[k] = __expf(__uint_as_float(__float_as_uint(top[k]) & ~0xFFu) - mx); den += ev[k]; }
        const float rden = 1.f / den;
        unsigned ex[16]; unsigned c_lo = 0, c_hi = 0;
#pragma unroll
        for (int k = 0; k < 16; ++k) {
            const unsigned code = __float_as_uint(top[k]) & 0xFFu;
            ex[k] = (unsigned)mytab[code >> 4] * 128u + (unsigned)mytab[16 + (code & 15u)];
        }
        unsigned rk[16];
#pragma unroll
        for (int k = 0; k < 16; ++k) {
            const unsigned pt = ex[k] >> 11; const unsigned sh = 8u * (pt & 3u); const bool islo = pt < 4u;
            rk[k] = ((islo ? c_lo : c_hi) >> sh) & 0xFFu;
            c_lo += islo ? (1u << sh) : 0u; c_hi += islo ? 0u : (1u << sh);
        }
        if (hh == 0) { Hs[(r * 8 + h) * 2] = c_lo; Hs[(r * 8 + h) * 2 + 1] = c_hi; }
        __syncthreads();
        unsigned tot_lo = 0, tot_hi = 0, bef_lo = 0, bef_hi = 0;
#pragma unroll
        for (int hq = 0; hq < 8; ++hq) {
            const unsigned a = Hs[(r * 8 + hq) * 2], b = Hs[(r * 8 + hq) * 2 + 1];
            tot_lo += a; tot_hi += b;
            if (hq < h) { bef_lo += a; bef_hi += b; }
        }
        unsigned offp[9]; offp[0] = 0;
#pragma unroll
        for (int pt = 0; pt < 8; ++pt) offp[pt + 1] = offp[pt] + (((pt < 4 ? tot_lo : tot_hi) >> (8 * (pt & 3))) & 0xFFu);
        if (h == 0 && hh == 0) {
            uint4 ob; ob.x = offp[0] | (offp[1] << 8) | (offp[2] << 16) | (offp[3] << 24); ob.y = offp[4] | (offp[5] << 8) | (offp[6] << 16) | (offp[7] << 24); ob.z = offp[8]; ob.w = 0;
            ((uint4*)(P.ws + OFF_OFFS))[tok] = ob;
        }
        const unsigned base_lo = (offp[0] | (offp[1] << 8) | (offp[2] << 16) | (offp[3] << 24)) + bef_lo;
        const unsigned base_hi = (offp[4] | (offp[5] << 8) | (offp[6] << 16) | (offp[7] << 24)) + bef_hi;
#pragma unroll
        for (int k = 0; k < 16; ++k) {
            if ((k >> 3) == hh) {
                const unsigned pt = ex[k] >> 11; const unsigned sh = 8u * (pt & 3u);
                const unsigned pos = (((pt < 4u ? base_lo : base_hi) >> sh) & 0xFFu) + rk[k];
                pk32[(size_t)tok * 128 + pos] = ((unsigned)f2bf(ev[k] * rden) << 16) | ex[k];
            }
        }
        __syncthreads();
    }
}

DI void fp8x16_to_f32(const uint4& u, float (&f)[16]) {
    const unsigned uu[4] = {u.x, u.y, u.z, u.w};
#pragma unroll
    for (int q = 0; q < 4; ++q) {
        const f32x2 lo = __builtin_amdgcn_cvt_pk_f32_fp8((int)uu[q], false), hi = __builtin_amdgcn_cvt_pk_f32_fp8((int)uu[q], true);
        f[4 * q] = lo[0]; f[4 * q + 1] = lo[1]; f[4 * q + 2] = hi[0]; f[4 * q + 3] = hi[1];
    }
}
template <int CTRL> DI int dpp_i(int v) { return __builtin_amdgcn_update_dpp(0, v, CTRL, 0xF, 0xF, true); }
template <int CTRL> DI float dpp_f(float v) { return __int_as_float(__builtin_amdgcn_update_dpp(0, __float_as_int(v), CTRL, 0xF, 0xF, true)); }
DI float wave_sum_fast(float v) { return wave_sum_u(v); }
DI int rowreduce4(int p0, int p1, int p2, int p3, bool odd, bool bit1) {
    const int a01 = odd ? p1 : p0, b01 = odd ? p0 : p1;
    const int r01 = a01 + dpp_i<0xB1>(b01);
    const int a23 = odd ? p3 : p2, b23 = odd ? p2 : p3;
    const int r23 = a23 + dpp_i<0xB1>(b23);
    const int a = bit1 ? r23 : r01, b = bit1 ? r01 : r23;
    int r = a + dpp_i<0x4E>(b);
    r += dpp_i<0x124>(r);
    r += dpp_i<0x128>(r);
    return r;
}
DI int dot16_i8(const uint4& u, const int (&xq)[4]) {
    int p = __builtin_amdgcn_sdot4((int)u.x, xq[0], 0, false);
    p = __builtin_amdgcn_sdot4((int)u.y, xq[1], p, false);
    p = __builtin_amdgcn_sdot4((int)u.z, xq[2], p, false);
    p = __builtin_amdgcn_sdot4((int)u.w, xq[3], p, false);
    return p;
}
#define PEER_LOAD8(buf_, tab_, ev_, base_) do { _Pragma("unroll") for (int i_ = 0; i_ < 8; ++i_) { \
        const int e_ = __builtin_amdgcn_readlane((ev_), (base_) + i_); buf_[i_] = *(const uint4*)((tab_) + (size_t)e_ * 1024 + lane * 16); } } while (0)

#define RL(v_, i_) __builtin_amdgcn_readlane((int)(v_), (i_))
#define PEER_OFFS(p_, j_, BASE_, N_) do { \
        const unsigned ox_ = (unsigned)RL(myoff.x, j_), oy_ = (unsigned)RL(myoff.y, j_), oz_ = (unsigned)RL(myoff.z, j_); \
        const int p0_ = (p_), p1_ = (p_) + 1; \
        const unsigned lo_ = p0_ < 4 ? (ox_ >> (8 * p0_)) & 255u : (oy_ >> (8 * (p0_ - 4))) & 255u; \
        const unsigned hi_ = p1_ < 4 ? (ox_ >> (8 * p1_)) & 255u : p1_ < 8 ? (oy_ >> (8 * (p1_ - 4))) & 255u : (oz_ & 255u); \
        BASE_ = (int)lo_; N_ = (int)(hi_ - lo_); } while (0)
typedef __attribute__((ext_vector_type(4))) unsigned u32x4_t;
typedef __attribute__((ext_vector_type(2))) unsigned u32x2_t;
#define PEER_ROWS8B(buf_, rs_, ev_, b_) do { _Pragma("unroll") for (int k_ = 0; k_ < 8; ++k_) { \
        int li_ = 8 * (b_) + k_; li_ = li_ > 63 ? 63 : li_; const int eo_ = RL(ev_, li_); \
        buf_[k_] = __builtin_bit_cast(uint4, __builtin_amdgcn_raw_buffer_load_b128(rs_, lane * 16, eo_, 0)); } } while (0)
#define PEER_ROWS8(buf_, tab_, ev_, b_) do { _Pragma("unroll") for (int k_ = 0; k_ < 8; ++k_) { \
        int li_ = 8 * (b_) + k_; li_ = li_ > 63 ? 63 : li_; const int e_ = RL(ev_, li_); buf_[k_] = *(const uint4*)((tab_) + (size_t)e_ * 1024 + lane * 16); } } while (0)

struct PeerMeta { int e; float g, su, sx, sv; int slot; int idx; int valid; };
DI void phase_peer_u(const Params& P, int layer, char* lds) {
    const int w = threadIdx.x >> 6, lane = threadIdx.x & 63;
    const uint8_t* UT = (const uint8_t*)(P.ws + OFF_UTAB) + (size_t)layer * 16384 * 1024;
    const __amdgpu_buffer_rsrc_t urs = __builtin_amdgcn_make_buffer_rsrc((void*)UT, 0, 16384 * 1024, 0x00020000);
    const unsigned* pk32 = (const unsigned*)(P.ws + OFF_PICKE);
    const float2* sc2 = (const float2*)(P.ws + OFF_V8SC) + layer * 16384;
    float* coefb = (float*)(P.ws + OFF_COEF);
    const uint4* XQ4 = (const uint4*)(P.ws + OFF_XQ); const float* SXp = (const float*)(P.ws + OFF_SX);
    const int stride = gridDim.x * 8, t_first = blockIdx.x * 8 + w;
    const int ntok = t_first < NT ? (NT - t_first + stride - 1) / stride : 0;
    uint4* xql = (uint4*)(lds + w * 16384);
#pragma unroll 1
    for (int jg = 0; jg < ntok; jg += 16) {
        const int ng = (ntok - jg) < 16 ? (ntok - jg) : 16;
        for (int j = 0; j < ng; ++j) xql[j * 64 + lane] = XQ4[(size_t)(t_first + (jg + j) * stride) * 64 + lane];
        uint4 myoff = make_uint4(0, 0, 0, 0); float sxv = 0.f;
        if (lane < ng) { const int t = t_first + (jg + lane) * stride; myoff = ((const uint4*)(P.ws + OFF_OFFS))[t]; sxv = SXp[t]; }
#pragma unroll 1
        for (int p = 0; p < 8; ++p) {
            int nj, basej;
            {
                const unsigned lo = p < 4 ? (myoff.x >> (8 * p)) & 255u : (myoff.y >> (8 * (p - 4))) & 255u;
                const int p1 = p + 1;
                const unsigned hi = p1 < 4 ? (myoff.x >> (8 * p1)) & 255u : p1 < 8 ? (myoff.y >> (8 * (p1 - 4))) & 255u : (myoff.z & 255u);
                basej = (int)lo; nj = lane < ng ? (int)(hi - lo) : 0;
            }
            int pend = nj;
#pragma unroll
            for (int o = 1; o < 16; o <<= 1) { const int tt = __shfl_up(pend, o); if (lane >= o) pend += tt; }
            const int pref = pend - nj;
            const int L = RL(pend, 15);
            if (L == 0) continue;
            const int nsb = (L + 63) >> 6;
#define U_META(sb_, M_) do { \
                const int f_ = 64 * (sb_) + 4 * (lane & 15) + (lane >> 4);        \
                M_.valid = f_ < L; const int fc_ = M_.valid ? f_ : L - 1; \
                int j_ = 0; \
                _Pragma("unroll") for (int jj_ = 0; jj_ < 15; ++jj_) j_ += (jj_ < ng - 1 && fc_ >= RL(pend, jj_)) ? 1 : 0; \
                const int pj_ = __shfl(pref, j_), bj_ = __shfl(basej, j_); \
                M_.slot = j_; M_.idx = (t_first + (jg + j_) * stride) * 128 + bj_ + (fc_ - pj_); \
                const unsigned pw_ = pk32[M_.idx]; const int ee_ = (int)(pw_ & 0xFFFFu); M_.e = (int)(((unsigned)ee_ << 10) | ((unsigned)j_ << 28)); M_.g = __uint_as_float(pw_ & 0xFFFF0000u); { const float2 s2_ = sc2[ee_]; M_.su = s2_.x; M_.sv = s2_.y; } M_.sx = __shfl(sxv, j_); } while (0)
#define U_LOADB(buf_, M_, b_) do { _Pragma("unroll") for (int h_ = 0; h_ < 2; ++h_) { \
                const int pk_ = __builtin_amdgcn_ds_bpermute(((lane & 48) + 2 * (b_) + h_) << 2, M_.e); \
                const int vo_ = (pk_ & 0x0FFFFFFF) + (lane & 15) * 16; \
                _Pragma("unroll") for (int c_ = 0; c_ < 4; ++c_) buf_[4 * h_ + c_] = __builtin_bit_cast(uint4, __builtin_amdgcn_raw_buffer_load_b128(urs, vo_ + 256 * c_, 0, 0)); } } while (0)
            PeerMeta cur, nxt;
            U_META(0, cur);
            uint4 bufA[8], bufB[8], bufC[8], bufD[8];
            U_LOADB(bufA, cur, 0); U_LOADB(bufB, cur, 1); U_LOADB(bufC, cur, 2);
            int xslot = -1; uint4 xc0 = make_uint4(0, 0, 0, 0), xc1 = xc0, xc2 = xc0, xc3 = xc0;
#pragma unroll 1
            for (int sb = 0; sb < nsb; ++sb) {
                const bool has_next = sb + 1 < nsb;
                if (has_next) U_META(sb + 1, nxt); else nxt = cur;
                int md = 0;
#define U_DOT4(acc_, r_, x_) do { acc_ = __builtin_amdgcn_sdot4((int)(r_).x, (int)(x_).x, acc_, false); acc_ = __builtin_amdgcn_sdot4((int)(r_).y, (int)(x_).y, acc_, false); \
                    acc_ = __builtin_amdgcn_sdot4((int)(r_).z, (int)(x_).z, acc_, false); acc_ = __builtin_amdgcn_sdot4((int)(r_).w, (int)(x_).w, acc_, false); } while (0)
#define U_STEP(k_, cur_, pf_) do { \
                    if ((k_) + 3 < 8) { U_LOADB(pf_, cur, (k_) + 3); } else if (has_next) { U_LOADB(pf_, nxt, (k_) + 3 - 8); } \
                    asm volatile("" ::: "memory"); __builtin_amdgcn_sched_barrier(0); \
                    _Pragma("unroll") for (int h_ = 0; h_ < 2; ++h_) { \
                        const int q_ = 2 * (k_) + h_; \
                        const int pk_ = __builtin_amdgcn_ds_bpermute(((lane & 48) + q_) << 2, cur.e); \
                        const int sl_ = (int)((unsigned)pk_ >> 28); \
                        if (__builtin_amdgcn_ballot_w64(sl_ != xslot) != 0ull) {        \
                            const uint4* xp_ = xql + sl_ * 64 + (lane & 15); \
                            xc0 = xp_[0]; xc1 = xp_[16]; xc2 = xp_[32]; xc3 = xp_[48]; xslot = sl_; } \
                        int a0_ = 0, a1_ = 0; \
                        U_DOT4(a0_, cur_[4 * h_ + 0], xc0); U_DOT4(a1_, cur_[4 * h_ + 1], xc1); U_DOT4(a0_, cur_[4 * h_ + 2], xc2); U_DOT4(a1_, cur_[4 * h_ + 3], xc3); \
                        int r_ = a0_ + a1_; \
                        r_ += dpp_i<0xB1>(r_); r_ += dpp_i<0x4E>(r_); r_ += dpp_i<0x124>(r_); r_ += dpp_i<0x128>(r_); \
                        md = ((lane & 15) == q_) ? r_ : md; } \
                    asm volatile("" ::: "memory"); __builtin_amdgcn_sched_barrier(0); } while (0)
                U_STEP(0, bufA, bufD); U_STEP(1, bufB, bufA); U_STEP(2, bufC, bufB); U_STEP(3, bufD, bufC);
                U_STEP(4, bufA, bufD); U_STEP(5, bufB, bufA); U_STEP(6, bufC, bufB); U_STEP(7, bufD, bufC);
#undef U_STEP
#undef U_DOT4
                const float dot = (float)md * cur.su * cur.sx;
                const float coef = cur.g * gelu_tanh(dot) * cur.sv;
                if (cur.valid) coefb[cur.idx] = coef;
                cur = nxt;
            }
#undef U_LOADB
#undef U_META
        }
    }
}

DI void peer_token_epilogue(const Params& P, int layer, int t, int lane, float4 (&v)[4], float* hout, bool last, const float* wab_lds) {
    u16* abuf = (u16*)(P.ws + OFF_ABUF);
    float ss = 0.f;
#pragma unroll
    for (int i = 0; i < 4; ++i) ss += v[i].x * v[i].x + v[i].y * v[i].y + v[i].z * v[i].z + v[i].w * v[i].w;
    ss = wave_sum_fast(ss);
    const float rstd = rsqrtf(ss * (1.f / DM) + 1e-6f);
    if (last) {
        const float4* g4 = (const float4*)(P.in[28]) + lane * 4;
        float4* o4 = (float4*)(hout + (size_t)t * DM + lane * 16);
#pragma unroll
        for (int i = 0; i < 4; ++i) { const float4 g = g4[i]; o4[i] = make_float4(v[i].x * rstd * g.x, v[i].y * rstd * g.y, v[i].z * rstd * g.z, v[i].w * rstd * g.w); }
    } else {
        {
            u16* hs = (u16*)(P.ws + OFF_HMID) + (size_t)t * DM + lane * 16;
            uint4 h0, h1;
            h0.x = pack2(v[0].x, v[0].y); h0.y = pack2(v[0].z, v[0].w); h0.z = pack2(v[1].x, v[1].y); h0.w = pack2(v[1].z, v[1].w);
            h1.x = pack2(v[2].x, v[2].y); h1.y = pack2(v[2].z, v[2].w); h1.z = pack2(v[3].x, v[3].y); h1.w = pack2(v[3].z, v[3].w);
            *(uint4*)hs = h0; *(uint4*)(hs + 8) = h1;
        }
        const float4* g4 = (const float4*)(P.in[1] + (layer + 1) * DM) + lane * 4;
        float vn[16];
#pragma unroll
        for (int i = 0; i < 4; ++i) { const float4 g = g4[i]; vn[4 * i] = v[i].x * rstd * g.x; vn[4 * i + 1] = v[i].y * rstd * g.y; vn[4 * i + 2] = v[i].z * rstd * g.z; vn[4 * i + 3] = v[i].w * rstd * g.w; }
        uint4 o0, o1;
        o0.x = pack2(vn[0], vn[1]); o0.y = pack2(vn[2], vn[3]); o0.z = pack2(vn[4], vn[5]); o0.w = pack2(vn[6], vn[7]);
        o1.x = pack2(vn[8], vn[9]); o1.y = pack2(vn[10], vn[11]); o1.z = pack2(vn[12], vn[13]); o1.w = pack2(vn[14], vn[15]);
        *(uint4*)(abuf + (size_t)t * DM + lane * 16) = o0; *(uint4*)(abuf + (size_t)t * DM + lane * 16 + 8) = o1;
        const float4* wab = (const float4*)wab_lds;
        float myacc = 0.f;
#pragma unroll 1
        for (int j = 0; j < 8; ++j) {
            float a = 0.f;
#pragma unroll
            for (int i = 0; i < 4; ++i) { const float4 ww = wab[j * 256 + lane * 4 + i]; a += vn[4 * i] * ww.x + vn[4 * i + 1] * ww.y + vn[4 * i + 2] * ww.z + vn[4 * i + 3] * ww.w; }
            a = wave_sum_fast(a);
            myacc = (lane == j) ? a : myacc;
        }
        const float bb = __shfl(myacc, (lane + 4) & 63);
        if (lane < 4) {
            const int L1 = layer + 1;
            const float a = myacc;
            const float xx = a + P.in[5][L1 * 4 + lane];
            const float sp = softplus_f(xx);
            ((float*)(P.ws + OFF_GG))[t * 4 + lane] = -__expf(P.in[4][L1 * 4 + lane]) * sp;
            ((float*)(P.ws + OFF_BETA))[t * 4 + lane] = sigmoidf_(bb);
        }
    }
}

#ifndef V4_THR
#define V4_THR 0.6f
#endif
DI int peer_v_compact(int& e, float& c, bool small, int lane) {
    unsigned long long m = __builtin_amdgcn_ballot_w64(small);
    const unsigned long long lt = (1ull << lane) - 1ull;
    const int n8 = 64 - __popcll(m), n8r = (n8 + 7) & ~7;
    const int rank4 = __popcll(m & lt);
    if (small && rank4 < n8r - n8) small = false;
    m = __builtin_amdgcn_ballot_w64(small);
    const int pos = small ? n8r + __popcll(m & lt) : __popcll(~m & lt);
    e = __builtin_amdgcn_ds_permute(pos * 4, e);
    c = __int_as_float(__builtin_amdgcn_ds_permute(pos * 4, __float_as_int(c)));
    return n8r;
}
DI float wave_max(float v) {
    v = fmaxf(v, dpp_f<0xB1>(v)); v = fmaxf(v, dpp_f<0x4E>(v)); v = fmaxf(v, dpp_f<0x124>(v)); v = fmaxf(v, dpp_f<0x128>(v));
    const float a = __int_as_float(__builtin_amdgcn_readlane(__float_as_int(v), 0)), b = __int_as_float(__builtin_amdgcn_readlane(__float_as_int(v), 16));
    const float c = __int_as_float(__builtin_amdgcn_readlane(__float_as_int(v), 32)), d = __int_as_float(__builtin_amdgcn_readlane(__float_as_int(v), 48));
    return fmaxf(fmaxf(a, b), fmaxf(c, d));
}
#define VPERM_LO(a_, b_) ((int)__builtin_amdgcn_perm((unsigned)(b_), (unsigned)(a_), 0x05010400u))
#define VPERM_HI(a_, b_) ((int)__builtin_amdgcn_perm((unsigned)(b_), (unsigned)(a_), 0x07030602u))
#define VDOT_PAIR(Y_, a0_, a1_, a2_, a3_, b0_, b1_, b2_, b3_, sl_, sh_) do { \
        const unsigned ua0_ = (a0_), ua1_ = (a1_), ua2_ = (a2_), ua3_ = (a3_), ub0_ = (b0_), ub1_ = (b1_), ub2_ = (b2_), ub3_ = (b3_); \
        __builtin_amdgcn_sched_barrier(0); \
        const int p0_ = VPERM_LO(ua0_, ub0_), q0_ = VPERM_HI(ua0_, ub0_), p1_ = VPERM_LO(ua1_, ub1_), q1_ = VPERM_HI(ua1_, ub1_); \
        const int p2_ = VPERM_LO(ua2_, ub2_), q2_ = VPERM_HI(ua2_, ub2_), p3_ = VPERM_LO(ua3_, ub3_), q3_ = VPERM_HI(ua3_, ub3_); \
        __builtin_amdgcn_sched_barrier(0); \
        Y_[0] = __builtin_amdgcn_sdot4(p0_, sl_, Y_[0], false); Y_[1] = __builtin_amdgcn_sdot4(p0_, sh_, Y_[1], false); \
        Y_[2] = __builtin_amdgcn_sdot4(q0_, sl_, Y_[2], false); Y_[3] = __builtin_amdgcn_sdot4(q0_, sh_, Y_[3], false); \
        Y_[4] = __builtin_amdgcn_sdot4(p1_, sl_, Y_[4], false); Y_[5] = __builtin_amdgcn_sdot4(p1_, sh_, Y_[5], false); \
        Y_[6] = __builtin_amdgcn_sdot4(q1_, sl_, Y_[6], false); Y_[7] = __builtin_amdgcn_sdot4(q1_, sh_, Y_[7], false); \
        Y_[8] = __builtin_amdgcn_sdot4(p2_, sl_, Y_[8], false); Y_[9] = __builtin_amdgcn_sdot4(p2_, sh_, Y_[9], false); \
        Y_[10] = __builtin_amdgcn_sdot4(q2_, sl_, Y_[10], false); Y_[11] = __builtin_amdgcn_sdot4(q2_, sh_, Y_[11], false); \
        Y_[12] = __builtin_amdgcn_sdot4(p3_, sl_, Y_[12], false); Y_[13] = __builtin_amdgcn_sdot4(p3_, sh_, Y_[13], false); \
        Y_[14] = __builtin_amdgcn_sdot4(q3_, sl_, Y_[14], false); Y_[15] = __builtin_amdgcn_sdot4(q3_, sh_, Y_[15], false); \
        __builtin_amdgcn_sched_barrier(0); } while (0)
struct VMeta { int e0, e1, cq0, cq1, nb0, nb1, zs; float f8, f4; };
DI VMeta peer_v_meta(int e0, int e1, float c0, float c1, int lane) {
    VMeta M;
    const float am = wave_max(fmaxf(fabsf(c0), fabsf(c1)));
    M.nb0 = peer_v_compact(e0, c0, fabsf(c0) < V4_THR * am, lane);
    M.nb1 = peer_v_compact(e1, c1, fabsf(c1) < V4_THR * am, lane);
    const bool q0 = lane >= M.nb0, q1 = lane >= M.nb1;
    if (q0) c0 *= (127.f / 7.f);
    if (q1) c1 *= (127.f / 7.f);
    const float m8 = wave_max(fmaxf(q0 ? 0.f : fabsf(c0), q1 ? 0.f : fabsf(c1)));
    const float m4 = wave_max(fmaxf(q0 ? fabsf(c0) : 0.f, q1 ? fabsf(c1) : 0.f));
    const float r8 = m8 > 0.f ? 127.f / m8 : 0.f, r4 = m4 > 0.f ? 127.f / m4 : 0.f;
    M.cq0 = (int)rintf(c0 * (q0 ? r4 : r8)); M.cq1 = (int)rintf(c1 * (q1 ? r4 : r8));
    int zs = (q0 ? M.cq0 : 0) + (q1 ? M.cq1 : 0);
    zs += dpp_i<0xB1>(zs); zs += dpp_i<0x4E>(zs); zs += dpp_i<0x124>(zs); zs += dpp_i<0x128>(zs);
    zs = __builtin_amdgcn_readlane(zs, 0) + __builtin_amdgcn_readlane(zs, 16) + __builtin_amdgcn_readlane(zs, 32) + __builtin_amdgcn_readlane(zs, 48);
    M.zs = zs; M.f8 = m8 * (1.f / 127.f); M.f4 = m4 * (1.f / 127.f);
    M.e0 = q0 ? (e0 << 9) : (e0 << 10); M.e1 = q1 ? (e1 << 9) : (e1 << 10);
    { const int p0 = dpp_i<0xB1>(M.cq0), p1 = dpp_i<0xB1>(M.cq1);
      M.cq0 = (M.cq0 & 0xFF) | ((p0 & 0xFF) << 8); M.cq1 = (M.cq1 & 0xFF) | ((p1 & 0xFF) << 8); }
    return M;
}
DI void phase_peer_v(const Params& P, int layer, const float* hin, float* hout, bool last, char* lds) {
    const int w = threadIdx.x >> 6, lane = threadIdx.x & 63;
    if (!last) { const float4* src = (const float4*)(P.ws + OFF_WAB) + (layer + 1) * 8 * 256; for (int i = threadIdx.x; i < 2048; i += NTHR) ((float4*)lds)[i] = src[i]; }
    __syncthreads();
    const uint8_t* VTb = (const uint8_t*)(P.ws + OFF_VTAB) + (size_t)layer * 16384 * 1024;
    const uint8_t* V4b = (const uint8_t*)(P.ws + OFF_V4TAB) + (size_t)layer * 16384 * 512;
    const __amdgpu_buffer_rsrc_t v8rs = __builtin_amdgcn_make_buffer_rsrc((void*)VTb, 0, 16384 * 1024, 0x00020000);
    const __amdgpu_buffer_rsrc_t v4rs = __builtin_amdgcn_make_buffer_rsrc((void*)V4b, 0, 16384 * 512, 0x00020000);
    const unsigned* pk32 = (const unsigned*)(P.ws + OFF_PICKE); const float* coefb = (const float*)(P.ws + OFF_COEF);
    const int stride = gridDim.x * 8;
    int t = blockIdx.x * 8 + w;
    if (t >= NT) return;
    u32x4_t bufA[8], bufB[8], bufC[8], bufD[8];
#define V_IS4(M_, k_) (8 * ((k_) & 7) >= (((k_) >> 3) ? M_.nb1 : M_.nb0))
#define V_LOAD(buf_, M_, k_) do { \
          \
        if (V_IS4(M_, k_)) { unsigned lo_; asm volatile("v_lshlrev_b32 %0, 3, %1" : "=v"(lo_) : "v"(lane)); _Pragma("unroll") for (int i_ = 0; i_ < 8; ++i_) { const int e_ = RL(((k_) >> 3) ? M_.e1 : M_.e0, 8 * ((k_) & 7) + i_); \
                const u32x2_t t_ = __builtin_bit_cast(u32x2_t, __builtin_amdgcn_raw_buffer_load_b64(v4rs, lo_, e_, 0)); buf_[i_] = __builtin_shufflevector(t_, t_, 0, 1, -1, -1); } } \
        else { unsigned lo_; asm volatile("v_lshlrev_b32 %0, 4, %1" : "=v"(lo_) : "v"(lane)); _Pragma("unroll") for (int i_ = 0; i_ < 8; ++i_) { const int e_ = RL(((k_) >> 3) ? M_.e1 : M_.e0, 8 * ((k_) & 7) + i_); \
                buf_[i_] = __builtin_bit_cast(u32x4_t, __builtin_amdgcn_raw_buffer_load_b128(v8rs, lo_, e_, 0)); } } } while (0)
    VMeta cur = peer_v_meta((int)(pk32[(size_t)t * 128 + lane] & 0xFFFFu), (int)(pk32[(size_t)t * 128 + 64 + lane] & 0xFFFFu), coefb[(size_t)t * 128 + lane], coefb[(size_t)t * 128 + 64 + lane], lane);
    V_LOAD(bufA, cur, 0); V_LOAD(bufB, cur, 1); V_LOAD(bufC, cur, 2);
#pragma unroll 1
    for (; t < NT; t += stride) {
        const int tn = t + stride; const bool has_next = tn < NT;
        int ne0 = 0, ne1 = 0; float nc0 = 0.f, nc1 = 0.f;
        if (has_next) { ne0 = (int)(pk32[(size_t)tn * 128 + lane] & 0xFFFFu); ne1 = (int)(pk32[(size_t)tn * 128 + 64 + lane] & 0xFFFFu); nc0 = coefb[(size_t)tn * 128 + lane]; nc1 = coefb[(size_t)tn * 128 + 64 + lane]; }
        int y8[16], y4[16];
#pragma unroll
        for (int i = 0; i < 16; ++i) { y8[i] = 0; y4[i] = 0; }
#define V_STEP(k_, cur_, pf_) do { \
            if ((k_) + 3 < 16) { V_LOAD(pf_, cur, (k_) + 3); } \
            asm volatile("" ::: "memory"); __builtin_amdgcn_sched_barrier(0); \
            if (V_IS4(cur, k_)) { \
                _Pragma("unroll") for (int i = 0; i < 8; i += 2) { \
                    const int sl_ = RL(((k_) >> 3) ? cur.cq1 : cur.cq0, 8 * ((k_) & 7) + i), sh_ = sl_ << 16; \
                    const unsigned xa0 = cur_[i].x, xa1 = cur_[i].y, xb0 = cur_[i + 1].x, xb1 = cur_[i + 1].y; \
                      \
                    VDOT_PAIR(y4, xa0, xa0 & 0x0F0F0F0Fu, xa1, xa1 & 0x0F0F0F0Fu, xb0, xb0 & 0x0F0F0F0Fu, xb1, xb1 & 0x0F0F0F0Fu, sl_, sh_); } \
            } else { \
                _Pragma("unroll") for (int i = 0; i < 8; i += 2) { \
                    const int sl_ = RL(((k_) >> 3) ? cur.cq1 : cur.cq0, 8 * ((k_) & 7) + i), sh_ = sl_ << 16; \
                    VDOT_PAIR(y8, cur_[i].x, cur_[i].y, cur_[i].z, cur_[i].w, cur_[i + 1].x, cur_[i + 1].y, cur_[i + 1].z, cur_[i + 1].w, sl_, sh_); } } \
            asm volatile("" ::: "memory"); __builtin_amdgcn_sched_barrier(0); } while (0)
        V_STEP(0, bufA, bufD); V_STEP(1, bufB, bufA); V_STEP(2, bufC, bufB); V_STEP(3, bufD, bufC);
        V_STEP(4, bufA, bufD); V_STEP(5, bufB, bufA); V_STEP(6, bufC, bufB); V_STEP(7, bufD, bufC);
        V_STEP(8, bufA, bufD); V_STEP(9, bufB, bufA); V_STEP(10, bufC, bufB); V_STEP(11, bufD, bufC);
        V_STEP(12, bufA, bufD);
        float4 hv[4];
        { const uint2* h2 = (const uint2*)((const u16*)(P.ws + OFF_HMID) + (size_t)t * DM + lane * 16);
#pragma unroll
          for (int i = 0; i < 4; ++i) { const uint2 p = h2[i]; hv[i] = make_float4(bf2f((u16)(p.x & 0xffff)), bf2f((u16)(p.x >> 16)), bf2f((u16)(p.y & 0xffff)), bf2f((u16)(p.y >> 16))); } }
        V_STEP(13, bufB, bufA);
        V_STEP(14, bufC, bufB); V_STEP(15, bufD, bufC);
#undef V_STEP
        float4 hy[4];
#pragma unroll
        for (int i = 0; i < 4; ++i) {
            int z4[4];
#pragma unroll
            for (int c = 0; c < 4; ++c) z4[c] = (i & 1) ? ((y4[8 * (i >> 1) + c] - y4[8 * (i >> 1) + 4 + c]) >> 4) : (y4[8 * (i >> 1) + 4 + c] - 8 * cur.zs);
            hy[i].x = hv[i].x + (float)y8[4 * i] * cur.f8 + (float)z4[0] * cur.f4;
            hy[i].y = hv[i].y + (float)y8[4 * i + 1] * cur.f8 + (float)z4[1] * cur.f4;
            hy[i].z = hv[i].z + (float)y8[4 * i + 2] * cur.f8 + (float)z4[2] * cur.f4;
            hy[i].w = hv[i].w + (float)y8[4 * i + 3] * cur.f8 + (float)z4[3] * cur.f4;
        }
        if (has_next) {
            cur = peer_v_meta(ne0, ne1, nc0, nc1, lane);
            V_LOAD(bufA, cur, 0); V_LOAD(bufB, cur, 1); V_LOAD(bufC, cur, 2);
        }
        asm volatile("" ::: "memory"); __builtin_amdgcn_sched_barrier(0);
        peer_token_epilogue(P, layer, t, lane, hy, hout, last, (const float*)lds);
    }
#undef V_LOAD
#undef V_IS4
}

#define XB_TMO      128
#define XB_XCNT(j)  (256  + 64 * (j))
#define XB_XSUB(j)  (1280 + 64 * (j))
#define XB_XGEN(j)  (2304 + 64 * (j))
#define XB_TOP      3328
#define XB_TOPGEN   3392
#define XCD_BAR_WORDS 3456
#define XB_SPIN_CAP (1u << 22)
#define LAS __attribute__((address_space(3)))
DI unsigned xb_ld(unsigned* p)              { return __hip_atomic_load(p, __ATOMIC_RELAXED, __HIP_MEMORY_SCOPE_AGENT); }
DI unsigned xb_add(unsigned* p, unsigned v) { return __hip_atomic_fetch_add(p, v, __ATOMIC_RELAXED, __HIP_MEMORY_SCOPE_AGENT); }
DI unsigned xb_xcc_id() { return (unsigned)__builtin_amdgcn_s_getreg((3 << 11) | 20) & 0xFu; }
#define XB_SPIN(cond, bar) do { unsigned _sp = 0; while (cond) { __builtin_amdgcn_s_sleep(1); \
    if ((++_sp & 255u) == 0u) { if (xb_ld(&(bar)[XB_TMO])) break; if (_sp > XB_SPIN_CAP) { atomicAdd(&(bar)[XB_TMO], 1u); break; } } } } while (0)
struct XcdBarrier { unsigned* bar; unsigned x; volatile LAS unsigned* st; };
DI XcdBarrier xcd_barrier_post(unsigned* bar, volatile LAS unsigned* st) {
    XcdBarrier b; b.bar = bar; b.x = xb_xcc_id(); b.st = st;
    if (threadIdx.x == 0) (void)xb_add(&bar[XB_XCNT(b.x)], 1u);
    return b;
}
DI void xcd_barrier_complete(unsigned* bar, unsigned x, unsigned& nloc, unsigned& nx) {
    const unsigned G = gridDim.x * gridDim.y * gridDim.z;
    unsigned sum, cnt, mine, sp = 0u;
    for (;;) {
        sum = 0u; cnt = 0u; mine = 0u;
#pragma unroll
        for (unsigned j = 0; j < 16; ++j) { const unsigned c = xb_ld(&bar[XB_XCNT(j)]); sum += c; cnt += (c > 0u) ? 1u : 0u; mine = (j == x) ? c : mine; }
        if (sum == G) break;
        __builtin_amdgcn_s_sleep(1);
        if ((++sp & 255u) == 0u) { if (xb_ld(&bar[XB_TMO])) break; if (sp > XB_SPIN_CAP) { atomicAdd(&bar[XB_TMO], 1u); break; } }
    }
    nloc = mine > 0u ? mine : 1u; nx = cnt > 0u ? cnt : 1u;
}
DI void xcd_barrier(const XcdBarrier& b) {
    asm volatile("s_waitcnt vmcnt(0)" ::: "memory");
    __syncthreads();
    if (threadIdx.x == 0) {
        unsigned* bar = b.bar;
        __builtin_amdgcn_s_waitcnt(0);
        unsigned nloc = b.st[0], nx = b.st[1];
        if (nloc == 0u) { xcd_barrier_complete(bar, b.x, nloc, nx); b.st[0] = nloc; b.st[1] = nx; }
        const unsigned old = xb_add(&bar[XB_XSUB(b.x)], 1u);
        const unsigned gen = old / nloc;
        if (old + 1u == (gen + 1u) * nloc) {
            __builtin_amdgcn_fence(__ATOMIC_RELEASE, "agent");
            asm volatile("s_waitcnt vmcnt(0)" ::: "memory");
            const unsigned og = xb_add(&bar[XB_TOP], 1u);
            const unsigned tg = og / nx;
            if (og + 1u == (tg + 1u) * nx) xb_add(&bar[XB_TOPGEN], 1u);
            else XB_SPIN(xb_ld(&bar[XB_TOPGEN]) == tg, bar);
            __builtin_amdgcn_fence(__ATOMIC_ACQUIRE, "agent");
            xb_add(&bar[XB_XGEN(b.x)], 1u);
            asm volatile("s_waitcnt vmcnt(0)" ::: "memory");
        } else {
            XB_SPIN(xb_ld(&bar[XB_XGEN(b.x)]) == gen, bar);
            __builtin_amdgcn_fence(__ATOMIC_ACQUIRE, "agent");
            asm volatile("s_waitcnt vmcnt(0)" ::: "memory");
        }
    }
    __syncthreads();
}

constexpr int PH_PER_LAYER = 11;
constexpr int NPHASE = 2 + 2 * PH_PER_LAYER;

#ifdef ONLY_SUB
#define SUB_ON(k) (ONLY_SUB == (k))
#else
#define SUB_ON(k) 1
#endif
DI void run_phase(const Params& P, int ph, char* lds) {
    char* ws = P.ws;
#if SUB_ON(100)
    if (ph == 0) { phase_prep(P, lds); return; }
#endif
#if SUB_ON(101)
    if (ph == 1) { phase_rms(P, P.in[0], P.in[1], (u16*)(ws + OFF_ABUF), 0); return; }
#endif
    if (ph < 2) return;
    const int layer = (ph - 2) / PH_PER_LAYER, sub = (ph - 2) % PH_PER_LAYER;
    const float* hin = layer == 0 ? P.in[0] : P.out;
    switch (sub) {
    #if SUB_ON(0)
    case 0: { EpiInProj8 e{ws}; phase_gemm((const u16*)(ws + OFF_ABUF), 1024, (const u16*)(ws + OFF_WINT) + (size_t)layer * PROJW * 1024, 1024, NT, PROJW, 1024, e, lds); } break;

#endif
    #if SUB_ON(1)
    case 1:
        { uint4 pre[4]; float4 pcw; float2 pgb; int it = blockIdx.x; if (it < 2048) gdn_prep_load(P, layer, it, pre, pcw, pgb);
          for (; it < 2048; it += gridDim.x) gdn_prep_item(P, layer, it, lds, pre, pcw, pgb, it + (int)gridDim.x); }
        __syncthreads();
        phase_s5<false>(P, layer, lds);
        break;

#endif
    #if SUB_ON(2)
    case 2:
        if (blockIdx.x < 16) gdn_scan_chain(P, blockIdx.x, lds);
        else if (blockIdx.x < 24) {
            const int gt = (blockIdx.x - 16) * NTHR + threadIdx.x;
            if (gt < 4096) {
                const int bg = gt >> 6, n = gt & 63;
                const float2 a = ((const float2*)(ws + OFF_S5P + layer * S5P_LAYER + S5P_A64))[(bg & 15) * 64 + n];
                float2* st = (float2*)(ws + OFF_S5ST) + (size_t)bg * 128 * 64 + n;
                float xr = 0.f, xi = 0.f;
                for (int c = 0; c < 128; ++c) {
                    const float2 sv = st[c * 64];
                    st[c * 64] = make_float2(xr, xi);
                    const float nr = a.x * xr - a.y * xi + sv.x, ni = a.x * xi + a.y * xr + sv.y;
                    xr = nr; xi = ni;
                }
            }
        }
        __syncthreads();
        phase_attn(P, layer, lds);
        break;

#endif
    #if SUB_ON(3)
    case 3: phase_s5<true>(P, layer, lds); phase_gdn_norm(P, layer); break;

#endif
    #if SUB_ON(4)
    case 4: {
        EpiGlu8 e{(u16*)(ws + OFF_ABUF), P.in[16] + layer * 512};
        phase_gemm((const u16*)(ws + OFF_YS5), 256, (const u16*)(ws + OFF_GLUT) + (size_t)layer * 512 * 256, 256, NT, 512, 256, e, lds);
    } break;

#endif
    #if SUB_ON(5)
    case 5: { EpiResidual8 e{hin, (u16*)(ws + OFF_HMID), layer == 0 ? (const u16*)nullptr : (const u16*)(ws + OFF_HMID)}; phase_gemm((const u16*)(ws + OFF_ABUF), 1024, (const u16*)(ws + OFF_WOUTT) + (size_t)layer * 1024 * 1024, 1024, NT, 1024, 1024, e, lds); } break;

#endif
    #if SUB_ON(6)
    case 6: phase_rms16(P, (const u16*)(ws + OFF_HMID), P.in[23] + layer * DM, (u16*)(ws + OFF_ABUF), true); break;

#endif
    #if SUB_ON(7)
    case 7: { pg8::EpiBf16<0> e{(u16*)(ws + OFF_PQ), 1024, nullptr, 0, 0}; phase_gemm((const u16*)(ws + OFF_ABUF), 1024, (const u16*)(ws + OFF_WQT) + (size_t)layer * 1024 * 1024, 1024, NT, 1024, 1024, e, lds); } break;

#endif
    #if SUB_ON(8)
    case 8: phase_topk(P, layer, lds); break;

#endif
    #if SUB_ON(9)
    case 9: phase_peer_u(P, layer, lds); break;
#endif
    #if SUB_ON(10)
    case 10: phase_peer_v(P, layer, P.out, P.out, layer == 1, lds); break;
#endif
    }
}

#ifndef USE_CG_SYNC
#define USE_CG_SYNC 0
#endif
#if USE_CG_SYNC
#define GRID_SYNC() cg::this_grid().sync()
#else
#define GRID_SYNC() xcd_barrier(xbar)
#endif
__global__ void __launch_bounds__(NTHR) mk_fwd(Params P, int ph_lo, int ph_hi) {
    extern __shared__ __attribute__((aligned(16))) char lds[];
    asm volatile("s_nop 0\n s_nop 0\n s_nop 0\n s_nop 0\n s_nop 0\n s_nop 0\n s_nop 0\n s_nop 0");
#if !USE_CG_SYNC
    volatile LAS unsigned* xst = (volatile LAS unsigned*)(lds + LDS_BYTES - 16);
    if (threadIdx.x == 0) { xst[0] = 0u; xst[1] = 0u; }
    __syncthreads();
    XcdBarrier xbar = xcd_barrier_post((unsigned*)(P.ws + OFF_CTL), xst);
#endif
#ifndef DUP_SUB
#define DUP_SUB -1
#endif
#define PH(k) if (ph_lo <= (k) && (k) < ph_hi) { \
        if ((k) >= 2 && (((k) - 2) % PH_PER_LAYER == DUP_SUB || (DUP_SUB == 20 && ((k) - 2) % PH_PER_LAYER == 2))) { \
            if (DUP_SUB == 9) phase_peer_u(P, ((k) - 2) / PH_PER_LAYER, lds); \
            else if (DUP_SUB == 2) { if (blockIdx.x < 16) gdn_scan_chain(P, blockIdx.x, lds); } \
            else if (DUP_SUB == 20 && ((k) - 2) % PH_PER_LAYER == 2) { phase_attn(P, ((k) - 2) / PH_PER_LAYER, lds, 1); } \
            else if (DUP_SUB == 5) { if ((k) < 2 + PH_PER_LAYER) run_phase(P, (k), lds); } \
            else run_phase(P, (k), lds); } \
        if ((k) < 2 && DUP_SUB == 100 + (k)) run_phase(P, (k), lds); \
        run_phase(P, (k), lds); if (DUP_SUB == 99) GRID_SYNC(); if ((k) + 1 < ph_hi) GRID_SYNC(); }
    PH(0) PH(1) PH(2) PH(3) PH(4) PH(5) PH(6) PH(7) PH(8) PH(9) PH(10) PH(11)
    PH(12) PH(13) PH(14) PH(15) PH(16) PH(17) PH(18) PH(19) PH(20) PH(21) PH(22) PH(23)
#undef PH
}

extern "C" void kernel_launch(void* const* d_in, const int* in_sizes, int n_in, void* d_out, int out_size, void* d_ws, size_t ws_size, hipStream_t stream) {
    static int grid = 0;
    if (grid == 0) {
        int dev = 0, cus = 0, per_cu = 0;
        hipGetDevice(&dev);
        hipDeviceGetAttribute(&cus, hipDeviceAttributeMultiprocessorCount, dev);
        hipFuncSetAttribute((const void*)mk_fwd, hipFuncAttributeMaxDynamicSharedMemorySize, LDS_BYTES);
        hipOccupancyMaxActiveBlocksPerMultiprocessor(&per_cu, (const void*)mk_fwd, NTHR, LDS_BYTES);
        if (per_cu < 1) { fprintf(stderr, "occupancy query says %d blocks per CU\n", per_cu); per_cu = 1; }
        grid = cus;
        if (ws_size < OFF_END2) { fprintf(stderr, "workspace too small: %zu < %zu\n", ws_size, (size_t)OFF_END2); }
    }
    Params p{};
    for (int i = 0; i < 29; ++i) p.in[i] = (const float*)d_in[i];
    p.out = (float*)d_out; p.ws = (char*)d_ws;
#if MK_ONE_LAUNCH
    int lo = 0, hi = NPHASE;
    (void)hipMemsetAsync((char*)d_ws + OFF_CTL, 0, 65536, stream);
#if USE_CG_SYNC
    void* args[] = {&p, &lo, &hi};
    hipError_t e = hipLaunchCooperativeKernel((const void*)mk_fwd, dim3(grid), dim3(NTHR), args, LDS_BYTES, stream);
    if (e != hipSuccess) fprintf(stderr, "cooperative launch failed: %s\n", hipGetErrorString(e));
#else
    hipLaunchKernelGGL(mk_fwd, dim3(grid), dim3(NTHR), LDS_BYTES, stream, p, lo, hi);
#endif
#else
    for (int ph = 0; ph < NPHASE; ++ph) hipLaunchKernelGGL(mk_fwd, dim3(grid), dim3(NTHR), LDS_BYTES, stream, p, ph, ph + 1);
#endif
}
```
